# Optimizing an MI355X kernel written in HIP

```python
import math
import jax, jax.numpy as jnp
from jax import lax
import numpy as np

D_MODEL = 1024
BATCH = 1
SEQ = 16384
DEPTH = 4

GRID_W = 64
CTX_LEN = 256
CHUNK = 64
N_BRANCH = 3
BRANCH_W = D_MODEL // 2
NORM_EPS = 1e-6
RW_HEAD = 64
RW_HEADS = BRANCH_W // RW_HEAD
RW_DECAY_LORA = 64
RW_A_LORA = 64
RW_G_LORA = 128
RW_GN_EPS = 64e-5
GLA_HEADS = 4
GLA_DK = 64
GLA_DV = BRANCH_W // GLA_HEADS
GLA_GATE_LORA = 16
GLA_GATE_NORM = 16.0
GDN_HEADS = 4
GDN_HEAD = BRANCH_W // GDN_HEADS
GDN_CONV = 5
MLP_HIDDEN = 4 * D_MODEL
RW_COLS = 3 * BRANCH_W + 2 * RW_DECAY_LORA + 2 * RW_A_LORA + RW_G_LORA
GLA_COLS = 2 * GLA_HEADS * GLA_DK + 2 * BRANCH_W + 2 * GLA_GATE_LORA
GDN_COLS = 4 * BRANCH_W + 4 * GDN_HEADS
GATE_COLS = N_BRANCH * D_MODEL
IN_COLS = RW_COLS + GLA_COLS + GDN_COLS + GATE_COLS

kernel_name = 'hybrid_rwkv7_gla_gdn_diffusion_block'


def _split(t, sizes):
    return jnp.split(t, np.cumsum(sizes)[:-1].tolist(), axis=-1)


def rmsnorm(t, g):
    tf = t.astype(jnp.float32)
    tf = tf * lax.rsqrt(jnp.mean(tf * tf, axis=-1, keepdims=True) + NORM_EPS)
    return (tf * g.astype(jnp.float32)).astype(t.dtype)


def l2norm(t):
    tf = t.astype(jnp.float32)
    return tf * lax.rsqrt(jnp.sum(tf * tf, axis=-1, keepdims=True) + 1e-12)


def seg_flip(t, n_ctx):
    return jnp.concatenate([jnp.flip(t[:, :n_ctx], 1), jnp.flip(t[:, n_ctx:], 1)], axis=1)


def dir_stack(t_fwd, t_bwd, n_ctx):
    return jnp.stack([t_fwd, seg_flip(t_bwd, n_ctx)], axis=0)


def dir_pair(t, n_ctx):
    return dir_stack(t[:, :, 0], t[:, :, 1], n_ctx)


def dir_merge(o, n_ctx):
    return o[0] + seg_flip(o[1], n_ctx)


def _centred_dwconv(t, w):
    k = w.shape[0]
    pad = k // 2
    n = t.shape[1]
    tp = jnp.pad(t, ((0, 0), (pad, pad), (0, 0)))
    out = tp[:, 0:n] * w[0]
    for i in range(1, k):
        out = out + tp[:, i:i + n] * w[i]
    return out


def seg_dwconv(t, w, n_ctx):
    return jnp.concatenate([_centred_dwconv(t[:, :n_ctx], w), _centred_dwconv(t[:, n_ctx:], w)], axis=1)


def to_colmajor(t, n_ctx, rows):
    lat = t[:, n_ctx:]
    b, n = lat.shape[:2]
    tail = lat.shape[2:]
    lat = lat.reshape((b, rows, GRID_W) + tail).swapaxes(1, 2).reshape((b, n) + tail)
    return jnp.concatenate([t[:, :n_ctx], lat], axis=1)


def from_colmajor(t, n_ctx, rows):
    lat = t[:, n_ctx:]
    b, n = lat.shape[:2]
    tail = lat.shape[2:]
    lat = lat.reshape((b, GRID_W, rows) + tail).swapaxes(1, 2).reshape((b, n) + tail)
    return jnp.concatenate([t[:, :n_ctx], lat], axis=1)


def seg_modulate(t, n_ctx, shift_c, scale_c, shift_l, scale_l):
    tc = t[:, :n_ctx] * (1 + scale_c) + shift_c
    tl = t[:, n_ctx:] * (1 + scale_l[:, None]) + shift_l[:, None]
    return jnp.concatenate([tc, tl], axis=1)


def seg_gate(t, n_ctx, gate_c, gate_l):
    return jnp.concatenate([t[:, :n_ctx] * gate_c, t[:, n_ctx:] * gate_l[:, None]], axis=1)


def rwkv7_scan(r, w, k, v, kk, b):
    def step(s, inp):
        r_t, w_t, k_t, v_t, kk_t, b_t = inp
        sa = jnp.einsum('zbhvk,zbhk->zbhv', s, kk_t)
        s = s * w_t[..., None, :] - sa[..., :, None] * b_t[..., None, :] + v_t[..., :, None] * k_t[..., None, :]
        return s, jnp.einsum('zbhvk,zbhk->zbhv', s, r_t)
    nd, bsz, _, h, n = r.shape
    s0 = jnp.zeros((nd, bsz, h, n, n), jnp.float32)
    xs = tuple(jnp.moveaxis(t, 2, 0) for t in (r, w, k, v, kk, b))
    _, y = lax.scan(step, s0, xs)
    return jnp.moveaxis(y, 0, 2)


def gla_chunked(q, k, v, log_a):
    nd, bsz, L, h, dk = q.shape
    dv = v.shape[-1]
    n = L // CHUNK
    cs = lambda t: t.reshape(nd, bsz, n, CHUNK, h, t.shape[-1])
    q, k, v, log_a = cs(q), cs(k), cs(v), cs(log_a)
    bcum = jnp.cumsum(log_a, axis=3)
    b_end = bcum[:, :, :, -1:]
    q_dec = q * jnp.exp(bcum)
    k_inv = k * jnp.exp(-bcum)
    k_end = k * jnp.exp(b_end - bcum)
    causal = jnp.tril(jnp.ones((CHUNK, CHUNK), jnp.float32))
    att = jnp.einsum('zbnthk,zbnshk->zbnhts', q_dec, k_inv) * causal
    o_intra = jnp.einsum('zbnhts,zbnshv->zbnthv', att, v)
    decay_end = jnp.exp(b_end[:, :, :, 0])

    def step(s, inp):
        q_c, k_c, v_c, dec = inp
        o = jnp.einsum('zbthk,zbhkv->zbthv', q_c, s)
        s = s * dec[..., None] + jnp.einsum('zbshk,zbshv->zbhkv', k_c, v_c)
        return s, o
    s0 = jnp.zeros((nd, bsz, h, dk, dv), jnp.float32)
    xs = tuple(jnp.moveaxis(t, 2, 0) for t in (q_dec, k_end, v, decay_end))
    _, o_inter = lax.scan(step, s0, xs)
    return (o_intra + jnp.moveaxis(o_inter, 0, 2)).reshape(nd, bsz, L, h, dv)


def gated_delta_chunked(q, k, v, g, beta):
    nd, bsz, L, h, dk = q.shape
    dv = v.shape[-1]
    n = L // CHUNK
    heads_first = lambda t: jnp.moveaxis(t.reshape(nd, bsz, n, CHUNK, h, -1), 4, 3)
    q, k, v = heads_first(q), heads_first(k), heads_first(v)
    g = jnp.moveaxis(g.reshape(nd, bsz, n, CHUNK, h), 4, 3)
    beta = jnp.moveaxis(beta.reshape(nd, bsz, n, CHUNK, h), 4, 3)
    gam = jnp.cumsum(g, axis=-1)
    incl = jnp.tril(jnp.ones((CHUNK, CHUNK), bool))
    strict = jnp.tril(jnp.ones((CHUNK, CHUNK), bool), -1)
    diff = gam[..., :, None] - gam[..., None, :]
    decay = jnp.where(incl, jnp.exp(jnp.where(incl, diff, 0.0)), 0.0)
    kk = jnp.einsum('zbnhtk,zbnhsk->zbnhts', k, k)
    a_mat = jnp.eye(CHUNK, dtype=jnp.float32) + jnp.where(strict, beta[..., :, None] * kk * decay, 0.0)
    u = lax.linalg.triangular_solve(a_mat, beta[..., None] * v, left_side=True, lower=True, unit_diagonal=True)
    wk = lax.linalg.triangular_solve(a_mat, (beta * jnp.exp(gam))[..., None] * k, left_side=True, lower=True, unit_diagonal=True)
    qk = jnp.einsum('zbnhtk,zbnhsk->zbnhts', q, k) * decay
    q_dec = q * jnp.exp(gam)[..., None]
    k_end = k * jnp.exp(gam[..., -1:] - gam)[..., None]
    dec_end = jnp.exp(gam[..., -1])

    def step(s, inp):
        u_c, wk_c, qk_c, qd_c, ke_c, de_c = inp
        w_c = u_c - jnp.einsum('zbhsk,zbhkv->zbhsv', wk_c, s)
        o = jnp.einsum('zbhtk,zbhkv->zbhtv', qd_c, s) + jnp.einsum('zbhts,zbhsv->zbhtv', qk_c, w_c)
        s = s * de_c[..., None, None] + jnp.einsum('zbhsk,zbhsv->zbhkv', ke_c, w_c)
        return s, o
    s0 = jnp.zeros((nd, bsz, h, dk, dv), jnp.float32)
    xs = tuple(jnp.moveaxis(t, 2, 0) for t in (u, wk, qk, q_dec, k_end, dec_end))
    _, o = lax.scan(step, s0, xs)
    o = jnp.moveaxis(o, 0, 2)
    return jnp.moveaxis(o, 3, 4).reshape(nd, bsz, L, h, dv)


def rwkv7_branch(p, n_ctx, w0, w2, a0, a2, g2, k_k, k_a, r_k, ln_w, ln_b):
    bsz, L, _ = p.shape
    H, N = RW_HEADS, RW_HEAD
    f32 = jnp.float32
    r, k, v, wl, al, gl = _split(p, [BRANCH_W] * 3 + [2 * RW_DECAY_LORA, 2 * RW_A_LORA, RW_G_LORA])
    wl = wl.reshape(bsz, L, 2, RW_DECAY_LORA)
    al = al.reshape(bsz, L, 2, RW_A_LORA)
    w = -jax.nn.softplus(-(w0 + jnp.einsum('blze,zec->blzc', jnp.tanh(wl), w2))) - 0.5
    decay = jnp.exp(-jnp.exp(w.astype(f32)))
    a = jax.nn.sigmoid(a0 + jnp.einsum('blze,zec->blzc', al, a2)).astype(f32)
    g = jax.nn.sigmoid(gl) @ g2
    kk = l2norm((k * k_k).reshape(bsz, L, H, N))
    k_dir = (k[:, :, None] * (1 + (a - 1) * k_a)).reshape(bsz, L, 2, H, N)
    b_dir = kk[:, :, None] * a.reshape(bsz, L, 2, H, N)
    r_h = r.reshape(bsz, L, H, N).astype(f32)
    v_h = v.reshape(bsz, L, H, N).astype(f32)
    y = rwkv7_scan(dir_stack(r_h, r_h, n_ctx), dir_pair(decay.reshape(bsz, L, 2, H, N), n_ctx),
                   dir_pair(k_dir, n_ctx), dir_stack(v_h, v_h, n_ctx), dir_stack(kk, kk, n_ctx),
                   dir_pair(b_dir, n_ctx))
    y = dir_merge(y, n_ctx)
    mu = jnp.mean(y, axis=-1, keepdims=True)
    var = jnp.mean(jnp.square(y - mu), axis=-1, keepdims=True)
    y = (y - mu) * lax.rsqrt(var + RW_GN_EPS) * ln_w.reshape(H, N) + ln_b.reshape(H, N)
    bonus = jnp.einsum('blhn,blzhn,hn->blh', r_h, k_dir, r_k)[..., None] * v_h
    y = (y + bonus).reshape(bsz, L, BRANCH_W)
    return (y * g.astype(f32)).astype(p.dtype)


def gla_branch(p, n_ctx, rows, a2, ab, norm_g):
    bsz, L, _ = p.shape
    H, K, V = GLA_HEADS, GLA_DK, GLA_DV
    f32 = jnp.float32
    q, k, v, og, al = _split(p, [H * K, H * K, H * V, H * V, 2 * GLA_GATE_LORA])
    z = jnp.einsum('blze,zek->blzk', al.reshape(bsz, L, 2, GLA_GATE_LORA), a2) + ab
    log_a = (jax.nn.log_sigmoid(z.astype(f32)) / GLA_GATE_NORM).reshape(bsz, L, 2, H, K)
    q = q.reshape(bsz, L, H, K).astype(f32) * K ** -0.5
    k = k.reshape(bsz, L, H, K).astype(f32)
    v = v.reshape(bsz, L, H, V).astype(f32)
    q, k, v, log_a = (to_colmajor(t, n_ctx, rows) for t in (q, k, v, log_a))
    o = gla_chunked(dir_stack(q, q, n_ctx), dir_stack(k, k, n_ctx), dir_stack(v, v, n_ctx), dir_pair(log_a, n_ctx))
    o = from_colmajor(dir_merge(o, n_ctx), n_ctx, rows)
    o = rmsnorm(o, norm_g) * jax.nn.silu(og.reshape(bsz, L, H, V).astype(f32))
    return o.reshape(bsz, L, BRANCH_W).astype(p.dtype)


def gdn_branch(p, n_ctx, conv_w, a_log, dt_bias, norm_g):
    bsz, L, _ = p.shape
    H, K = GDN_HEADS, GDN_HEAD
    f32 = jnp.float32
    qkv, zg, a, b = _split(p, [3 * BRANCH_W, BRANCH_W, 2 * H, 2 * H])
    qkv = jax.nn.silu(seg_dwconv(qkv, conv_w, n_ctx))
    q, k, v = _split(qkv, [BRANCH_W] * 3)
    q = l2norm(q.reshape(bsz, L, H, K)) * K ** -0.5
    k = l2norm(k.reshape(bsz, L, H, K))
    v = v.reshape(bsz, L, H, K).astype(f32)
    g = -jnp.exp(a_log.astype(f32)) * jax.nn.softplus((a.reshape(bsz, L, 2, H) + dt_bias).astype(f32))
    beta = jax.nn.sigmoid(b.reshape(bsz, L, 2, H).astype(f32))
    o = gated_delta_chunked(dir_stack(q, q, n_ctx), dir_stack(k, k, n_ctx), dir_stack(v, v, n_ctx),
                            dir_pair(g, n_ctx), dir_pair(beta, n_ctx))
    o = dir_merge(o, n_ctx)
    o = rmsnorm(o, norm_g) * jax.nn.silu(zg.reshape(bsz, L, H, K).astype(f32))
    return o.reshape(bsz, L, BRANCH_W).astype(p.dtype)


def sq_relu_mlp(t, w1, w2):
    return jnp.square(jax.nn.relu(t @ w1)) @ w2


def setup_inputs(seed: int = 0) -> dict:
    key = jax.random.key(seed)
    keys = list(jax.random.split(key, 40))

    def nrm(shape, scale):
        return jax.random.normal(keys.pop(), shape, jnp.float32) * scale

    def uni(shape, lo, hi):
        return jax.random.uniform(keys.pop(), shape, jnp.float32, lo, hi)

    D, NL = D_MODEL, DEPTH
    dt = jnp.exp(uni((NL, 2, GDN_HEADS), math.log(1e-3), math.log(1e-1)))
    return {
        'x': nrm((BATCH, SEQ, D), 1.0),
        'c': nrm((BATCH, D), 1.0),
        'ctx': nrm((BATCH, CTX_LEN, D), 1.0),
        'c_ctx': nrm((D,), 1.0),
        'w_mod': nrm((NL, D, 6 * D), 0.02),
        'b_mod': nrm((NL, 6 * D), 0.01),
        'norm1_g': 1.0 + nrm((NL, D), 0.02),
        'w_in': nrm((NL, D, IN_COLS), D ** -0.5),
        'rw_mu': uni((NL, 2, RW_COLS), 0.0, 0.5),
        'rw_w0': uni((NL, 2, BRANCH_W), -6.0, -1.0),
        'rw_w2': nrm((NL, 2, RW_DECAY_LORA, BRANCH_W), 0.1),
        'rw_a0': nrm((NL, 2, BRANCH_W), 0.1),
        'rw_a2': nrm((NL, 2, RW_A_LORA, BRANCH_W), RW_A_LORA ** -0.5),
        'rw_g2': nrm((NL, RW_G_LORA, BRANCH_W), RW_G_LORA ** -0.5),
        'rw_kk': 0.85 + nrm((NL, BRANCH_W), 0.02),
        'rw_ka': 1.0 + nrm((NL, BRANCH_W), 0.02),
        'rw_rk': nrm((NL, RW_HEADS, RW_HEAD), 0.1),
        'rw_ln_w': 1.0 + nrm((NL, BRANCH_W), 0.02),
        'rw_ln_b': nrm((NL, BRANCH_W), 0.01),
        'gla_a2': nrm((NL, 2, GLA_GATE_LORA, GLA_HEADS * GLA_DK), GLA_GATE_LORA ** -0.5),
        'gla_ab': uni((NL, 2, GLA_HEADS * GLA_DK), 0.5, 3.0),
        'gla_norm_g': 1.0 + nrm((NL, GLA_DV), 0.02),
        'gdn_conv': nrm((NL, GDN_CONV, 3 * BRANCH_W), GDN_CONV ** -0.5),
        'gdn_a_log': jnp.log(uni((NL, 2, GDN_HEADS), 1.0, 16.0)),
        'gdn_dt_bias': dt + jnp.log(-jnp.expm1(-dt)),
        'gdn_norm_g': 1.0 + nrm((NL, GDN_HEAD), 0.02),
        'w_branch': nrm((NL, N_BRANCH, BRANCH_W, D), BRANCH_W ** -0.5),
        'w_out': nrm((NL, D, D), D ** -0.5),
        'norm2_g': 1.0 + nrm((NL, D), 0.02),
        'w_mlp1': nrm((NL, D, MLP_HIDDEN), D ** -0.5),
        'w_mlp2': nrm((NL, MLP_HIDDEN, D), MLP_HIDDEN ** -0.5),
        'final_g': 1.0 + nrm((D,), 0.02),
    }


def reference(x, c, ctx, c_ctx, w_mod, b_mod, norm1_g, w_in, rw_mu, rw_w0, rw_w2, rw_a0, rw_a2, rw_g2,
              rw_kk, rw_ka, rw_rk, rw_ln_w, rw_ln_b, gla_a2, gla_ab, gla_norm_g, gdn_conv, gdn_a_log,
              gdn_dt_bias, gdn_norm_g, w_branch, w_out, norm2_g, w_mlp1, w_mlp2, final_g):
    bsz, n_lat, dm = x.shape
    rows = n_lat // GRID_W
    n_ctx = ctx.shape[1]
    h = jnp.concatenate([ctx, x], axis=1)
    for l in range(DEPTH):
        m_lat = jnp.split(jax.nn.silu(c) @ w_mod[l] + b_mod[l], 6, axis=-1)
        m_ctx = jnp.split(jax.nn.silu(c_ctx) @ w_mod[l] + b_mod[l], 6, axis=-1)
        hn = seg_modulate(rmsnorm(h, norm1_g[l]), n_ctx, m_ctx[0], m_ctx[1], m_lat[0], m_lat[1])
        p = hn @ w_in[l]
        p_rw, p_gla, p_gdn, p_gate = _split(p, [RW_COLS, GLA_COLS, GDN_COLS, GATE_COLS])
        mu = rw_mu[l]
        p_rw = seg_dwconv(p_rw, jnp.stack([mu[0], 1 - mu[0] - mu[1], mu[1]]), n_ctx)
        y_rw = rwkv7_branch(p_rw, n_ctx, rw_w0[l], rw_w2[l], rw_a0[l], rw_a2[l], rw_g2[l], rw_kk[l],
                            rw_ka[l], rw_rk[l], rw_ln_w[l], rw_ln_b[l])
        y_gla = gla_branch(p_gla, n_ctx, rows, gla_a2[l], gla_ab[l], gla_norm_g[l])
        y_gdn = gdn_branch(p_gdn, n_ctx, gdn_conv[l], gdn_a_log[l], gdn_dt_bias[l], gdn_norm_g[l])
        branches = jnp.stack([y_rw, y_gla, y_gdn], axis=2)
        gates = jax.nn.sigmoid(p_gate).reshape(bsz, -1, N_BRANCH, dm)
        merged = jnp.sum(jnp.einsum('blgc,gcd->blgd', branches, w_branch[l]) * gates, axis=2)
        mix = merged @ w_out[l]
        if l < DEPTH - 1:
            h = h + seg_gate(mix, n_ctx, m_ctx[2], m_lat[2])
            hn = seg_modulate(rmsnorm(h, norm2_g[l]), n_ctx, m_ctx[3], m_ctx[4], m_lat[3], m_lat[4])
            h = h + seg_gate(sq_relu_mlp(hn, w_mlp1[l], w_mlp2[l]), n_ctx, m_ctx[5], m_lat[5])
        else:
            h = h[:, n_ctx:] + mix[:, n_ctx:] * m_lat[2][:, None]
            hn = rmsnorm(h, norm2_g[l]) * (1 + m_lat[4][:, None]) + m_lat[3][:, None]
            h = h + sq_relu_mlp(hn, w_mlp1[l], w_mlp2[l]) * m_lat[5][:, None]
    return rmsnorm(h, final_g)
```

```cpp
#include <hip/hip_runtime.h>
#include <hip/hip_cooperative_groups.h>
#include <cstdio>
#include <cstdint>
namespace cg = cooperative_groups;

#define LAS __attribute__((address_space(3)))
typedef unsigned short bf16_t;
typedef short bf16x8 __attribute__((ext_vector_type(8)));
typedef float f32x4 __attribute__((ext_vector_type(4)));
typedef float f32x2 __attribute__((ext_vector_type(2)));
typedef unsigned u32x4 __attribute__((ext_vector_type(4)));
typedef unsigned u32x2 __attribute__((ext_vector_type(2)));

constexpr int L = 16640, NCTX = 256, NLAT = 16384, DM = 1024, BW = 512, DEPTH = 4;
constexpr int IN_COLS = 8624;
constexpr int NMAIN = 5888;
constexpr int NWIN = 8960;
constexpr int R_LD = 2048, PG_LD = 3840;
constexpr int GLA_Q = 0, GLA_K = 256, GLA_V = 512, GLA_OG = 1024, GLA_AL = 1536;
constexpr int GDN_QKV = 1568, GDN_ZG = 3104, GDN_A = 3616, GDN_B = 3624;
constexpr int YRW_COL = 1568;

constexpr size_t al256(size_t x) { return (x + 255) & ~(size_t)255; }
constexpr size_t OFF_MOD = 0;
constexpr size_t OFF_H = al256(OFF_MOD + (size_t)4 * 2 * 6144 * 4);
constexpr size_t OFF_HN = OFF_H + (size_t)L * 1024 * 4;
constexpr size_t OFF_WIN = OFF_HN + (size_t)L * 1024 * 2;
constexpr size_t OFF_R = OFF_WIN + (size_t)NWIN * 1024 * 2;
constexpr size_t OFF_PG = OFF_R + (size_t)L * R_LD * 2;
constexpr size_t OFF_B = OFF_PG + (size_t)L * PG_LD * 2;
constexpr size_t OFF_RWG = OFF_B + (size_t)L * 4096 * 2;
constexpr size_t OFF_BONUS = OFF_RWG + (size_t)L * 512 * 2;
constexpr size_t OFF_GLAD = OFF_BONUS + (size_t)L * 8 * 4;
constexpr size_t OFF_GDNC = OFF_GLAD + (size_t)L * 512 * 2;
constexpr size_t OFF_GDNGB = OFF_GDNC + (size_t)L * 1536 * 2;
constexpr size_t WS_END = OFF_GDNGB + (size_t)L * 16 * 4;
constexpr size_t OFF_WBR = OFF_R;
constexpr size_t OFF_WOUT = OFF_WBR + (size_t)3 * 1024 * 512 * 2;
constexpr size_t OFF_W1 = OFF_WOUT + (size_t)1024 * 1024 * 2;
constexpr size_t OFF_W2 = OFF_W1 + (size_t)4096 * 1024 * 2;

constexpr int LDS_BYTES = 131072;

struct P { const float* in[32]; float* out; unsigned char* ws; };
enum { I_X = 0, I_C, I_CTX, I_CCTX, I_WMOD, I_BMOD, I_N1G, I_WIN, I_RWMU, I_RWW0, I_RWW2, I_RWA0, I_RWA2, I_RWG2, I_RWKK, I_RWKA, I_RWRK,
       I_RWLNW, I_RWLNB, I_GLAA2, I_GLAAB, I_GLANG, I_GDNCONV, I_GDNALOG, I_GDNDT, I_GDNNG, I_WBR, I_WOUT, I_N2G, I_W1, I_W2, I_FINALG };

__device__ __forceinline__ float bf2f(bf16_t b) { return __uint_as_float(((unsigned)b) << 16); }
__device__ __forceinline__ unsigned pk2(float lo, float hi) { unsigned r; asm("v_cvt_pk_bf16_f32 %0, %1, %2" : "=v"(r) : "v"(lo), "v"(hi)); return r; }
__device__ __forceinline__ bf16_t f2bf(float f) { return (bf16_t)(pk2(f, 0.f) & 0xffffu); }
__device__ __forceinline__ float sigmoid_(float x) { return 1.f / (1.f + __expf(-x)); }
__device__ __forceinline__ float silu_(float x) { return x / (1.f + __expf(-x)); }
__device__ __forceinline__ float softplus_(float x) { return fmaxf(x, 0.f) + log1pf(__expf(-fabsf(x))); }
__device__ __forceinline__ float wave_sum(float v) {
#pragma unroll
    for (int o = 1; o < 64; o <<= 1) v += __shfl_xor(v, o);
    return v;
}
template <int CTRL> __device__ __forceinline__ float dpp_(float x) { return __int_as_float(__builtin_amdgcn_update_dpp(0, __float_as_int(x), CTRL, 0xF, 0xF, true)); }
__device__ __forceinline__ float reduce8(float x) { x += dpp_<0xB1>(x); x += dpp_<0x4E>(x); x += dpp_<0x141>(x); return x; }
__device__ __forceinline__ float reduce16(float x) { x = reduce8(x); x += dpp_<0x140>(x); return x; }

__device__ __forceinline__ int otid() { int t = threadIdx.x; asm volatile("" : "+v"(t)); return t; }
__device__ __forceinline__ int osgpr(int x) { asm volatile("" : "+s"(x)); return x; }
namespace pg8 {
constexpr int BM = 256, BK = 64, HALF = 128, HTB = HALF * BK * 2, STAGE_BYTES = 8 * HTB, NXCD = 8, WGM = 8;
__host__ __device__ __forceinline__ int lds_byte(int r, int c) { const int st = (r >> 4) * 2 + (c >> 5), rr = r & 15, cc = c & 31, ob = rr * 64 + cc * 2; return st * 1024 + (ob ^ (((ob >> 9) & 1) << 5)); }
__host__ __device__ __forceinline__ void stage_rc(int b, int& R, int& C) { const int st = b / 1024, sb = b % 1024, swz = sb ^ (((sb >> 9) & 1) << 5); R = (st >> 1) * 16 + swz / 64; C = (st & 1) * 32 + (swz % 64) / 2; }
struct Unit { int pm, pn; };
struct Gemm { const bf16_t* A; const bf16_t* Bt; int M, N, K; };
struct StaticOrder {
    int nM, nN, nwg, G, c;
    __host__ __device__ void init(int M, int N, int G_, int c_) { nM = M / BM; nN = N / BM; nwg = nM * nN; G = G_; c = c_; }
    __host__ __device__ bool next(int i, Unit& u) const {
        const long Lx = (long)i * G + c; if (Lx >= nwg) return false;
        int wgid = (int)Lx; { const int q = nwg / NXCD, r = nwg % NXCD, xcd = wgid % NXCD, off = wgid / NXCD; wgid = (xcd < r ? xcd * (q + 1) : r * (q + 1) + (xcd - r) * q) + off; }
        const int nig = WGM * nN, gid = wgid / nig, fm = gid * WGM, gsz = (nM - fm) < WGM ? (nM - fm) : WGM;
        u.pm = fm + ((wgid % nig) % gsz); u.pn = (wgid % nig) / gsz; return true;
    }
};
template <class Epi>
__device__ __forceinline__ void gemm_phase(LAS unsigned char* lds, const Gemm g, const StaticOrder& S, const Epi& E) {
#ifdef NO_GEMM
    return;
#endif
    const int tid = otid(), wid = __builtin_amdgcn_readfirstlane(tid >> 6), lane = tid & 63, wr = wid >> 2, wc = wid & 3, fr = lane & 15, fq = lane >> 4;
    const int K = g.K, nt = K / BK;
    unsigned voffA[2];
#pragma unroll
    for (int i = 0; i < 2; ++i) { int R, C; stage_rc(tid * 16 + i * 8192, R, C); voffA[i] = (unsigned)(R * K + C) * 2u; }
    const size_t kstep = (size_t)(BK * 2);
    const size_t hstep = (size_t)HALF * K * 2;
    const size_t tstep = 2 * hstep;
    const unsigned ldsw = (unsigned)wid * 1024u;
    const int aoff = lds_byte(wr * 64 + fr, fq * 8), boff = lds_byte(wc * 32 + fr, fq * 8);
#define PG8_SA(b, h) (((b) * 2 + (h)) * HTB)
#define PG8_SB(b, h) ((4 + (b) * 2 + (h)) * HTB)
#define PG8_STAGE(bufoff, gbase, voff) do { _Pragma("unroll") for (int _i = 0; _i < 2; ++_i) \
        __builtin_amdgcn_global_load_lds((const unsigned*)((const char*)(gbase) + (voff)[_i]), (LAS unsigned*)(lds + (bufoff) + ldsw + _i * 8192), 16, 0, 0); } while (0)
#define PG8_LDA(dst, b, h) do { _Pragma("unroll") for (int m = 0; m < 4; ++m) _Pragma("unroll") for (int k = 0; k < 2; ++k) dst[m][k] = *(const LAS bf16x8*)(lds + PG8_SA(b, h) + aoff + m * 2048 + k * 1024); } while (0)
#define PG8_LDB(dst, b, h) do { _Pragma("unroll") for (int n = 0; n < 2; ++n) _Pragma("unroll") for (int k = 0; k < 2; ++k) dst[n][k] = *(const LAS bf16x8*)(lds + PG8_SB(b, h) + boff + n * 2048 + k * 1024); } while (0)
#define PG8_MMA(ai, bj, At, Bt) do { __builtin_amdgcn_s_setprio(1); _Pragma("unroll") for (int m = 0; m < 4; ++m) _Pragma("unroll") for (int n = 0; n < 2; ++n) _Pragma("unroll") for (int k = 0; k < 2; ++k) \
        acc[ai][bj][m][n] = __builtin_amdgcn_mfma_f32_16x16x32_bf16(Bt[n][k], At[m][k], acc[ai][bj][m][n], 0, 0, 0); __builtin_amdgcn_s_setprio(0); } while (0)
#define PG8_WAIT_V(n) asm volatile("s_waitcnt vmcnt(" #n ")" ::: "memory")
#define PG8_WAIT_L(n) asm volatile("s_waitcnt lgkmcnt(" #n ")" ::: "memory")
#define PG8_BAR __builtin_amdgcn_s_barrier()
#define PG8_SCHED __builtin_amdgcn_sched_barrier(0)
    Unit cur, nxt; int ui = 0;
    if (!S.next(0, cur)) return;
    f32x4 acc[2][2][4][2];
#pragma unroll
    for (int a = 0; a < 2; ++a)
#pragma unroll
        for (int b = 0; b < 2; ++b)
#pragma unroll
            for (int m = 0; m < 4; ++m)
#pragma unroll
                for (int n = 0; n < 2; ++n) acc[a][b][m][n] = (f32x4){0.f, 0.f, 0.f, 0.f};
    bf16x8 At[4][2], B0[2][2], B1[2][2];
    const char* cA = (const char*)g.A + (size_t)cur.pm * tstep; const char* cB = (const char*)g.Bt + (size_t)cur.pn * tstep;
    PG8_STAGE(PG8_SB(0, 0), cB, voffA); PG8_STAGE(PG8_SA(0, 0), cA, voffA); PG8_STAGE(PG8_SB(0, 1), cB + hstep, voffA); PG8_STAGE(PG8_SA(0, 1), cA + hstep, voffA);
    if (wr == 1) PG8_BAR;
    PG8_WAIT_V(4); PG8_BAR;
    PG8_STAGE(PG8_SB(1, 0), cB + kstep, voffA); PG8_STAGE(PG8_SA(1, 0), cA + kstep, voffA); PG8_STAGE(PG8_SB(1, 1), cB + hstep + kstep, voffA);
    PG8_WAIT_V(6); PG8_BAR;
    for (;;) {
        const bool has_next = S.next(ui + 1, nxt);
        const char* nA = has_next ? (const char*)g.A + (size_t)nxt.pm * tstep : cA; const char* nB = has_next ? (const char*)g.Bt + (size_t)nxt.pn * tstep : cB;
        for (int t = 0; t < nt; t += 2) {
            const bool last = (t == nt - 2);
            const char* a1 = cA + (size_t)(t + 1) * kstep;
            const char* a2 = last ? nA : cA + (size_t)(t + 2) * kstep; const char* b2 = last ? nB : cB + (size_t)(t + 2) * kstep;
            const char* a3 = a2 + kstep; const char* b3 = b2 + kstep;
            PG8_LDB(B0, 0, 0); PG8_SCHED; PG8_LDA(At, 0, 0); PG8_STAGE(PG8_SA(1, 1), a1 + hstep, voffA);
            PG8_WAIT_L(8); PG8_BAR; PG8_WAIT_L(0); PG8_MMA(0, 0, At, B0); PG8_BAR; PG8_SCHED;
            PG8_LDB(B1, 0, 1); PG8_STAGE(PG8_SB(0, 0), b2, voffA);
            PG8_BAR; PG8_WAIT_L(0); PG8_MMA(0, 1, At, B1); PG8_BAR;
            PG8_LDA(At, 0, 1); PG8_STAGE(PG8_SA(0, 0), a2, voffA);
            PG8_BAR; PG8_WAIT_L(0); PG8_MMA(1, 0, At, B0); PG8_BAR; PG8_SCHED;
            PG8_STAGE(PG8_SB(0, 1), b2 + hstep, voffA);
            PG8_WAIT_V(6); PG8_BAR; PG8_MMA(1, 1, At, B1); PG8_BAR;
            PG8_LDB(B0, 1, 0); PG8_SCHED; PG8_LDA(At, 1, 0); PG8_STAGE(PG8_SA(0, 1), a2 + hstep, voffA);
            PG8_WAIT_L(8); PG8_BAR; PG8_WAIT_L(0); PG8_MMA(0, 0, At, B0); PG8_BAR; PG8_SCHED;
            PG8_LDB(B1, 1, 1); PG8_STAGE(PG8_SB(1, 0), b3, voffA);
            PG8_BAR; PG8_WAIT_L(0); PG8_MMA(0, 1, At, B1); PG8_BAR;
            PG8_LDA(At, 1, 1); PG8_STAGE(PG8_SA(1, 0), a3, voffA);
            PG8_BAR; PG8_WAIT_L(0); PG8_MMA(1, 0, At, B0); PG8_BAR; PG8_SCHED;
            PG8_STAGE(PG8_SB(1, 1), b3 + hstep, voffA);
            PG8_WAIT_V(6); PG8_BAR; PG8_MMA(1, 1, At, B1); PG8_BAR;
        }
        E(acc, cur, wr, wc, fr, fq);
        if (!has_next) break;
#pragma unroll
        for (int a = 0; a < 2; ++a)
#pragma unroll
            for (int b = 0; b < 2; ++b)
#pragma unroll
                for (int m = 0; m < 4; ++m)
#pragma unroll
                    for (int n = 0; n < 2; ++n) acc[a][b][m][n] = (f32x4){0.f, 0.f, 0.f, 0.f};
        cur = nxt; cA = nA; cB = nB; ++ui;
    }
    PG8_WAIT_V(0);
    if (wr == 0) PG8_BAR;
    PG8_BAR;
#undef PG8_SA
#undef PG8_SB
#undef PG8_STAGE
#undef PG8_LDA
#undef PG8_LDB
#undef PG8_MMA
#undef PG8_WAIT_V
#undef PG8_WAIT_L
#undef PG8_BAR
#undef PG8_SCHED
}
}
using pg8::Unit;

#define EPI_LOOP_ROWS for (int ai = 0; ai < 2; ++ai) for (int m = 0; m < 4; ++m)
#define EPI_LOOP_COLS for (int bj = 0; bj < 2; ++bj) for (int n = 0; n < 2; ++n)
struct EpiInMain {
    bf16_t* R; bf16_t* PG;
    __device__ __forceinline__ void operator()(const f32x4 (&acc)[2][2][4][2], const Unit& u, int wr, int wc, int fr, int fq) const {
        bf16_t* dst; int ld, c0;
        if (u.pn < 8) { dst = R; ld = R_LD; c0 = u.pn * 256; } else { dst = PG; ld = PG_LD; c0 = (u.pn - 8) * 256; }
        const int row0 = u.pm * 256 + wr * 64 + fr, col0 = c0 + wc * 32 + 4 * fq;
#pragma unroll
        EPI_LOOP_ROWS { bf16_t* rowp = dst + (size_t)(row0 + ai * 128 + m * 16) * ld + col0;
#pragma unroll
            EPI_LOOP_COLS { const f32x4 v = acc[ai][bj][m][n]; *(u32x2*)(rowp + bj * 128 + n * 16) = (u32x2){pk2(v[0], v[1]), pk2(v[2], v[3])}; } }
    }
};
struct EpiGates {
    bf16_t* G;
    __device__ __forceinline__ void operator()(const f32x4 (&acc)[2][2][4][2], const Unit& u, int wr, int wc, int fr, int fq) const {
        const int row0 = u.pm * 256 + wr * 64 + fr, col0 = u.pn * 256 + wc * 32 + 4 * fq;
#pragma unroll
        EPI_LOOP_ROWS { bf16_t* rowp = G + (size_t)(row0 + ai * 128 + m * 16) * 3072 + col0;
#pragma unroll
            EPI_LOOP_COLS { const f32x4 v = acc[ai][bj][m][n];
                *(u32x2*)(rowp + bj * 128 + n * 16) = (u32x2){pk2(sigmoid_(v[0]), sigmoid_(v[1])), pk2(sigmoid_(v[2]), sigmoid_(v[3]))}; } }
    }
};
template <int GI> struct EpiBranch {
    const bf16_t* G; float* MG; bf16_t* MB;
    __device__ __forceinline__ void operator()(const f32x4 (&acc)[2][2][4][2], const Unit& u, int wr, int wc, int fr, int fq) const {
        const int row0 = u.pm * 256 + wr * 64 + fr, col0 = u.pn * 256 + wc * 32 + 4 * fq;
#pragma unroll
        EPI_LOOP_ROWS { const size_t row = (size_t)(row0 + ai * 128 + m * 16);
#pragma unroll
            EPI_LOOP_COLS { const int col = col0 + bj * 128 + n * 16; const f32x4 v = acc[ai][bj][m][n];
                const u32x2 gq = *(const u32x2*)(G + row * 3072 + GI * 1024 + col);
                f32x4 gv = (f32x4){__uint_as_float(gq[0] << 16), __uint_as_float(gq[0] & 0xffff0000u), __uint_as_float(gq[1] << 16), __uint_as_float(gq[1] & 0xffff0000u)};
                f32x4 r = v * gv;
                if (GI > 0) r += *(const f32x4*)(MG + row * 1024 + col);
                if (GI < 2) *(f32x4*)(MG + row * 1024 + col) = r;
                else *(u32x2*)(MB + row * 1024 + col) = (u32x2){pk2(r[0], r[1]), pk2(r[2], r[3])}; } }
    }
};
struct EpiResid {
    float* H; const float* gate_lat; const float* gate_ctx;
    __device__ __forceinline__ void operator()(const f32x4 (&acc)[2][2][4][2], const Unit& u, int wr, int wc, int fr, int fq) const {
        const int row0 = u.pm * 256 + wr * 64 + fr, col0 = u.pn * 256 + wc * 32 + 4 * fq;
        const float* gp = (u.pm == 0) ? gate_ctx : gate_lat;
        f32x4 gv[2][2];
#pragma unroll
        EPI_LOOP_COLS gv[bj][n] = *(const f32x4*)(gp + col0 + bj * 128 + n * 16);
#pragma unroll
        EPI_LOOP_ROWS { float* rowp = H + (size_t)(row0 + ai * 128 + m * 16) * 1024 + col0;
#pragma unroll
            EPI_LOOP_COLS { f32x4* q = (f32x4*)(rowp + bj * 128 + n * 16); *q = *q + acc[ai][bj][m][n] * gv[bj][n]; } }
    }
};
struct EpiMlp1 {
    bf16_t* U;
    __device__ __forceinline__ void operator()(const f32x4 (&acc)[2][2][4][2], const Unit& u, int wr, int wc, int fr, int fq) const {
        const int row0 = u.pm * 256 + wr * 64 + fr, col0 = u.pn * 256 + wc * 32 + 4 * fq;
#pragma unroll
        EPI_LOOP_ROWS { bf16_t* rowp = U + (size_t)(row0 + ai * 128 + m * 16) * 4096 + col0;
#pragma unroll
            EPI_LOOP_COLS { f32x4 v = acc[ai][bj][m][n];
#pragma unroll
                for (int j = 0; j < 4; ++j) { const float t = fmaxf(v[j], 0.f); v[j] = t * t; }
                *(u32x2*)(rowp + bj * 128 + n * 16) = (u32x2){pk2(v[0], v[1]), pk2(v[2], v[3])}; } }
    }
};

__device__ __forceinline__ void convert_T(const float* src, int ld, int K, int n0, int ncols, bf16_t* dst, LAS float* tile, int wg, int nwg) {
    const int ntn = (ncols + 63) >> 6, ntk = K >> 6, tid = otid();
    for (int t = wg; t < ntn * ntk; t += nwg) {
        const int tn = t / ntk, tk = t - tn * ntk, k0 = tk * 64, nb = tn * 64;
#pragma unroll
        for (int i = 0; i < 2; ++i) { const int idx = tid + i * 512, kk = idx >> 4, n4 = (idx & 15) * 4;
            f32x4 v = (f32x4){0.f, 0.f, 0.f, 0.f};
            if (nb + n4 < ncols) v = *(const f32x4*)(src + (size_t)(k0 + kk) * ld + n0 + nb + n4);
            tile[kk * 65 + n4 + 0] = v[0]; tile[kk * 65 + n4 + 1] = v[1]; tile[kk * 65 + n4 + 2] = v[2]; tile[kk * 65 + n4 + 3] = v[3]; }
        __syncthreads();
        { const int nn = tid >> 3, k8 = (tid & 7) * 8;
          if (nb + nn < ncols) { const LAS float* s = tile + k8 * 65 + nn;
              u32x4 o; o[0] = pk2(s[0], s[65]); o[1] = pk2(s[130], s[195]); o[2] = pk2(s[260], s[325]); o[3] = pk2(s[390], s[455]);
              *(u32x4*)(dst + (size_t)(nb + nn) * K + k0 + k8) = o; } }
        __syncthreads();
    }
}

__device__ __forceinline__ void phase_mod(const P& p, LAS unsigned char* lds) {
    const float* c = p.in[I_C]; const float* cc = p.in[I_CCTX]; const float* wm = p.in[I_WMOD]; const float* bm = p.in[I_BMOD];
    float* MOD = (float*)(p.ws + OFF_MOD);
    LAS float* red = (LAS float*)lds;
    const int tid = otid();
    for (int blk = blockIdx.x; blk < 256; blk += gridDim.x) {
        const int l = blk >> 6, col0 = (blk & 63) * 96;
        if (tid < 384) {
            const int cgp = tid % 24, ks = tid / 24;
            f32x4 a0 = (f32x4){0.f, 0.f, 0.f, 0.f}, a1 = a0;
            const float* w = wm + (size_t)l * 1024 * 6144 + col0 + cgp * 4;
#pragma unroll 8
            for (int k = ks * 64; k < ks * 64 + 64; ++k) {
                const f32x4 wv = *(const f32x4*)(w + (size_t)k * 6144);
                const float s0 = silu_(c[k]), s1 = silu_(cc[k]);
                a0 += wv * s0; a1 += wv * s1;
            }
            LAS f32x4* r4 = (LAS f32x4*)red;
            r4[(ks * 24 + cgp) * 2 + 0] = a0; r4[(ks * 24 + cgp) * 2 + 1] = a1;
        }
        __syncthreads();
        if (tid < 192) {
            const int col = tid % 96, s = tid / 96;
            float sum = 0.f;
#pragma unroll
            for (int k2 = 0; k2 < 16; ++k2) sum += red[((k2 * 24 + (col >> 2)) * 2 + s) * 4 + (col & 3)];
            MOD[((size_t)l * 2 + s) * 6144 + col0 + col] = sum + bm[l * 6144 + col0 + col];
        }
        __syncthreads();
    }
}

template <bool FROM_INPUT>
__device__ __forceinline__ void phase_norm(const P& p, int l, const float* gamma, int shift_idx, int scale_idx) {
    float* H = (float*)(p.ws + OFF_H); bf16_t* HN = (bf16_t*)(p.ws + OFF_HN);
    const float* MOD = (const float*)(p.ws + OFF_MOD) + (size_t)l * 2 * 6144;
    const int tid_ = otid(); const int wave = tid_ >> 6, lane = tid_ & 63;
    for (int row = blockIdx.x * 8 + wave; row < L; row += gridDim.x * 8) {
        const float* src = FROM_INPUT ? (row < NCTX ? p.in[I_CTX] + (size_t)row * 1024 : p.in[I_X] + (size_t)(row - NCTX) * 1024) : H + (size_t)row * 1024;
        f32x4 v[4]; float ss = 0.f;
#pragma unroll
        for (int j = 0; j < 4; ++j) { v[j] = *(const f32x4*)(src + j * 256 + lane * 4); ss += (v[j][0] * v[j][0] + v[j][1] * v[j][1]) + (v[j][2] * v[j][2] + v[j][3] * v[j][3]); }
        ss = wave_sum(ss);
        const float rstd = rsqrtf(ss * (1.f / 1024.f) + 1e-6f);
        const float* m = MOD + (row < NCTX ? 6144 : 0);
#pragma unroll
        for (int j = 0; j < 4; ++j) { const int col = j * 256 + lane * 4;
            const f32x4 g = *(const f32x4*)(gamma + col), sh = *(const f32x4*)(m + shift_idx * 1024 + col), sc = *(const f32x4*)(m + scale_idx * 1024 + col);
            const f32x4 o = v[j] * rstd * g * (sc + 1.f) + sh;
            *(u32x2*)(HN + (size_t)row * 1024 + col) = (u32x2){pk2(o[0], o[1]), pk2(o[2], o[3])};
            if (FROM_INPUT) *(f32x4*)(H + (size_t)row * 1024 + col) = v[j]; }
    }
}

constexpr int TT = 13;
__device__ __forceinline__ float rw_shift(const bf16_t* R, int t, int c, float m0, float m1) {
    const float cur = bf2f(R[(size_t)t * R_LD + c]);
    const float pv = (t != 0 && t != NCTX) ? bf2f(R[(size_t)(t - 1) * R_LD + c]) : 0.f;
    const float nv = (t != NCTX - 1 && t != L - 1) ? bf2f(R[(size_t)(t + 1) * R_LD + c]) : 0.f;
    return m0 * pv + (1.f - m0 - m1) * cur + m1 * nv;
}
__device__ __forceinline__ void phase_prep(const P& p, int l, LAS unsigned char* lds) {
    const bf16_t* R = (const bf16_t*)(p.ws + OFF_R); const bf16_t* PG = (const bf16_t*)(p.ws + OFF_PG);
    bf16_t* B = (bf16_t*)(p.ws + OFF_B); bf16_t* RWG = (bf16_t*)(p.ws + OFF_RWG); float* BONUS = (float*)(p.ws + OFF_BONUS);
    bf16_t* GLAD = (bf16_t*)(p.ws + OFF_GLAD); bf16_t* GDNC = (bf16_t*)(p.ws + OFF_GDNC); float* GDNGB = (float*)(p.ws + OFF_GDNGB);
    const float* mu = p.in[I_RWMU] + (size_t)l * 2 * 1920;
    const float* w0 = p.in[I_RWW0] + (size_t)l * 1024; const float* w2 = p.in[I_RWW2] + (size_t)l * 2 * 64 * 512;
    const float* a0 = p.in[I_RWA0] + (size_t)l * 1024; const float* a2 = p.in[I_RWA2] + (size_t)l * 2 * 64 * 512;
    const float* g2 = p.in[I_RWG2] + (size_t)l * 128 * 512;
    const float* kkw = p.in[I_RWKK] + l * 512; const float* kaw = p.in[I_RWKA] + l * 512; const float* rkw = p.in[I_RWRK] + l * 512;
    const float* ga2 = p.in[I_GLAA2] + (size_t)l * 2 * 16 * 256; const float* gab = p.in[I_GLAAB] + l * 512;
    const float* cw = p.in[I_GDNCONV] + (size_t)l * 5 * 1536; const float* alog = p.in[I_GDNALOG] + l * 8; const float* dtb = p.in[I_GDNDT] + l * 8;
    LAS float* xs = (LAS float*)lds;
    LAS float* gal = xs + 384 * 16;
    LAS float* red = gal + TT * 32;
    const int tid = otid(), wave = tid >> 6;
    const int c = tid;
    const int gz = tid >> 8, gk = tid & 255;
    for (int tile = blockIdx.x; tile < L / TT; tile += gridDim.x) {
        const int t0 = tile * TT;
#pragma unroll 2
        for (int i = 0; i < 10; ++i) { const int idx = tid + i * 512;
            if (idx < TT * 384) { const int tt = idx / 384, e = idx - tt * 384, col = 1536 + e;
                float v = rw_shift(R, t0 + tt, col, mu[col], mu[1920 + col]);
                if (e < 128) v = tanhf(v); else if (e >= 256) v = sigmoid_(v);
                xs[e * 16 + tt] = v; } }
        if (tid < TT * 32) { const int tt = tid >> 5, e = tid & 31; gal[tt * 32 + e] = bf2f(PG[(size_t)(t0 + tt) * PG_LD + GLA_AL + e]); }
        __syncthreads();
        {
            float aw0[TT], aw1[TT];
#pragma unroll
            for (int tt = 0; tt < TT; ++tt) { aw0[tt] = 0.f; aw1[tt] = 0.f; }
#pragma unroll 1
            for (int e = 0; e < 64; ++e) {
                const float q0 = w2[e * 512 + c], q1 = w2[(64 + e) * 512 + c];
                float x0[16], x1[16];
#pragma unroll
                for (int j = 0; j < 4; ++j) { *(f32x4*)(x0 + 4 * j) = *(const LAS f32x4*)(xs + e * 16 + 4 * j); *(f32x4*)(x1 + 4 * j) = *(const LAS f32x4*)(xs + (64 + e) * 16 + 4 * j); }
#pragma unroll
                for (int tt = 0; tt < TT; ++tt) { aw0[tt] += x0[tt] * q0; aw1[tt] += x1[tt] * q1; }
            }
            const float w00 = w0[c], w01 = w0[512 + c];
#pragma unroll
            for (int tt = 0; tt < TT; ++tt) {
                const float wz0 = -softplus_(-(w00 + aw0[tt])) - 0.5f, wz1 = -softplus_(-(w01 + aw1[tt])) - 0.5f;
                bf16_t* bp = B + (size_t)(t0 + tt) * 4096 + c;
                bp[3072] = f2bf(-expm1f(-__expf(wz0))); bp[3584] = f2bf(-expm1f(-__expf(wz1)));
            }
        }
        {
            float ag[TT];
#pragma unroll
            for (int tt = 0; tt < TT; ++tt) ag[tt] = 0.f;
#pragma unroll 1
            for (int e = 0; e < 128; ++e) {
                const float q0 = g2[e * 512 + c];
                float x0[16];
#pragma unroll
                for (int j = 0; j < 4; ++j) *(f32x4*)(x0 + 4 * j) = *(const LAS f32x4*)(xs + (256 + e) * 16 + 4 * j);
#pragma unroll
                for (int tt = 0; tt < TT; ++tt) ag[tt] += x0[tt] * q0;
            }
#pragma unroll
            for (int tt = 0; tt < TT; ++tt) RWG[(size_t)(t0 + tt) * 512 + c] = f2bf(ag[tt]);
        }
        {
            float aa0[TT], aa1[TT];
#pragma unroll
            for (int tt = 0; tt < TT; ++tt) { aa0[tt] = 0.f; aa1[tt] = 0.f; }
#pragma unroll 1
            for (int e = 0; e < 64; ++e) {
                const float q2 = a2[e * 512 + c], q3 = a2[(64 + e) * 512 + c];
                float x2[16], x3[16];
#pragma unroll
                for (int j = 0; j < 4; ++j) { *(f32x4*)(x2 + 4 * j) = *(const LAS f32x4*)(xs + (128 + e) * 16 + 4 * j); *(f32x4*)(x3 + 4 * j) = *(const LAS f32x4*)(xs + (192 + e) * 16 + 4 * j); }
#pragma unroll
                for (int tt = 0; tt < TT; ++tt) { aa0[tt] += x2[tt] * q2; aa1[tt] += x3[tt] * q3; }
            }
            const float mr0 = mu[c], mr1 = mu[1920 + c], mk0 = mu[512 + c], mk1 = mu[1920 + 512 + c], mv0 = mu[1024 + c], mv1 = mu[1920 + 1024 + c];
            const float a00 = a0[c], a01 = a0[512 + c], kkc = kkw[c], kac = kaw[c], rkc = rkw[c];
#pragma unroll
            for (int tt = 0; tt < TT; ++tt) {
                const int t = t0 + tt;
                const float r = rw_shift(R, t, c, mr0, mr1), k = rw_shift(R, t, 512 + c, mk0, mk1), v = rw_shift(R, t, 1024 + c, mv0, mv1);
                const float az0 = sigmoid_(a00 + aa0[tt]), az1 = sigmoid_(a01 + aa1[tt]);
                const float kr = k * kkc;
                const float ssq = wave_sum(kr * kr);
                const float kk = kr * rsqrtf(ssq + 1e-12f);
                const float kd = k * (1.f + (az0 - 1.f) * kac) + k * (1.f + (az1 - 1.f) * kac);
                const float bon = wave_sum(r * rkc * kd);
                bf16_t* bp = B + (size_t)t * 4096 + c;
                bp[0] = f2bf(r); bp[512] = f2bf(k); bp[1024] = f2bf(v); bp[1536] = f2bf(kk); bp[2048] = f2bf(az0); bp[2560] = f2bf(az1);
                if ((tid & 63) == 0) BONUS[t * 8 + wave] = bon;
                asm volatile("" ::: "memory");
            }
        }
        {
        float ga2v[16];
#pragma unroll
        for (int e = 0; e < 16; ++e) ga2v[e] = ga2[(gz * 16 + e) * 256 + gk];
        const float gabv = gab[gz * 256 + gk];
#pragma unroll
        for (int tt = 0; tt < TT; ++tt) {
            float zv = gabv;
#pragma unroll
            for (int e = 0; e < 16; ++e) zv += gal[tt * 32 + gz * 16 + e] * ga2v[e];
            const float la = -softplus_(-zv) * (1.f / 16.f);
            GLAD[(size_t)(t0 + tt) * 512 + tid] = f2bf(-expm1f(la));
            asm volatile("" ::: "memory");
        }
        }
        {
            float cwv[5], xv[TT + 4];
#pragma unroll
            for (int i = 0; i < 5; ++i) cwv[i] = cw[i * 1536 + 1024 + c];
#pragma unroll
            for (int i = 0; i < TT + 4; ++i) { const int rr = t0 - 2 + i; xv[i] = (rr >= 0 && rr < L) ? bf2f(PG[(size_t)rr * PG_LD + GDN_QKV + 1024 + c]) : 0.f; }
#pragma unroll
            for (int tt = 0; tt < TT; ++tt) { const int t = t0 + tt; float sv = 0.f;
#pragma unroll
                for (int i = 0; i < 5; ++i) { const int rr = t + i - 2; const bool ok_ = (rr >= 0) && (rr < L) && ((rr < NCTX) == (t < NCTX)); if (ok_) sv += xv[tt + i] * cwv[i]; }
                GDNC[(size_t)t * 1536 + 1024 + c] = f2bf(silu_(sv)); }
        }
        float oq[TT], ok[TT];
        {
            float cwq[5], cwk[5], xq[TT + 4], xk[TT + 4];
#pragma unroll
            for (int i = 0; i < 5; ++i) { cwq[i] = cw[i * 1536 + c]; cwk[i] = cw[i * 1536 + 512 + c]; }
#pragma unroll
            for (int i = 0; i < TT + 4; ++i) { const int rr = t0 - 2 + i;
                if (rr >= 0 && rr < L) { const bf16_t* rp = PG + (size_t)rr * PG_LD + GDN_QKV + c; xq[i] = bf2f(rp[0]); xk[i] = bf2f(rp[512]); } else { xq[i] = 0.f; xk[i] = 0.f; } }
#pragma unroll
            for (int tt = 0; tt < TT; ++tt) {
                const int t = t0 + tt; float sq = 0.f, sk = 0.f;
#pragma unroll
                for (int i = 0; i < 5; ++i) { const int rr = t + i - 2; const bool ok_ = (rr >= 0) && (rr < L) && ((rr < NCTX) == (t < NCTX));
                    if (ok_) { sq += xq[tt + i] * cwq[i]; sk += xk[tt + i] * cwk[i]; } }
                oq[tt] = silu_(sq); ok[tt] = silu_(sk);
                const float pq = wave_sum(oq[tt] * oq[tt]), pk = wave_sum(ok[tt] * ok[tt]);
                if ((tid & 63) == 0) { red[(tt * 8 + wave) * 2 + 0] = pq; red[(tt * 8 + wave) * 2 + 1] = pk; }
            }
        }
        __syncthreads();
#pragma unroll
        for (int tt = 0; tt < TT; ++tt) {
            const int w0i = (wave >> 1) * 2;
            const float ssq = red[(tt * 8 + w0i) * 2 + 0] + red[(tt * 8 + w0i + 1) * 2 + 0], ssk = red[(tt * 8 + w0i) * 2 + 1] + red[(tt * 8 + w0i + 1) * 2 + 1];
            bf16_t* gp = GDNC + (size_t)(t0 + tt) * 1536 + c;
            gp[0] = f2bf(oq[tt] * rsqrtf(ssq + 1e-12f) * 0.08838834764831845f); gp[512] = f2bf(ok[tt] * rsqrtf(ssk + 1e-12f));
        }
        if (tid < TT * 16) { const int tt = tid >> 4, j = tid & 15, t = t0 + tt;
            float o;
            if (j < 8) { const float a = bf2f(PG[(size_t)t * PG_LD + GDN_A + j]); o = __expf(-__expf(alog[j]) * softplus_(a + dtb[j])); }
            else o = sigmoid_(bf2f(PG[(size_t)t * PG_LD + GDN_B + (j - 8)]));
            GDNGB[t * 16 + j] = o; }
        __syncthreads();
    }
}

constexpr int TB = 16, NBLK = L / TB;
__device__ __forceinline__ int tok_seq(int z, int j) { return z == 0 ? j : (j < NCTX ? NCTX - 1 - j : L - 1 - (j - NCTX)); }
__device__ __forceinline__ int tok_gla(int z, int j) {
    if (j < NCTX) return z == 0 ? j : NCTX - 1 - j;
    const int jj = j - NCTX, pp = z == 0 ? jj : NLAT - 1 - jj;
    return NCTX + (pp & 255) * 64 + (pp >> 8);
}

__device__ __forceinline__ void scan_rwkv(const P& p, int l, int unit, LAS unsigned char* lds) {
    const int z = unit >> 4, h = (unit >> 1) & 7, rh = unit & 1;
    const bf16_t* B = (const bf16_t*)(p.ws + OFF_B); bf16_t* Y = (bf16_t*)(p.ws + OFF_PG) + YRW_COL + z * 512 + h * 64 + rh * 32;
    const float* kaw = p.in[I_RWKA] + l * 512 + h * 64;
    LAS float* vec = (LAS float*)lds;
    LAS float* vv = vec + 2 * TB * 320;
    LAS float* yo = vv + 2 * TB * 32;
    const int tid = otid(), ct = tid & 255; const bool prod = tid >= 256;
    float pr[4], pk[4], pkk[4], pa[4], pw[4], pv[2]; float kac[4];
#pragma unroll
    for (int i = 0; i < 4; ++i) kac[i] = kaw[(ct + i * 256) & 63];
    auto p_load = [&](int blk) {
#pragma unroll
        for (int i = 0; i < 4; ++i) { const int idx = ct + i * 256, s = idx >> 6, n = idx & 63; const int t = tok_seq(z, blk * TB + s);
            const bf16_t* bp = B + (size_t)t * 4096 + h * 64 + n;
            pr[i] = bf2f(bp[0]); pk[i] = bf2f(bp[512]); pkk[i] = bf2f(bp[1536]); pa[i] = bf2f(bp[2048 + z * 512]); pw[i] = bf2f(bp[3072 + z * 512]); }
#pragma unroll
        for (int i = 0; i < 2; ++i) { const int idx = ct + i * 256, s = idx >> 5, r = idx & 31; const int t = tok_seq(z, blk * TB + s);
            pv[i] = bf2f(B[(size_t)t * 4096 + 1024 + h * 64 + rh * 32 + r]); }
    };
    auto p_write = [&](int buf) {
#pragma unroll
        for (int i = 0; i < 4; ++i) { const int idx = ct + i * 256, s = idx >> 6, n = idx & 63;
            LAS float* d = vec + ((buf * TB + s) * 8 + (n >> 3)) * 40 + (n & 7);
            d[0] = pkk[i]; d[8] = 1.f - pw[i]; d[16] = pkk[i] * pa[i]; d[24] = pk[i] * (1.f + (pa[i] - 1.f) * kac[i]); d[32] = pr[i]; }
#pragma unroll
        for (int i = 0; i < 2; ++i) { const int idx = ct + i * 256; vv[buf * TB * 32 + idx] = pv[i]; }
    };
    auto p_yout = [&](int blk) {
        const int buf = blk & 1;
#pragma unroll
        for (int i = 0; i < 2; ++i) { const int idx = ct + i * 256, s = idx >> 5, r = idx & 31; const int t = tok_seq(z, blk * TB + s);
            Y[(size_t)t * PG_LD + r] = f2bf(yo[buf * TB * 32 + idx]); }
    };
    const int irow = ct >> 3, ks = ct & 7;
    f32x2 S[4];
#pragma unroll
    for (int j = 0; j < 4; ++j) S[j] = (f32x2){0.f, 0.f};
    if (prod) { p_load(0); p_write(0); p_load(1); }
    __syncthreads();
    for (int b = 0; b < NBLK; ++b) {
        if (prod) {
            if (b + 1 < NBLK) p_write((b + 1) & 1);
            if (b + 2 < NBLK) p_load(b + 2);
            if (b > 0) p_yout(b - 1);
        } else {
            const int buf = b & 1;
#pragma unroll 4
            for (int s = 0; s < TB; ++s) {
                const LAS float* d = vec + ((buf * TB + s) * 8 + ks) * 40;
                const f32x4 kk0 = *(const LAS f32x4*)(d), kk1 = *(const LAS f32x4*)(d + 4), w0 = *(const LAS f32x4*)(d + 8), w1 = *(const LAS f32x4*)(d + 12);
                const f32x4 b0 = *(const LAS f32x4*)(d + 16), b1 = *(const LAS f32x4*)(d + 20), k0 = *(const LAS f32x4*)(d + 24), k1 = *(const LAS f32x4*)(d + 28);
                const f32x4 r0 = *(const LAS f32x4*)(d + 32), r1 = *(const LAS f32x4*)(d + 36);
                const float v = vv[(buf * TB + s) * 32 + irow];
                f32x2 sa2 = S[0] * (f32x2){kk0[0], kk0[1]} + S[1] * (f32x2){kk0[2], kk0[3]} + S[2] * (f32x2){kk1[0], kk1[1]} + S[3] * (f32x2){kk1[2], kk1[3]};
                const float sa = reduce8(sa2[0] + sa2[1]);
                const f32x2 vv2 = (f32x2){v, v}, nsa = (f32x2){-sa, -sa};
                S[0] = S[0] * (f32x2){w0[0], w0[1]} + (vv2 * (f32x2){k0[0], k0[1]} + nsa * (f32x2){b0[0], b0[1]});
                S[1] = S[1] * (f32x2){w0[2], w0[3]} + (vv2 * (f32x2){k0[2], k0[3]} + nsa * (f32x2){b0[2], b0[3]});
                S[2] = S[2] * (f32x2){w1[0], w1[1]} + (vv2 * (f32x2){k1[0], k1[1]} + nsa * (f32x2){b1[0], b1[1]});
                S[3] = S[3] * (f32x2){w1[2], w1[3]} + (vv2 * (f32x2){k1[2], k1[3]} + nsa * (f32x2){b1[2], b1[3]});
                f32x2 y2 = S[0] * (f32x2){r0[0], r0[1]} + S[1] * (f32x2){r0[2], r0[3]} + S[2] * (f32x2){r1[0], r1[1]} + S[3] * (f32x2){r1[2], r1[3]};
                const float y = reduce8(y2[0] + y2[1]);
                if (ks == 0) yo[(buf * TB + s) * 32 + irow] = y;
            }
        }
        __syncthreads();
    }
    if (prod) p_yout(NBLK - 1);
    __syncthreads();
}

__device__ __forceinline__ void scan_gla(const P& p, int l, int unit, LAS unsigned char* lds) {
    const int z = unit >> 4, h = (unit >> 2) & 3, cb = unit & 3;
    const bf16_t* PG = (const bf16_t*)(p.ws + OFF_PG); const bf16_t* GLAD = (const bf16_t*)(p.ws + OFF_GLAD);
    bf16_t* O = (bf16_t*)(p.ws + OFF_R) + z * 512 + h * 128 + cb * 32;
    LAS float* vec = (LAS float*)lds;
    LAS float* vv = vec + 2 * TB * 192;
    LAS float* yo = vv + 2 * TB * 32;
    const int tid = otid(), ct = tid & 255; const bool prod = tid >= 256;
    float pq[4], pk[4], pa[4], pv[2];
    auto p_load = [&](int blk) {
#pragma unroll
        for (int i = 0; i < 4; ++i) { const int idx = ct + i * 256, s = idx >> 6, n = idx & 63; const int t = tok_gla(z, blk * TB + s);
            const bf16_t* bp = PG + (size_t)t * PG_LD + h * 64 + n;
            pq[i] = bf2f(bp[GLA_Q]); pk[i] = bf2f(bp[GLA_K]); pa[i] = bf2f(GLAD[(size_t)t * 512 + z * 256 + h * 64 + n]); }
#pragma unroll
        for (int i = 0; i < 2; ++i) { const int idx = ct + i * 256, s = idx >> 5, r = idx & 31; const int t = tok_gla(z, blk * TB + s);
            pv[i] = bf2f(PG[(size_t)t * PG_LD + GLA_V + h * 128 + cb * 32 + r]); }
    };
    auto p_write = [&](int buf) {
#pragma unroll
        for (int i = 0; i < 4; ++i) { const int idx = ct + i * 256, s = idx >> 6, n = idx & 63;
            LAS float* d = vec + ((buf * TB + s) * 8 + (n >> 3)) * 24 + (n & 7);
            d[0] = pq[i] * 0.125f; d[8] = pk[i]; d[16] = 1.f - pa[i]; }
#pragma unroll
        for (int i = 0; i < 2; ++i) { const int idx = ct + i * 256; vv[buf * TB * 32 + idx] = pv[i]; }
    };
    auto p_yout = [&](int blk) {
        const int buf = blk & 1;
#pragma unroll
        for (int i = 0; i < 2; ++i) { const int idx = ct + i * 256, s = idx >> 5, r = idx & 31; const int t = tok_gla(z, blk * TB + s);
            O[(size_t)t * R_LD + r] = f2bf(yo[buf * TB * 32 + idx]); }
    };
    const int icol = ct >> 3, ks = ct & 7;
    f32x2 S[4];
#pragma unroll
    for (int j = 0; j < 4; ++j) S[j] = (f32x2){0.f, 0.f};
    if (prod) { p_load(0); p_write(0); p_load(1); }
    __syncthreads();
    for (int b = 0; b < NBLK; ++b) {
        if (prod) {
            if (b + 1 < NBLK) p_write((b + 1) & 1);
            if (b + 2 < NBLK) p_load(b + 2);
            if (b > 0) p_yout(b - 1);
        } else {
            const int buf = b & 1;
#pragma unroll 4
            for (int s = 0; s < TB; ++s) {
                const LAS float* d = vec + ((buf * TB + s) * 8 + ks) * 24;
                const f32x4 q0 = *(const LAS f32x4*)(d), q1 = *(const LAS f32x4*)(d + 4), k0 = *(const LAS f32x4*)(d + 8), k1 = *(const LAS f32x4*)(d + 12);
                const f32x4 a0 = *(const LAS f32x4*)(d + 16), a1 = *(const LAS f32x4*)(d + 20);
                const float v = vv[(buf * TB + s) * 32 + icol];
                const f32x2 vv2 = (f32x2){v, v};
                S[0] = S[0] * (f32x2){a0[0], a0[1]} + vv2 * (f32x2){k0[0], k0[1]};
                S[1] = S[1] * (f32x2){a0[2], a0[3]} + vv2 * (f32x2){k0[2], k0[3]};
                S[2] = S[2] * (f32x2){a1[0], a1[1]} + vv2 * (f32x2){k1[0], k1[1]};
                S[3] = S[3] * (f32x2){a1[2], a1[3]} + vv2 * (f32x2){k1[2], k1[3]};
                f32x2 y2 = S[0] * (f32x2){q0[0], q0[1]} + S[1] * (f32x2){q0[2], q0[3]} + S[2] * (f32x2){q1[0], q1[1]} + S[3] * (f32x2){q1[2], q1[3]};
                const float y = reduce8(y2[0] + y2[1]);
                if (ks == 0) yo[(buf * TB + s) * 32 + icol] = y;
            }
        }
        __syncthreads();
    }
    if (prod) p_yout(NBLK - 1);
    __syncthreads();
}

__device__ __forceinline__ void scan_gdn(const P& p, int l, int unit, LAS unsigned char* lds) {
    const int z = unit >> 5, h = (unit >> 3) & 3, cb = unit & 7;
    const bf16_t* GDNC = (const bf16_t*)(p.ws + OFF_GDNC); const float* GDNGB = (const float*)(p.ws + OFF_GDNGB);
    bf16_t* O = (bf16_t*)(p.ws + OFF_R) + 1024 + z * 512 + h * 128 + cb * 16;
    LAS float* vec = (LAS float*)lds;
    LAS float* vv = vec + 2 * TB * 256;
    LAS float* sc = vv + 2 * TB * 16;
    LAS float* yo = sc + 2 * TB * 2;
    const int tid = otid(), ct = tid & 255; const bool prod = tid >= 256;
    float pq[8], pk[8], pv, psc;
    auto p_load = [&](int blk) {
#pragma unroll
        for (int i = 0; i < 8; ++i) { const int idx = ct + i * 256, s = idx >> 7, n = idx & 127; const int t = tok_seq(z, blk * TB + s);
            const bf16_t* bp = GDNC + (size_t)t * 1536 + h * 128 + n;
            pq[i] = bf2f(bp[0]); pk[i] = bf2f(bp[512]); }
        { const int s = ct >> 4, r = ct & 15; const int t = tok_seq(z, blk * TB + s); pv = bf2f(GDNC[(size_t)t * 1536 + 1024 + h * 128 + cb * 16 + r]); }
        if (ct < 32) { const int s = ct >> 1, w = ct & 1; const int t = tok_seq(z, blk * TB + s); psc = GDNGB[t * 16 + w * 8 + z * 4 + h]; }
    };
    auto p_write = [&](int buf) {
#pragma unroll
        for (int i = 0; i < 8; ++i) { const int idx = ct + i * 256, s = idx >> 7, n = idx & 127;
            LAS float* d = vec + ((buf * TB + s) * 16 + (n >> 3)) * 16 + (n & 7);
            d[0] = pq[i]; d[8] = pk[i]; }
        vv[buf * TB * 16 + ct] = pv;
        if (ct < 32) sc[buf * TB * 2 + ct] = psc;
    };
    auto p_yout = [&](int blk) {
        const int buf = blk & 1; const int s = ct >> 4, r = ct & 15; const int t = tok_seq(z, blk * TB + s);
        O[(size_t)t * R_LD + r] = f2bf(yo[buf * TB * 16 + ct]);
    };
    const int icol = ct >> 4, ks = ct & 15;
    f32x2 S[4];
#pragma unroll
    for (int j = 0; j < 4; ++j) S[j] = (f32x2){0.f, 0.f};
    if (prod) { p_load(0); p_write(0); p_load(1); }
    __syncthreads();
    for (int b = 0; b < NBLK; ++b) {
        if (prod) {
            if (b + 1 < NBLK) p_write((b + 1) & 1);
            if (b + 2 < NBLK) p_load(b + 2);
            if (b > 0) p_yout(b - 1);
        } else {
            const int buf = b & 1;
#pragma unroll 4
            for (int s = 0; s < TB; ++s) {
                const LAS float* d = vec + ((buf * TB + s) * 16 + ks) * 16;
                const f32x4 q0 = *(const LAS f32x4*)(d), q1 = *(const LAS f32x4*)(d + 4), k0 = *(const LAS f32x4*)(d + 8), k1 = *(const LAS f32x4*)(d + 12);
                const float v = vv[(buf * TB + s) * 16 + icol];
                const float eg = sc[(buf * TB + s) * 2 + 0], beta = sc[(buf * TB + s) * 2 + 1];
                f32x2 d2 = S[0] * (f32x2){k0[0], k0[1]} + S[1] * (f32x2){k0[2], k0[3]} + S[2] * (f32x2){k1[0], k1[1]} + S[3] * (f32x2){k1[2], k1[3]};
                const float dd = reduce16(d2[0] + d2[1]);
                const float cc = beta * (v - eg * dd);
                const f32x2 eg2 = (f32x2){eg, eg}, cc2 = (f32x2){cc, cc};
                S[0] = S[0] * eg2 + cc2 * (f32x2){k0[0], k0[1]};
                S[1] = S[1] * eg2 + cc2 * (f32x2){k0[2], k0[3]};
                S[2] = S[2] * eg2 + cc2 * (f32x2){k1[0], k1[1]};
                S[3] = S[3] * eg2 + cc2 * (f32x2){k1[2], k1[3]};
                f32x2 y2 = S[0] * (f32x2){q0[0], q0[1]} + S[1] * (f32x2){q0[2], q0[3]} + S[2] * (f32x2){q1[0], q1[1]} + S[3] * (f32x2){q1[2], q1[3]};
                const float y = reduce16(y2[0] + y2[1]);
                if (ks == 0) yo[(buf * TB + s) * 16 + icol] = y;
            }
        }
        __syncthreads();
    }
    if (prod) p_yout(NBLK - 1);
    __syncthreads();
}

__device__ __forceinline__ void phase_post(const P& p, int l, LAS unsigned char* lds) {
    const bf16_t* PG = (const bf16_t*)(p.ws + OFF_PG); const bf16_t* Rb = (const bf16_t*)(p.ws + OFF_R); const bf16_t* B = (const bf16_t*)(p.ws + OFF_B);
    const bf16_t* RWG = (const bf16_t*)(p.ws + OFF_RWG); const float* BONUS = (const float*)(p.ws + OFF_BONUS);
    bf16_t* YC = (bf16_t*)(p.ws + OFF_GDNC);
    const int tid = otid(), wave = tid >> 6, c = tid;
    const float lnw = p.in[I_RWLNW][l * 512 + c], lnb = p.in[I_RWLNB][l * 512 + c];
    const float gng = p.in[I_GLANG][l * 128 + (c & 127)], dng = p.in[I_GDNNG][l * 128 + (c & 127)];
    LAS float* red = (LAS float*)lds;
    for (int tile = blockIdx.x; tile < L / TT; tile += gridDim.x) {
        const int t0 = tile * TT;
        float og[TT], od[TT];
#pragma unroll
        for (int tt = 0; tt < TT; ++tt) {
            const int t = t0 + tt;
            const float y = bf2f(PG[(size_t)t * PG_LD + YRW_COL + c]) + bf2f(PG[(size_t)t * PG_LD + YRW_COL + 512 + c]);
            const float mean = wave_sum(y) * (1.f / 64.f);
            const float dy = y - mean;
            const float var = wave_sum(dy * dy) * (1.f / 64.f);
            const float yn = dy * rsqrtf(var + 64e-5f) * lnw + lnb;
            const float v = bf2f(B[(size_t)t * 4096 + 1024 + c]);
            const float o = (yn + BONUS[t * 8 + wave] * v) * bf2f(RWG[(size_t)t * 512 + c]);
            YC[(size_t)t * 512 + c] = f2bf(o);
            og[tt] = bf2f(Rb[(size_t)t * R_LD + c]) + bf2f(Rb[(size_t)t * R_LD + 512 + c]);
            od[tt] = bf2f(Rb[(size_t)t * R_LD + 1024 + c]) + bf2f(Rb[(size_t)t * R_LD + 1536 + c]);
            const float pg_ = wave_sum(og[tt] * og[tt]), pd_ = wave_sum(od[tt] * od[tt]);
            if ((tid & 63) == 0) { red[(tt * 8 + wave) * 2 + 0] = pg_; red[(tt * 8 + wave) * 2 + 1] = pd_; }
        }
        __syncthreads();
#pragma unroll
        for (int tt = 0; tt < TT; ++tt) {
            const int t = t0 + tt, w0i = (wave >> 1) * 2;
            const float sg = red[(tt * 8 + w0i) * 2 + 0] + red[(tt * 8 + w0i + 1) * 2 + 0], sd = red[(tt * 8 + w0i) * 2 + 1] + red[(tt * 8 + w0i + 1) * 2 + 1];
            const float gate_g = silu_(bf2f(PG[(size_t)t * PG_LD + GLA_OG + c])), gate_d = silu_(bf2f(PG[(size_t)t * PG_LD + GDN_ZG + c]));
            YC[(size_t)L * 512 + (size_t)t * 512 + c] = f2bf(og[tt] * rsqrtf(sg * (1.f / 128.f) + 1e-6f) * gng * gate_g);
            YC[(size_t)2 * L * 512 + (size_t)t * 512 + c] = f2bf(od[tt] * rsqrtf(sd * (1.f / 128.f) + 1e-6f) * dng * gate_d);
        }
        __syncthreads();
    }
}

__device__ __forceinline__ void phase_final(const P& p) {
    const float* H = (const float*)(p.ws + OFF_H); const float* gamma = p.in[I_FINALG];
    const int tid_ = otid(); const int wave = tid_ >> 6, lane = tid_ & 63;
    for (int row = blockIdx.x * 8 + wave; row < NLAT; row += gridDim.x * 8) {
        const float* src = H + (size_t)(row + NCTX) * 1024;
        f32x4 v[4]; float ss = 0.f;
#pragma unroll
        for (int j = 0; j < 4; ++j) { v[j] = *(const f32x4*)(src + j * 256 + lane * 4); ss += (v[j][0] * v[j][0] + v[j][1] * v[j][1]) + (v[j][2] * v[j][2] + v[j][3] * v[j][3]); }
        ss = wave_sum(ss);
        const float rstd = rsqrtf(ss * (1.f / 1024.f) + 1e-6f);
#pragma unroll
        for (int j = 0; j < 4; ++j) { const int col = j * 256 + lane * 4; const f32x4 g = *(const f32x4*)(gamma + col);
            *(f32x4*)(p.out + (size_t)row * 1024 + col) = v[j] * rstd * g; }
    }
}

__global__ void __launch_bounds__(512, 2) fwd_megakernel(P p) {
    extern __shared__ __attribute__((aligned(16))) unsigned char shm_raw[];
    LAS unsigned char* lds = (LAS unsigned char*)shm_raw;
    cg::grid_group grid = cg::this_grid();
    const int G = gridDim.x, wg = blockIdx.x;
    unsigned char* ws = p.ws;
    float* H = (float*)(ws + OFF_H); bf16_t* HN = (bf16_t*)(ws + OFF_HN); bf16_t* WIN = (bf16_t*)(ws + OFF_WIN);
    const float* MODall = (const float*)(ws + OFF_MOD);

    phase_mod(p, lds);
    grid.sync();
    for (int l = 0; l < DEPTH; ++l) {
        const float* MOD = MODall + (size_t)l * 2 * 6144;
        if (l == 0) phase_norm<true>(p, l, p.in[I_N1G] + l * 1024, 0, 1); else phase_norm<false>(p, l, p.in[I_N1G] + l * 1024, 0, 1);
        {
            const float* win = p.in[I_WIN] + (size_t)l * 1024 * IN_COLS;
            convert_T(win, IN_COLS, 1024, 0, 1920, WIN, (LAS float*)lds, wg, G);
            convert_T(win, IN_COLS, 1024, 1920, 3632, WIN + (size_t)2048 * 1024, (LAS float*)lds, (wg + 64) % G, G);
            convert_T(win, IN_COLS, 1024, 5552, 3072, WIN + (size_t)NMAIN * 1024, (LAS float*)lds, (wg + 128) % G, G);
        }
        grid.sync();
        {
            pg8::Gemm g{HN, WIN, L, NMAIN, 1024}; pg8::StaticOrder S; S.init(L, NMAIN, G, wg);
            EpiInMain E{(bf16_t*)(ws + OFF_R), (bf16_t*)(ws + OFF_PG)};
            pg8::gemm_phase(lds, g, S, E);
        }
        grid.sync();
#ifndef NO_PREP
        phase_prep(p, l, lds);
#endif
        grid.sync();
#ifndef NO_SCAN
        if (wg < 32) scan_rwkv(p, l, wg, lds);
        else if (wg < 64) scan_gla(p, l, wg - 32, lds);
        else if (wg < 128) scan_gdn(p, l, wg - 64, lds);
#endif
        grid.sync();
#ifndef NO_POST
        phase_post(p, l, lds);
#endif
        grid.sync();
        {
            convert_T(p.in[I_WBR] + (size_t)l * 3 * 512 * 1024, 1024, 512, 0, 1024, (bf16_t*)(ws + OFF_WBR), (LAS float*)lds, wg, G);
            convert_T(p.in[I_WBR] + (size_t)l * 3 * 512 * 1024 + (size_t)512 * 1024, 1024, 512, 0, 1024, (bf16_t*)(ws + OFF_WBR) + (size_t)1024 * 512, (LAS float*)lds, (wg + 128) % G, G);
            convert_T(p.in[I_WBR] + (size_t)l * 3 * 512 * 1024 + (size_t)2 * 512 * 1024, 1024, 512, 0, 1024, (bf16_t*)(ws + OFF_WBR) + (size_t)2 * 1024 * 512, (LAS float*)lds, wg, G);
            convert_T(p.in[I_WOUT] + (size_t)l * 1024 * 1024, 1024, 1024, 0, 1024, (bf16_t*)(ws + OFF_WOUT), (LAS float*)lds, wg, G);
            convert_T(p.in[I_W1] + (size_t)l * 1024 * 4096, 4096, 1024, 0, 4096, (bf16_t*)(ws + OFF_W1), (LAS float*)lds, wg, G);
            convert_T(p.in[I_W2] + (size_t)l * 4096 * 1024, 1024, 4096, 0, 1024, (bf16_t*)(ws + OFF_W2), (LAS float*)lds, wg, G);
            pg8::Gemm g{HN, WIN + (size_t)NMAIN * 1024, L, 3072, 1024}; pg8::StaticOrder S; S.init(L, 3072, G, wg);
            EpiGates E{(bf16_t*)(ws + OFF_B)};
            pg8::gemm_phase(lds, g, S, E);
        }
        grid.sync();
        {
            const bf16_t* YC = (const bf16_t*)(ws + OFF_GDNC); const bf16_t* WBR = (const bf16_t*)(ws + OFF_WBR);
            pg8::StaticOrder S; S.init(L, 1024, G, wg);
            { pg8::Gemm g{YC, WBR, L, 1024, 512}; EpiBranch<0> E{(const bf16_t*)(ws + OFF_B), (float*)(ws + OFF_PG), HN}; pg8::gemm_phase(lds, g, S, E); }
            { pg8::Gemm g{YC + (size_t)L * 512, WBR + (size_t)1024 * 512, L, 1024, 512}; EpiBranch<1> E{(const bf16_t*)(ws + OFF_B), (float*)(ws + OFF_PG), HN}; pg8::gemm_phase(lds, g, S, E); }
            { pg8::Gemm g{YC + (size_t)2 * L * 512, WBR + (size_t)2 * 1024 * 512, L, 1024, 512}; EpiBranch<2> E{(const bf16_t*)(ws + OFF_B), (float*)(ws + OFF_PG), HN}; pg8::gemm_phase(lds, g, S, E); }
        }
        grid.sync();
        {
            pg8::Gemm g{HN, (const bf16_t*)(ws + OFF_WOUT), L, 1024, 1024}; pg8::StaticOrder S; S.init(L, 1024, G, wg);
            EpiResid E{H, MOD + 2 * 1024, MOD + 6144 + 2 * 1024};
            pg8::gemm_phase(lds, g, S, E);
        }
        grid.sync();
        phase_norm<false>(p, l, p.in[I_N2G] + l * 1024, 3, 4);
        grid.sync();
        {
            pg8::Gemm g{HN, (const bf16_t*)(ws + OFF_W1), L, 4096, 1024}; pg8::StaticOrder S; S.init(L, 4096, G, wg);
            EpiMlp1 E{(bf16_t*)(ws + OFF_B)};
            pg8::gemm_phase(lds, g, S, E);
        }
        grid.sync();
        {
            pg8::Gemm g{(const bf16_t*)(ws + OFF_B), (const bf16_t*)(ws + OFF_W2), L, 1024, 4096}; pg8::StaticOrder S; S.init(L, 1024, G, wg);
            EpiResid E{H, MOD + 5 * 1024, MOD + 6144 + 5 * 1024};
            pg8::gemm_phase(lds, g, S, E);
        }
        grid.sync();
    }
    phase_final(p);
}

extern "C" void kernel_launch(void* const* d_in, const int* in_sizes, int n_in, void* d_out, int out_size, void* d_ws, size_t ws_size, hipStream_t stream) {
    static int grid_blocks = 0;
    if (n_in != 32 || ws_size < WS_END || out_size != NLAT * DM) {
        fprintf(stderr, "kernel_launch: unexpected shapes / workspace (n_in %d, ws %zu need %zu, out %d)\n", n_in, ws_size, (size_t)WS_END, out_size);
        hipMemsetAsync(d_out, 0xFF, (size_t)out_size * 4, stream);
        return;
    }
    if (!grid_blocks) {
        int dev = 0, cus = 0, per_cu = 0;
        hipGetDevice(&dev);
        hipDeviceGetAttribute(&cus, hipDeviceAttributeMultiprocessorCount, dev);
        hipFuncSetAttribute((const void*)fwd_megakernel, hipFuncAttributeMaxDynamicSharedMemorySize, LDS_BYTES);
        hipOccupancyMaxActiveBlocksPerMultiprocessor(&per_cu, (const void*)fwd_megakernel, 512, LDS_BYTES);
        if (per_cu < 1) per_cu = 1;
        grid_blocks = cus * 1;
        (void)hipGetLastError();
    }
    P p{};
    for (int i = 0; i < 32; ++i) p.in[i] = (const float*)d_in[i];
    p.out = (float*)d_out; p.ws = (unsigned char*)d_ws;
    void* args[] = {&p};
    hipError_t e = hipLaunchCooperativeKernel((const void*)fwd_megakernel, dim3(grid_blocks), dim3(512), args, LDS_BYTES, stream);
    if (e != hipSuccess) fprintf(stderr, "cooperative launch failed: %s (grid %d)\n", hipGetErrorString(e), grid_blocks);
}
```

```cpp
#include <hip/hip_runtime.h>
#include <hip/hip_cooperative_groups.h>
#include <cstdio>
#include <cstdint>
namespace cg = cooperative_groups;

#define LAS __attribute__((address_space(3)))
typedef unsigned short bf16_t;
typedef short bf16x8 __attribute__((ext_vector_type(8)));
typedef float f32x4 __attribute__((ext_vector_type(4)));
typedef float f32x2 __attribute__((ext_vector_type(2)));
typedef unsigned u32x4 __attribute__((ext_vector_type(4)));
typedef unsigned u32x2 __attribute__((ext_vector_type(2)));

constexpr int L = 16640, NCTX = 256, NLAT = 16384, DM = 1024, BW = 512, DEPTH = 4;
constexpr int IN_COLS = 8624;
constexpr int NMAIN = 5888;
constexpr int NWIN = 8960;
constexpr int R_LD = 2048, PG_LD = 3840;
constexpr int GLA_Q = 0, GLA_K = 256, GLA_V = 512, GLA_OG = 1024, GLA_AL = 1536;
constexpr int GDN_QKV = 1568, GDN_ZG = 3104, GDN_A = 3616, GDN_B = 3624;
constexpr int YRW_COL = 1568;

constexpr size_t al256(size_t x) { return (x + 255) & ~(size_t)255; }
constexpr size_t OFF_MOD = 0;
constexpr size_t OFF_H = al256(OFF_MOD + (size_t)4 * 2 * 6144 * 4);
constexpr size_t OFF_HN = OFF_H + (size_t)L * 1024 * 4;
constexpr size_t OFF_WIN = OFF_HN + (size_t)L * 1024 * 2;
constexpr size_t OFF_R = OFF_WIN + (size_t)NWIN * 1024 * 2;
constexpr size_t OFF_PG = OFF_R + (size_t)L * R_LD * 2;
constexpr size_t OFF_B = OFF_PG + (size_t)L * PG_LD * 2;
constexpr size_t OFF_RWG = OFF_B + (size_t)L * 4096 * 2;
constexpr size_t OFF_BONUS = OFF_RWG + (size_t)L * 512 * 2;
constexpr size_t OFF_GLAD = OFF_BONUS + (size_t)L * 8 * 4;
constexpr size_t OFF_GDNC = OFF_GLAD + (size_t)L * 512 * 2;
constexpr size_t OFF_GDNGB = OFF_GDNC + (size_t)L * 1536 * 2;
constexpr size_t WS_END = OFF_GDNGB + (size_t)L * 16 * 4;
constexpr size_t OFF_WBR = OFF_R;
constexpr size_t OFF_WOUT = OFF_WBR + (size_t)3 * 1024 * 512 * 2;
constexpr size_t OFF_W1 = OFF_WOUT + (size_t)1024 * 1024 * 2;
constexpr size_t OFF_W2 = OFF_W1 + (size_t)4096 * 1024 * 2;

constexpr int LDS_BYTES = 131072;

struct P { const float* in[32]; float* out; unsigned char* ws; };
enum { I_X = 0, I_C, I_CTX, I_CCTX, I_WMOD, I_BMOD, I_N1G, I_WIN, I_RWMU, I_RWW0, I_RWW2, I_RWA0, I_RWA2, I_RWG2, I_RWKK, I_RWKA, I_RWRK,
       I_RWLNW, I_RWLNB, I_GLAA2, I_GLAAB, I_GLANG, I_GDNCONV, I_GDNALOG, I_GDNDT, I_GDNNG, I_WBR, I_WOUT, I_N2G, I_W1, I_W2, I_FINALG };

__device__ __forceinline__ float bf2f(bf16_t b) { return __uint_as_float(((unsigned)b) << 16); }
__device__ __forceinline__ unsigned pk2(float lo, float hi) { unsigned r; asm("v_cvt_pk_bf16_f32 %0, %1, %2" : "=v"(r) : "v"(lo), "v"(hi)); return r; }
__device__ __forceinline__ bf16_t f2bf(float f) { return (bf16_t)(pk2(f, 0.f) & 0xffffu); }
__device__ __forceinline__ float sigmoid_(float x) { return 1.f / (1.f + __expf(-x)); }
__device__ __forceinline__ float silu_(float x) { return x / (1.f + __expf(-x)); }
__device__ __forceinline__ float softplus_(float x) { return fmaxf(x, 0.f) + log1pf(__expf(-fabsf(x))); }
__device__ __forceinline__ float wave_sum(float v) {
#pragma unroll
    for (int o = 1; o < 64; o <<= 1) v += __shfl_xor(v, o);
    return v;
}
template <int CTRL> __device__ __forceinline__ float dpp_(float x) { return __int_as_float(__builtin_amdgcn_update_dpp(0, __float_as_int(x), CTRL, 0xF, 0xF, true)); }
__device__ __forceinline__ float reduce8(float x) { x += dpp_<0xB1>(x); x += dpp_<0x4E>(x); x += dpp_<0x141>(x); return x; }
__device__ __forceinline__ float reduce16(float x) { x = reduce8(x); x += dpp_<0x140>(x); return x; }

__device__ __forceinline__ int otid() { int t = threadIdx.x; asm volatile("" : "+v"(t)); return t; }
__device__ __forceinline__ int osgpr(int x) { asm volatile("" : "+s"(x)); return x; }
namespace pg8 {
constexpr int BM = 256, BK = 64, HALF = 128, HTB = HALF * BK * 2, STAGE_BYTES = 8 * HTB, NXCD = 8, WGM = 8;
__host__ __device__ __forceinline__ int lds_byte(int r, int c) { const int st = (r >> 4) * 2 + (c >> 5), rr = r & 15, cc = c & 31, ob = rr * 64 + cc * 2; return st * 1024 + (ob ^ (((ob >> 9) & 1) << 5)); }
__host__ __device__ __forceinline__ void stage_rc(int b, int& R, int& C) { const int st = b / 1024, sb = b % 1024, swz = sb ^ (((sb >> 9) & 1) << 5); R = (st >> 1) * 16 + swz / 64; C = (st & 1) * 32 + (swz % 64) / 2; }
struct Unit { int pm, pn; };
struct Gemm { const bf16_t* A; const bf16_t* Bt; int M, N, K; };
struct StaticOrder {
    int nM, nN, nwg, G, c;
    __host__ __device__ void init(int M, int N, int G_, int c_) { nM = M / BM; nN = N / BM; nwg = nM * nN; G = G_; c = c_; }
    __host__ __device__ bool next(int i, Unit& u) const {
        const long Lx = (long)i * G + c; if (Lx >= nwg) return false;
        int wgid = (int)Lx; { const int q = nwg / NXCD, r = nwg % NXCD, xcd = wgid % NXCD, off = wgid / NXCD; wgid = (xcd < r ? xcd * (q + 1) : r * (q + 1) + (xcd - r) * q) + off; }
        const int nig = WGM * nN, gid = wgid / nig, fm = gid * WGM, gsz = (nM - fm) < WGM ? (nM - fm) : WGM;
        u.pm = fm + ((wgid % nig) % gsz); u.pn = (wgid % nig) / gsz; return true;
    }
};
template <class Epi>
__device__ __forceinline__ void gemm_phase(LAS unsigned char* lds, const Gemm g, const StaticOrder& S, const Epi& E) {
#ifdef NO_GEMM
    return;
#endif
    const int tid = otid(), wid = __builtin_amdgcn_readfirstlane(tid >> 6), lane = tid & 63, wr = wid >> 2, wc = wid & 3, fr = lane & 15, fq = lane >> 4;
    const int K = g.K, nt = K / BK;
    unsigned voffA[2];
#pragma unroll
    for (int i = 0; i < 2; ++i) { int R, C; stage_rc(tid * 16 + i * 8192, R, C); voffA[i] = (unsigned)(R * K + C) * 2u; }
    const size_t kstep = (size_t)(BK * 2);
    const size_t hstep = (size_t)HALF * K * 2;
    const size_t tstep = 2 * hstep;
    const unsigned ldsw = (unsigned)wid * 1024u;
    const int aoff = lds_byte(wr * 64 + fr, fq * 8), boff = lds_byte(wc * 32 + fr, fq * 8);
#define PG8_SA(b, h) (((b) * 2 + (h)) * HTB)
#define PG8_SB(b, h) ((4 + (b) * 2 + (h)) * HTB)
#define PG8_STAGE(bufoff, gbase, voff) do { _Pragma("unroll") for (int _i = 0; _i < 2; ++_i) \
        __builtin_amdgcn_global_load_lds((const unsigned*)((const char*)(gbase) + (voff)[_i]), (LAS unsigned*)(lds + (bufoff) + ldsw + _i * 8192), 16, 0, 0); } while (0)
#define PG8_LDA(dst, b, h) do { _Pragma("unroll") for (int m = 0; m < 4; ++m) _Pragma("unroll") for (int k = 0; k < 2; ++k) dst[m][k] = *(const LAS bf16x8*)(lds + PG8_SA(b, h) + aoff + m * 2048 + k * 1024); } while (0)
#define PG8_LDB(dst, b, h) do { _Pragma("unroll") for (int n = 0; n < 2; ++n) _Pragma("unroll") for (int k = 0; k < 2; ++k) dst[n][k] = *(const LAS bf16x8*)(lds + PG8_SB(b, h) + boff + n * 2048 + k * 1024); } while (0)
#define PG8_MMA(ai, bj, At, Bt) do { __builtin_amdgcn_s_setprio(1); _Pragma("unroll") for (int m = 0; m < 4; ++m) _Pragma("unroll") for (int n = 0; n < 2; ++n) _Pragma("unroll") for (int k = 0; k < 2; ++k) \
        acc[ai][bj][m][n] = __builtin_amdgcn_mfma_f32_16x16x32_bf16(Bt[n][k], At[m][k], acc[ai][bj][m][n], 0, 0, 0); __builtin_amdgcn_s_setprio(0); } while (0)
#define PG8_WAIT_V(n) asm volatile("s_waitcnt vmcnt(" #n ")" ::: "memory")
#define PG8_WAIT_L(n) asm volatile("s_waitcnt lgkmcnt(" #n ")" ::: "memory")
#define PG8_BAR __builtin_amdgcn_s_barrier()
#define PG8_SCHED __builtin_amdgcn_sched_barrier(0)
    Unit cur, nxt; int ui = 0;
    if (!S.next(0, cur)) return;
    f32x4 acc[2][2][4][2];
#pragma unroll
    for (int a = 0; a < 2; ++a)
#pragma unroll
        for (int b = 0; b < 2; ++b)
#pragma unroll
            for (int m = 0; m < 4; ++m)
#pragma unroll
                for (int n = 0; n < 2; ++n) acc[a][b][m][n] = (f32x4){0.f, 0.f, 0.f, 0.f};
    bf16x8 At[4][2], B0[2][2], B1[2][2];
    const char* cA = (const char*)g.A + (size_t)cur.pm * tstep; const char* cB = (const char*)g.Bt + (size_t)cur.pn * tstep;
    PG8_STAGE(PG8_SB(0, 0), cB, voffA); PG8_STAGE(PG8_SA(0, 0), cA, voffA); PG8_STAGE(PG8_SB(0, 1), cB + hstep, voffA); PG8_STAGE(PG8_SA(0, 1), cA + hstep, voffA);
    if (wr == 1) PG8_BAR;
    PG8_WAIT_V(4); PG8_BAR;
    PG8_STAGE(PG8_SB(1, 0), cB + kstep, voffA); PG8_STAGE(PG8_SA(1, 0), cA + kstep, voffA); PG8_STAGE(PG8_SB(1, 1), cB + hstep + kstep, voffA);
    PG8_WAIT_V(6); PG8_BAR;
    for (;;) {
        const bool has_next = S.next(ui + 1, nxt);
        const char* nA = has_next ? (const char*)g.A + (size_t)nxt.pm * tstep : cA; const char* nB = has_next ? (const char*)g.Bt + (size_t)nxt.pn * tstep : cB;
        for (int t = 0; t < nt; t += 2) {
            const bool last = (t == nt - 2);
            const char* a1 = cA + (size_t)(t + 1) * kstep;
            const char* a2 = last ? nA : cA + (size_t)(t + 2) * kstep; const char* b2 = last ? nB : cB + (size_t)(t + 2) * kstep;
            const char* a3 = a2 + kstep; const char* b3 = b2 + kstep;
            PG8_LDB(B0, 0, 0); PG8_SCHED; PG8_LDA(At, 0, 0); PG8_STAGE(PG8_SA(1, 1), a1 + hstep, voffA);
            PG8_WAIT_L(8); PG8_BAR; PG8_WAIT_L(0); PG8_MMA(0, 0, At, B0); PG8_BAR; PG8_SCHED;
            PG8_LDB(B1, 0, 1); PG8_STAGE(PG8_SB(0, 0), b2, voffA);
            PG8_BAR; PG8_WAIT_L(0); PG8_MMA(0, 1, At, B1); PG8_BAR;
            PG8_LDA(At, 0, 1); PG8_STAGE(PG8_SA(0, 0), a2, voffA);
            PG8_BAR; PG8_WAIT_L(0); PG8_MMA(1, 0, At, B0); PG8_BAR; PG8_SCHED;
            PG8_STAGE(PG8_SB(0, 1), b2 + hstep, voffA);
            PG8_WAIT_V(6); PG8_BAR; PG8_MMA(1, 1, At, B1); PG8_BAR;
            PG8_LDB(B0, 1, 0); PG8_SCHED; PG8_LDA(At, 1, 0); PG8_STAGE(PG8_SA(0, 1), a2 + hstep, voffA);
            PG8_WAIT_L(8); PG8_BAR; PG8_WAIT_L(0); PG8_MMA(0, 0, At, B0); PG8_BAR; PG8_SCHED;
            PG8_LDB(B1, 1, 1); PG8_STAGE(PG8_SB(1, 0), b3, voffA);
            PG8_BAR; PG8_WAIT_L(0); PG8_MMA(0, 1, At, B1); PG8_BAR;
            PG8_LDA(At, 1, 1); PG8_STAGE(PG8_SA(1, 0), a3, voffA);
            PG8_BAR; PG8_WAIT_L(0); PG8_MMA(1, 0, At, B0); PG8_BAR; PG8_SCHED;
            PG8_STAGE(PG8_SB(1, 1), b3 + hstep, voffA);
            PG8_WAIT_V(6); PG8_BAR; PG8_MMA(1, 1, At, B1); PG8_BAR;
        }
        E(acc, cur, wr, wc, fr, fq);
        if (!has_next) break;
#pragma unroll
        for (int a = 0; a < 2; ++a)
#pragma unroll
            for (int b = 0; b < 2; ++b)
#pragma unroll
                for (int m = 0; m < 4; ++m)
#pragma unroll
                    for (int n = 0; n < 2; ++n) acc[a][b][m][n] = (f32x4){0.f, 0.f, 0.f, 0.f};
        cur = nxt; cA = nA; cB = nB; ++ui;
    }
    PG8_WAIT_V(0);
    if (wr == 0) PG8_BAR;
    PG8_BAR;
#undef PG8_SA
#undef PG8_SB
#undef PG8_STAGE
#undef PG8_LDA
#undef PG8_LDB
#undef PG8_MMA
#undef PG8_WAIT_V
#undef PG8_WAIT_L
#undef PG8_BAR
#undef PG8_SCHED
}
}
using pg8::Unit;

#define EPI_LOOP_ROWS for (int ai = 0; ai < 2; ++ai) for (int m = 0; m < 4; ++m)
#define EPI_LOOP_COLS for (int bj = 0; bj < 2; ++bj) for (int n = 0; n < 2; ++n)
struct EpiInMain {
    bf16_t* R; bf16_t* PG;
    __device__ __forceinline__ void operator()(const f32x4 (&acc)[2][2][4][2], const Unit& u, int wr, int wc, int fr, int fq) const {
        bf16_t* dst; int ld, c0;
        if (u.pn < 8) { dst = R; ld = R_LD; c0 = u.pn * 256; } else { dst = PG; ld = PG_LD; c0 = (u.pn - 8) * 256; }
        const int row0 = u.pm * 256 + wr * 64 + fr, col0 = c0 + wc * 32 + 4 * fq;
#pragma unroll
        EPI_LOOP_ROWS { bf16_t* rowp = dst + (size_t)(row0 + ai * 128 + m * 16) * ld + col0;
#pragma unroll
            EPI_LOOP_COLS { const f32x4 v = acc[ai][bj][m][n]; *(u32x2*)(rowp + bj * 128 + n * 16) = (u32x2){pk2(v[0], v[1]), pk2(v[2], v[3])}; } }
    }
};
struct EpiGates {
    bf16_t* G;
    __device__ __forceinline__ void operator()(const f32x4 (&acc)[2][2][4][2], const Unit& u, int wr, int wc, int fr, int fq) const {
        const int row0 = u.pm * 256 + wr * 64 + fr, col0 = u.pn * 256 + wc * 32 + 4 * fq;
#pragma unroll
        EPI_LOOP_ROWS { bf16_t* rowp = G + (size_t)(row0 + ai * 128 + m * 16) * 3072 + col0;
#pragma unroll
            EPI_LOOP_COLS { const f32x4 v = acc[ai][bj][m][n];
                *(u32x2*)(rowp + bj * 128 + n * 16) = (u32x2){pk2(sigmoid_(v[0]), sigmoid_(v[1])), pk2(sigmoid_(v[2]), sigmoid_(v[3]))}; } }
    }
};
template <int GI> struct EpiBranch {
    const bf16_t* G; float* MG; bf16_t* MB;
    __device__ __forceinline__ void operator()(const f32x4 (&acc)[2][2][4][2], const Unit& u, int wr, int wc, int fr, int fq) const {
        const int row0 = u.pm * 256 + wr * 64 + fr, col0 = u.pn * 256 + wc * 32 + 4 * fq;
#pragma unroll
        EPI_LOOP_ROWS { const size_t row = (size_t)(row0 + ai * 128 + m * 16);
#pragma unroll
            EPI_LOOP_COLS { const int col = col0 + bj * 128 + n * 16; const f32x4 v = acc[ai][bj][m][n];
                const u32x2 gq = *(const u32x2*)(G + row * 3072 + GI * 1024 + col);
                f32x4 gv = (f32x4){__uint_as_float(gq[0] << 16), __uint_as_float(gq[0] & 0xffff0000u), __uint_as_float(gq[1] << 16), __uint_as_float(gq[1] & 0xffff0000u)};
                f32x4 r = v * gv;
                if (GI > 0) r += *(const f32x4*)(MG + row * 1024 + col);
                if (GI < 2) *(f32x4*)(MG + row * 1024 + col) = r;
                else *(u32x2*)(MB + row * 1024 + col) = (u32x2){pk2(r[0], r[1]), pk2(r[2], r[3])}; } }
    }
};
struct EpiResid {
    float* H; const float* gate_lat; const float* gate_ctx;
    __device__ __forceinline__ void operator()(const f32x4 (&acc)[2][2][4][2], const Unit& u, int wr, int wc, int fr, int fq) const {
        const int row0 = u.pm * 256 + wr * 64 + fr, col0 = u.pn * 256 + wc * 32 + 4 * fq;
        const float* gp = (u.pm == 0) ? gate_ctx : gate_lat;
        f32x4 gv[2][2];
#pragma unroll
        EPI_LOOP_COLS gv[bj][n] = *(const f32x4*)(gp + col0 + bj * 128 + n * 16);
#pragma unroll
        EPI_LOOP_ROWS { float* rowp = H + (size_t)(row0 + ai * 128 + m * 16) * 1024 + col0;
#pragma unroll
            EPI_LOOP_COLS { f32x4* q = (f32x4*)(rowp + bj * 128 + n * 16); *q = *q + acc[ai][bj][m][n] * gv[bj][n]; } }
    }
};
struct EpiMlp1 {
    bf16_t* U;
    __device__ __forceinline__ void operator()(const f32x4 (&acc)[2][2][4][2], const Unit& u, int wr, int wc, int fr, int fq) const {
        const int row0 = u.pm * 256 + wr * 64 + fr, col0 = u.pn * 256 + wc * 32 + 4 * fq;
#pragma unroll
        EPI_LOOP_ROWS { bf16_t* rowp = U + (size_t)(row0 + ai * 128 + m * 16) * 4096 + col0;
#pragma unroll
            EPI_LOOP_COLS { f32x4 v = acc[ai][bj][m][n];
#pragma unroll
                for (int j = 0; j < 4; ++j) { const float t = fmaxf(v[j], 0.f); v[j] = t * t; }
                *(u32x2*)(rowp + bj * 128 + n * 16) = (u32x2){pk2(v[0], v[1]), pk2(v[2], v[3])}; } }
    }
};

__device__ __forceinline__ void convert_T(const float* src, int ld, int K, int n0, int ncols, bf16_t* dst, LAS float* tile, int wg, int nwg) {
    const int ntn = (ncols + 63) >> 6, ntk = K >> 6, tid = otid();
    for (int t = wg; t < ntn * ntk; t += nwg) {
        const int tn = t / ntk, tk = t - tn * ntk, k0 = tk * 64, nb = tn * 64;
#pragma unroll
        for (int i = 0; i < 2; ++i) { const int idx = tid + i * 512, kk = idx >> 4, n4 = (idx & 15) * 4;
            f32x4 v = (f32x4){0.f, 0.f, 0.f, 0.f};
            if (nb + n4 < ncols) v = *(const f32x4*)(src + (size_t)(k0 + kk) * ld + n0 + nb + n4);
            tile[kk * 65 + n4 + 0] = v[0]; tile[kk * 65 + n4 + 1] = v[1]; tile[kk * 65 + n4 + 2] = v[2]; tile[kk * 65 + n4 + 3] = v[3]; }
        __syncthreads();
        { const int nn = tid >> 3, k8 = (tid & 7) * 8;
          if (nb + nn < ncols) { const LAS float* s = tile + k8 * 65 + nn;
              u32x4 o; o[0] = pk2(s[0], s[65]); o[1] = pk2(s[130], s[195]); o[2] = pk2(s[260], s[325]); o[3] = pk2(s[390], s[455]);
              *(u32x4*)(dst + (size_t)(nb + nn) * K + k0 + k8) = o; } }
        __syncthreads();
    }
}

__device__ __forceinline__ void phase_mod(const P& p, LAS unsigned char* lds) {
    const float* c = p.in[I_C]; const float* cc = p.in[I_CCTX]; const float* wm = p.in[I_WMOD]; const float* bm = p.in[I_BMOD];
    float* MOD = (float*)(p.ws + OFF_MOD);
    LAS float* red = (LAS float*)lds;
    const int tid = otid();
    for (int blk = blockIdx.x; blk < 256; blk += gridDim.x) {
        const int l = blk >> 6, col0 = (blk & 63) * 96;
        if (tid < 384) {
            const int cgp = tid % 24, ks = tid / 24;
            f32x4 a0 = (f32x4){0.f, 0.f, 0.f, 0.f}, a1 = a0;
            const float* w = wm + (size_t)l * 1024 * 6144 + col0 + cgp * 4;
#pragma unroll 8
            for (int k = ks * 64; k < ks * 64 + 64; ++k) {
                const f32x4 wv = *(const f32x4*)(w + (size_t)k * 6144);
                const float s0 = silu_(c[k]), s1 = silu_(cc[k]);
                a0 += wv * s0; a1 += wv * s1;
            }
            LAS f32x4* r4 = (LAS f32x4*)red;
            r4[(ks * 24 + cgp) * 2 + 0] = a0; r4[(ks * 24 + cgp) * 2 + 1] = a1;
        }
        __syncthreads();
        if (tid < 192) {
            const int col = tid % 96, s = tid / 96;
            float sum = 0.f;
#pragma unroll
            for (int k2 = 0; k2 < 16; ++k2) sum += red[((k2 * 24 + (col >> 2)) * 2 + s) * 4 + (col & 3)];
            MOD[((size_t)l * 2 + s) * 6144 + col0 + col] = sum + bm[l * 6144 + col0 + col];
        }
        __syncthreads();
    }
}

template <bool FROM_INPUT>
__device__ __forceinline__ void phase_norm(const P& p, int l, const float* gamma, int shift_idx, int scale_idx) {
    float* H = (float*)(p.ws + OFF_H); bf16_t* HN = (bf16_t*)(p.ws + OFF_HN);
    const float* MOD = (const float*)(p.ws + OFF_MOD) + (size_t)l * 2 * 6144;
    const int tid_ = otid(); const int wave = tid_ >> 6, lane = tid_ & 63;
    for (int row = blockIdx.x * 8 + wave; row < L; row += gridDim.x * 8) {
        const float* src = FROM_INPUT ? (row < NCTX ? p.in[I_CTX] + (size_t)row * 1024 : p.in[I_X] + (size_t)(row - NCTX) * 1024) : H + (size_t)row * 1024;
        f32x4 v[4]; float ss = 0.f;
#pragma unroll
        for (int j = 0; j < 4; ++j) { v[j] = *(const f32x4*)(src + j * 256 + lane * 4); ss += (v[j][0] * v[j][0] + v[j][1] * v[j][1]) + (v[j][2] * v[j][2] + v[j][3] * v[j][3]); }
        ss = wave_sum(ss);
        const float rstd = rsqrtf(ss * (1.f / 1024.f) + 1e-6f);
        const float* m = MOD + (row < NCTX ? 6144 : 0);
#pragma unroll
        for (int j = 0; j < 4; ++j) { const int col = j * 256 + lane * 4;
            const f32x4 g = *(const f32x4*)(gamma + col), sh = *(const f32x4*)(m + shift_idx * 1024 + col), sc = *(const f32x4*)(m + scale_idx * 1024 + col);
            const f32x4 o = v[j] * rstd * g * (sc + 1.f) + sh;
            *(u32x2*)(HN + (size_t)row * 1024 + col) = (u32x2){pk2(o[0], o[1]), pk2(o[2], o[3])};
            if (FROM_INPUT) *(f32x4*)(H + (size_t)row * 1024 + col) = v[j]; }
    }
}

constexpr int TT = 13;
__device__ __forceinline__ float rw_shift(const bf16_t* R, int t, int c, float m0, float m1) {
    const float cur = bf2f(R[(size_t)t * R_LD + c]);
    const float pv = (t != 0 && t != NCTX) ? bf2f(R[(size_t)(t - 1) * R_LD + c]) : 0.f;
    const float nv = (t != NCTX - 1 && t != L - 1) ? bf2f(R[(size_t)(t + 1) * R_LD + c]) : 0.f;
    return m0 * pv + (1.f - m0 - m1) * cur + m1 * nv;
}
__device__ __forceinline__ void phase_prep(const P& p, int l, LAS unsigned char* lds) {
    const bf16_t* R = (const bf16_t*)(p.ws + OFF_R); const bf16_t* PG = (const bf16_t*)(p.ws + OFF_PG);
    bf16_t* B = (bf16_t*)(p.ws + OFF_B); bf16_t* RWG = (bf16_t*)(p.ws + OFF_RWG); float* BONUS = (float*)(p.ws + OFF_BONUS);
    bf16_t* GLAD = (bf16_t*)(p.ws + OFF_GLAD); bf16_t* GDNC = (bf16_t*)(p.ws + OFF_GDNC); float* GDNGB = (float*)(p.ws + OFF_GDNGB);
    const float* mu = p.in[I_RWMU] + (size_t)l * 2 * 1920;
    const float* w0 = p.in[I_RWW0] + (size_t)l * 1024; const float* w2 = p.in[I_RWW2] + (size_t)l * 2 * 64 * 512;
    const float* a0 = p.in[I_RWA0] + (size_t)l * 1024; const float* a2 = p.in[I_RWA2] + (size_t)l * 2 * 64 * 512;
    const float* g2 = p.in[I_RWG2] + (size_t)l * 128 * 512;
    const float* kkw = p.in[I_RWKK] + l * 512; const float* kaw = p.in[I_RWKA] + l * 512; const float* rkw = p.in[I_RWRK] + l * 512;
    const float* ga2 = p.in[I_GLAA2] + (size_t)l * 2 * 16 * 256; const float* gab = p.in[I_GLAAB] + l * 512;
    const float* cw = p.in[I_GDNCONV] + (size_t)l * 5 * 1536; const float* alog = p.in[I_GDNALOG] + l * 8; const float* dtb = p.in[I_GDNDT] + l * 8;
    LAS float* xs = (LAS float*)lds;
    LAS float* gal = xs + 384 * 16;
    LAS float* red = gal + TT * 32;
    const int tid = otid(), wave = tid >> 6;
    const int c = tid;
    const int gz = tid >> 8, gk = tid & 255;
    for (int tile = blockIdx.x; tile < L / TT; tile += gridDim.x) {
        const int t0 = tile * TT;
#pragma unroll 2
        for (int i = 0; i < 10; ++i) { const int idx = tid + i * 512;
            if (idx < TT * 384) { const int tt = idx / 384, e = idx - tt * 384, col = 1536 + e;
                float v = rw_shift(R, t0 + tt, col, mu[col], mu[1920 + col]);
                if (e < 128) v = tanhf(v); else if (e >= 256) v = sigmoid_(v);
                xs[e * 16 + tt] = v; } }
        if (tid < TT * 32) { const int tt = tid >> 5, e = tid & 31; gal[tt * 32 + e] = bf2f(PG[(size_t)(t0 + tt) * PG_LD + GLA_AL + e]); }
        __syncthreads();
        {
            float aw0[TT], aw1[TT];
#pragma unroll
            for (int tt = 0; tt < TT; ++tt) { aw0[tt] = 0.f; aw1[tt] = 0.f; }
#pragma unroll 1
            for (int e = 0; e < 64; ++e) {
                const float q0 = w2[e * 512 + c], q1 = w2[(64 + e) * 512 + c];
                float x0[16], x1[16];
#pragma unroll
                for (int j = 0; j < 4; ++j) { *(f32x4*)(x0 + 4 * j) = *(const LAS f32x4*)(xs + e * 16 + 4 * j); *(f32x4*)(x1 + 4 * j) = *(const LAS f32x4*)(xs + (64 + e) * 16 + 4 * j); }
#pragma unroll
                for (int tt = 0; tt < TT; ++tt) { aw0[tt] += x0[tt] * q0; aw1[tt] += x1[tt] * q1; }
            }
            const float w00 = w0[c], w01 = w0[512 + c];
#pragma unroll
            for (int tt = 0; tt < TT; ++tt) {
                const float wz0 = -softplus_(-(w00 + aw0[tt])) - 0.5f, wz1 = -softplus_(-(w01 + aw1[tt])) - 0.5f;
                bf16_t* bp = B + (size_t)(t0 + tt) * 4096 + c;
                bp[3072] = f2bf(-expm1f(-__expf(wz0))); bp[3584] = f2bf(-expm1f(-__expf(wz1)));
            }
        }
        {
            float ag[TT];
#pragma unroll
            for (int tt = 0; tt < TT; ++tt) ag[tt] = 0.f;
#pragma unroll 1
            for (int e = 0; e < 128; ++e) {
                const float q0 = g2[e * 512 + c];
                float x0[16];
#pragma unroll
                for (int j = 0; j < 4; ++j) *(f32x4*)(x0 + 4 * j) = *(const LAS f32x4*)(xs + (256 + e) * 16 + 4 * j);
#pragma unroll
                for (int tt = 0; tt < TT; ++tt) ag[tt] += x0[tt] * q0;
            }
#pragma unroll
            for (int tt = 0; tt < TT; ++tt) RWG[(size_t)(t0 + tt) * 512 + c] = f2bf(ag[tt]);
        }
        {
            float aa0[TT], aa1[TT];
#pragma unroll
            for (int tt = 0; tt < TT; ++tt) { aa0[tt] = 0.f; aa1[tt] = 0.f; }
#pragma unroll 1
            for (int e = 0; e < 64; ++e) {
                const float q2 = a2[e * 512 + c], q3 = a2[(64 + e) * 512 + c];
                float x2[16], x3[16];
#pragma unroll
                for (int j = 0; j < 4; ++j) { *(f32x4*)(x2 + 4 * j) = *(const LAS f32x4*)(xs + (128 + e) * 16 + 4 * j); *(f32x4*)(x3 + 4 * j) = *(const LAS f32x4*)(xs + (192 + e) * 16 + 4 * j); }
#pragma unroll
                for (int tt = 0; tt < TT; ++tt) { aa0[tt] += x2[tt] * q2; aa1[tt] += x3[tt] * q3; }
            }
            const float mr0 = mu[c], mr1 = mu[1920 + c], mk0 = mu[512 + c], mk1 = mu[1920 + 512 + c], mv0 = mu[1024 + c], mv1 = mu[1920 + 1024 + c];
            const float a00 = a0[c], a01 = a0[512 + c], kkc = kkw[c], kac = kaw[c], rkc = rkw[c];
#pragma unroll
            for (int tt = 0; tt < TT; ++tt) {
                const int t = t0 + tt;
                const float r = rw_shift(R, t, c, mr0, mr1), k = rw_shift(R, t, 512 + c, mk0, mk1), v = rw_shift(R, t, 1024 + c, mv0, mv1);
                const float az0 = sigmoid_(a00 + aa0[tt]), az1 = sigmoid_(a01 + aa1[tt]);
                const float kr = k * kkc;
                const float ssq = wave_sum(kr * kr);
                const float kk = kr * rsqrtf(ssq + 1e-12f);
                const float kd = k * (1.f + (az0 - 1.f) * kac) + k * (1.f + (az1 - 1.f) * kac);
                const float bon = wave_sum(r * rkc * kd);
                bf16_t* bp = B + (size_t)t * 4096 + c;
                bp[0] = f2bf(r); bp[512] = f2bf(k); bp[1024] = f2bf(v); bp[1536] = f2bf(kk); bp[2048] = f2bf(az0); bp[2560] = f2bf(az1);
                if ((tid & 63) == 0) BONUS[t * 8 + wave] = bon;
                asm volatile("" ::: "memory");
            }
        }
        {
        float ga2v[16];
#pragma unroll
        for (int e = 0; e < 16; ++e) ga2v[e] = ga2[(gz * 16 + e) * 256 + gk];
        const float gabv = gab[gz * 256 + gk];
#pragma unroll
        for (int tt = 0; tt < TT; ++tt) {
            float zv = gabv;
#pragma unroll
            for (int e = 0; e < 16; ++e) zv += gal[tt * 32 + gz * 16 + e] * ga2v[e];
            const float la = -softplus_(-zv) * (1.f / 16.f);
            GLAD[(size_t)(t0 + tt) * 512 + tid] = f2bf(-expm1f(la));
            asm volatile("" ::: "memory");
        }
        }
        {
            float cwv[5], xv[TT + 4];
#pragma unroll
            for (int i = 0; i < 5; ++i) cwv[i] = cw[i * 1536 + 1024 + c];
#pragma unroll
            for (int i = 0; i < TT + 4; ++i) { const int rr = t0 - 2 + i; xv[i] = (rr >= 0 && rr < L) ? bf2f(PG[(size_t)rr * PG_LD + GDN_QKV + 1024 + c]) : 0.f; }
#pragma unroll
            for (int tt = 0; tt < TT; ++tt) { const int t = t0 + tt; float sv = 0.f;
#pragma unroll
                for (int i = 0; i < 5; ++i) { const int rr = t + i - 2; const bool ok_ = (rr >= 0) && (rr < L) && ((rr < NCTX) == (t < NCTX)); if (ok_) sv += xv[tt + i] * cwv[i]; }
                GDNC[(size_t)t * 1536 + 1024 + c] = f2bf(silu_(sv)); }
        }
        float oq[TT], ok[TT];
        {
            float cwq[5], cwk[5], xq[TT + 4], xk[TT + 4];
#pragma unroll
            for (int i = 0; i < 5; ++i) { cwq[i] = cw[i * 1536 + c]; cwk[i] = cw[i * 1536 + 512 + c]; }
#pragma unroll
            for (int i = 0; i < TT + 4; ++i) { const int rr = t0 - 2 + i;
                if (rr >= 0 && rr < L) { const bf16_t* rp = PG + (size_t)rr * PG_LD + GDN_QKV + c; xq[i] = bf2f(rp[0]); xk[i] = bf2f(rp[512]); } else { xq[i] = 0.f; xk[i] = 0.f; } }
#pragma unroll
            for (int tt = 0; tt < TT; ++tt) {
                const int t = t0 + tt; float sq = 0.f, sk = 0.f;
#pragma unroll
                for (int i = 0; i < 5; ++i) { const int rr = t + i - 2; const bool ok_ = (rr >= 0) && (rr < L) && ((rr < NCTX) == (t < NCTX));
                    if (ok_) { sq += xq[tt + i] * cwq[i]; sk += xk[tt + i] * cwk[i]; } }
                oq[tt] = silu_(sq); ok[tt] = silu_(sk);
                const float pq = wave_sum(oq[tt] * oq[tt]), pk = wave_sum(ok[tt] * ok[tt]);
                if ((tid & 63) == 0) { red[(tt * 8 + wave) * 2 + 0] = pq; red[(tt * 8 + wave) * 2 + 1] = pk; }
            }
        }
        __syncthreads();
#pragma unroll
        for (int tt = 0; tt < TT; ++tt) {
            const int w0i = (wave >> 1) * 2;
            const float ssq = red[(tt * 8 + w0i) * 2 + 0] + red[(tt * 8 + w0i + 1) * 2 + 0], ssk = red[(tt * 8 + w0i) * 2 + 1] + red[(tt * 8 + w0i + 1) * 2 + 1];
            bf16_t* gp = GDNC + (size_t)(t0 + tt) * 1536 + c;
            gp[0] = f2bf(oq[tt] * rsqrtf(ssq + 1e-12f) * 0.08838834764831845f); gp[512] = f2bf(ok[tt] * rsqrtf(ssk + 1e-12f));
        }
        if (tid < TT * 16) { const int tt = tid >> 4, j = tid & 15, t = t0 + tt;
            float o;
            if (j < 8) { const float a = bf2f(PG[(size_t)t * PG_LD + GDN_A + j]); o = __expf(-__expf(alog[j]) * softplus_(a + dtb[j])); }
            else o = sigmoid_(bf2f(PG[(size_t)t * PG_LD + GDN_B + (j - 8)]));
            GDNGB[t * 16 + j] = o; }
        __syncthreads();
    }
}

constexpr int TB = 32, NBLK = L / TB;
__device__ __forceinline__ int tok_seq(int z, int j) { return z == 0 ? j : (j < NCTX ? NCTX - 1 - j : L - 1 - (j - NCTX)); }
__device__ __forceinline__ int tok_gla(int z, int j) {
    if (j < NCTX) return z == 0 ? j : NCTX - 1 - j;
    const int jj = j - NCTX, pp = z == 0 ? jj : NLAT - 1 - jj;
    return NCTX + (pp & 255) * 64 + (pp >> 8);
}

template <int NCW> struct ScanRole {
    bool cons, prod; int ct;
    __device__ __forceinline__ ScanRole(int tid) {
        const int w = tid >> 6, lane = tid & 63;
        if (NCW == 4) { cons = w < 4; prod = !cons; ct = tid & 255; }
        else { cons = w < 2; prod = (w & 2) != 0; ct = cons ? tid : ((((w >> 2) << 1) | (w & 1)) * 64 + lane); }
    }
};
#define SCAN_BARRIER() asm volatile("s_waitcnt lgkmcnt(0)\n\ts_barrier" ::: "memory")
__device__ __forceinline__ float bfraw2f(unsigned short b) { return __uint_as_float(((unsigned)b) << 16); }

__device__ __forceinline__ void scan_rwkv(const P& p, int l, int unit, LAS unsigned char* lds) {
    const int z = unit >> 6, h = (unit >> 3) & 7, rq = unit & 7;
    const bf16_t* B = (const bf16_t*)(p.ws + OFF_B); bf16_t* Y = (bf16_t*)(p.ws + OFF_PG) + YRW_COL + z * 512 + h * 64 + rq * 8;
    const float* kaw = p.in[I_RWKA] + l * 512 + h * 64;
    LAS float* vec = (LAS float*)lds;
    LAS float* vv = vec + 2 * TB * 320;
    LAS float* yo = vv + 2 * TB * 8;
    const int tid = otid(); const ScanRole<2> role(tid); const int ct = role.ct; const bool prod = role.prod, cons = role.cons;
    unsigned short pr[8], pk[8], pkk[8], pa[8], pw[8], pv;
    const float kac = kaw[ct & 63];
    auto p_load = [&](int blk) {
#pragma unroll
        for (int i = 0; i < 8; ++i) { const int idx = ct + i * 256, s = idx >> 6, n = idx & 63; const int t = tok_seq(z, blk * TB + s);
            const bf16_t* bp = B + (size_t)t * 4096 + h * 64 + n;
            pr[i] = bp[0]; pk[i] = bp[512]; pkk[i] = bp[1536]; pa[i] = bp[2048 + z * 512]; pw[i] = bp[3072 + z * 512]; }
        { const int s = ct >> 3, r = ct & 7; const int t = tok_seq(z, blk * TB + s); pv = B[(size_t)t * 4096 + 1024 + h * 64 + rq * 8 + r]; }
    };
    auto p_write = [&](int buf) {
#pragma unroll
        for (int i = 0; i < 8; ++i) { const int idx = ct + i * 256, s = idx >> 6, n = idx & 63;
            LAS float* d = vec + ((buf * TB + s) * 16 + (n >> 2)) * 20 + (n & 3);
            const float kk = bfraw2f(pkk[i]), a = bfraw2f(pa[i]);
            d[0] = kk; d[4] = 1.f - bfraw2f(pw[i]); d[8] = kk * a; d[12] = bfraw2f(pk[i]) * (1.f + (a - 1.f) * kac); d[16] = bfraw2f(pr[i]); }
        vv[buf * TB * 8 + ct] = bfraw2f(pv);
    };
    auto p_yout = [&](int blk) {
        const int buf = blk & 1; const int s = ct >> 3, r = ct & 7; const int t = tok_seq(z, blk * TB + s);
        Y[(size_t)t * PG_LD + r] = f2bf(yo[buf * TB * 8 + ct]);
    };
    const int irow = (ct >> 4) & 7, ks = ct & 15;
    f32x2 S0 = (f32x2){0.f, 0.f}, S1 = S0;
    struct Vx { f32x4 kk, w, b, k, r; float v; };
    auto c_ld = [&](Vx& x, int buf, int s) {
        const LAS float* d = vec + ((buf * TB + s) * 16 + ks) * 20;
        x.kk = *(const LAS f32x4*)(d); x.w = *(const LAS f32x4*)(d + 4); x.b = *(const LAS f32x4*)(d + 8); x.k = *(const LAS f32x4*)(d + 12);
        x.r = *(const LAS f32x4*)(d + 16); x.v = vv[(buf * TB + s) * 8 + irow];
    };
    float sa = 0.f;
    auto c_step = [&](const Vx& x, const f32x4& kkn, int buf, int s) {
        const f32x2 vv2 = (f32x2){x.v, x.v}, nsa = (f32x2){-sa, -sa};
        S0 = S0 * (f32x2){x.w[0], x.w[1]} + (vv2 * (f32x2){x.k[0], x.k[1]} + nsa * (f32x2){x.b[0], x.b[1]});
        S1 = S1 * (f32x2){x.w[2], x.w[3]} + (vv2 * (f32x2){x.k[2], x.k[3]} + nsa * (f32x2){x.b[2], x.b[3]});
        const f32x2 y2 = S0 * (f32x2){x.r[0], x.r[1]} + S1 * (f32x2){x.r[2], x.r[3]};
        const f32x2 s2 = S0 * (f32x2){kkn[0], kkn[1]} + S1 * (f32x2){kkn[2], kkn[3]};
        float yp = y2[0] + y2[1], sp = s2[0] + s2[1];
        yp += dpp_<0xB1>(yp); sp += dpp_<0xB1>(sp); yp += dpp_<0x4E>(yp); sp += dpp_<0x4E>(sp);
        yp += dpp_<0x141>(yp); sp += dpp_<0x141>(sp); yp += dpp_<0x140>(yp); sp += dpp_<0x140>(sp);
        sa = sp;
        if (ks == 0) yo[(buf * TB + s) * 8 + irow] = yp;
    };
    if (prod) { p_load(0); p_write(0); p_load(1); }
    SCAN_BARRIER();
    for (int b = 0; b < NBLK; ++b) {
        if (prod) {
            if (b + 1 < NBLK) p_write((b + 1) & 1);
            if (b + 2 < NBLK) p_load(b + 2);
            if (b > 0) p_yout(b - 1);
        } else if (cons) {
            const int buf = b & 1;
            Vx xa, xb;
            c_ld(xa, buf, 0);
            { const f32x2 s2 = S0 * (f32x2){xa.kk[0], xa.kk[1]} + S1 * (f32x2){xa.kk[2], xa.kk[3]}; sa = reduce16(s2[0] + s2[1]); }
#pragma unroll 1
            for (int s = 0; s < TB; s += 2) {
                c_ld(xb, buf, s + 1); c_step(xa, xb.kk, buf, s);
                if (s + 2 < TB) c_ld(xa, buf, s + 2);
                c_step(xb, xa.kk, buf, s + 1);
            }
        }
        SCAN_BARRIER();
    }
    if (prod) p_yout(NBLK - 1);
    SCAN_BARRIER();
}

__device__ __forceinline__ void scan_gla(const P& p, int l, int unit, LAS unsigned char* lds) {
    const int z = unit >> 4, h = (unit >> 2) & 3, cb = unit & 3;
    const bf16_t* PG = (const bf16_t*)(p.ws + OFF_PG); const bf16_t* GLAD = (const bf16_t*)(p.ws + OFF_GLAD);
    bf16_t* O = (bf16_t*)(p.ws + OFF_R) + z * 512 + h * 128 + cb * 32;
    LAS float* vec = (LAS float*)lds;
    LAS float* vv = vec + 2 * TB * 192;
    LAS float* yo = vv + 2 * TB * 32;
    const int tid = otid(); const ScanRole<4> role(tid); const int ct = role.ct; const bool prod = role.prod, cons = role.cons;
    unsigned short pq[8], pk[8], pa[8], pv[4];
    auto p_load = [&](int blk) {
#pragma unroll
        for (int i = 0; i < 8; ++i) { const int idx = ct + i * 256, s = idx >> 6, n = idx & 63; const int t = tok_gla(z, blk * TB + s);
            const bf16_t* bp = PG + (size_t)t * PG_LD + h * 64 + n;
            pq[i] = bp[GLA_Q]; pk[i] = bp[GLA_K]; pa[i] = GLAD[(size_t)t * 512 + z * 256 + h * 64 + n]; }
#pragma unroll
        for (int i = 0; i < 4; ++i) { const int idx = ct + i * 256, s = idx >> 5, r = idx & 31; const int t = tok_gla(z, blk * TB + s);
            pv[i] = PG[(size_t)t * PG_LD + GLA_V + h * 128 + cb * 32 + r]; }
    };
    auto p_write = [&](int buf) {
#pragma unroll
        for (int i = 0; i < 8; ++i) { const int idx = ct + i * 256, s = idx >> 6, n = idx & 63;
            LAS float* d = vec + ((buf * TB + s) * 8 + (n >> 3)) * 24 + (n & 7);
            d[0] = bfraw2f(pq[i]) * 0.125f; d[8] = bfraw2f(pk[i]); d[16] = 1.f - bfraw2f(pa[i]); }
#pragma unroll
        for (int i = 0; i < 4; ++i) vv[buf * TB * 32 + ct + i * 256] = bfraw2f(pv[i]);
    };
    auto p_yout = [&](int blk) {
        const int buf = blk & 1;
#pragma unroll
        for (int i = 0; i < 4; ++i) { const int idx = ct + i * 256, s = idx >> 5, r = idx & 31; const int t = tok_gla(z, blk * TB + s);
            O[(size_t)t * R_LD + r] = f2bf(yo[buf * TB * 32 + idx]); }
    };
    const int icol = (ct >> 3) & 31, ks = ct & 7;
    f32x2 S[4];
#pragma unroll
    for (int j = 0; j < 4; ++j) S[j] = (f32x2){0.f, 0.f};
    struct Vx { f32x4 q0, q1, k0, k1, a0, a1; float v; };
    auto c_ld = [&](Vx& x, int buf, int s) {
        const LAS float* d = vec + ((buf * TB + s) * 8 + ks) * 24;
        x.q0 = *(const LAS f32x4*)(d); x.q1 = *(const LAS f32x4*)(d + 4); x.k0 = *(const LAS f32x4*)(d + 8); x.k1 = *(const LAS f32x4*)(d + 12);
        x.a0 = *(const LAS f32x4*)(d + 16); x.a1 = *(const LAS f32x4*)(d + 20); x.v = vv[(buf * TB + s) * 32 + icol];
    };
    auto c_upd = [&](const Vx& x) -> float {
        const f32x2 vv2 = (f32x2){x.v, x.v};
        S[0] = S[0] * (f32x2){x.a0[0], x.a0[1]} + vv2 * (f32x2){x.k0[0], x.k0[1]};
        S[1] = S[1] * (f32x2){x.a0[2], x.a0[3]} + vv2 * (f32x2){x.k0[2], x.k0[3]};
        S[2] = S[2] * (f32x2){x.a1[0], x.a1[1]} + vv2 * (f32x2){x.k1[0], x.k1[1]};
        S[3] = S[3] * (f32x2){x.a1[2], x.a1[3]} + vv2 * (f32x2){x.k1[2], x.k1[3]};
        const f32x2 y2 = (S[0] * (f32x2){x.q0[0], x.q0[1]} + S[1] * (f32x2){x.q0[2], x.q0[3]}) + (S[2] * (f32x2){x.q1[0], x.q1[1]} + S[3] * (f32x2){x.q1[2], x.q1[3]});
        return y2[0] + y2[1];
    };
    if (prod) { p_load(0); p_write(0); p_load(1); }
    SCAN_BARRIER();
    for (int b = 0; b < NBLK; ++b) {
        if (prod) {
            if (b + 1 < NBLK) p_write((b + 1) & 1);
            if (b + 2 < NBLK) p_load(b + 2);
            if (b > 0) p_yout(b - 1);
        } else if (cons) {
            const int buf = b & 1;
            Vx xa, xb;
            c_ld(xa, buf, 0);
#pragma unroll 1
            for (int s = 0; s < TB; s += 2) {
                c_ld(xb, buf, s + 1);
                float ya = c_upd(xa);
                if (s + 2 < TB) c_ld(xa, buf, s + 2);
                float yb = c_upd(xb);
                ya += dpp_<0xB1>(ya); yb += dpp_<0xB1>(yb); ya += dpp_<0x4E>(ya); yb += dpp_<0x4E>(yb); ya += dpp_<0x141>(ya); yb += dpp_<0x141>(yb);
                if (ks == 0) { yo[(buf * TB + s) * 32 + icol] = ya; yo[(buf * TB + s + 1) * 32 + icol] = yb; }
            }
        }
        SCAN_BARRIER();
    }
    if (prod) p_yout(NBLK - 1);
    SCAN_BARRIER();
}

__device__ __forceinline__ void scan_gdn(const P& p, int l, int unit, LAS unsigned char* lds) {
    const int z = unit >> 5, h = (unit >> 3) & 3, cb = unit & 7;
    const bf16_t* GDNC = (const bf16_t*)(p.ws + OFF_GDNC); const float* GDNGB = (const float*)(p.ws + OFF_GDNGB);
    bf16_t* O = (bf16_t*)(p.ws + OFF_R) + 1024 + z * 512 + h * 128 + cb * 16;
    LAS float* vec = (LAS float*)lds;
    LAS float* vv = vec + 2 * TB * 320;
    LAS float* sc = vv + 2 * TB * 16;
    LAS float* yo = sc + 2 * TB * 2;
    const int tid = otid(); const ScanRole<4> role(tid); const int ct = role.ct; const bool prod = role.prod, cons = role.cons;
    unsigned short pq[16], pk[16], pv[2]; float psc = 0.f;
    auto p_load = [&](int blk) {
#pragma unroll
        for (int i = 0; i < 16; ++i) { const int idx = ct + i * 256, s = idx >> 7, n = idx & 127; const int t = tok_seq(z, blk * TB + s);
            const bf16_t* bp = GDNC + (size_t)t * 1536 + h * 128 + n;
            pq[i] = bp[0]; pk[i] = bp[512]; }
#pragma unroll
        for (int i = 0; i < 2; ++i) { const int idx = ct + i * 256, s = idx >> 4, r = idx & 15; const int t = tok_seq(z, blk * TB + s);
            pv[i] = GDNC[(size_t)t * 1536 + 1024 + h * 128 + cb * 16 + r]; }
        if (ct < 64) { const int s = ct >> 1, w = ct & 1; const int t = tok_seq(z, blk * TB + s); psc = GDNGB[t * 16 + w * 8 + z * 4 + h]; }
    };
    auto p_write = [&](int buf) {
#pragma unroll
        for (int i = 0; i < 16; ++i) { const int idx = ct + i * 256, s = idx >> 7, n = idx & 127;
            LAS float* d = vec + ((buf * TB + s) * 16 + (n >> 3)) * 20 + (n & 7);
            d[0] = bfraw2f(pq[i]); d[8] = bfraw2f(pk[i]); }
#pragma unroll
        for (int i = 0; i < 2; ++i) vv[buf * TB * 16 + ct + i * 256] = bfraw2f(pv[i]);
        if (ct < 64) sc[buf * TB * 2 + ct] = psc;
    };
    auto p_yout = [&](int blk) {
        const int buf = blk & 1;
#pragma unroll
        for (int i = 0; i < 2; ++i) { const int idx = ct + i * 256, s = idx >> 4, r = idx & 15; const int t = tok_seq(z, blk * TB + s);
            O[(size_t)t * R_LD + r] = f2bf(yo[buf * TB * 16 + idx]); }
    };
    const int icol = (ct >> 4) & 15, ks = ct & 15;
    f32x2 S[4];
#pragma unroll
    for (int j = 0; j < 4; ++j) S[j] = (f32x2){0.f, 0.f};
    struct Vx { f32x4 q0, q1, k0, k1; float v; f32x2 gb; };
    auto c_ld = [&](Vx& x, int buf, int s) {
        const LAS float* d = vec + ((buf * TB + s) * 16 + ks) * 20;
        x.q0 = *(const LAS f32x4*)(d); x.q1 = *(const LAS f32x4*)(d + 4); x.k0 = *(const LAS f32x4*)(d + 8); x.k1 = *(const LAS f32x4*)(d + 12);
        x.v = vv[(buf * TB + s) * 16 + icol]; x.gb = *(const LAS f32x2*)(sc + (buf * TB + s) * 2);
    };
    float dd = 0.f;
    auto c_step = [&](const Vx& x, const f32x4& kn0, const f32x4& kn1, int buf, int s) {
        const float eg = x.gb[0];
        const float cc = x.gb[1] * (x.v - eg * dd);
        const f32x2 eg2 = (f32x2){eg, eg}, cc2 = (f32x2){cc, cc};
        S[0] = S[0] * eg2 + cc2 * (f32x2){x.k0[0], x.k0[1]};
        S[1] = S[1] * eg2 + cc2 * (f32x2){x.k0[2], x.k0[3]};
        S[2] = S[2] * eg2 + cc2 * (f32x2){x.k1[0], x.k1[1]};
        S[3] = S[3] * eg2 + cc2 * (f32x2){x.k1[2], x.k1[3]};
        const f32x2 y2 = (S[0] * (f32x2){x.q0[0], x.q0[1]} + S[1] * (f32x2){x.q0[2], x.q0[3]}) + (S[2] * (f32x2){x.q1[0], x.q1[1]} + S[3] * (f32x2){x.q1[2], x.q1[3]});
        const f32x2 d2 = (S[0] * (f32x2){kn0[0], kn0[1]} + S[1] * (f32x2){kn0[2], kn0[3]}) + (S[2] * (f32x2){kn1[0], kn1[1]} + S[3] * (f32x2){kn1[2], kn1[3]});
        float yp = y2[0] + y2[1], dp = d2[0] + d2[1];
        yp += dpp_<0xB1>(yp); dp += dpp_<0xB1>(dp); yp += dpp_<0x4E>(yp); dp += dpp_<0x4E>(dp);
        yp += dpp_<0x141>(yp); dp += dpp_<0x141>(dp); yp += dpp_<0x140>(yp); dp += dpp_<0x140>(dp);
        dd = dp;
        if (ks == 0) yo[(buf * TB + s) * 16 + icol] = yp;
    };
    if (prod) { p_load(0); p_write(0); p_load(1); }
    SCAN_BARRIER();
    for (int b = 0; b < NBLK; ++b) {
        if (prod) {
            if (b + 1 < NBLK) p_write((b + 1) & 1);
            if (b + 2 < NBLK) p_load(b + 2);
            if (b > 0) p_yout(b - 1);
        } else if (cons) {
            const int buf = b & 1;
            Vx xa, xb;
            c_ld(xa, buf, 0);
            { const f32x2 d2 = (S[0] * (f32x2){xa.k0[0], xa.k0[1]} + S[1] * (f32x2){xa.k0[2], xa.k0[3]}) + (S[2] * (f32x2){xa.k1[0], xa.k1[1]} + S[3] * (f32x2){xa.k1[2], xa.k1[3]});
              dd = reduce16(d2[0] + d2[1]); }
#pragma unroll 1
            for (int s = 0; s < TB; s += 2) {
                c_ld(xb, buf, s + 1); c_step(xa, xb.k0, xb.k1, buf, s);
                if (s + 2 < TB) c_ld(xa, buf, s + 2);
                c_step(xb, xa.k0, xa.k1, buf, s + 1);
            }
        }
        SCAN_BARRIER();
    }
    if (prod) p_yout(NBLK - 1);
    SCAN_BARRIER();
}

__device__ __forceinline__ void phase_post(const P& p, int l, LAS unsigned char* lds) {
    const bf16_t* PG = (const bf16_t*)(p.ws + OFF_PG); const bf16_t* Rb = (const bf16_t*)(p.ws + OFF_R); const bf16_t* B = (const bf16_t*)(p.ws + OFF_B);
    const bf16_t* RWG = (const bf16_t*)(p.ws + OFF_RWG); const float* BONUS = (const float*)(p.ws + OFF_BONUS);
    bf16_t* YC = (bf16_t*)(p.ws + OFF_GDNC);
    const int tid = otid(), wave = tid >> 6, c = tid;
    const float lnw = p.in[I_RWLNW][l * 512 + c], lnb = p.in[I_RWLNB][l * 512 + c];
    const float gng = p.in[I_GLANG][l * 128 + (c & 127)], dng = p.in[I_GDNNG][l * 128 + (c & 127)];
    LAS float* red = (LAS float*)lds;
    for (int tile = blockIdx.x; tile < L / TT; tile += gridDim.x) {
        const int t0 = tile * TT;
        float og[TT], od[TT];
#pragma unroll
        for (int tt = 0; tt < TT; ++tt) {
            const int t = t0 + tt;
            const float y = bf2f(PG[(size_t)t * PG_LD + YRW_COL + c]) + bf2f(PG[(size_t)t * PG_LD + YRW_COL + 512 + c]);
            const float mean = wave_sum(y) * (1.f / 64.f);
            const float dy = y - mean;
            const float var = wave_sum(dy * dy) * (1.f / 64.f);
            const float yn = dy * rsqrtf(var + 64e-5f) * lnw + lnb;
            const float v = bf2f(B[(size_t)t * 4096 + 1024 + c]);
            const float o = (yn + BONUS[t * 8 + wave] * v) * bf2f(RWG[(size_t)t * 512 + c]);
            YC[(size_t)t * 512 + c] = f2bf(o);
            og[tt] = bf2f(Rb[(size_t)t * R_LD + c]) + bf2f(Rb[(size_t)t * R_LD + 512 + c]);
            od[tt] = bf2f(Rb[(size_t)t * R_LD + 1024 + c]) + bf2f(Rb[(size_t)t * R_LD + 1536 + c]);
            const float pg_ = wave_sum(og[tt] * og[tt]), pd_ = wave_sum(od[tt] * od[tt]);
            if ((tid & 63) == 0) { red[(tt * 8 + wave) * 2 + 0] = pg_; red[(tt * 8 + wave) * 2 + 1] = pd_; }
        }
        __syncthreads();
#pragma unroll
        for (int tt = 0; tt < TT; ++tt) {
            const int t = t0 + tt, w0i = (wave >> 1) * 2;
            const float sg = red[(tt * 8 + w0i) * 2 + 0] + red[(tt * 8 + w0i + 1) * 2 + 0], sd = red[(tt * 8 + w0i) * 2 + 1] + red[(tt * 8 + w0i + 1) * 2 + 1];
            const float gate_g = silu_(bf2f(PG[(size_t)t * PG_LD + GLA_OG + c])), gate_d = silu_(bf2f(PG[(size_t)t * PG_LD + GDN_ZG + c]));
            YC[(size_t)L * 512 + (size_t)t * 512 + c] = f2bf(og[tt] * rsqrtf(sg * (1.f / 128.f) + 1e-6f) * gng * gate_g);
            YC[(size_t)2 * L * 512 + (size_t)t * 512 + c] = f2bf(od[tt] * rsqrtf(sd * (1.f / 128.f) + 1e-6f) * dng * gate_d);
        }
        __syncthreads();
    }
}

__device__ __forceinline__ void phase_final(const P& p) {
    const float* H = (const float*)(p.ws + OFF_H); const float* gamma = p.in[I_FINALG];
    const int tid_ = otid(); const int wave = tid_ >> 6, lane = tid_ & 63;
    for (int row = blockIdx.x * 8 + wave; row < NLAT; row += gridDim.x * 8) {
        const float* src = H + (size_t)(row + NCTX) * 1024;
        f32x4 v[4]; float ss = 0.f;
#pragma unroll
        for (int j = 0; j < 4; ++j) { v[j] = *(const f32x4*)(src + j * 256 + lane * 4); ss += (v[j][0] * v[j][0] + v[j][1] * v[j][1]) + (v[j][2] * v[j][2] + v[j][3] * v[j][3]); }
        ss = wave_sum(ss);
        const float rstd = rsqrtf(ss * (1.f / 1024.f) + 1e-6f);
#pragma unroll
        for (int j = 0; j < 4; ++j) { const int col = j * 256 + lane * 4; const f32x4 g = *(const f32x4*)(gamma + col);
            *(f32x4*)(p.out + (size_t)row * 1024 + col) = v[j] * rstd * g; }
    }
}

__global__ void __launch_bounds__(512, 2) fwd_megakernel(P p) {
    extern __shared__ __attribute__((aligned(16))) unsigned char shm_raw[];
    LAS unsigned char* lds = (LAS unsigned char*)shm_raw;
    cg::grid_group grid = cg::this_grid();
    const int G = gridDim.x, wg = blockIdx.x;
    unsigned char* ws = p.ws;
    float* H = (float*)(ws + OFF_H); bf16_t* HN = (bf16_t*)(ws + OFF_HN); bf16_t* WIN = (bf16_t*)(ws + OFF_WIN);
    const float* MODall = (const float*)(ws + OFF_MOD);

    phase_mod(p, lds);
    grid.sync();
    for (int l = 0; l < DEPTH; ++l) {
        const float* MOD = MODall + (size_t)l * 2 * 6144;
        if (l == 0) phase_norm<true>(p, l, p.in[I_N1G] + l * 1024, 0, 1); else phase_norm<false>(p, l, p.in[I_N1G] + l * 1024, 0, 1);
        {
            const float* win = p.in[I_WIN] + (size_t)l * 1024 * IN_COLS;
            convert_T(win, IN_COLS, 1024, 0, 1920, WIN, (LAS float*)lds, wg, G);
            convert_T(win, IN_COLS, 1024, 1920, 3632, WIN + (size_t)2048 * 1024, (LAS float*)lds, (wg + 64) % G, G);
            convert_T(win, IN_COLS, 1024, 5552, 3072, WIN + (size_t)NMAIN * 1024, (LAS float*)lds, (wg + 128) % G, G);
        }
        grid.sync();
        {
            pg8::Gemm g{HN, WIN, L, NMAIN, 1024}; pg8::StaticOrder S; S.init(L, NMAIN, G, wg);
            EpiInMain E{(bf16_t*)(ws + OFF_R), (bf16_t*)(ws + OFF_PG)};
            pg8::gemm_phase(lds, g, S, E);
        }
        grid.sync();
#ifndef NO_PREP
        phase_prep(p, l, lds);
#endif
        grid.sync();
#ifndef NO_SCAN
        if (wg < 128) scan_rwkv(p, l, wg, lds);
        else if (wg < 160) scan_gla(p, l, wg - 128, lds);
        else if (wg < 224) scan_gdn(p, l, wg - 160, lds);
#endif
        grid.sync();
#ifndef NO_POST
        phase_post(p, l, lds);
#endif
        grid.sync();
        {
            convert_T(p.in[I_WBR] + (size_t)l * 3 * 512 * 1024, 1024, 512, 0, 1024, (bf16_t*)(ws + OFF_WBR), (LAS float*)lds, wg, G);
            convert_T(p.in[I_WBR] + (size_t)l * 3 * 512 * 1024 + (size_t)512 * 1024, 1024, 512, 0, 1024, (bf16_t*)(ws + OFF_WBR) + (size_t)1024 * 512, (LAS float*)lds, (wg + 128) % G, G);
            convert_T(p.in[I_WBR] + (size_t)l * 3 * 512 * 1024 + (size_t)2 * 512 * 1024, 1024, 512, 0, 1024, (bf16_t*)(ws + OFF_WBR) + (size_t)2 * 1024 * 512, (LAS float*)lds, wg, G);
            convert_T(p.in[I_WOUT] + (size_t)l * 1024 * 1024, 1024, 1024, 0, 1024, (bf16_t*)(ws + OFF_WOUT), (LAS float*)lds, wg, G);
            convert_T(p.in[I_W1] + (size_t)l * 1024 * 4096, 4096, 1024, 0, 4096, (bf16_t*)(ws + OFF_W1), (LAS float*)lds, wg, G);
            convert_T(p.in[I_W2] + (size_t)l * 4096 * 1024, 1024, 4096, 0, 1024, (bf16_t*)(ws + OFF_W2), (LAS float*)lds, wg, G);
            pg8::Gemm g{HN, WIN + (size_t)NMAIN * 1024, L, 3072, 1024}; pg8::StaticOrder S; S.init(L, 3072, G, wg);
            EpiGates E{(bf16_t*)(ws + OFF_B)};
            pg8::gemm_phase(lds, g, S, E);
        }
        grid.sync();
        {
            const bf16_t* YC = (const bf16_t*)(ws + OFF_GDNC); const bf16_t* WBR = (const bf16_t*)(ws + OFF_WBR);
            pg8::StaticOrder S; S.init(L, 1024, G, wg);
            { pg8::Gemm g{YC, WBR, L, 1024, 512}; EpiBranch<0> E{(const bf16_t*)(ws + OFF_B), (float*)(ws + OFF_PG), HN}; pg8::gemm_phase(lds, g, S, E); }
            { pg8::Gemm g{YC + (size_t)L * 512, WBR + (size_t)1024 * 512, L, 1024, 512}; EpiBranch<1> E{(const bf16_t*)(ws + OFF_B), (float*)(ws + OFF_PG), HN}; pg8::gemm_phase(lds, g, S, E); }
            { pg8::Gemm g{YC + (size_t)2 * L * 512, WBR + (size_t)2 * 1024 * 512, L, 1024, 512}; EpiBranch<2> E{(const bf16_t*)(ws + OFF_B), (float*)(ws + OFF_PG), HN}; pg8::gemm_phase(lds, g, S, E); }
        }
        grid.sync();
        {
            pg8::Gemm g{HN, (const bf16_t*)(ws + OFF_WOUT), L, 1024, 1024}; pg8::StaticOrder S; S.init(L, 1024, G, wg);
            EpiResid E{H, MOD + 2 * 1024, MOD + 6144 + 2 * 1024};
            pg8::gemm_phase(lds, g, S, E);
        }
        grid.sync();
        phase_norm<false>(p, l, p.in[I_N2G] + l * 1024, 3, 4);
        grid.sync();
        {
            pg8::Gemm g{HN, (const bf16_t*)(ws + OFF_W1), L, 4096, 1024}; pg8::StaticOrder S; S.init(L, 4096, G, wg);
            EpiMlp1 E{(bf16_t*)(ws + OFF_B)};
            pg8::gemm_phase(lds, g, S, E);
        }
        grid.sync();
        {
            pg8::Gemm g{(const bf16_t*)(ws + OFF_B), (const bf16_t*)(ws + OFF_W2), L, 1024, 4096}; pg8::StaticOrder S; S.init(L, 1024, G, wg);
            EpiResid E{H, MOD + 5 * 1024, MOD + 6144 + 5 * 1024};
            pg8::gemm_phase(lds, g, S, E);
        }
        grid.sync();
    }
    phase_final(p);
}

extern "C" void kernel_launch(void* const* d_in, const int* in_sizes, int n_in, void* d_out, int out_size, void* d_ws, size_t ws_size, hipStream_t stream) {
    static int grid_blocks = 0;
    if (n_in != 32 || ws_size < WS_END || out_size != NLAT * DM) {
        fprintf(stderr, "kernel_launch: unexpected shapes / workspace (n_in %d, ws %zu need %zu, out %d)\n", n_in, ws_size, (size_t)WS_END, out_size);
        hipMemsetAsync(d_out, 0xFF, (size_t)out_size * 4, stream);
        return;
    }
    if (!grid_blocks) {
        int dev = 0, cus = 0, per_cu = 0;
        hipGetDevice(&dev);
        hipDeviceGetAttribute(&cus, hipDeviceAttributeMultiprocessorCount, dev);
        hipFuncSetAttribute((const void*)fwd_megakernel, hipFuncAttributeMaxDynamicSharedMemorySize, LDS_BYTES);
        hipOccupancyMaxActiveBlocksPerMultiprocessor(&per_cu, (const void*)fwd_megakernel, 512, LDS_BYTES);
        if (per_cu < 1) per_cu = 1;
        grid_blocks = cus * 1;
        (void)hipGetLastError();
    }
    P p{};
    for (int i = 0; i < 32; ++i) p.in[i] = (const float*)d_in[i];
    p.out = (float*)d_out; p.ws = (unsigned char*)d_ws;
    void* args[] = {&p};
    hipError_t e = hipLaunchCooperativeKernel((const void*)fwd_megakernel, dim3(grid_blocks), dim3(512), args, LDS_BYTES, stream);
    if (e != hipSuccess) fprintf(stderr, "cooperative launch failed: %s (grid %d)\n", hipGetErrorString(e), grid_blocks);
}
```

```cpp
#include <hip/hip_runtime.h>
#include <hip/hip_cooperative_groups.h>
#include <cstdio>
#include <cstdint>
namespace cg = cooperative_groups;

#define LAS __attribute__((address_space(3)))
typedef unsigned short bf16_t;
typedef short bf16x8 __attribute__((ext_vector_type(8)));
typedef float f32x4 __attribute__((ext_vector_type(4)));
typedef float f32x2 __attribute__((ext_vector_type(2)));
typedef unsigned u32x4 __attribute__((ext_vector_type(4)));
typedef unsigned u32x2 __attribute__((ext_vector_type(2)));

constexpr int L = 16640, NCTX = 256, NLAT = 16384, DM = 1024, BW = 512, DEPTH = 4;
constexpr int IN_COLS = 8624;
constexpr int NMAIN = 5888;
constexpr int NWIN = 8960;
constexpr int R_LD = 2048, PG_LD = 3840;
constexpr int GLA_Q = 0, GLA_K = 256, GLA_V = 512, GLA_OG = 1024, GLA_AL = 1536;
constexpr int GDN_QKV = 1568, GDN_ZG = 3104, GDN_A = 3616, GDN_B = 3624;
constexpr int YRW_COL = 1568;

constexpr size_t al256(size_t x) { return (x + 255) & ~(size_t)255; }
constexpr size_t OFF_MOD = 0;
constexpr size_t OFF_H = al256(OFF_MOD + (size_t)4 * 2 * 6144 * 4);
constexpr size_t OFF_HN = OFF_H + (size_t)L * 1024 * 4;
constexpr size_t OFF_WIN = OFF_HN + (size_t)L * 1024 * 2;
constexpr size_t OFF_R = OFF_WIN + (size_t)NWIN * 1024 * 2;
constexpr size_t OFF_PG = OFF_R + (size_t)L * R_LD * 2;
constexpr size_t OFF_B = OFF_PG + (size_t)L * PG_LD * 2;
constexpr size_t OFF_RWG = OFF_B + (size_t)L * 4096 * 2;
constexpr size_t OFF_BONUS = OFF_RWG + (size_t)L * 512 * 2;
constexpr size_t OFF_GLAD = OFF_BONUS + (size_t)L * 8 * 4;
constexpr size_t OFF_GDNC = OFF_GLAD + (size_t)L * 512 * 2;
constexpr size_t OFF_GDNGB = OFF_GDNC + (size_t)L * 1536 * 2;
constexpr size_t OFF_XL = OFF_GDNGB + (size_t)L * 16 * 4;
constexpr size_t OFF_WL = OFF_XL + (size_t)L * 512 * 2;
constexpr size_t WS_END = OFF_WL + (size_t)2560 * 512 * 2;
constexpr size_t OFF_WBR = OFF_R;
constexpr size_t OFF_WOUT = OFF_WBR + (size_t)3 * 1024 * 512 * 2;
constexpr size_t OFF_W1 = OFF_WOUT + (size_t)1024 * 1024 * 2;
constexpr size_t OFF_W2 = OFF_W1 + (size_t)4096 * 1024 * 2;

constexpr int LDS_BYTES = 131072;

struct P { const float* in[32]; float* out; unsigned char* ws; };
enum { I_X = 0, I_C, I_CTX, I_CCTX, I_WMOD, I_BMOD, I_N1G, I_WIN, I_RWMU, I_RWW0, I_RWW2, I_RWA0, I_RWA2, I_RWG2, I_RWKK, I_RWKA, I_RWRK,
       I_RWLNW, I_RWLNB, I_GLAA2, I_GLAAB, I_GLANG, I_GDNCONV, I_GDNALOG, I_GDNDT, I_GDNNG, I_WBR, I_WOUT, I_N2G, I_W1, I_W2, I_FINALG };

__device__ __forceinline__ float bf2f(bf16_t b) { return __uint_as_float(((unsigned)b) << 16); }
__device__ __forceinline__ unsigned pk2(float lo, float hi) { unsigned r; asm("v_cvt_pk_bf16_f32 %0, %1, %2" : "=v"(r) : "v"(lo), "v"(hi)); return r; }
__device__ __forceinline__ bf16_t f2bf(float f) { return (bf16_t)(pk2(f, 0.f) & 0xffffu); }
__device__ __forceinline__ float sigmoid_(float x) { return 1.f / (1.f + __expf(-x)); }
__device__ __forceinline__ float silu_(float x) { return x / (1.f + __expf(-x)); }
__device__ __forceinline__ float softplus_(float x) { return fmaxf(x, 0.f) + log1pf(__expf(-fabsf(x))); }
__device__ __forceinline__ float wave_sum(float v) {
#pragma unroll
    for (int o = 1; o < 64; o <<= 1) v += __shfl_xor(v, o);
    return v;
}
template <int CTRL> __device__ __forceinline__ float dpp_(float x) { return __int_as_float(__builtin_amdgcn_update_dpp(0, __float_as_int(x), CTRL, 0xF, 0xF, true)); }
__device__ __forceinline__ float reduce8(float x) { x += dpp_<0xB1>(x); x += dpp_<0x4E>(x); x += dpp_<0x141>(x); return x; }
__device__ __forceinline__ float reduce16(float x) { x = reduce8(x); x += dpp_<0x140>(x); return x; }

__device__ __forceinline__ int otid() { int t = threadIdx.x; asm volatile("" : "+v"(t)); return t; }
__device__ __forceinline__ int osgpr(int x) { asm volatile("" : "+s"(x)); return x; }
namespace pg8 {
constexpr int BM = 256, BK = 64, HALF = 128, HTB = HALF * BK * 2, STAGE_BYTES = 8 * HTB, NXCD = 8, WGM = 8;
__host__ __device__ __forceinline__ int lds_byte(int r, int c) { const int st = (r >> 4) * 2 + (c >> 5), rr = r & 15, cc = c & 31, ob = rr * 64 + cc * 2; return st * 1024 + (ob ^ (((ob >> 9) & 1) << 5)); }
__host__ __device__ __forceinline__ void stage_rc(int b, int& R, int& C) { const int st = b / 1024, sb = b % 1024, swz = sb ^ (((sb >> 9) & 1) << 5); R = (st >> 1) * 16 + swz / 64; C = (st & 1) * 32 + (swz % 64) / 2; }
struct Unit { int pm, pn; };
struct Gemm { const bf16_t* A; const bf16_t* Bt; int M, N, K; };
struct StaticOrder {
    int nM, nN, nwg, G, c;
    __host__ __device__ void init(int M, int N, int G_, int c_) { nM = M / BM; nN = N / BM; nwg = nM * nN; G = G_; c = c_; }
    __host__ __device__ bool next(int i, Unit& u) const {
        const long Lx = (long)i * G + c; if (Lx >= nwg) return false;
        int wgid = (int)Lx; { const int q = nwg / NXCD, r = nwg % NXCD, xcd = wgid % NXCD, off = wgid / NXCD; wgid = (xcd < r ? xcd * (q + 1) : r * (q + 1) + (xcd - r) * q) + off; }
        const int nig = WGM * nN, gid = wgid / nig, fm = gid * WGM, gsz = (nM - fm) < WGM ? (nM - fm) : WGM;
        u.pm = fm + ((wgid % nig) % gsz); u.pn = (wgid % nig) / gsz; return true;
    }
};
template <class Epi>
__device__ __forceinline__ void gemm_phase(LAS unsigned char* lds, const Gemm g, const StaticOrder& S, const Epi& E) {
#ifdef NO_GEMM
    return;
#endif
    const int tid = otid(), wid = __builtin_amdgcn_readfirstlane(tid >> 6), lane = tid & 63, wr = wid >> 2, wc = wid & 3, fr = lane & 15, fq = lane >> 4;
    const int K = g.K, nt = K / BK;
    unsigned voffA[2];
#pragma unroll
    for (int i = 0; i < 2; ++i) { int R, C; stage_rc(tid * 16 + i * 8192, R, C); voffA[i] = (unsigned)(R * K + C) * 2u; }
    const size_t kstep = (size_t)(BK * 2);
    const size_t hstep = (size_t)HALF * K * 2;
    const size_t tstep = 2 * hstep;
    const unsigned ldsw = (unsigned)wid * 1024u;
    const int aoff = lds_byte(wr * 64 + fr, fq * 8), boff = lds_byte(wc * 32 + fr, fq * 8);
#define PG8_SA(b, h) (((b) * 2 + (h)) * HTB)
#define PG8_SB(b, h) ((4 + (b) * 2 + (h)) * HTB)
#define PG8_STAGE(bufoff, gbase, voff) do { _Pragma("unroll") for (int _i = 0; _i < 2; ++_i) \
        __builtin_amdgcn_global_load_lds((const unsigned*)((const char*)(gbase) + (voff)[_i]), (LAS unsigned*)(lds + (bufoff) + ldsw + _i * 8192), 16, 0, 0); } while (0)
#define PG8_LDA(dst, b, h) do { _Pragma("unroll") for (int m = 0; m < 4; ++m) _Pragma("unroll") for (int k = 0; k < 2; ++k) dst[m][k] = *(const LAS bf16x8*)(lds + PG8_SA(b, h) + aoff + m * 2048 + k * 1024); } while (0)
#define PG8_LDB(dst, b, h) do { _Pragma("unroll") for (int n = 0; n < 2; ++n) _Pragma("unroll") for (int k = 0; k < 2; ++k) dst[n][k] = *(const LAS bf16x8*)(lds + PG8_SB(b, h) + boff + n * 2048 + k * 1024); } while (0)
#define PG8_MMA(ai, bj, At, Bt) do { __builtin_amdgcn_s_setprio(1); _Pragma("unroll") for (int m = 0; m < 4; ++m) _Pragma("unroll") for (int n = 0; n < 2; ++n) _Pragma("unroll") for (int k = 0; k < 2; ++k) \
        acc[ai][bj][m][n] = __builtin_amdgcn_mfma_f32_16x16x32_bf16(Bt[n][k], At[m][k], acc[ai][bj][m][n], 0, 0, 0); __builtin_amdgcn_s_setprio(0); } while (0)
#define PG8_WAIT_V(n) asm volatile("s_waitcnt vmcnt(" #n ")" ::: "memory")
#define PG8_WAIT_L(n) asm volatile("s_waitcnt lgkmcnt(" #n ")" ::: "memory")
#define PG8_BAR __builtin_amdgcn_s_barrier()
#define PG8_SCHED __builtin_amdgcn_sched_barrier(0)
    Unit cur, nxt; int ui = 0;
    if (!S.next(0, cur)) return;
    f32x4 acc[2][2][4][2];
#pragma unroll
    for (int a = 0; a < 2; ++a)
#pragma unroll
        for (int b = 0; b < 2; ++b)
#pragma unroll
            for (int m = 0; m < 4; ++m)
#pragma unroll
                for (int n = 0; n < 2; ++n) acc[a][b][m][n] = (f32x4){0.f, 0.f, 0.f, 0.f};
    bf16x8 At[4][2], B0[2][2], B1[2][2];
    const char* cA = (const char*)g.A + (size_t)cur.pm * tstep; const char* cB = (const char*)g.Bt + (size_t)cur.pn * tstep;
    PG8_STAGE(PG8_SB(0, 0), cB, voffA); PG8_STAGE(PG8_SA(0, 0), cA, voffA); PG8_STAGE(PG8_SB(0, 1), cB + hstep, voffA); PG8_STAGE(PG8_SA(0, 1), cA + hstep, voffA);
    if (wr == 1) PG8_BAR;
    PG8_WAIT_V(4); PG8_BAR;
    PG8_STAGE(PG8_SB(1, 0), cB + kstep, voffA); PG8_STAGE(PG8_SA(1, 0), cA + kstep, voffA); PG8_STAGE(PG8_SB(1, 1), cB + hstep + kstep, voffA);
    PG8_WAIT_V(6); PG8_BAR;
    for (;;) {
        const bool has_next = S.next(ui + 1, nxt);
        const char* nA = has_next ? (const char*)g.A + (size_t)nxt.pm * tstep : cA; const char* nB = has_next ? (const char*)g.Bt + (size_t)nxt.pn * tstep : cB;
        for (int t = 0; t < nt; t += 2) {
            const bool last = (t == nt - 2);
            const char* a1 = cA + (size_t)(t + 1) * kstep;
            const char* a2 = last ? nA : cA + (size_t)(t + 2) * kstep; const char* b2 = last ? nB : cB + (size_t)(t + 2) * kstep;
            const char* a3 = a2 + kstep; const char* b3 = b2 + kstep;
            PG8_LDB(B0, 0, 0); PG8_SCHED; PG8_LDA(At, 0, 0); PG8_STAGE(PG8_SA(1, 1), a1 + hstep, voffA);
            PG8_WAIT_L(8); PG8_BAR; PG8_WAIT_L(0); PG8_MMA(0, 0, At, B0); PG8_BAR; PG8_SCHED;
            PG8_LDB(B1, 0, 1); PG8_STAGE(PG8_SB(0, 0), b2, voffA);
            PG8_BAR; PG8_WAIT_L(0); PG8_MMA(0, 1, At, B1); PG8_BAR;
            PG8_LDA(At, 0, 1); PG8_STAGE(PG8_SA(0, 0), a2, voffA);
            PG8_BAR; PG8_WAIT_L(0); PG8_MMA(1, 0, At, B0); PG8_BAR; PG8_SCHED;
            PG8_STAGE(PG8_SB(0, 1), b2 + hstep, voffA);
            PG8_WAIT_V(6); PG8_BAR; PG8_MMA(1, 1, At, B1); PG8_BAR;
            PG8_LDB(B0, 1, 0); PG8_SCHED; PG8_LDA(At, 1, 0); PG8_STAGE(PG8_SA(0, 1), a2 + hstep, voffA);
            PG8_WAIT_L(8); PG8_BAR; PG8_WAIT_L(0); PG8_MMA(0, 0, At, B0); PG8_BAR; PG8_SCHED;
            PG8_LDB(B1, 1, 1); PG8_STAGE(PG8_SB(1, 0), b3, voffA);
            PG8_BAR; PG8_WAIT_L(0); PG8_MMA(0, 1, At, B1); PG8_BAR;
            PG8_LDA(At, 1, 1); PG8_STAGE(PG8_SA(1, 0), a3, voffA);
            PG8_BAR; PG8_WAIT_L(0); PG8_MMA(1, 0, At, B0); PG8_BAR; PG8_SCHED;
            PG8_STAGE(PG8_SB(1, 1), b3 + hstep, voffA);
            PG8_WAIT_V(6); PG8_BAR; PG8_MMA(1, 1, At, B1); PG8_BAR;
        }
        E(acc, cur, wr, wc, fr, fq);
        if (!has_next) break;
#pragma unroll
        for (int a = 0; a < 2; ++a)
#pragma unroll
            for (int b = 0; b < 2; ++b)
#pragma unroll
                for (int m = 0; m < 4; ++m)
#pragma unroll
                    for (int n = 0; n < 2; ++n) acc[a][b][m][n] = (f32x4){0.f, 0.f, 0.f, 0.f};
        cur = nxt; cA = nA; cB = nB; ++ui;
    }
    PG8_WAIT_V(0);
    if (wr == 0) PG8_BAR;
    PG8_BAR;
#undef PG8_SA
#undef PG8_SB
#undef PG8_STAGE
#undef PG8_LDA
#undef PG8_LDB
#undef PG8_MMA
#undef PG8_WAIT_V
#undef PG8_WAIT_L
#undef PG8_BAR
#undef PG8_SCHED
}
}
using pg8::Unit;

#define EPI_LOOP_ROWS for (int ai = 0; ai < 2; ++ai) for (int m = 0; m < 4; ++m)
#define EPI_LOOP_COLS for (int bj = 0; bj < 2; ++bj) for (int n = 0; n < 2; ++n)
struct EpiInMain {
    bf16_t* R; bf16_t* PG;
    __device__ __forceinline__ void operator()(const f32x4 (&acc)[2][2][4][2], const Unit& u, int wr, int wc, int fr, int fq) const {
        bf16_t* dst; int ld, c0;
        if (u.pn < 8) { dst = R; ld = R_LD; c0 = u.pn * 256; } else { dst = PG; ld = PG_LD; c0 = (u.pn - 8) * 256; }
        const int row0 = u.pm * 256 + wr * 64 + fr, col0 = c0 + wc * 32 + 4 * fq;
#pragma unroll
        EPI_LOOP_ROWS { bf16_t* rowp = dst + (size_t)(row0 + ai * 128 + m * 16) * ld + col0;
#pragma unroll
            EPI_LOOP_COLS { const f32x4 v = acc[ai][bj][m][n]; *(u32x2*)(rowp + bj * 128 + n * 16) = (u32x2){pk2(v[0], v[1]), pk2(v[2], v[3])}; } }
    }
};
struct EpiGates {
    bf16_t* G;
    __device__ __forceinline__ void operator()(const f32x4 (&acc)[2][2][4][2], const Unit& u, int wr, int wc, int fr, int fq) const {
        const int row0 = u.pm * 256 + wr * 64 + fr, col0 = u.pn * 256 + wc * 32 + 4 * fq;
#pragma unroll
        EPI_LOOP_ROWS { bf16_t* rowp = G + (size_t)(row0 + ai * 128 + m * 16) * 3072 + col0;
#pragma unroll
            EPI_LOOP_COLS { const f32x4 v = acc[ai][bj][m][n];
                *(u32x2*)(rowp + bj * 128 + n * 16) = (u32x2){pk2(sigmoid_(v[0]), sigmoid_(v[1])), pk2(sigmoid_(v[2]), sigmoid_(v[3]))}; } }
    }
};
template <int GI> struct EpiBranch {
    const bf16_t* G; float* MG; bf16_t* MB;
    __device__ __forceinline__ void operator()(const f32x4 (&acc)[2][2][4][2], const Unit& u, int wr, int wc, int fr, int fq) const {
        const int row0 = u.pm * 256 + wr * 64 + fr, col0 = u.pn * 256 + wc * 32 + 4 * fq;
#pragma unroll
        EPI_LOOP_ROWS { const size_t row = (size_t)(row0 + ai * 128 + m * 16);
#pragma unroll
            EPI_LOOP_COLS { const int col = col0 + bj * 128 + n * 16; const f32x4 v = acc[ai][bj][m][n];
                const u32x2 gq = *(const u32x2*)(G + row * 3072 + GI * 1024 + col);
                f32x4 gv = (f32x4){__uint_as_float(gq[0] << 16), __uint_as_float(gq[0] & 0xffff0000u), __uint_as_float(gq[1] << 16), __uint_as_float(gq[1] & 0xffff0000u)};
                f32x4 r = v * gv;
                if (GI > 0) r += *(const f32x4*)(MG + row * 1024 + col);
                if (GI < 2) *(f32x4*)(MG + row * 1024 + col) = r;
                else *(u32x2*)(MB + row * 1024 + col) = (u32x2){pk2(r[0], r[1]), pk2(r[2], r[3])}; } }
    }
};
struct EpiResid {
    float* H; const float* gate_lat; const float* gate_ctx;
    __device__ __forceinline__ void operator()(const f32x4 (&acc)[2][2][4][2], const Unit& u, int wr, int wc, int fr, int fq) const {
        const int row0 = u.pm * 256 + wr * 64 + fr, col0 = u.pn * 256 + wc * 32 + 4 * fq;
        const float* gp = (u.pm == 0) ? gate_ctx : gate_lat;
        f32x4 gv[2][2];
#pragma unroll
        EPI_LOOP_COLS gv[bj][n] = *(const f32x4*)(gp + col0 + bj * 128 + n * 16);
#pragma unroll
        EPI_LOOP_ROWS { float* rowp = H + (size_t)(row0 + ai * 128 + m * 16) * 1024 + col0;
#pragma unroll
            EPI_LOOP_COLS { f32x4* q = (f32x4*)(rowp + bj * 128 + n * 16); *q = *q + acc[ai][bj][m][n] * gv[bj][n]; } }
    }
};
struct EpiLora {
    bf16_t* B; bf16_t* RWG; const float* w0; const float* a0;
    __device__ __forceinline__ void operator()(const f32x4 (&acc)[2][2][4][2], const Unit& u, int wr, int wc, int fr, int fq) const {
        const int row0 = u.pm * 256 + wr * 64 + fr, blk = u.pn >> 1, cbase = (u.pn & 1) * 256 + wc * 32 + 4 * fq;
        f32x4 bv[2][2];
#pragma unroll
        EPI_LOOP_COLS { const int cc = cbase + bj * 128 + n * 16;
            bv[bj][n] = blk < 2 ? *(const f32x4*)(w0 + blk * 512 + cc) : (blk < 4 ? *(const f32x4*)(a0 + (blk - 2) * 512 + cc) : (f32x4){0.f, 0.f, 0.f, 0.f}); }
        bf16_t* dst; int ld;
        if (blk < 2) { dst = B + 3072 + blk * 512; ld = 4096; } else if (blk < 4) { dst = B + 2048 + (blk - 2) * 512; ld = 4096; } else { dst = RWG; ld = 512; }
#pragma unroll
        EPI_LOOP_ROWS { bf16_t* rowp = dst + (size_t)(row0 + ai * 128 + m * 16) * ld + cbase;
#pragma unroll
            EPI_LOOP_COLS { f32x4 v = acc[ai][bj][m][n] + bv[bj][n];
                if (blk < 2) {
#pragma unroll
                    for (int j = 0; j < 4; ++j) { const float x = -v[j]; const float sp = fmaxf(x, 0.f) + __logf(1.f + __expf(-fabsf(x))); v[j] = 1.f - __expf(-__expf(-sp - 0.5f)); }
                } else if (blk < 4) {
#pragma unroll
                    for (int j = 0; j < 4; ++j) v[j] = sigmoid_(v[j]);
                }
                *(u32x2*)(rowp + bj * 128 + n * 16) = (u32x2){pk2(v[0], v[1]), pk2(v[2], v[3])}; } }
    }
};
struct EpiMlp1 {
    bf16_t* U;
    __device__ __forceinline__ void operator()(const f32x4 (&acc)[2][2][4][2], const Unit& u, int wr, int wc, int fr, int fq) const {
        const int row0 = u.pm * 256 + wr * 64 + fr, col0 = u.pn * 256 + wc * 32 + 4 * fq;
#pragma unroll
        EPI_LOOP_ROWS { bf16_t* rowp = U + (size_t)(row0 + ai * 128 + m * 16) * 4096 + col0;
#pragma unroll
            EPI_LOOP_COLS { f32x4 v = acc[ai][bj][m][n];
#pragma unroll
                for (int j = 0; j < 4; ++j) { const float t = fmaxf(v[j], 0.f); v[j] = t * t; }
                *(u32x2*)(rowp + bj * 128 + n * 16) = (u32x2){pk2(v[0], v[1]), pk2(v[2], v[3])}; } }
    }
};

__device__ __forceinline__ void convert_T(const float* src, int ld, int K, int n0, int ncols, bf16_t* dst, LAS float* tile, int wg, int nwg) {
    const int ntn = (ncols + 63) >> 6, ntk = K >> 6, tid = otid();
    for (int t = wg; t < ntn * ntk; t += nwg) {
        const int tn = t / ntk, tk = t - tn * ntk, k0 = tk * 64, nb = tn * 64;
#pragma unroll
        for (int i = 0; i < 2; ++i) { const int idx = tid + i * 512, kk = idx >> 4, n4 = (idx & 15) * 4;
            f32x4 v = (f32x4){0.f, 0.f, 0.f, 0.f};
            if (nb + n4 < ncols) v = *(const f32x4*)(src + (size_t)(k0 + kk) * ld + n0 + nb + n4);
            tile[kk * 65 + n4 + 0] = v[0]; tile[kk * 65 + n4 + 1] = v[1]; tile[kk * 65 + n4 + 2] = v[2]; tile[kk * 65 + n4 + 3] = v[3]; }
        __syncthreads();
        { const int nn = tid >> 3, k8 = (tid & 7) * 8;
          if (nb + nn < ncols) { const LAS float* s = tile + k8 * 65 + nn;
              u32x4 o; o[0] = pk2(s[0], s[65]); o[1] = pk2(s[130], s[195]); o[2] = pk2(s[260], s[325]); o[3] = pk2(s[390], s[455]);
              *(u32x4*)(dst + (size_t)(nb + nn) * K + k0 + k8) = o; } }
        __syncthreads();
    }
}

__device__ __forceinline__ void phase_mod(const P& p, LAS unsigned char* lds) {
    const float* c = p.in[I_C]; const float* cc = p.in[I_CCTX]; const float* wm = p.in[I_WMOD]; const float* bm = p.in[I_BMOD];
    float* MOD = (float*)(p.ws + OFF_MOD);
    LAS float* red = (LAS float*)lds;
    const int tid = otid();
    for (int blk = blockIdx.x; blk < 256; blk += gridDim.x) {
        const int l = blk >> 6, col0 = (blk & 63) * 96;
        if (tid < 384) {
            const int cgp = tid % 24, ks = tid / 24;
            f32x4 a0 = (f32x4){0.f, 0.f, 0.f, 0.f}, a1 = a0;
            const float* w = wm + (size_t)l * 1024 * 6144 + col0 + cgp * 4;
#pragma unroll 8
            for (int k = ks * 64; k < ks * 64 + 64; ++k) {
                const f32x4 wv = *(const f32x4*)(w + (size_t)k * 6144);
                const float s0 = silu_(c[k]), s1 = silu_(cc[k]);
                a0 += wv * s0; a1 += wv * s1;
            }
            LAS f32x4* r4 = (LAS f32x4*)red;
            r4[(ks * 24 + cgp) * 2 + 0] = a0; r4[(ks * 24 + cgp) * 2 + 1] = a1;
        }
        __syncthreads();
        if (tid < 192) {
            const int col = tid % 96, s = tid / 96;
            float sum = 0.f;
#pragma unroll
            for (int k2 = 0; k2 < 16; ++k2) sum += red[((k2 * 24 + (col >> 2)) * 2 + s) * 4 + (col & 3)];
            MOD[((size_t)l * 2 + s) * 6144 + col0 + col] = sum + bm[l * 6144 + col0 + col];
        }
        __syncthreads();
    }
}

template <bool FROM_INPUT>
__device__ __forceinline__ void phase_norm(const P& p, int l, const float* gamma, int shift_idx, int scale_idx) {
    float* H = (float*)(p.ws + OFF_H); bf16_t* HN = (bf16_t*)(p.ws + OFF_HN);
    const float* MOD = (const float*)(p.ws + OFF_MOD) + (size_t)l * 2 * 6144;
    const int tid_ = otid(); const int wave = tid_ >> 6, lane = tid_ & 63;
    for (int row = blockIdx.x * 8 + wave; row < L; row += gridDim.x * 8) {
        const float* src = FROM_INPUT ? (row < NCTX ? p.in[I_CTX] + (size_t)row * 1024 : p.in[I_X] + (size_t)(row - NCTX) * 1024) : H + (size_t)row * 1024;
        f32x4 v[4]; float ss = 0.f;
#pragma unroll
        for (int j = 0; j < 4; ++j) { v[j] = *(const f32x4*)(src + j * 256 + lane * 4); ss += (v[j][0] * v[j][0] + v[j][1] * v[j][1]) + (v[j][2] * v[j][2] + v[j][3] * v[j][3]); }
        ss = wave_sum(ss);
        const float rstd = rsqrtf(ss * (1.f / 1024.f) + 1e-6f);
        const float* m = MOD + (row < NCTX ? 6144 : 0);
#pragma unroll
        for (int j = 0; j < 4; ++j) { const int col = j * 256 + lane * 4;
            const f32x4 g = *(const f32x4*)(gamma + col), sh = *(const f32x4*)(m + shift_idx * 1024 + col), sc = *(const f32x4*)(m + scale_idx * 1024 + col);
            const f32x4 o = v[j] * rstd * g * (sc + 1.f) + sh;
            *(u32x2*)(HN + (size_t)row * 1024 + col) = (u32x2){pk2(o[0], o[1]), pk2(o[2], o[3])};
            if (FROM_INPUT) *(f32x4*)(H + (size_t)row * 1024 + col) = v[j]; }
    }
}

constexpr int TT = 13;
__device__ __forceinline__ void phase_prep(const P& p, int l, LAS unsigned char* lds) {
    const bf16_t* R = (const bf16_t*)(p.ws + OFF_R); const bf16_t* PG = (const bf16_t*)(p.ws + OFF_PG);
    bf16_t* B = (bf16_t*)(p.ws + OFF_B); bf16_t* XL = (bf16_t*)(p.ws + OFF_XL);
    bf16_t* GLAD = (bf16_t*)(p.ws + OFF_GLAD); bf16_t* GDNC = (bf16_t*)(p.ws + OFF_GDNC); float* GDNGB = (float*)(p.ws + OFF_GDNGB);
    const float* mu = p.in[I_RWMU] + (size_t)l * 2 * 1920;
    const float* kkw = p.in[I_RWKK] + l * 512;
    const float* ga2 = p.in[I_GLAA2] + (size_t)l * 2 * 16 * 256; const float* gab = p.in[I_GLAAB] + l * 512;
    const float* cw = p.in[I_GDNCONV] + (size_t)l * 5 * 1536; const float* alog = p.in[I_GDNALOG] + l * 8; const float* dtb = p.in[I_GDNDT] + l * 8;
    LAS float* gal = (LAS float*)lds;
    LAS float* red = gal + TT * 32;
    const int tid = otid(), wave = tid >> 6;
    const int c = tid;
    const int gz = tid >> 8, gk = tid & 255;
    for (int tile = blockIdx.x; tile < L / TT; tile += gridDim.x) {
        const int t0 = tile * TT;
        if (tid < TT * 32) { const int tt = tid >> 5, e = tid & 31; gal[tt * 32 + e] = bf2f(PG[(size_t)(t0 + tt) * PG_LD + GLA_AL + e]); }
        {
            float xr[TT + 2], xk[TT + 2], xv[TT + 2], xe[TT + 2];
#pragma unroll
            for (int i = 0; i < TT + 2; ++i) { const int rr = t0 - 1 + i;
                if (rr >= 0 && rr < L) { const bf16_t* rp = R + (size_t)rr * R_LD + c; xr[i] = bf2f(rp[0]); xk[i] = bf2f(rp[512]); xv[i] = bf2f(rp[1024]); xe[i] = (c < 384) ? bf2f(rp[1536]) : 0.f; }
                else { xr[i] = 0.f; xk[i] = 0.f; xv[i] = 0.f; xe[i] = 0.f; } }
            const float mr0 = mu[c], mr1 = mu[1920 + c], mk0 = mu[512 + c], mk1 = mu[1920 + 512 + c], mv0 = mu[1024 + c], mv1 = mu[1920 + 1024 + c];
            const float me0 = (c < 384) ? mu[1536 + c] : 0.f, me1 = (c < 384) ? mu[1920 + 1536 + c] : 0.f;
            const float kkc = kkw[c];
#pragma unroll
            for (int tt = 0; tt < TT; ++tt) {
                const int t = t0 + tt;
                const float hp = (t != 0 && t != NCTX) ? 1.f : 0.f, hn = (t != NCTX - 1 && t != L - 1) ? 1.f : 0.f;
                const float r = mr0 * hp * xr[tt] + (1.f - mr0 - mr1) * xr[tt + 1] + mr1 * hn * xr[tt + 2];
                const float k = mk0 * hp * xk[tt] + (1.f - mk0 - mk1) * xk[tt + 1] + mk1 * hn * xk[tt + 2];
                const float v = mv0 * hp * xv[tt] + (1.f - mv0 - mv1) * xv[tt + 1] + mv1 * hn * xv[tt + 2];
                float e = me0 * hp * xe[tt] + (1.f - me0 - me1) * xe[tt + 1] + me1 * hn * xe[tt + 2];
                if (c < 128) e = tanhf(e); else if (c >= 256 && c < 384) e = sigmoid_(e); else if (c >= 384) e = 0.f;
                const float kr = k * kkc;
                const float ssq = wave_sum(kr * kr);
                bf16_t* bp = B + (size_t)t * 4096 + c;
                bp[0] = f2bf(r); bp[512] = f2bf(k); bp[1024] = f2bf(v); bp[1536] = f2bf(kr * rsqrtf(ssq + 1e-12f));
                XL[(size_t)t * 512 + c] = f2bf(e);
            }
        }
        __syncthreads();
        {
        float ga2v[16];
#pragma unroll
        for (int e = 0; e < 16; ++e) ga2v[e] = ga2[(gz * 16 + e) * 256 + gk];
        const float gabv = gab[gz * 256 + gk];
#pragma unroll
        for (int tt = 0; tt < TT; ++tt) {
            float zv = gabv;
#pragma unroll
            for (int e = 0; e < 16; ++e) zv += gal[tt * 32 + gz * 16 + e] * ga2v[e];
            const float la = -softplus_(-zv) * (1.f / 16.f);
            GLAD[(size_t)(t0 + tt) * 512 + tid] = f2bf(-expm1f(la));
        }
        }
        {
            float cwv[5], xv[TT + 4];
#pragma unroll
            for (int i = 0; i < 5; ++i) cwv[i] = cw[i * 1536 + 1024 + c];
#pragma unroll
            for (int i = 0; i < TT + 4; ++i) { const int rr = t0 - 2 + i; xv[i] = (rr >= 0 && rr < L) ? bf2f(PG[(size_t)rr * PG_LD + GDN_QKV + 1024 + c]) : 0.f; }
#pragma unroll
            for (int tt = 0; tt < TT; ++tt) { const int t = t0 + tt; float sv = 0.f;
#pragma unroll
                for (int i = 0; i < 5; ++i) { const int rr = t + i - 2; const bool ok_ = (rr >= 0) && (rr < L) && ((rr < NCTX) == (t < NCTX)); if (ok_) sv += xv[tt + i] * cwv[i]; }
                GDNC[(size_t)t * 1536 + 1024 + c] = f2bf(silu_(sv)); }
        }
        float oq[TT], ok[TT];
        {
            float cwq[5], cwk[5], xq[TT + 4], xk[TT + 4];
#pragma unroll
            for (int i = 0; i < 5; ++i) { cwq[i] = cw[i * 1536 + c]; cwk[i] = cw[i * 1536 + 512 + c]; }
#pragma unroll
            for (int i = 0; i < TT + 4; ++i) { const int rr = t0 - 2 + i;
                if (rr >= 0 && rr < L) { const bf16_t* rp = PG + (size_t)rr * PG_LD + GDN_QKV + c; xq[i] = bf2f(rp[0]); xk[i] = bf2f(rp[512]); } else { xq[i] = 0.f; xk[i] = 0.f; } }
#pragma unroll
            for (int tt = 0; tt < TT; ++tt) {
                const int t = t0 + tt; float sq = 0.f, sk = 0.f;
#pragma unroll
                for (int i = 0; i < 5; ++i) { const int rr = t + i - 2; const bool ok_ = (rr >= 0) && (rr < L) && ((rr < NCTX) == (t < NCTX));
                    if (ok_) { sq += xq[tt + i] * cwq[i]; sk += xk[tt + i] * cwk[i]; } }
                oq[tt] = silu_(sq); ok[tt] = silu_(sk);
                const float pq = wave_sum(oq[tt] * oq[tt]), pk = wave_sum(ok[tt] * ok[tt]);
                if ((tid & 63) == 0) { red[(tt * 8 + wave) * 2 + 0] = pq; red[(tt * 8 + wave) * 2 + 1] = pk; }
            }
        }
        __syncthreads();
#pragma unroll
        for (int tt = 0; tt < TT; ++tt) {
            const int w0i = (wave >> 1) * 2;
            const float ssq = red[(tt * 8 + w0i) * 2 + 0] + red[(tt * 8 + w0i + 1) * 2 + 0], ssk = red[(tt * 8 + w0i) * 2 + 1] + red[(tt * 8 + w0i + 1) * 2 + 1];
            bf16_t* gp = GDNC + (size_t)(t0 + tt) * 1536 + c;
            gp[0] = f2bf(oq[tt] * rsqrtf(ssq + 1e-12f) * 0.08838834764831845f); gp[512] = f2bf(ok[tt] * rsqrtf(ssk + 1e-12f));
        }
        if (tid < TT * 16) { const int tt = tid >> 4, j = tid & 15, t = t0 + tt;
            float o;
            if (j < 8) { const float a = bf2f(PG[(size_t)t * PG_LD + GDN_A + j]); o = __expf(-__expf(alog[j]) * softplus_(a + dtb[j])); }
            else o = sigmoid_(bf2f(PG[(size_t)t * PG_LD + GDN_B + (j - 8)]));
            GDNGB[t * 16 + j] = o; }
        __syncthreads();
    }
}
__device__ __forceinline__ void build_wl(const P& p, int l, int wg, int nwg) {
    const float* w2 = p.in[I_RWW2] + (size_t)l * 2 * 64 * 512; const float* a2 = p.in[I_RWA2] + (size_t)l * 2 * 64 * 512; const float* g2 = p.in[I_RWG2] + (size_t)l * 128 * 512;
    bf16_t* WL = (bf16_t*)(p.ws + OFF_WL);
    const int tid = otid();
    for (int it = wg * 512 + tid; it < 2560 * 64; it += nwg * 512) {
        const int kc = it / 2560, n = it - kc * 2560, k0 = kc * 8, blk = n >> 9, cc = n & 511;
        const float* src = nullptr; int kb = 0, kn = 0;
        if (blk == 0) { src = w2; kb = 0; kn = 64; } else if (blk == 1) { src = w2 + 64 * 512; kb = 64; kn = 64; }
        else if (blk == 2) { src = a2; kb = 128; kn = 64; } else if (blk == 3) { src = a2 + 64 * 512; kb = 192; kn = 64; }
        else { src = g2; kb = 256; kn = 128; }
        float v[8];
#pragma unroll
        for (int j = 0; j < 8; ++j) { const int k = k0 + j - kb; v[j] = (k >= 0 && k < kn) ? src[(size_t)k * 512 + cc] : 0.f; }
        u32x4 o; o[0] = pk2(v[0], v[1]); o[1] = pk2(v[2], v[3]); o[2] = pk2(v[4], v[5]); o[3] = pk2(v[6], v[7]);
        *(u32x4*)(WL + (size_t)n * 512 + k0) = o;
    }
}

constexpr int TB = 32, NBLK = L / TB;
__device__ __forceinline__ int tok_seq(int z, int j) { return z == 0 ? j : (j < NCTX ? NCTX - 1 - j : L - 1 - (j - NCTX)); }
__device__ __forceinline__ int tok_gla(int z, int j) {
    if (j < NCTX) return z == 0 ? j : NCTX - 1 - j;
    const int jj = j - NCTX, pp = z == 0 ? jj : NLAT - 1 - jj;
    return NCTX + (pp & 255) * 64 + (pp >> 8);
}

template <int NCW> struct ScanRole {
    bool cons, prod; int ct;
    __device__ __forceinline__ ScanRole(int tid) {
        const int w = tid >> 6, lane = tid & 63;
        if (NCW == 4) { cons = w < 4; prod = !cons; ct = tid & 255; }
        else { cons = w < 2; prod = (w & 2) != 0; ct = cons ? tid : ((((w >> 2) << 1) | (w & 1)) * 64 + lane); }
    }
};
#define SCAN_BARRIER() asm volatile("s_waitcnt lgkmcnt(0)\n\ts_barrier" ::: "memory")
__device__ __forceinline__ float bfraw2f(unsigned short b) { return __uint_as_float(((unsigned)b) << 16); }

__device__ __forceinline__ void scan_rwkv(const P& p, int l, int unit, LAS unsigned char* lds) {
    const int z = unit >> 6, h = (unit >> 3) & 7, rq = unit & 7;
    const bf16_t* B = (const bf16_t*)(p.ws + OFF_B); bf16_t* Y = (bf16_t*)(p.ws + OFF_PG) + YRW_COL + z * 512 + h * 64 + rq * 8;
    const float* kaw = p.in[I_RWKA] + l * 512 + h * 64;
    LAS float* vec = (LAS float*)lds;
    LAS float* vv = vec + 2 * TB * 320;
    LAS float* yo = vv + 2 * TB * 8;
    const int tid = otid(); const ScanRole<2> role(tid); const int ct = role.ct; const bool prod = role.prod, cons = role.cons;
    unsigned short pr[8], pk[8], pkk[8], pa[8], pw[8], pv;
    const float kac = kaw[ct & 63];
    auto p_load = [&](int blk) {
#pragma unroll
        for (int i = 0; i < 8; ++i) { const int idx = ct + i * 256, s = idx >> 6, n = idx & 63; const int t = tok_seq(z, blk * TB + s);
            const bf16_t* bp = B + (size_t)t * 4096 + h * 64 + n;
            pr[i] = bp[0]; pk[i] = bp[512]; pkk[i] = bp[1536]; pa[i] = bp[2048 + z * 512]; pw[i] = bp[3072 + z * 512]; }
        { const int s = ct >> 3, r = ct & 7; const int t = tok_seq(z, blk * TB + s); pv = B[(size_t)t * 4096 + 1024 + h * 64 + rq * 8 + r]; }
    };
    auto p_write = [&](int buf) {
#pragma unroll
        for (int i = 0; i < 8; ++i) { const int idx = ct + i * 256, s = idx >> 6, n = idx & 63;
            LAS float* d = vec + ((buf * TB + s) * 16 + (n >> 2)) * 20 + (n & 3);
            const float kk = bfraw2f(pkk[i]), a = bfraw2f(pa[i]);
            d[0] = kk; d[4] = 1.f - bfraw2f(pw[i]); d[8] = kk * a; d[12] = bfraw2f(pk[i]) * (1.f + (a - 1.f) * kac); d[16] = bfraw2f(pr[i]); }
        vv[buf * TB * 8 + ct] = bfraw2f(pv);
    };
    auto p_yout = [&](int blk) {
        const int buf = blk & 1; const int s = ct >> 3, r = ct & 7; const int t = tok_seq(z, blk * TB + s);
        Y[(size_t)t * PG_LD + r] = f2bf(yo[buf * TB * 8 + ct]);
    };
    const int irow = (ct >> 4) & 7, ks = ct & 15;
    f32x2 S0 = (f32x2){0.f, 0.f}, S1 = S0;
    struct Vx { f32x4 kk, w, b, k, r; float v; };
    auto c_ld = [&](Vx& x, int buf, int s) {
        const LAS float* d = vec + ((buf * TB + s) * 16 + ks) * 20;
        x.kk = *(const LAS f32x4*)(d); x.w = *(const LAS f32x4*)(d + 4); x.b = *(const LAS f32x4*)(d + 8); x.k = *(const LAS f32x4*)(d + 12);
        x.r = *(const LAS f32x4*)(d + 16); x.v = vv[(buf * TB + s) * 8 + irow];
    };
    float sa = 0.f;
    auto c_step = [&](const Vx& x, const f32x4& kkn, int buf, int s) {
        const f32x2 vv2 = (f32x2){x.v, x.v}, nsa = (f32x2){-sa, -sa};
        S0 = S0 * (f32x2){x.w[0], x.w[1]} + (vv2 * (f32x2){x.k[0], x.k[1]} + nsa * (f32x2){x.b[0], x.b[1]});
        S1 = S1 * (f32x2){x.w[2], x.w[3]} + (vv2 * (f32x2){x.k[2], x.k[3]} + nsa * (f32x2){x.b[2], x.b[3]});
        const f32x2 y2 = S0 * (f32x2){x.r[0], x.r[1]} + S1 * (f32x2){x.r[2], x.r[3]};
        const f32x2 s2 = S0 * (f32x2){kkn[0], kkn[1]} + S1 * (f32x2){kkn[2], kkn[3]};
        float yp = y2[0] + y2[1], sp = s2[0] + s2[1];
        yp += dpp_<0xB1>(yp); sp += dpp_<0xB1>(sp); yp += dpp_<0x4E>(yp); sp += dpp_<0x4E>(sp);
        yp += dpp_<0x141>(yp); sp += dpp_<0x141>(sp); yp += dpp_<0x140>(yp); sp += dpp_<0x140>(sp);
        sa = sp;
        if (ks == 0) yo[(buf * TB + s) * 8 + irow] = yp;
    };
    if (prod) { p_load(0); p_write(0); p_load(1); }
    SCAN_BARRIER();
    for (int b = 0; b < NBLK; ++b) {
        if (prod) {
            if (b + 1 < NBLK) p_write((b + 1) & 1);
            if (b + 2 < NBLK) p_load(b + 2);
            if (b > 0) p_yout(b - 1);
        } else if (cons) {
            const int buf = b & 1;
            Vx xa, xb;
            c_ld(xa, buf, 0);
            { const f32x2 s2 = S0 * (f32x2){xa.kk[0], xa.kk[1]} + S1 * (f32x2){xa.kk[2], xa.kk[3]}; sa = reduce16(s2[0] + s2[1]); }
#pragma unroll 1
            for (int s = 0; s < TB; s += 2) {
                c_ld(xb, buf, s + 1); c_step(xa, xb.kk, buf, s);
                if (s + 2 < TB) c_ld(xa, buf, s + 2);
                c_step(xb, xa.kk, buf, s + 1);
            }
        }
        SCAN_BARRIER();
    }
    if (prod) p_yout(NBLK - 1);
    SCAN_BARRIER();
}

__device__ __forceinline__ void scan_gla(const P& p, int l, int unit, LAS unsigned char* lds) {
    const int z = unit >> 4, h = (unit >> 2) & 3, cb = unit & 3;
    const bf16_t* PG = (const bf16_t*)(p.ws + OFF_PG); const bf16_t* GLAD = (const bf16_t*)(p.ws + OFF_GLAD);
    bf16_t* O = (bf16_t*)(p.ws + OFF_R) + z * 512 + h * 128 + cb * 32;
    LAS float* vec = (LAS float*)lds;
    LAS float* vv = vec + 2 * TB * 192;
    LAS float* yo = vv + 2 * TB * 32;
    const int tid = otid(); const ScanRole<4> role(tid); const int ct = role.ct; const bool prod = role.prod, cons = role.cons;
    unsigned short pq[8], pk[8], pa[8], pv[4];
    auto p_load = [&](int blk) {
#pragma unroll
        for (int i = 0; i < 8; ++i) { const int idx = ct + i * 256, s = idx >> 6, n = idx & 63; const int t = tok_gla(z, blk * TB + s);
            const bf16_t* bp = PG + (size_t)t * PG_LD + h * 64 + n;
            pq[i] = bp[GLA_Q]; pk[i] = bp[GLA_K]; pa[i] = GLAD[(size_t)t * 512 + z * 256 + h * 64 + n]; }
#pragma unroll
        for (int i = 0; i < 4; ++i) { const int idx = ct + i * 256, s = idx >> 5, r = idx & 31; const int t = tok_gla(z, blk * TB + s);
            pv[i] = PG[(size_t)t * PG_LD + GLA_V + h * 128 + cb * 32 + r]; }
    };
    auto p_write = [&](int buf) {
#pragma unroll
        for (int i = 0; i < 8; ++i) { const int idx = ct + i * 256, s = idx >> 6, n = idx & 63;
            LAS float* d = vec + ((buf * TB + s) * 8 + (n >> 3)) * 24 + (n & 7);
            d[0] = bfraw2f(pq[i]) * 0.125f; d[8] = bfraw2f(pk[i]); d[16] = 1.f - bfraw2f(pa[i]); }
#pragma unroll
        for (int i = 0; i < 4; ++i) vv[buf * TB * 32 + ct + i * 256] = bfraw2f(pv[i]);
    };
    auto p_yout = [&](int blk) {
        const int buf = blk & 1;
#pragma unroll
        for (int i = 0; i < 4; ++i) { const int idx = ct + i * 256, s = idx >> 5, r = idx & 31; const int t = tok_gla(z, blk * TB + s);
            O[(size_t)t * R_LD + r] = f2bf(yo[buf * TB * 32 + idx]); }
    };
    const int icol = (ct >> 3) & 31, ks = ct & 7;
    f32x2 S[4];
#pragma unroll
    for (int j = 0; j < 4; ++j) S[j] = (f32x2){0.f, 0.f};
    struct Vx { f32x4 q0, q1, k0, k1, a0, a1; float v; };
    auto c_ld = [&](Vx& x, int buf, int s) {
        const LAS float* d = vec + ((buf * TB + s) * 8 + ks) * 24;
        x.q0 = *(const LAS f32x4*)(d); x.q1 = *(const LAS f32x4*)(d + 4); x.k0 = *(const LAS f32x4*)(d + 8); x.k1 = *(const LAS f32x4*)(d + 12);
        x.a0 = *(const LAS f32x4*)(d + 16); x.a1 = *(const LAS f32x4*)(d + 20); x.v = vv[(buf * TB + s) * 32 + icol];
    };
    auto c_upd = [&](const Vx& x) -> float {
        const f32x2 vv2 = (f32x2){x.v, x.v};
        S[0] = S[0] * (f32x2){x.a0[0], x.a0[1]} + vv2 * (f32x2){x.k0[0], x.k0[1]};
        S[1] = S[1] * (f32x2){x.a0[2], x.a0[3]} + vv2 * (f32x2){x.k0[2], x.k0[3]};
        S[2] = S[2] * (f32x2){x.a1[0], x.a1[1]} + vv2 * (f32x2){x.k1[0], x.k1[1]};
        S[3] = S[3] * (f32x2){x.a1[2], x.a1[3]} + vv2 * (f32x2){x.k1[2], x.k1[3]};
        const f32x2 y2 = (S[0] * (f32x2){x.q0[0], x.q0[1]} + S[1] * (f32x2){x.q0[2], x.q0[3]}) + (S[2] * (f32x2){x.q1[0], x.q1[1]} + S[3] * (f32x2){x.q1[2], x.q1[3]});
        return y2[0] + y2[1];
    };
    if (prod) { p_load(0); p_write(0); p_load(1); }
    SCAN_BARRIER();
    for (int b = 0; b < NBLK; ++b) {
        if (prod) {
            if (b + 1 < NBLK) p_write((b + 1) & 1);
            if (b + 2 < NBLK) p_load(b + 2);
            if (b > 0) p_yout(b - 1);
        } else if (cons) {
            const int buf = b & 1;
            Vx xa, xb;
            c_ld(xa, buf, 0);
#pragma unroll 1
            for (int s = 0; s < TB; s += 2) {
                c_ld(xb, buf, s + 1);
                float ya = c_upd(xa);
                if (s + 2 < TB) c_ld(xa, buf, s + 2);
                float yb = c_upd(xb);
                ya += dpp_<0xB1>(ya); yb += dpp_<0xB1>(yb); ya += dpp_<0x4E>(ya); yb += dpp_<0x4E>(yb); ya += dpp_<0x141>(ya); yb += dpp_<0x141>(yb);
                if (ks == 0) { yo[(buf * TB + s) * 32 + icol] = ya; yo[(buf * TB + s + 1) * 32 + icol] = yb; }
            }
        }
        SCAN_BARRIER();
    }
    if (prod) p_yout(NBLK - 1);
    SCAN_BARRIER();
}

__device__ __forceinline__ void scan_gdn(const P& p, int l, int unit, LAS unsigned char* lds) {
    const int z = unit >> 5, h = (unit >> 3) & 3, cb = unit & 7;
    const bf16_t* GDNC = (const bf16_t*)(p.ws + OFF_GDNC); const float* GDNGB = (const float*)(p.ws + OFF_GDNGB);
    bf16_t* O = (bf16_t*)(p.ws + OFF_R) + 1024 + z * 512 + h * 128 + cb * 16;
    LAS float* vec = (LAS float*)lds;
    LAS float* vv = vec + 2 * TB * 320;
    LAS float* sc = vv + 2 * TB * 16;
    LAS float* yo = sc + 2 * TB * 2;
    const int tid = otid(); const ScanRole<4> role(tid); const int ct = role.ct; const bool prod = role.prod, cons = role.cons;
    unsigned short pq[16], pk[16], pv[2]; float psc = 0.f;
    auto p_load = [&](int blk) {
#pragma unroll
        for (int i = 0; i < 16; ++i) { const int idx = ct + i * 256, s = idx >> 7, n = idx & 127; const int t = tok_seq(z, blk * TB + s);
            const bf16_t* bp = GDNC + (size_t)t * 1536 + h * 128 + n;
            pq[i] = bp[0]; pk[i] = bp[512]; }
#pragma unroll
        for (int i = 0; i < 2; ++i) { const int idx = ct + i * 256, s = idx >> 4, r = idx & 15; const int t = tok_seq(z, blk * TB + s);
            pv[i] = GDNC[(size_t)t * 1536 + 1024 + h * 128 + cb * 16 + r]; }
        if (ct < 64) { const int s = ct >> 1, w = ct & 1; const int t = tok_seq(z, blk * TB + s); psc = GDNGB[t * 16 + w * 8 + z * 4 + h]; }
    };
    auto p_write = [&](int buf) {
#pragma unroll
        for (int i = 0; i < 16; ++i) { const int idx = ct + i * 256, s = idx >> 7, n = idx & 127;
            LAS float* d = vec + ((buf * TB + s) * 16 + (n >> 3)) * 20 + (n & 7);
            d[0] = bfraw2f(pq[i]); d[8] = bfraw2f(pk[i]); }
#pragma unroll
        for (int i = 0; i < 2; ++i) vv[buf * TB * 16 + ct + i * 256] = bfraw2f(pv[i]);
        if (ct < 64) sc[buf * TB * 2 + ct] = psc;
    };
    auto p_yout = [&](int blk) {
        const int buf = blk & 1;
#pragma unroll
        for (int i = 0; i < 2; ++i) { const int idx = ct + i * 256, s = idx >> 4, r = idx & 15; const int t = tok_seq(z, blk * TB + s);
            O[(size_t)t * R_LD + r] = f2bf(yo[buf * TB * 16 + idx]); }
    };
    const int icol = (ct >> 4) & 15, ks = ct & 15;
    f32x2 S[4];
#pragma unroll
    for (int j = 0; j < 4; ++j) S[j] = (f32x2){0.f, 0.f};
    struct Vx { f32x4 q0, q1, k0, k1; float v; f32x2 gb; };
    auto c_ld = [&](Vx& x, int buf, int s) {
        const LAS float* d = vec + ((buf * TB + s) * 16 + ks) * 20;
        x.q0 = *(const LAS f32x4*)(d); x.q1 = *(const LAS f32x4*)(d + 4); x.k0 = *(const LAS f32x4*)(d + 8); x.k1 = *(const LAS f32x4*)(d + 12);
        x.v = vv[(buf * TB + s) * 16 + icol]; x.gb = *(const LAS f32x2*)(sc + (buf * TB + s) * 2);
    };
    float dd = 0.f;
    auto c_step = [&](const Vx& x, const f32x4& kn0, const f32x4& kn1, int buf, int s) {
        const float eg = x.gb[0];
        const float cc = x.gb[1] * (x.v - eg * dd);
        const f32x2 eg2 = (f32x2){eg, eg}, cc2 = (f32x2){cc, cc};
        S[0] = S[0] * eg2 + cc2 * (f32x2){x.k0[0], x.k0[1]};
        S[1] = S[1] * eg2 + cc2 * (f32x2){x.k0[2], x.k0[3]};
        S[2] = S[2] * eg2 + cc2 * (f32x2){x.k1[0], x.k1[1]};
        S[3] = S[3] * eg2 + cc2 * (f32x2){x.k1[2], x.k1[3]};
        const f32x2 y2 = (S[0] * (f32x2){x.q0[0], x.q0[1]} + S[1] * (f32x2){x.q0[2], x.q0[3]}) + (S[2] * (f32x2){x.q1[0], x.q1[1]} + S[3] * (f32x2){x.q1[2], x.q1[3]});
        const f32x2 d2 = (S[0] * (f32x2){kn0[0], kn0[1]} + S[1] * (f32x2){kn0[2], kn0[3]}) + (S[2] * (f32x2){kn1[0], kn1[1]} + S[3] * (f32x2){kn1[2], kn1[3]});
        float yp = y2[0] + y2[1], dp = d2[0] + d2[1];
        yp += dpp_<0xB1>(yp); dp += dpp_<0xB1>(dp); yp += dpp_<0x4E>(yp); dp += dpp_<0x4E>(dp);
        yp += dpp_<0x141>(yp); dp += dpp_<0x141>(dp); yp += dpp_<0x140>(yp); dp += dpp_<0x140>(dp);
        dd = dp;
        if (ks == 0) yo[(buf * TB + s) * 16 + icol] = yp;
    };
    if (prod) { p_load(0); p_write(0); p_load(1); }
    SCAN_BARRIER();
    for (int b = 0; b < NBLK; ++b) {
        if (prod) {
            if (b + 1 < NBLK) p_write((b + 1) & 1);
            if (b + 2 < NBLK) p_load(b + 2);
            if (b > 0) p_yout(b - 1);
        } else if (cons) {
            const int buf = b & 1;
            Vx xa, xb;
            c_ld(xa, buf, 0);
            { const f32x2 d2 = (S[0] * (f32x2){xa.k0[0], xa.k0[1]} + S[1] * (f32x2){xa.k0[2], xa.k0[3]}) + (S[2] * (f32x2){xa.k1[0], xa.k1[1]} + S[3] * (f32x2){xa.k1[2], xa.k1[3]});
              dd = reduce16(d2[0] + d2[1]); }
#pragma unroll 1
            for (int s = 0; s < TB; s += 2) {
                c_ld(xb, buf, s + 1); c_step(xa, xb.k0, xb.k1, buf, s);
                if (s + 2 < TB) c_ld(xa, buf, s + 2);
                c_step(xb, xa.k0, xa.k1, buf, s + 1);
            }
        }
        SCAN_BARRIER();
    }
    if (prod) p_yout(NBLK - 1);
    SCAN_BARRIER();
}

__device__ __forceinline__ void phase_post(const P& p, int l, LAS unsigned char* lds) {
    const bf16_t* PG = (const bf16_t*)(p.ws + OFF_PG); const bf16_t* Rb = (const bf16_t*)(p.ws + OFF_R); const bf16_t* B = (const bf16_t*)(p.ws + OFF_B);
    const bf16_t* RWG = (const bf16_t*)(p.ws + OFF_RWG);
    bf16_t* YC = (bf16_t*)(p.ws + OFF_GDNC);
    const int tid = otid(), wave = tid >> 6, c = tid;
    const float lnw = p.in[I_RWLNW][l * 512 + c], lnb = p.in[I_RWLNB][l * 512 + c], kac = p.in[I_RWKA][l * 512 + c], rkc = p.in[I_RWRK][l * 512 + c];
    const float gng = p.in[I_GLANG][l * 128 + (c & 127)], dng = p.in[I_GDNNG][l * 128 + (c & 127)];
    LAS float* red = (LAS float*)lds;
    for (int tile = blockIdx.x; tile < L / TT; tile += gridDim.x) {
        const int t0 = tile * TT;
        float og[TT], od[TT];
#pragma unroll
        for (int tt = 0; tt < TT; ++tt) {
            const int t = t0 + tt;
            const float y = bf2f(PG[(size_t)t * PG_LD + YRW_COL + c]) + bf2f(PG[(size_t)t * PG_LD + YRW_COL + 512 + c]);
            const float mean = wave_sum(y) * (1.f / 64.f);
            const float dy = y - mean;
            const float var = wave_sum(dy * dy) * (1.f / 64.f);
            const float yn = dy * rsqrtf(var + 64e-5f) * lnw + lnb;
            const bf16_t* bp = B + (size_t)t * 4096 + c;
            const float v = bf2f(bp[1024]), rr_ = bf2f(bp[0]), kk_ = bf2f(bp[512]), az0 = bf2f(bp[2048]), az1 = bf2f(bp[2560]);
            const float bon = wave_sum(rr_ * rkc * (kk_ * (1.f + (az0 - 1.f) * kac) + kk_ * (1.f + (az1 - 1.f) * kac)));
            const float o = (yn + bon * v) * bf2f(RWG[(size_t)t * 512 + c]);
            YC[(size_t)t * 512 + c] = f2bf(o);
            og[tt] = bf2f(Rb[(size_t)t * R_LD + c]) + bf2f(Rb[(size_t)t * R_LD + 512 + c]);
            od[tt] = bf2f(Rb[(size_t)t * R_LD + 1024 + c]) + bf2f(Rb[(size_t)t * R_LD + 1536 + c]);
            const float pg_ = wave_sum(og[tt] * og[tt]), pd_ = wave_sum(od[tt] * od[tt]);
            if ((tid & 63) == 0) { red[(tt * 8 + wave) * 2 + 0] = pg_; red[(tt * 8 + wave) * 2 + 1] = pd_; }
        }
        __syncthreads();
#pragma unroll
        for (int tt = 0; tt < TT; ++tt) {
            const int t = t0 + tt, w0i = (wave >> 1) * 2;
            const float sg = red[(tt * 8 + w0i) * 2 + 0] + red[(tt * 8 + w0i + 1) * 2 + 0], sd = red[(tt * 8 + w0i) * 2 + 1] + red[(tt * 8 + w0i + 1) * 2 + 1];
            const float gate_g = silu_(bf2f(PG[(size_t)t * PG_LD + GLA_OG + c])), gate_d = silu_(bf2f(PG[(size_t)t * PG_LD + GDN_ZG + c]));
            YC[(size_t)L * 512 + (size_t)t * 512 + c] = f2bf(og[tt] * rsqrtf(sg * (1.f / 128.f) + 1e-6f) * gng * gate_g);
            YC[(size_t)2 * L * 512 + (size_t)t * 512 + c] = f2bf(od[tt] * rsqrtf(sd * (1.f / 128.f) + 1e-6f) * dng * gate_d);
        }
        __syncthreads();
    }
}

__device__ __forceinline__ void phase_final(const P& p) {
    const float* H = (const float*)(p.ws + OFF_H); const float* gamma = p.in[I_FINALG];
    const int tid_ = otid(); const int wave = tid_ >> 6, lane = tid_ & 63;
    for (int row = blockIdx.x * 8 + wave; row < NLAT; row += gridDim.x * 8) {
        const float* src = H + (size_t)(row + NCTX) * 1024;
        f32x4 v[4]; float ss = 0.f;
#pragma unroll
        for (int j = 0; j < 4; ++j) { v[j] = *(const f32x4*)(src + j * 256 + lane * 4); ss += (v[j][0] * v[j][0] + v[j][1] * v[j][1]) + (v[j][2] * v[j][2] + v[j][3] * v[j][3]); }
        ss = wave_sum(ss);
        const float rstd = rsqrtf(ss * (1.f / 1024.f) + 1e-6f);
#pragma unroll
        for (int j = 0; j < 4; ++j) { const int col = j * 256 + lane * 4; const f32x4 g = *(const f32x4*)(gamma + col);
            *(f32x4*)(p.out + (size_t)row * 1024 + col) = v[j] * rstd * g; }
    }
}

__global__ void __launch_bounds__(512, 2) fwd_megakernel(P p) {
    extern __shared__ __attribute__((aligned(16))) unsigned char shm_raw[];
    LAS unsigned char* lds = (LAS unsigned char*)shm_raw;
    cg::grid_group grid = cg::this_grid();
    const int G = gridDim.x, wg = blockIdx.x;
    unsigned char* ws = p.ws;
    float* H = (float*)(ws + OFF_H); bf16_t* HN = (bf16_t*)(ws + OFF_HN); bf16_t* WIN = (bf16_t*)(ws + OFF_WIN);
    const float* MODall = (const float*)(ws + OFF_MOD);

    phase_mod(p, lds);
    grid.sync();
    for (int l = 0; l < DEPTH; ++l) {
        const float* MOD = MODall + (size_t)l * 2 * 6144;
        if (l == 0) phase_norm<true>(p, l, p.in[I_N1G] + l * 1024, 0, 1); else phase_norm<false>(p, l, p.in[I_N1G] + l * 1024, 0, 1);
        {
            const float* win = p.in[I_WIN] + (size_t)l * 1024 * IN_COLS;
            convert_T(win, IN_COLS, 1024, 0, 1920, WIN, (LAS float*)lds, wg, G);
            convert_T(win, IN_COLS, 1024, 1920, 3632, WIN + (size_t)2048 * 1024, (LAS float*)lds, (wg + 64) % G, G);
            convert_T(win, IN_COLS, 1024, 5552, 3072, WIN + (size_t)NMAIN * 1024, (LAS float*)lds, (wg + 128) % G, G);
            build_wl(p, l, wg, G);
        }
        grid.sync();
        {
            pg8::Gemm g{HN, WIN, L, NMAIN, 1024}; pg8::StaticOrder S; S.init(L, NMAIN, G, wg);
            EpiInMain E{(bf16_t*)(ws + OFF_R), (bf16_t*)(ws + OFF_PG)};
            pg8::gemm_phase(lds, g, S, E);
        }
        grid.sync();
#ifndef NO_PREP
        phase_prep(p, l, lds);
        grid.sync();
        {
            pg8::Gemm g{(const bf16_t*)(ws + OFF_XL), (const bf16_t*)(ws + OFF_WL), L, 2560, 512}; pg8::StaticOrder S; S.init(L, 2560, G, wg);
            EpiLora E{(bf16_t*)(ws + OFF_B), (bf16_t*)(ws + OFF_RWG), p.in[I_RWW0] + (size_t)l * 1024, p.in[I_RWA0] + (size_t)l * 1024};
            pg8::gemm_phase(lds, g, S, E);
        }
#endif
        grid.sync();
#ifndef NO_SCAN
        if (wg < 128) scan_rwkv(p, l, wg, lds);
        else if (wg < 160) scan_gla(p, l, wg - 128, lds);
        else if (wg < 224) scan_gdn(p, l, wg - 160, lds);
#endif
        grid.sync();
#ifndef NO_POST
        phase_post(p, l, lds);
#endif
        grid.sync();
        {
            convert_T(p.in[I_WBR] + (size_t)l * 3 * 512 * 1024, 1024, 512, 0, 1024, (bf16_t*)(ws + OFF_WBR), (LAS float*)lds, wg, G);
            convert_T(p.in[I_WBR] + (size_t)l * 3 * 512 * 1024 + (size_t)512 * 1024, 1024, 512, 0, 1024, (bf16_t*)(ws + OFF_WBR) + (size_t)1024 * 512, (LAS float*)lds, (wg + 128) % G, G);
            convert_T(p.in[I_WBR] + (size_t)l * 3 * 512 * 1024 + (size_t)2 * 512 * 1024, 1024, 512, 0, 1024, (bf16_t*)(ws + OFF_WBR) + (size_t)2 * 1024 * 512, (LAS float*)lds, wg, G);
            convert_T(p.in[I_WOUT] + (size_t)l * 1024 * 1024, 1024, 1024, 0, 1024, (bf16_t*)(ws + OFF_WOUT), (LAS float*)lds, wg, G);
            convert_T(p.in[I_W1] + (size_t)l * 1024 * 4096, 4096, 1024, 0, 4096, (bf16_t*)(ws + OFF_W1), (LAS float*)lds, wg, G);
            convert_T(p.in[I_W2] + (size_t)l * 4096 * 1024, 1024, 4096, 0, 1024, (bf16_t*)(ws + OFF_W2), (LAS float*)lds, wg, G);
            pg8::Gemm g{HN, WIN + (size_t)NMAIN * 1024, L, 3072, 1024}; pg8::StaticOrder S; S.init(L, 3072, G, wg);
            EpiGates E{(bf16_t*)(ws + OFF_B)};
            pg8::gemm_phase(lds, g, S, E);
        }
        grid.sync();
        {
            const bf16_t* YC = (const bf16_t*)(ws + OFF_GDNC); const bf16_t* WBR = (const bf16_t*)(ws + OFF_WBR);
            pg8::StaticOrder S; S.init(L, 1024, G, wg);
            { pg8::Gemm g{YC, WBR, L, 1024, 512}; EpiBranch<0> E{(const bf16_t*)(ws + OFF_B), (float*)(ws + OFF_PG), HN}; pg8::gemm_phase(lds, g, S, E); }
            { pg8::Gemm g{YC + (size_t)L * 512, WBR + (size_t)1024 * 512, L, 1024, 512}; EpiBranch<1> E{(const bf16_t*)(ws + OFF_B), (float*)(ws + OFF_PG), HN}; pg8::gemm_phase(lds, g, S, E); }
            { pg8::Gemm g{YC + (size_t)2 * L * 512, WBR + (size_t)2 * 1024 * 512, L, 1024, 512}; EpiBranch<2> E{(const bf16_t*)(ws + OFF_B), (float*)(ws + OFF_PG), HN}; pg8::gemm_phase(lds, g, S, E); }
        }
        grid.sync();
        {
            pg8::Gemm g{HN, (const bf16_t*)(ws + OFF_WOUT), L, 1024, 1024}; pg8::StaticOrder S; S.init(L, 1024, G, wg);
            EpiResid E{H, MOD + 2 * 1024, MOD + 6144 + 2 * 1024};
            pg8::gemm_phase(lds, g, S, E);
        }
        grid.sync();
        phase_norm<false>(p, l, p.in[I_N2G] + l * 1024, 3, 4);
        grid.sync();
        {
            pg8::Gemm g{HN, (const bf16_t*)(ws + OFF_W1), L, 4096, 1024}; pg8::StaticOrder S; S.init(L, 4096, G, wg);
            EpiMlp1 E{(bf16_t*)(ws + OFF_B)};
            pg8::gemm_phase(lds, g, S, E);
        }
        grid.sync();
        {
            pg8::Gemm g{(const bf16_t*)(ws + OFF_B), (const bf16_t*)(ws + OFF_W2), L, 1024, 4096}; pg8::StaticOrder S; S.init(L, 1024, G, wg);
            EpiResid E{H, MOD + 5 * 1024, MOD + 6144 + 5 * 1024};
            pg8::gemm_phase(lds, g, S, E);
        }
        grid.sync();
    }
    phase_final(p);
}

extern "C" void kernel_launch(void* const* d_in, const int* in_sizes, int n_in, void* d_out, int out_size, void* d_ws, size_t ws_size, hipStream_t stream) {
    static int grid_blocks = 0;
    if (n_in != 32 || ws_size < WS_END || out_size != NLAT * DM) {
        fprintf(stderr, "kernel_launch: unexpected shapes / workspace (n_in %d, ws %zu need %zu, out %d)\n", n_in, ws_size, (size_t)WS_END, out_size);
        hipMemsetAsync(d_out, 0xFF, (size_t)out_size * 4, stream);
        return;
    }
    if (!grid_blocks) {
        int dev = 0, cus = 0, per_cu = 0;
        hipGetDevice(&dev);
        hipDeviceGetAttribute(&cus, hipDeviceAttributeMultiprocessorCount, dev);
        hipFuncSetAttribute((const void*)fwd_megakernel, hipFuncAttributeMaxDynamicSharedMemorySize, LDS_BYTES);
        hipOccupancyMaxActiveBlocksPerMultiprocessor(&per_cu, (const void*)fwd_megakernel, 512, LDS_BYTES);
        if (per_cu < 1) per_cu = 1;
        grid_blocks = cus * 1;
        (void)hipGetLastError();
    }
    P p{};
    for (int i = 0; i < 32; ++i) p.in[i] = (const float*)d_in[i];
    p.out = (float*)d_out; p.ws = (unsigned char*)d_ws;
    void* args[] = {&p};
    hipError_t e = hipLaunchCooperativeKernel((const void*)fwd_megakernel, dim3(grid_blocks), dim3(512), args, LDS_BYTES, stream);
    if (e != hipSuccess) fprintf(stderr, "cooperative launch failed: %s (grid %d)\n", hipGetErrorString(e), grid_blocks);
}
```

```cpp
#include <hip/hip_runtime.h>
#include <hip/hip_cooperative_groups.h>
#include <cstdio>
#include <cstdint>
namespace cg = cooperative_groups;

#define LAS __attribute__((address_space(3)))
typedef unsigned short bf16_t;
typedef short bf16x8 __attribute__((ext_vector_type(8)));
typedef float f32x4 __attribute__((ext_vector_type(4)));
typedef float f32x2 __attribute__((ext_vector_type(2)));
typedef unsigned u32x4 __attribute__((ext_vector_type(4)));
typedef unsigned u32x2 __attribute__((ext_vector_type(2)));

constexpr int L = 16640, NCTX = 256, NLAT = 16384, DM = 1024, BW = 512, DEPTH = 4;
constexpr int IN_COLS = 8624;
constexpr int NMAIN = 5888;
constexpr int NWIN = 8960;
constexpr int R_LD = 2048, PG_LD = 3840;
constexpr int GLA_Q = 0, GLA_K = 256, GLA_V = 512, GLA_OG = 1024, GLA_AL = 1536;
constexpr int GDN_QKV = 1568, GDN_ZG = 3104, GDN_A = 3616, GDN_B = 3624;
constexpr int YRW_COL = 1568;

constexpr size_t al256(size_t x) { return (x + 255) & ~(size_t)255; }
constexpr size_t OFF_MOD = 0;
constexpr size_t OFF_H = al256(OFF_MOD + (size_t)4 * 2 * 6144 * 4);
constexpr size_t OFF_HN = OFF_H + (size_t)L * 1024 * 4;
constexpr size_t OFF_WIN = OFF_HN + (size_t)L * 1024 * 2;
constexpr size_t OFF_R = OFF_WIN + (size_t)NWIN * 1024 * 2;
constexpr size_t OFF_PG = OFF_R + (size_t)L * R_LD * 2;
constexpr size_t OFF_B = OFF_PG + (size_t)L * PG_LD * 2;
constexpr size_t OFF_RWG = OFF_B + (size_t)L * 4096 * 2;
constexpr size_t OFF_BONUS = OFF_RWG + (size_t)L * 512 * 2;
constexpr size_t OFF_GLAD = OFF_BONUS + (size_t)L * 8 * 4;
constexpr size_t OFF_GDNC = OFF_GLAD + (size_t)L * 512 * 2;
constexpr size_t OFF_GDNGB = OFF_GDNC + (size_t)L * 1536 * 2;
constexpr size_t OFF_XL = OFF_GDNGB + (size_t)L * 16 * 4;
constexpr size_t OFF_WL = OFF_XL + (size_t)L * 512 * 2;
constexpr size_t OFF_BAR = OFF_WL + (size_t)2560 * 512 * 2;
constexpr size_t WS_END = OFF_BAR + 16384;
constexpr size_t OFF_WBR = OFF_R;
constexpr size_t OFF_WOUT = OFF_WBR + (size_t)3 * 1024 * 512 * 2;
constexpr size_t OFF_W1 = OFF_WOUT + (size_t)1024 * 1024 * 2;
constexpr size_t OFF_W2 = OFF_W1 + (size_t)4096 * 1024 * 2;

constexpr int LDS_BYTES = 131072 + 16;

struct P { const float* in[32]; float* out; unsigned char* ws; };
enum { I_X = 0, I_C, I_CTX, I_CCTX, I_WMOD, I_BMOD, I_N1G, I_WIN, I_RWMU, I_RWW0, I_RWW2, I_RWA0, I_RWA2, I_RWG2, I_RWKK, I_RWKA, I_RWRK,
       I_RWLNW, I_RWLNB, I_GLAA2, I_GLAAB, I_GLANG, I_GDNCONV, I_GDNALOG, I_GDNDT, I_GDNNG, I_WBR, I_WOUT, I_N2G, I_W1, I_W2, I_FINALG };

__device__ __forceinline__ float bf2f(bf16_t b) { return __uint_as_float(((unsigned)b) << 16); }
__device__ __forceinline__ unsigned pk2(float lo, float hi) { unsigned r; asm("v_cvt_pk_bf16_f32 %0, %1, %2" : "=v"(r) : "v"(lo), "v"(hi)); return r; }
__device__ __forceinline__ bf16_t f2bf(float f) { return (bf16_t)(pk2(f, 0.f) & 0xffffu); }
__device__ __forceinline__ float sigmoid_(float x) { return 1.f / (1.f + __expf(-x)); }
__device__ __forceinline__ float silu_(float x) { return x / (1.f + __expf(-x)); }
__device__ __forceinline__ float softplus_(float x) { return fmaxf(x, 0.f) + log1pf(__expf(-fabsf(x))); }
__device__ __forceinline__ float wave_sum(float v) {
#pragma unroll
    for (int o = 1; o < 64; o <<= 1) v += __shfl_xor(v, o);
    return v;
}
template <int CTRL> __device__ __forceinline__ float dpp_(float x) { return __int_as_float(__builtin_amdgcn_update_dpp(0, __float_as_int(x), CTRL, 0xF, 0xF, true)); }
__device__ __forceinline__ float reduce8(float x) { x += dpp_<0xB1>(x); x += dpp_<0x4E>(x); x += dpp_<0x141>(x); return x; }
__device__ __forceinline__ float reduce16(float x) { x = reduce8(x); x += dpp_<0x140>(x); return x; }

__device__ __forceinline__ int otid() { int t = threadIdx.x; asm volatile("" : "+v"(t)); return t; }
__device__ __forceinline__ int osgpr(int x) { asm volatile("" : "+s"(x)); return x; }
namespace pg8 {
constexpr int BM = 256, BK = 64, HALF = 128, HTB = HALF * BK * 2, STAGE_BYTES = 8 * HTB, NXCD = 8, WGM = 8;
__host__ __device__ __forceinline__ int lds_byte(int r, int c) { const int st = (r >> 4) * 2 + (c >> 5), rr = r & 15, cc = c & 31, ob = rr * 64 + cc * 2; return st * 1024 + (ob ^ (((ob >> 9) & 1) << 5)); }
__host__ __device__ __forceinline__ void stage_rc(int b, int& R, int& C) { const int st = b / 1024, sb = b % 1024, swz = sb ^ (((sb >> 9) & 1) << 5); R = (st >> 1) * 16 + swz / 64; C = (st & 1) * 32 + (swz % 64) / 2; }
struct Unit { int pm, pn; };
struct Gemm { const bf16_t* A; const bf16_t* Bt; int M, N, K; };
struct StaticOrder {
    int nM, nN, nwg, G, c;
    __host__ __device__ void init(int M, int N, int G_, int c_) { nM = M / BM; nN = N / BM; nwg = nM * nN; G = G_; c = c_; }
    __host__ __device__ bool next(int i, Unit& u) const {
        const long Lx = (long)i * G + c; if (Lx >= nwg) return false;
        int wgid = (int)Lx; { const int q = nwg / NXCD, r = nwg % NXCD, xcd = wgid % NXCD, off = wgid / NXCD; wgid = (xcd < r ? xcd * (q + 1) : r * (q + 1) + (xcd - r) * q) + off; }
        const int nig = WGM * nN, gid = wgid / nig, fm = gid * WGM, gsz = (nM - fm) < WGM ? (nM - fm) : WGM;
        u.pm = fm + ((wgid % nig) % gsz); u.pn = (wgid % nig) / gsz; return true;
    }
};
template <class Epi>
__device__ __forceinline__ void gemm_phase(LAS unsigned char* lds, const Gemm g, const StaticOrder& S, const Epi& E) {
#ifdef NO_GEMM
    return;
#endif
    const int tid = otid(), wid = __builtin_amdgcn_readfirstlane(tid >> 6), lane = tid & 63, wr = wid >> 2, wc = wid & 3, fr = lane & 15, fq = lane >> 4;
    const int K = g.K, nt = K / BK;
    unsigned voffA[2];
#pragma unroll
    for (int i = 0; i < 2; ++i) { int R, C; stage_rc(tid * 16 + i * 8192, R, C); voffA[i] = (unsigned)(R * K + C) * 2u; }
    const size_t kstep = (size_t)(BK * 2);
    const size_t hstep = (size_t)HALF * K * 2;
    const size_t tstep = 2 * hstep;
    const unsigned ldsw = (unsigned)wid * 1024u;
    const int aoff = lds_byte(wr * 64 + fr, fq * 8), boff = lds_byte(wc * 32 + fr, fq * 8);
#define PG8_SA(b, h) (((b) * 2 + (h)) * HTB)
#define PG8_SB(b, h) ((4 + (b) * 2 + (h)) * HTB)
#define PG8_STAGE(bufoff, gbase, voff) do { _Pragma("unroll") for (int _i = 0; _i < 2; ++_i) \
        __builtin_amdgcn_global_load_lds((const unsigned*)((const char*)(gbase) + (voff)[_i]), (LAS unsigned*)(lds + (bufoff) + ldsw + _i * 8192), 16, 0, 0); } while (0)
#define PG8_LDA(dst, b, h) do { _Pragma("unroll") for (int m = 0; m < 4; ++m) _Pragma("unroll") for (int k = 0; k < 2; ++k) dst[m][k] = *(const LAS bf16x8*)(lds + PG8_SA(b, h) + aoff + m * 2048 + k * 1024); } while (0)
#define PG8_LDB(dst, b, h) do { _Pragma("unroll") for (int n = 0; n < 2; ++n) _Pragma("unroll") for (int k = 0; k < 2; ++k) dst[n][k] = *(const LAS bf16x8*)(lds + PG8_SB(b, h) + boff + n * 2048 + k * 1024); } while (0)
#define PG8_MMA(ai, bj, At, Bt) do { __builtin_amdgcn_s_setprio(1); _Pragma("unroll") for (int m = 0; m < 4; ++m) _Pragma("unroll") for (int n = 0; n < 2; ++n) _Pragma("unroll") for (int k = 0; k < 2; ++k) \
        acc[ai][bj][m][n] = __builtin_amdgcn_mfma_f32_16x16x32_bf16(Bt[n][k], At[m][k], acc[ai][bj][m][n], 0, 0, 0); __builtin_amdgcn_s_setprio(0); } while (0)
#define PG8_WAIT_V(n) asm volatile("s_waitcnt vmcnt(" #n ")" ::: "memory")
#define PG8_WAIT_L(n) asm volatile("s_waitcnt lgkmcnt(" #n ")" ::: "memory")
#define PG8_BAR __builtin_amdgcn_s_barrier()
#define PG8_SCHED __builtin_amdgcn_sched_barrier(0)
    Unit cur, nxt; int ui = 0;
    if (!S.next(0, cur)) return;
    f32x4 acc[2][2][4][2];
#pragma unroll
    for (int a = 0; a < 2; ++a)
#pragma unroll
        for (int b = 0; b < 2; ++b)
#pragma unroll
            for (int m = 0; m < 4; ++m)
#pragma unroll
                for (int n = 0; n < 2; ++n) acc[a][b][m][n] = (f32x4){0.f, 0.f, 0.f, 0.f};
    bf16x8 At[4][2], B0[2][2], B1[2][2];
    const char* cA = (const char*)g.A + (size_t)cur.pm * tstep; const char* cB = (const char*)g.Bt + (size_t)cur.pn * tstep;
    PG8_STAGE(PG8_SB(0, 0), cB, voffA); PG8_STAGE(PG8_SA(0, 0), cA, voffA); PG8_STAGE(PG8_SB(0, 1), cB + hstep, voffA); PG8_STAGE(PG8_SA(0, 1), cA + hstep, voffA);
    if (wr == 1) PG8_BAR;
    PG8_WAIT_V(4); PG8_BAR;
    PG8_STAGE(PG8_SB(1, 0), cB + kstep, voffA); PG8_STAGE(PG8_SA(1, 0), cA + kstep, voffA); PG8_STAGE(PG8_SB(1, 1), cB + hstep + kstep, voffA);
    PG8_WAIT_V(6); PG8_BAR;
    for (;;) {
        const bool has_next = S.next(ui + 1, nxt);
        const char* nA = has_next ? (const char*)g.A + (size_t)nxt.pm * tstep : cA; const char* nB = has_next ? (const char*)g.Bt + (size_t)nxt.pn * tstep : cB;
        for (int t = 0; t < nt; t += 2) {
            const bool last = (t == nt - 2);
            const char* a1 = cA + (size_t)(t + 1) * kstep;
            const char* a2 = last ? nA : cA + (size_t)(t + 2) * kstep; const char* b2 = last ? nB : cB + (size_t)(t + 2) * kstep;
            const char* a3 = a2 + kstep; const char* b3 = b2 + kstep;
            PG8_LDB(B0, 0, 0); PG8_SCHED; PG8_LDA(At, 0, 0); PG8_STAGE(PG8_SA(1, 1), a1 + hstep, voffA);
            PG8_WAIT_L(8); PG8_BAR; PG8_WAIT_L(0); PG8_MMA(0, 0, At, B0); PG8_BAR; PG8_SCHED;
            PG8_LDB(B1, 0, 1); PG8_STAGE(PG8_SB(0, 0), b2, voffA);
            PG8_BAR; PG8_WAIT_L(0); PG8_MMA(0, 1, At, B1); PG8_BAR;
            PG8_LDA(At, 0, 1); PG8_STAGE(PG8_SA(0, 0), a2, voffA);
            PG8_BAR; PG8_WAIT_L(0); PG8_MMA(1, 0, At, B0); PG8_BAR; PG8_SCHED;
            PG8_STAGE(PG8_SB(0, 1), b2 + hstep, voffA);
            PG8_WAIT_V(6); PG8_BAR; PG8_MMA(1, 1, At, B1); PG8_BAR;
            PG8_LDB(B0, 1, 0); PG8_SCHED; PG8_LDA(At, 1, 0); PG8_STAGE(PG8_SA(0, 1), a2 + hstep, voffA);
            PG8_WAIT_L(8); PG8_BAR; PG8_WAIT_L(0); PG8_MMA(0, 0, At, B0); PG8_BAR; PG8_SCHED;
            PG8_LDB(B1, 1, 1); PG8_STAGE(PG8_SB(1, 0), b3, voffA);
            PG8_BAR; PG8_WAIT_L(0); PG8_MMA(0, 1, At, B1); PG8_BAR;
            PG8_LDA(At, 1, 1); PG8_STAGE(PG8_SA(1, 0), a3, voffA);
            PG8_BAR; PG8_WAIT_L(0); PG8_MMA(1, 0, At, B0); PG8_BAR; PG8_SCHED;
            PG8_STAGE(PG8_SB(1, 1), b3 + hstep, voffA);
            PG8_WAIT_V(6); PG8_BAR; PG8_MMA(1, 1, At, B1); PG8_BAR;
        }
        E(acc, cur, wr, wc, fr, fq);
        if (!has_next) break;
#pragma unroll
        for (int a = 0; a < 2; ++a)
#pragma unroll
            for (int b = 0; b < 2; ++b)
#pragma unroll
                for (int m = 0; m < 4; ++m)
#pragma unroll
                    for (int n = 0; n < 2; ++n) acc[a][b][m][n] = (f32x4){0.f, 0.f, 0.f, 0.f};
        cur = nxt; cA = nA; cB = nB; ++ui;
    }
    PG8_WAIT_V(0);
    if (wr == 0) PG8_BAR;
    PG8_BAR;
#undef PG8_SA
#undef PG8_SB
#undef PG8_STAGE
#undef PG8_LDA
#undef PG8_LDB
#undef PG8_MMA
#undef PG8_WAIT_V
#undef PG8_WAIT_L
#undef PG8_BAR
#undef PG8_SCHED
}
}
using pg8::Unit;

#define EPI_LOOP_ROWS for (int ai = 0; ai < 2; ++ai) for (int m = 0; m < 4; ++m)
#define EPI_LOOP_COLS for (int bj = 0; bj < 2; ++bj) for (int n = 0; n < 2; ++n)
struct EpiInMain {
    bf16_t* R; bf16_t* PG;
    __device__ __forceinline__ void operator()(const f32x4 (&acc)[2][2][4][2], const Unit& u, int wr, int wc, int fr, int fq) const {
        bf16_t* dst; int ld, c0;
        if (u.pn < 8) { dst = R; ld = R_LD; c0 = u.pn * 256; } else { dst = PG; ld = PG_LD; c0 = (u.pn - 8) * 256; }
        const int row0 = u.pm * 256 + wr * 64 + fr, col0 = c0 + wc * 32 + 4 * fq;
#pragma unroll
        EPI_LOOP_ROWS { bf16_t* rowp = dst + (size_t)(row0 + ai * 128 + m * 16) * ld + col0;
#pragma unroll
            EPI_LOOP_COLS { const f32x4 v = acc[ai][bj][m][n]; *(u32x2*)(rowp + bj * 128 + n * 16) = (u32x2){pk2(v[0], v[1]), pk2(v[2], v[3])}; } }
    }
};
struct EpiGates {
    bf16_t* G;
    __device__ __forceinline__ void operator()(const f32x4 (&acc)[2][2][4][2], const Unit& u, int wr, int wc, int fr, int fq) const {
        const int row0 = u.pm * 256 + wr * 64 + fr, col0 = u.pn * 256 + wc * 32 + 4 * fq;
#pragma unroll
        EPI_LOOP_ROWS { bf16_t* rowp = G + (size_t)(row0 + ai * 128 + m * 16) * 3072 + col0;
#pragma unroll
            EPI_LOOP_COLS { const f32x4 v = acc[ai][bj][m][n];
                *(u32x2*)(rowp + bj * 128 + n * 16) = (u32x2){pk2(sigmoid_(v[0]), sigmoid_(v[1])), pk2(sigmoid_(v[2]), sigmoid_(v[3]))}; } }
    }
};
template <int GI> struct EpiBranch {
    const bf16_t* G; float* MG; bf16_t* MB;
    __device__ __forceinline__ void operator()(const f32x4 (&acc)[2][2][4][2], const Unit& u, int wr, int wc, int fr, int fq) const {
        const int row0 = u.pm * 256 + wr * 64 + fr, col0 = u.pn * 256 + wc * 32 + 4 * fq;
#pragma unroll
        EPI_LOOP_ROWS { const size_t row = (size_t)(row0 + ai * 128 + m * 16);
#pragma unroll
            EPI_LOOP_COLS { const int col = col0 + bj * 128 + n * 16; const f32x4 v = acc[ai][bj][m][n];
                const u32x2 gq = *(const u32x2*)(G + row * 3072 + GI * 1024 + col);
                f32x4 gv = (f32x4){__uint_as_float(gq[0] << 16), __uint_as_float(gq[0] & 0xffff0000u), __uint_as_float(gq[1] << 16), __uint_as_float(gq[1] & 0xffff0000u)};
                f32x4 r = v * gv;
                if (GI > 0) r += *(const f32x4*)(MG + row * 1024 + col);
                if (GI < 2) *(f32x4*)(MG + row * 1024 + col) = r;
                else *(u32x2*)(MB + row * 1024 + col) = (u32x2){pk2(r[0], r[1]), pk2(r[2], r[3])}; } }
    }
};
struct EpiResid {
    float* H; const float* gate_lat; const float* gate_ctx;
    __device__ __forceinline__ void operator()(const f32x4 (&acc)[2][2][4][2], const Unit& u, int wr, int wc, int fr, int fq) const {
        const int row0 = u.pm * 256 + wr * 64 + fr, col0 = u.pn * 256 + wc * 32 + 4 * fq;
        const float* gp = (u.pm == 0) ? gate_ctx : gate_lat;
        f32x4 gv[2][2];
#pragma unroll
        EPI_LOOP_COLS gv[bj][n] = *(const f32x4*)(gp + col0 + bj * 128 + n * 16);
#pragma unroll
        EPI_LOOP_ROWS { float* rowp = H + (size_t)(row0 + ai * 128 + m * 16) * 1024 + col0;
#pragma unroll
            EPI_LOOP_COLS { f32x4* q = (f32x4*)(rowp + bj * 128 + n * 16); *q = *q + acc[ai][bj][m][n] * gv[bj][n]; } }
    }
};
struct EpiLora {
    bf16_t* B; bf16_t* RWG; const float* w0; const float* a0;
    __device__ __forceinline__ void operator()(const f32x4 (&acc)[2][2][4][2], const Unit& u, int wr, int wc, int fr, int fq) const {
        const int row0 = u.pm * 256 + wr * 64 + fr, blk = u.pn >> 1, cbase = (u.pn & 1) * 256 + wc * 32 + 4 * fq;
        f32x4 bv[2][2];
#pragma unroll
        EPI_LOOP_COLS { const int cc = cbase + bj * 128 + n * 16;
            bv[bj][n] = blk < 2 ? *(const f32x4*)(w0 + blk * 512 + cc) : (blk < 4 ? *(const f32x4*)(a0 + (blk - 2) * 512 + cc) : (f32x4){0.f, 0.f, 0.f, 0.f}); }
        bf16_t* dst; int ld;
        if (blk < 2) { dst = B + 3072 + blk * 512; ld = 4096; } else if (blk < 4) { dst = B + 2048 + (blk - 2) * 512; ld = 4096; } else { dst = RWG; ld = 512; }
#pragma unroll
        EPI_LOOP_ROWS { bf16_t* rowp = dst + (size_t)(row0 + ai * 128 + m * 16) * ld + cbase;
#pragma unroll
            EPI_LOOP_COLS { f32x4 v = acc[ai][bj][m][n] + bv[bj][n];
                if (blk < 2) {
#pragma unroll
                    for (int j = 0; j < 4; ++j) { const float x = -v[j]; const float sp = fmaxf(x, 0.f) + __logf(1.f + __expf(-fabsf(x))); v[j] = 1.f - __expf(-__expf(-sp - 0.5f)); }
                } else if (blk < 4) {
#pragma unroll
                    for (int j = 0; j < 4; ++j) v[j] = sigmoid_(v[j]);
                }
                *(u32x2*)(rowp + bj * 128 + n * 16) = (u32x2){pk2(v[0], v[1]), pk2(v[2], v[3])}; } }
    }
};
struct EpiMlp1 {
    bf16_t* U;
    __device__ __forceinline__ void operator()(const f32x4 (&acc)[2][2][4][2], const Unit& u, int wr, int wc, int fr, int fq) const {
        const int row0 = u.pm * 256 + wr * 64 + fr, col0 = u.pn * 256 + wc * 32 + 4 * fq;
#pragma unroll
        EPI_LOOP_ROWS { bf16_t* rowp = U + (size_t)(row0 + ai * 128 + m * 16) * 4096 + col0;
#pragma unroll
            EPI_LOOP_COLS { f32x4 v = acc[ai][bj][m][n];
#pragma unroll
                for (int j = 0; j < 4; ++j) { const float t = fmaxf(v[j], 0.f); v[j] = t * t; }
                *(u32x2*)(rowp + bj * 128 + n * 16) = (u32x2){pk2(v[0], v[1]), pk2(v[2], v[3])}; } }
    }
};

__device__ __forceinline__ void convert_T(const float* src, int ld, int K, int n0, int ncols, bf16_t* dst, LAS float* tile, int wg, int nwg) {
    const int ntn = (ncols + 63) >> 6, ntk = K >> 6, tid = otid();
    for (int t = wg; t < ntn * ntk; t += nwg) {
        const int tn = t / ntk, tk = t - tn * ntk, k0 = tk * 64, nb = tn * 64;
#pragma unroll
        for (int i = 0; i < 2; ++i) { const int idx = tid + i * 512, kk = idx >> 4, n4 = (idx & 15) * 4;
            f32x4 v = (f32x4){0.f, 0.f, 0.f, 0.f};
            if (nb + n4 < ncols) v = *(const f32x4*)(src + (size_t)(k0 + kk) * ld + n0 + nb + n4);
            tile[kk * 65 + n4 + 0] = v[0]; tile[kk * 65 + n4 + 1] = v[1]; tile[kk * 65 + n4 + 2] = v[2]; tile[kk * 65 + n4 + 3] = v[3]; }
        __syncthreads();
        { const int nn = tid >> 3, k8 = (tid & 7) * 8;
          if (nb + nn < ncols) { const LAS float* s = tile + k8 * 65 + nn;
              u32x4 o; o[0] = pk2(s[0], s[65]); o[1] = pk2(s[130], s[195]); o[2] = pk2(s[260], s[325]); o[3] = pk2(s[390], s[455]);
              *(u32x4*)(dst + (size_t)(nb + nn) * K + k0 + k8) = o; } }
        __syncthreads();
    }
}

__device__ __forceinline__ void phase_mod(const P& p, LAS unsigned char* lds) {
    const float* c = p.in[I_C]; const float* cc = p.in[I_CCTX]; const float* wm = p.in[I_WMOD]; const float* bm = p.in[I_BMOD];
    float* MOD = (float*)(p.ws + OFF_MOD);
    LAS float* red = (LAS float*)lds;
    const int tid = otid();
    for (int blk = blockIdx.x; blk < 256; blk += gridDim.x) {
        const int l = blk >> 6, col0 = (blk & 63) * 96;
        if (tid < 384) {
            const int cgp = tid % 24, ks = tid / 24;
            f32x4 a0 = (f32x4){0.f, 0.f, 0.f, 0.f}, a1 = a0;
            const float* w = wm + (size_t)l * 1024 * 6144 + col0 + cgp * 4;
#pragma unroll 8
            for (int k = ks * 64; k < ks * 64 + 64; ++k) {
                const f32x4 wv = *(const f32x4*)(w + (size_t)k * 6144);
                const float s0 = silu_(c[k]), s1 = silu_(cc[k]);
                a0 += wv * s0; a1 += wv * s1;
            }
            LAS f32x4* r4 = (LAS f32x4*)red;
            r4[(ks * 24 + cgp) * 2 + 0] = a0; r4[(ks * 24 + cgp) * 2 + 1] = a1;
        }
        __syncthreads();
        if (tid < 192) {
            const int col = tid % 96, s = tid / 96;
            float sum = 0.f;
#pragma unroll
            for (int k2 = 0; k2 < 16; ++k2) sum += red[((k2 * 24 + (col >> 2)) * 2 + s) * 4 + (col & 3)];
            MOD[((size_t)l * 2 + s) * 6144 + col0 + col] = sum + bm[l * 6144 + col0 + col];
        }
        __syncthreads();
    }
}

template <bool FROM_INPUT>
__device__ __forceinline__ void phase_norm(const P& p, int l, const float* gamma, int shift_idx, int scale_idx) {
    float* H = (float*)(p.ws + OFF_H); bf16_t* HN = (bf16_t*)(p.ws + OFF_HN);
    const float* MOD = (const float*)(p.ws + OFF_MOD) + (size_t)l * 2 * 6144;
    const int tid_ = otid(); const int wave = tid_ >> 6, lane = tid_ & 63;
    for (int row = blockIdx.x * 8 + wave; row < L; row += gridDim.x * 8) {
        const float* src = FROM_INPUT ? (row < NCTX ? p.in[I_CTX] + (size_t)row * 1024 : p.in[I_X] + (size_t)(row - NCTX) * 1024) : H + (size_t)row * 1024;
        f32x4 v[4]; float ss = 0.f;
#pragma unroll
        for (int j = 0; j < 4; ++j) { v[j] = *(const f32x4*)(src + j * 256 + lane * 4); ss += (v[j][0] * v[j][0] + v[j][1] * v[j][1]) + (v[j][2] * v[j][2] + v[j][3] * v[j][3]); }
        ss = wave_sum(ss);
        const float rstd = rsqrtf(ss * (1.f / 1024.f) + 1e-6f);
        const float* m = MOD + (row < NCTX ? 6144 : 0);
#pragma unroll
        for (int j = 0; j < 4; ++j) { const int col = j * 256 + lane * 4;
            const f32x4 g = *(const f32x4*)(gamma + col), sh = *(const f32x4*)(m + shift_idx * 1024 + col), sc = *(const f32x4*)(m + scale_idx * 1024 + col);
            const f32x4 o = v[j] * rstd * g * (sc + 1.f) + sh;
            *(u32x2*)(HN + (size_t)row * 1024 + col) = (u32x2){pk2(o[0], o[1]), pk2(o[2], o[3])};
            if (FROM_INPUT) *(f32x4*)(H + (size_t)row * 1024 + col) = v[j]; }
    }
}

constexpr int TT = 13;
__device__ __forceinline__ void phase_prep(const P& p, int l, LAS unsigned char* lds) {
    const bf16_t* R = (const bf16_t*)(p.ws + OFF_R); const bf16_t* PG = (const bf16_t*)(p.ws + OFF_PG);
    bf16_t* B = (bf16_t*)(p.ws + OFF_B); bf16_t* XL = (bf16_t*)(p.ws + OFF_XL);
    bf16_t* GLAD = (bf16_t*)(p.ws + OFF_GLAD); bf16_t* GDNC = (bf16_t*)(p.ws + OFF_GDNC); float* GDNGB = (float*)(p.ws + OFF_GDNGB);
    const float* mu = p.in[I_RWMU] + (size_t)l * 2 * 1920;
    const float* kkw = p.in[I_RWKK] + l * 512;
    const float* ga2 = p.in[I_GLAA2] + (size_t)l * 2 * 16 * 256; const float* gab = p.in[I_GLAAB] + l * 512;
    const float* cw = p.in[I_GDNCONV] + (size_t)l * 5 * 1536; const float* alog = p.in[I_GDNALOG] + l * 8; const float* dtb = p.in[I_GDNDT] + l * 8;
    LAS float* gal = (LAS float*)lds;
    LAS float* red = gal + TT * 32;
    const int tid = otid(), wave = tid >> 6;
    const int c = tid;
    const int gz = tid >> 8, gk = tid & 255;
    for (int tile = blockIdx.x; tile < L / TT; tile += gridDim.x) {
        const int t0 = tile * TT;
        if (tid < TT * 32) { const int tt = tid >> 5, e = tid & 31; gal[tt * 32 + e] = bf2f(PG[(size_t)(t0 + tt) * PG_LD + GLA_AL + e]); }
        {
            float xr[TT + 2], xk[TT + 2], xv[TT + 2], xe[TT + 2];
#pragma unroll
            for (int i = 0; i < TT + 2; ++i) { const int rr = t0 - 1 + i;
                if (rr >= 0 && rr < L) { const bf16_t* rp = R + (size_t)rr * R_LD + c; xr[i] = bf2f(rp[0]); xk[i] = bf2f(rp[512]); xv[i] = bf2f(rp[1024]); xe[i] = (c < 384) ? bf2f(rp[1536]) : 0.f; }
                else { xr[i] = 0.f; xk[i] = 0.f; xv[i] = 0.f; xe[i] = 0.f; } }
            const float mr0 = mu[c], mr1 = mu[1920 + c], mk0 = mu[512 + c], mk1 = mu[1920 + 512 + c], mv0 = mu[1024 + c], mv1 = mu[1920 + 1024 + c];
            const float me0 = (c < 384) ? mu[1536 + c] : 0.f, me1 = (c < 384) ? mu[1920 + 1536 + c] : 0.f;
            const float kkc = kkw[c];
#pragma unroll
            for (int tt = 0; tt < TT; ++tt) {
                const int t = t0 + tt;
                const float hp = (t != 0 && t != NCTX) ? 1.f : 0.f, hn = (t != NCTX - 1 && t != L - 1) ? 1.f : 0.f;
                const float r = mr0 * hp * xr[tt] + (1.f - mr0 - mr1) * xr[tt + 1] + mr1 * hn * xr[tt + 2];
                const float k = mk0 * hp * xk[tt] + (1.f - mk0 - mk1) * xk[tt + 1] + mk1 * hn * xk[tt + 2];
                const float v = mv0 * hp * xv[tt] + (1.f - mv0 - mv1) * xv[tt + 1] + mv1 * hn * xv[tt + 2];
                float e = me0 * hp * xe[tt] + (1.f - me0 - me1) * xe[tt + 1] + me1 * hn * xe[tt + 2];
                if (c < 128) e = tanhf(e); else if (c >= 256 && c < 384) e = sigmoid_(e); else if (c >= 384) e = 0.f;
                const float kr = k * kkc;
                const float ssq = wave_sum(kr * kr);
                bf16_t* bp = B + (size_t)t * 4096 + c;
                bp[0] = f2bf(r); bp[512] = f2bf(k); bp[1024] = f2bf(v); bp[1536] = f2bf(kr * rsqrtf(ssq + 1e-12f));
                XL[(size_t)t * 512 + c] = f2bf(e);
            }
        }
        __syncthreads();
        {
        float ga2v[16];
#pragma unroll
        for (int e = 0; e < 16; ++e) ga2v[e] = ga2[(gz * 16 + e) * 256 + gk];
        const float gabv = gab[gz * 256 + gk];
#pragma unroll
        for (int tt = 0; tt < TT; ++tt) {
            float zv = gabv;
#pragma unroll
            for (int e = 0; e < 16; ++e) zv += gal[tt * 32 + gz * 16 + e] * ga2v[e];
            const float la = -softplus_(-zv) * (1.f / 16.f);
            GLAD[(size_t)(t0 + tt) * 512 + tid] = f2bf(-expm1f(la));
        }
        }
        {
            float cwv[5], xv[TT + 4];
#pragma unroll
            for (int i = 0; i < 5; ++i) cwv[i] = cw[i * 1536 + 1024 + c];
#pragma unroll
            for (int i = 0; i < TT + 4; ++i) { const int rr = t0 - 2 + i; xv[i] = (rr >= 0 && rr < L) ? bf2f(PG[(size_t)rr * PG_LD + GDN_QKV + 1024 + c]) : 0.f; }
#pragma unroll
            for (int tt = 0; tt < TT; ++tt) { const int t = t0 + tt; float sv = 0.f;
#pragma unroll
                for (int i = 0; i < 5; ++i) { const int rr = t + i - 2; const bool ok_ = (rr >= 0) && (rr < L) && ((rr < NCTX) == (t < NCTX)); if (ok_) sv += xv[tt + i] * cwv[i]; }
                GDNC[(size_t)t * 1536 + 1024 + c] = f2bf(silu_(sv)); }
        }
        float oq[TT], ok[TT];
        {
            float cwq[5], cwk[5], xq[TT + 4], xk[TT + 4];
#pragma unroll
            for (int i = 0; i < 5; ++i) { cwq[i] = cw[i * 1536 + c]; cwk[i] = cw[i * 1536 + 512 + c]; }
#pragma unroll
            for (int i = 0; i < TT + 4; ++i) { const int rr = t0 - 2 + i;
                if (rr >= 0 && rr < L) { const bf16_t* rp = PG + (size_t)rr * PG_LD + GDN_QKV + c; xq[i] = bf2f(rp[0]); xk[i] = bf2f(rp[512]); } else { xq[i] = 0.f; xk[i] = 0.f; } }
#pragma unroll
            for (int tt = 0; tt < TT; ++tt) {
                const int t = t0 + tt; float sq = 0.f, sk = 0.f;
#pragma unroll
                for (int i = 0; i < 5; ++i) { const int rr = t + i - 2; const bool ok_ = (rr >= 0) && (rr < L) && ((rr < NCTX) == (t < NCTX));
                    if (ok_) { sq += xq[tt + i] * cwq[i]; sk += xk[tt + i] * cwk[i]; } }
                oq[tt] = silu_(sq); ok[tt] = silu_(sk);
                const float pq = wave_sum(oq[tt] * oq[tt]), pk = wave_sum(ok[tt] * ok[tt]);
                if ((tid & 63) == 0) { red[(tt * 8 + wave) * 2 + 0] = pq; red[(tt * 8 + wave) * 2 + 1] = pk; }
            }
        }
        __syncthreads();
#pragma unroll
        for (int tt = 0; tt < TT; ++tt) {
            const int w0i = (wave >> 1) * 2;
            const float ssq = red[(tt * 8 + w0i) * 2 + 0] + red[(tt * 8 + w0i + 1) * 2 + 0], ssk = red[(tt * 8 + w0i) * 2 + 1] + red[(tt * 8 + w0i + 1) * 2 + 1];
            bf16_t* gp = GDNC + (size_t)(t0 + tt) * 1536 + c;
            gp[0] = f2bf(oq[tt] * rsqrtf(ssq + 1e-12f) * 0.08838834764831845f); gp[512] = f2bf(ok[tt] * rsqrtf(ssk + 1e-12f));
        }
        if (tid < TT * 16) { const int tt = tid >> 4, j = tid & 15, t = t0 + tt;
            float o;
            if (j < 8) { const float a = bf2f(PG[(size_t)t * PG_LD + GDN_A + j]); o = __expf(-__expf(alog[j]) * softplus_(a + dtb[j])); }
            else o = sigmoid_(bf2f(PG[(size_t)t * PG_LD + GDN_B + (j - 8)]));
            GDNGB[t * 16 + j] = o; }
        __syncthreads();
    }
}
__device__ __forceinline__ void build_wl(const P& p, int l, int wg, int nwg) {
    const float* w2 = p.in[I_RWW2] + (size_t)l * 2 * 64 * 512; const float* a2 = p.in[I_RWA2] + (size_t)l * 2 * 64 * 512; const float* g2 = p.in[I_RWG2] + (size_t)l * 128 * 512;
    bf16_t* WL = (bf16_t*)(p.ws + OFF_WL);
    const int tid = otid();
    for (int it = wg * 512 + tid; it < 2560 * 64; it += nwg * 512) {
        const int kc = it / 2560, n = it - kc * 2560, k0 = kc * 8, blk = n >> 9, cc = n & 511;
        const float* src = nullptr; int kb = 0, kn = 0;
        if (blk == 0) { src = w2; kb = 0; kn = 64; } else if (blk == 1) { src = w2 + 64 * 512; kb = 64; kn = 64; }
        else if (blk == 2) { src = a2; kb = 128; kn = 64; } else if (blk == 3) { src = a2 + 64 * 512; kb = 192; kn = 64; }
        else { src = g2; kb = 256; kn = 128; }
        float v[8];
#pragma unroll
        for (int j = 0; j < 8; ++j) { const int k = k0 + j - kb; v[j] = (k >= 0 && k < kn) ? src[(size_t)k * 512 + cc] : 0.f; }
        u32x4 o; o[0] = pk2(v[0], v[1]); o[1] = pk2(v[2], v[3]); o[2] = pk2(v[4], v[5]); o[3] = pk2(v[6], v[7]);
        *(u32x4*)(WL + (size_t)n * 512 + k0) = o;
    }
}

constexpr int TB = 32, NBLK = L / TB;
__device__ __forceinline__ int tok_seq(int z, int j) { return z == 0 ? j : (j < NCTX ? NCTX - 1 - j : L - 1 - (j - NCTX)); }
__device__ __forceinline__ int tok_gla(int z, int j) {
    if (j < NCTX) return z == 0 ? j : NCTX - 1 - j;
    const int jj = j - NCTX, pp = z == 0 ? jj : NLAT - 1 - jj;
    return NCTX + (pp & 255) * 64 + (pp >> 8);
}

template <int NCW> struct ScanRole {
    bool cons, prod; int ct;
    __device__ __forceinline__ ScanRole(int tid) {
        const int w = tid >> 6, lane = tid & 63;
        if (NCW == 4) { cons = w < 4; prod = !cons; ct = tid & 255; }
        else { cons = w < 2; prod = (w & 2) != 0; ct = cons ? tid : ((((w >> 2) << 1) | (w & 1)) * 64 + lane); }
    }
};
#define SCAN_BARRIER() asm volatile("s_waitcnt lgkmcnt(0)\n\ts_barrier" ::: "memory")
__device__ __forceinline__ float bfraw2f(unsigned short b) { return __uint_as_float(((unsigned)b) << 16); }

__device__ __forceinline__ void scan_rwkv(const P& p, int l, int unit, LAS unsigned char* lds) {
    const int z = unit >> 6, h = (unit >> 3) & 7, rq = unit & 7;
    const bf16_t* B = (const bf16_t*)(p.ws + OFF_B); bf16_t* Y = (bf16_t*)(p.ws + OFF_PG) + YRW_COL + z * 512 + h * 64 + rq * 8;
    const float* kaw = p.in[I_RWKA] + l * 512 + h * 64;
    LAS float* vec = (LAS float*)lds;
    LAS float* vv = vec + 2 * TB * 320;
    LAS float* yo = vv + 2 * TB * 8;
    const int tid = otid(); const ScanRole<2> role(tid); const int ct = role.ct; const bool prod = role.prod, cons = role.cons;
    unsigned short pr[8], pk[8], pkk[8], pa[8], pw[8], pv;
    const float kac = kaw[ct & 63];
    auto p_load = [&](int blk) {
#pragma unroll
        for (int i = 0; i < 8; ++i) { const int idx = ct + i * 256, s = idx >> 6, n = idx & 63; const int t = tok_seq(z, blk * TB + s);
            const bf16_t* bp = B + (size_t)t * 4096 + h * 64 + n;
            pr[i] = bp[0]; pk[i] = bp[512]; pkk[i] = bp[1536]; pa[i] = bp[2048 + z * 512]; pw[i] = bp[3072 + z * 512]; }
        { const int s = ct >> 3, r = ct & 7; const int t = tok_seq(z, blk * TB + s); pv = B[(size_t)t * 4096 + 1024 + h * 64 + rq * 8 + r]; }
    };
    auto p_write = [&](int buf) {
#pragma unroll
        for (int i = 0; i < 8; ++i) { const int idx = ct + i * 256, s = idx >> 6, n = idx & 63;
            LAS float* d = vec + ((buf * TB + s) * 16 + (n >> 2)) * 20 + (n & 3);
            const float kk = bfraw2f(pkk[i]), a = bfraw2f(pa[i]);
            d[0] = kk; d[4] = 1.f - bfraw2f(pw[i]); d[8] = kk * a; d[12] = bfraw2f(pk[i]) * (1.f + (a - 1.f) * kac); d[16] = bfraw2f(pr[i]); }
        vv[buf * TB * 8 + ct] = bfraw2f(pv);
    };
    auto p_yout = [&](int blk) {
        const int buf = blk & 1; const int s = ct >> 3, r = ct & 7; const int t = tok_seq(z, blk * TB + s);
        Y[(size_t)t * PG_LD + r] = f2bf(yo[buf * TB * 8 + ct]);
    };
    const int irow = (ct >> 4) & 7, ks = ct & 15;
    f32x2 S0 = (f32x2){0.f, 0.f}, S1 = S0;
    struct Vx { f32x4 kk, w, b, k, r; float v; };
    auto c_ld = [&](Vx& x, int buf, int s) {
        const LAS float* d = vec + ((buf * TB + s) * 16 + ks) * 20;
        x.kk = *(const LAS f32x4*)(d); x.w = *(const LAS f32x4*)(d + 4); x.b = *(const LAS f32x4*)(d + 8); x.k = *(const LAS f32x4*)(d + 12);
        x.r = *(const LAS f32x4*)(d + 16); x.v = vv[(buf * TB + s) * 8 + irow];
    };
    float sa = 0.f;
    auto c_step = [&](const Vx& x, const f32x4& kkn, int buf, int s) {
        const f32x2 vv2 = (f32x2){x.v, x.v}, nsa = (f32x2){-sa, -sa};
        S0 = S0 * (f32x2){x.w[0], x.w[1]} + (vv2 * (f32x2){x.k[0], x.k[1]} + nsa * (f32x2){x.b[0], x.b[1]});
        S1 = S1 * (f32x2){x.w[2], x.w[3]} + (vv2 * (f32x2){x.k[2], x.k[3]} + nsa * (f32x2){x.b[2], x.b[3]});
        const f32x2 y2 = S0 * (f32x2){x.r[0], x.r[1]} + S1 * (f32x2){x.r[2], x.r[3]};
        const f32x2 s2 = S0 * (f32x2){kkn[0], kkn[1]} + S1 * (f32x2){kkn[2], kkn[3]};
        float yp = y2[0] + y2[1], sp = s2[0] + s2[1];
        yp += dpp_<0xB1>(yp); sp += dpp_<0xB1>(sp); yp += dpp_<0x4E>(yp); sp += dpp_<0x4E>(sp);
        yp += dpp_<0x141>(yp); sp += dpp_<0x141>(sp); yp += dpp_<0x140>(yp); sp += dpp_<0x140>(sp);
        sa = sp;
        if (ks == 0) yo[(buf * TB + s) * 8 + irow] = yp;
    };
    if (prod) { p_load(0); p_write(0); p_load(1); }
    SCAN_BARRIER();
    for (int b = 0; b < NBLK; ++b) {
        if (prod) {
            if (b + 1 < NBLK) p_write((b + 1) & 1);
            if (b + 2 < NBLK) p_load(b + 2);
            if (b > 0) p_yout(b - 1);
        } else if (cons) {
            const int buf = b & 1;
            Vx xa, xb;
            c_ld(xa, buf, 0);
            { const f32x2 s2 = S0 * (f32x2){xa.kk[0], xa.kk[1]} + S1 * (f32x2){xa.kk[2], xa.kk[3]}; sa = reduce16(s2[0] + s2[1]); }
#pragma unroll 1
            for (int s = 0; s < TB; s += 2) {
                c_ld(xb, buf, s + 1); c_step(xa, xb.kk, buf, s);
                if (s + 2 < TB) c_ld(xa, buf, s + 2);
                c_step(xb, xa.kk, buf, s + 1);
            }
        }
        SCAN_BARRIER();
    }
    if (prod) p_yout(NBLK - 1);
    SCAN_BARRIER();
}

__device__ __forceinline__ void scan_gla(const P& p, int l, int unit, LAS unsigned char* lds) {
    const int z = unit >> 4, h = (unit >> 2) & 3, cb = unit & 3;
    const bf16_t* PG = (const bf16_t*)(p.ws + OFF_PG); const bf16_t* GLAD = (const bf16_t*)(p.ws + OFF_GLAD);
    bf16_t* O = (bf16_t*)(p.ws + OFF_R) + z * 512 + h * 128 + cb * 32;
    LAS float* vec = (LAS float*)lds;
    LAS float* vv = vec + 2 * TB * 192;
    LAS float* yo = vv + 2 * TB * 32;
    const int tid = otid(); const ScanRole<4> role(tid); const int ct = role.ct; const bool prod = role.prod, cons = role.cons;
    unsigned short pq[8], pk[8], pa[8], pv[4];
    auto p_load = [&](int blk) {
#pragma unroll
        for (int i = 0; i < 8; ++i) { const int idx = ct + i * 256, s = idx >> 6, n = idx & 63; const int t = tok_gla(z, blk * TB + s);
            const bf16_t* bp = PG + (size_t)t * PG_LD + h * 64 + n;
            pq[i] = bp[GLA_Q]; pk[i] = bp[GLA_K]; pa[i] = GLAD[(size_t)t * 512 + z * 256 + h * 64 + n]; }
#pragma unroll
        for (int i = 0; i < 4; ++i) { const int idx = ct + i * 256, s = idx >> 5, r = idx & 31; const int t = tok_gla(z, blk * TB + s);
            pv[i] = PG[(size_t)t * PG_LD + GLA_V + h * 128 + cb * 32 + r]; }
    };
    auto p_write = [&](int buf) {
#pragma unroll
        for (int i = 0; i < 8; ++i) { const int idx = ct + i * 256, s = idx >> 6, n = idx & 63;
            LAS float* d = vec + ((buf * TB + s) * 8 + (n >> 3)) * 24 + (n & 7);
            d[0] = bfraw2f(pq[i]) * 0.125f; d[8] = bfraw2f(pk[i]); d[16] = 1.f - bfraw2f(pa[i]); }
#pragma unroll
        for (int i = 0; i < 4; ++i) vv[buf * TB * 32 + ct + i * 256] = bfraw2f(pv[i]);
    };
    auto p_yout = [&](int blk) {
        const int buf = blk & 1;
#pragma unroll
        for (int i = 0; i < 4; ++i) { const int idx = ct + i * 256, s = idx >> 5, r = idx & 31; const int t = tok_gla(z, blk * TB + s);
            O[(size_t)t * R_LD + r] = f2bf(yo[buf * TB * 32 + idx]); }
    };
    const int icol = (ct >> 3) & 31, ks = ct & 7;
    f32x2 S[4];
#pragma unroll
    for (int j = 0; j < 4; ++j) S[j] = (f32x2){0.f, 0.f};
    struct Vx { f32x4 q0, q1, k0, k1, a0, a1; float v; };
    auto c_ld = [&](Vx& x, int buf, int s) {
        const LAS float* d = vec + ((buf * TB + s) * 8 + ks) * 24;
        x.q0 = *(const LAS f32x4*)(d); x.q1 = *(const LAS f32x4*)(d + 4); x.k0 = *(const LAS f32x4*)(d + 8); x.k1 = *(const LAS f32x4*)(d + 12);
        x.a0 = *(const LAS f32x4*)(d + 16); x.a1 = *(const LAS f32x4*)(d + 20); x.v = vv[(buf * TB + s) * 32 + icol];
    };
    auto c_upd = [&](const Vx& x) -> float {
        const f32x2 vv2 = (f32x2){x.v, x.v};
        S[0] = S[0] * (f32x2){x.a0[0], x.a0[1]} + vv2 * (f32x2){x.k0[0], x.k0[1]};
        S[1] = S[1] * (f32x2){x.a0[2], x.a0[3]} + vv2 * (f32x2){x.k0[2], x.k0[3]};
        S[2] = S[2] * (f32x2){x.a1[0], x.a1[1]} + vv2 * (f32x2){x.k1[0], x.k1[1]};
        S[3] = S[3] * (f32x2){x.a1[2], x.a1[3]} + vv2 * (f32x2){x.k1[2], x.k1[3]};
        const f32x2 y2 = (S[0] * (f32x2){x.q0[0], x.q0[1]} + S[1] * (f32x2){x.q0[2], x.q0[3]}) + (S[2] * (f32x2){x.q1[0], x.q1[1]} + S[3] * (f32x2){x.q1[2], x.q1[3]});
        return y2[0] + y2[1];
    };
    if (prod) { p_load(0); p_write(0); p_load(1); }
    SCAN_BARRIER();
    for (int b = 0; b < NBLK; ++b) {
        if (prod) {
            if (b + 1 < NBLK) p_write((b + 1) & 1);
            if (b + 2 < NBLK) p_load(b + 2);
            if (b > 0) p_yout(b - 1);
        } else if (cons) {
            const int buf = b & 1;
            Vx xa, xb;
            c_ld(xa, buf, 0);
#pragma unroll 1
            for (int s = 0; s < TB; s += 2) {
                c_ld(xb, buf, s + 1);
                float ya = c_upd(xa);
                if (s + 2 < TB) c_ld(xa, buf, s + 2);
                float yb = c_upd(xb);
                ya += dpp_<0xB1>(ya); yb += dpp_<0xB1>(yb); ya += dpp_<0x4E>(ya); yb += dpp_<0x4E>(yb); ya += dpp_<0x141>(ya); yb += dpp_<0x141>(yb);
                if (ks == 0) { yo[(buf * TB + s) * 32 + icol] = ya; yo[(buf * TB + s + 1) * 32 + icol] = yb; }
            }
        }
        SCAN_BARRIER();
    }
    if (prod) p_yout(NBLK - 1);
    SCAN_BARRIER();
}

__device__ __forceinline__ void scan_gdn(const P& p, int l, int unit, LAS unsigned char* lds) {
    const int z = unit >> 5, h = (unit >> 3) & 3, cb = unit & 7;
    const bf16_t* GDNC = (const bf16_t*)(p.ws + OFF_GDNC); const float* GDNGB = (const float*)(p.ws + OFF_GDNGB);
    bf16_t* O = (bf16_t*)(p.ws + OFF_R) + 1024 + z * 512 + h * 128 + cb * 16;
    LAS float* vec = (LAS float*)lds;
    LAS float* vv = vec + 2 * TB * 320;
    LAS float* sc = vv + 2 * TB * 16;
    LAS float* yo = sc + 2 * TB * 2;
    const int tid = otid(); const ScanRole<4> role(tid); const int ct = role.ct; const bool prod = role.prod, cons = role.cons;
    unsigned short pq[16], pk[16], pv[2]; float psc = 0.f;
    auto p_load = [&](int blk) {
#pragma unroll
        for (int i = 0; i < 16; ++i) { const int idx = ct + i * 256, s = idx >> 7, n = idx & 127; const int t = tok_seq(z, blk * TB + s);
            const bf16_t* bp = GDNC + (size_t)t * 1536 + h * 128 + n;
            pq[i] = bp[0]; pk[i] = bp[512]; }
#pragma unroll
        for (int i = 0; i < 2; ++i) { const int idx = ct + i * 256, s = idx >> 4, r = idx & 15; const int t = tok_seq(z, blk * TB + s);
            pv[i] = GDNC[(size_t)t * 1536 + 1024 + h * 128 + cb * 16 + r]; }
        if (ct < 64) { const int s = ct >> 1, w = ct & 1; const int t = tok_seq(z, blk * TB + s); psc = GDNGB[t * 16 + w * 8 + z * 4 + h]; }
    };
    auto p_write = [&](int buf) {
#pragma unroll
        for (int i = 0; i < 16; ++i) { const int idx = ct + i * 256, s = idx >> 7, n = idx & 127;
            LAS float* d = vec + ((buf * TB + s) * 16 + (n >> 3)) * 20 + (n & 7);
            d[0] = bfraw2f(pq[i]); d[8] = bfraw2f(pk[i]); }
#pragma unroll
        for (int i = 0; i < 2; ++i) vv[buf * TB * 16 + ct + i * 256] = bfraw2f(pv[i]);
        if (ct < 64) sc[buf * TB * 2 + ct] = psc;
    };
    auto p_yout = [&](int blk) {
        const int buf = blk & 1;
#pragma unroll
        for (int i = 0; i < 2; ++i) { const int idx = ct + i * 256, s = idx >> 4, r = idx & 15; const int t = tok_seq(z, blk * TB + s);
            O[(size_t)t * R_LD + r] = f2bf(yo[buf * TB * 16 + idx]); }
    };
    const int icol = (ct >> 4) & 15, ks = ct & 15;
    f32x2 S[4];
#pragma unroll
    for (int j = 0; j < 4; ++j) S[j] = (f32x2){0.f, 0.f};
    struct Vx { f32x4 q0, q1, k0, k1; float v; f32x2 gb; };
    auto c_ld = [&](Vx& x, int buf, int s) {
        const LAS float* d = vec + ((buf * TB + s) * 16 + ks) * 20;
        x.q0 = *(const LAS f32x4*)(d); x.q1 = *(const LAS f32x4*)(d + 4); x.k0 = *(const LAS f32x4*)(d + 8); x.k1 = *(const LAS f32x4*)(d + 12);
        x.v = vv[(buf * TB + s) * 16 + icol]; x.gb = *(const LAS f32x2*)(sc + (buf * TB + s) * 2);
    };
    float dd = 0.f;
    auto c_step = [&](const Vx& x, const f32x4& kn0, const f32x4& kn1, int buf, int s) {
        const float eg = x.gb[0];
        const float cc = x.gb[1] * (x.v - eg * dd);
        const f32x2 eg2 = (f32x2){eg, eg}, cc2 = (f32x2){cc, cc};
        S[0] = S[0] * eg2 + cc2 * (f32x2){x.k0[0], x.k0[1]};
        S[1] = S[1] * eg2 + cc2 * (f32x2){x.k0[2], x.k0[3]};
        S[2] = S[2] * eg2 + cc2 * (f32x2){x.k1[0], x.k1[1]};
        S[3] = S[3] * eg2 + cc2 * (f32x2){x.k1[2], x.k1[3]};
        const f32x2 y2 = (S[0] * (f32x2){x.q0[0], x.q0[1]} + S[1] * (f32x2){x.q0[2], x.q0[3]}) + (S[2] * (f32x2){x.q1[0], x.q1[1]} + S[3] * (f32x2){x.q1[2], x.q1[3]});
        const f32x2 d2 = (S[0] * (f32x2){kn0[0], kn0[1]} + S[1] * (f32x2){kn0[2], kn0[3]}) + (S[2] * (f32x2){kn1[0], kn1[1]} + S[3] * (f32x2){kn1[2], kn1[3]});
        float yp = y2[0] + y2[1], dp = d2[0] + d2[1];
        yp += dpp_<0xB1>(yp); dp += dpp_<0xB1>(dp); yp += dpp_<0x4E>(yp); dp += dpp_<0x4E>(dp);
        yp += dpp_<0x141>(yp); dp += dpp_<0x141>(dp); yp += dpp_<0x140>(yp); dp += dpp_<0x140>(dp);
        dd = dp;
        if (ks == 0) yo[(buf * TB + s) * 16 + icol] = yp;
    };
    if (prod) { p_load(0); p_write(0); p_load(1); }
    SCAN_BARRIER();
    for (int b = 0; b < NBLK; ++b) {
        if (prod) {
            if (b + 1 < NBLK) p_write((b + 1) & 1);
            if (b + 2 < NBLK) p_load(b + 2);
            if (b > 0) p_yout(b - 1);
        } else if (cons) {
            const int buf = b & 1;
            Vx xa, xb;
            c_ld(xa, buf, 0);
            { const f32x2 d2 = (S[0] * (f32x2){xa.k0[0], xa.k0[1]} + S[1] * (f32x2){xa.k0[2], xa.k0[3]}) + (S[2] * (f32x2){xa.k1[0], xa.k1[1]} + S[3] * (f32x2){xa.k1[2], xa.k1[3]});
              dd = reduce16(d2[0] + d2[1]); }
#pragma unroll 1
            for (int s = 0; s < TB; s += 2) {
                c_ld(xb, buf, s + 1); c_step(xa, xb.k0, xb.k1, buf, s);
                if (s + 2 < TB) c_ld(xa, buf, s + 2);
                c_step(xb, xa.k0, xa.k1, buf, s + 1);
            }
        }
        SCAN_BARRIER();
    }
    if (prod) p_yout(NBLK - 1);
    SCAN_BARRIER();
}

__device__ __forceinline__ void phase_post(const P& p, int l, LAS unsigned char* lds) {
    const bf16_t* PG = (const bf16_t*)(p.ws + OFF_PG); const bf16_t* Rb = (const bf16_t*)(p.ws + OFF_R); const bf16_t* B = (const bf16_t*)(p.ws + OFF_B);
    const bf16_t* RWG = (const bf16_t*)(p.ws + OFF_RWG);
    bf16_t* YC = (bf16_t*)(p.ws + OFF_GDNC);
    const int tid = otid(), wave = tid >> 6, c = tid;
    const float lnw = p.in[I_RWLNW][l * 512 + c], lnb = p.in[I_RWLNB][l * 512 + c], kac = p.in[I_RWKA][l * 512 + c], rkc = p.in[I_RWRK][l * 512 + c];
    const float gng = p.in[I_GLANG][l * 128 + (c & 127)], dng = p.in[I_GDNNG][l * 128 + (c & 127)];
    LAS float* red = (LAS float*)lds;
    for (int tile = blockIdx.x; tile < L / TT; tile += gridDim.x) {
        const int t0 = tile * TT;
        float og[TT], od[TT];
#pragma unroll
        for (int tt = 0; tt < TT; ++tt) {
            const int t = t0 + tt;
            const float y = bf2f(PG[(size_t)t * PG_LD + YRW_COL + c]) + bf2f(PG[(size_t)t * PG_LD + YRW_COL + 512 + c]);
            const float mean = wave_sum(y) * (1.f / 64.f);
            const float dy = y - mean;
            const float var = wave_sum(dy * dy) * (1.f / 64.f);
            const float yn = dy * rsqrtf(var + 64e-5f) * lnw + lnb;
            const bf16_t* bp = B + (size_t)t * 4096 + c;
            const float v = bf2f(bp[1024]), rr_ = bf2f(bp[0]), kk_ = bf2f(bp[512]), az0 = bf2f(bp[2048]), az1 = bf2f(bp[2560]);
            const float bon = wave_sum(rr_ * rkc * (kk_ * (1.f + (az0 - 1.f) * kac) + kk_ * (1.f + (az1 - 1.f) * kac)));
            const float o = (yn + bon * v) * bf2f(RWG[(size_t)t * 512 + c]);
            YC[(size_t)t * 512 + c] = f2bf(o);
            og[tt] = bf2f(Rb[(size_t)t * R_LD + c]) + bf2f(Rb[(size_t)t * R_LD + 512 + c]);
            od[tt] = bf2f(Rb[(size_t)t * R_LD + 1024 + c]) + bf2f(Rb[(size_t)t * R_LD + 1536 + c]);
            const float pg_ = wave_sum(og[tt] * og[tt]), pd_ = wave_sum(od[tt] * od[tt]);
            if ((tid & 63) == 0) { red[(tt * 8 + wave) * 2 + 0] = pg_; red[(tt * 8 + wave) * 2 + 1] = pd_; }
        }
        __syncthreads();
#pragma unroll
        for (int tt = 0; tt < TT; ++tt) {
            const int t = t0 + tt, w0i = (wave >> 1) * 2;
            const float sg = red[(tt * 8 + w0i) * 2 + 0] + red[(tt * 8 + w0i + 1) * 2 + 0], sd = red[(tt * 8 + w0i) * 2 + 1] + red[(tt * 8 + w0i + 1) * 2 + 1];
            const float gate_g = silu_(bf2f(PG[(size_t)t * PG_LD + GLA_OG + c])), gate_d = silu_(bf2f(PG[(size_t)t * PG_LD + GDN_ZG + c]));
            YC[(size_t)L * 512 + (size_t)t * 512 + c] = f2bf(og[tt] * rsqrtf(sg * (1.f / 128.f) + 1e-6f) * gng * gate_g);
            YC[(size_t)2 * L * 512 + (size_t)t * 512 + c] = f2bf(od[tt] * rsqrtf(sd * (1.f / 128.f) + 1e-6f) * dng * gate_d);
        }
        __syncthreads();
    }
}

__device__ __forceinline__ void phase_final(const P& p) {
    const float* H = (const float*)(p.ws + OFF_H); const float* gamma = p.in[I_FINALG];
    const int tid_ = otid(); const int wave = tid_ >> 6, lane = tid_ & 63;
    for (int row = blockIdx.x * 8 + wave; row < NLAT; row += gridDim.x * 8) {
        const float* src = H + (size_t)(row + NCTX) * 1024;
        f32x4 v[4]; float ss = 0.f;
#pragma unroll
        for (int j = 0; j < 4; ++j) { v[j] = *(const f32x4*)(src + j * 256 + lane * 4); ss += (v[j][0] * v[j][0] + v[j][1] * v[j][1]) + (v[j][2] * v[j][2] + v[j][3] * v[j][3]); }
        ss = wave_sum(ss);
        const float rstd = rsqrtf(ss * (1.f / 1024.f) + 1e-6f);
#pragma unroll
        for (int j = 0; j < 4; ++j) { const int col = j * 256 + lane * 4; const f32x4 g = *(const f32x4*)(gamma + col);
            *(f32x4*)(p.out + (size_t)row * 1024 + col) = v[j] * rstd * g; }
    }
}


#define XB_TMO      128
#define XB_XCNT(j)  (256  + 64 * (j))
#define XB_XSUB(j)  (1280 + 64 * (j))
#define XB_XGEN(j)  (2304 + 64 * (j))
#define XB_TOP      3328
#define XB_TOPGEN   3392
#define XCD_BAR_WORDS 3456
#define XB_SPIN_CAP (1u << 18)
__device__ __forceinline__ unsigned xb_ld(unsigned* p)              { return __hip_atomic_load(p, __ATOMIC_RELAXED, __HIP_MEMORY_SCOPE_AGENT); }
__device__ __forceinline__ unsigned xb_add(unsigned* p, unsigned v) { return __hip_atomic_fetch_add(p, v, __ATOMIC_RELAXED, __HIP_MEMORY_SCOPE_AGENT); }
__device__ __forceinline__ unsigned xb_xcc_id() { return (unsigned)__builtin_amdgcn_s_getreg((3 << 11) | 20) & 0xFu; }
#define XB_SPIN(cond, bar) do { unsigned _sp = 0; while (cond) { __builtin_amdgcn_s_sleep(1); \
    if ((++_sp & 255u) == 0u) { if (xb_ld(&(bar)[XB_TMO])) break; if (_sp > XB_SPIN_CAP) { atomicAdd(&(bar)[XB_TMO], 1u); break; } } } } while (0)
struct XcdBarrier { unsigned* bar; unsigned x; volatile LAS unsigned* st; };
__device__ __forceinline__ XcdBarrier xcd_barrier_post(unsigned* bar, volatile LAS unsigned* st) {
    XcdBarrier b; b.bar = bar; b.x = xb_xcc_id(); b.st = st;
    if (threadIdx.x == 0) (void)xb_add(&bar[XB_XCNT(b.x)], 1u);
    return b;
}
__device__ __forceinline__ void xcd_barrier_complete(unsigned* bar, unsigned x, unsigned& nloc, unsigned& nx) {
    const unsigned G = gridDim.x * gridDim.y * gridDim.z;
    unsigned sum, cnt, mine, sp = 0u;
    for (;;) {
        sum = 0u; cnt = 0u; mine = 0u;
#pragma unroll
        for (unsigned j = 0; j < 16; ++j) { const unsigned c = xb_ld(&bar[XB_XCNT(j)]); sum += c; cnt += (c > 0u) ? 1u : 0u; mine = (j == x) ? c : mine; }
        if (sum == G) break;
        __builtin_amdgcn_s_sleep(1);
        if ((++sp & 255u) == 0u) { if (xb_ld(&bar[XB_TMO])) break; if (sp > XB_SPIN_CAP) { atomicAdd(&bar[XB_TMO], 1u); break; } }
    }
    nloc = mine > 0u ? mine : 1u; nx = cnt > 0u ? cnt : 1u;
}
__device__ __forceinline__ void xcd_barrier(const XcdBarrier& b) {
    asm volatile("s_waitcnt vmcnt(0)" ::: "memory");
    __syncthreads();
    if (threadIdx.x == 0) {
        unsigned* bar = b.bar;
        __builtin_amdgcn_s_waitcnt(0);
        unsigned nloc = b.st[0], nx = b.st[1];
        if (nloc == 0u) { xcd_barrier_complete(bar, b.x, nloc, nx); b.st[0] = nloc; b.st[1] = nx; }
        const unsigned old = xb_add(&bar[XB_XSUB(b.x)], 1u);
        const unsigned gen = old / nloc;
        if (old + 1u == (gen + 1u) * nloc) {
            __builtin_amdgcn_fence(__ATOMIC_RELEASE, "agent");
            asm volatile("s_waitcnt vmcnt(0)" ::: "memory");
            const unsigned og = xb_add(&bar[XB_TOP], 1u);
            const unsigned tg = og / nx;
            if (og + 1u == (tg + 1u) * nx) xb_add(&bar[XB_TOPGEN], 1u);
            else XB_SPIN(xb_ld(&bar[XB_TOPGEN]) == tg, bar);
            __builtin_amdgcn_fence(__ATOMIC_ACQUIRE, "agent");
            xb_add(&bar[XB_XGEN(b.x)], 1u);
            asm volatile("s_waitcnt vmcnt(0)" ::: "memory");
        } else {
            XB_SPIN(xb_ld(&bar[XB_XGEN(b.x)]) == gen, bar);
            __builtin_amdgcn_fence(__ATOMIC_ACQUIRE, "agent");
            asm volatile("s_waitcnt vmcnt(0)" ::: "memory");
        }
    }
    __syncthreads();
}

__global__ void __launch_bounds__(512, 2) fwd_megakernel(P p) {
    extern __shared__ __attribute__((aligned(16))) unsigned char shm_raw[];
    LAS unsigned char* lds = (LAS unsigned char*)shm_raw;
    cg::grid_group grid = cg::this_grid();
    const int G = gridDim.x, wg = blockIdx.x;
    unsigned char* ws = p.ws;
    float* H = (float*)(ws + OFF_H); bf16_t* HN = (bf16_t*)(ws + OFF_HN); bf16_t* WIN = (bf16_t*)(ws + OFF_WIN);
    const float* MODall = (const float*)(ws + OFF_MOD);

    volatile LAS unsigned* xbst = (volatile LAS unsigned*)(lds + 131072);
    if (threadIdx.x == 0) { xbst[0] = 0u; xbst[1] = 0u; xbst[2] = 0u; xbst[3] = 0u; }
    __syncthreads();
    const XcdBarrier xb = xcd_barrier_post((unsigned*)(ws + OFF_BAR), xbst);
    phase_mod(p, lds);
    grid.sync();
    for (int l = 0; l < DEPTH; ++l) {
        const float* MOD = MODall + (size_t)l * 2 * 6144;
        if (l == 0) phase_norm<true>(p, l, p.in[I_N1G] + l * 1024, 0, 1); else phase_norm<false>(p, l, p.in[I_N1G] + l * 1024, 0, 1);
        {
            const float* win = p.in[I_WIN] + (size_t)l * 1024 * IN_COLS;
            convert_T(win, IN_COLS, 1024, 0, 1920, WIN, (LAS float*)lds, wg, G);
            convert_T(win, IN_COLS, 1024, 1920, 3632, WIN + (size_t)2048 * 1024, (LAS float*)lds, (wg + 64) % G, G);
            convert_T(win, IN_COLS, 1024, 5552, 3072, WIN + (size_t)NMAIN * 1024, (LAS float*)lds, (wg + 128) % G, G);
            build_wl(p, l, wg, G);
        }
        xcd_barrier(xb);
        {
            pg8::Gemm g{HN, WIN, L, NMAIN, 1024}; pg8::StaticOrder S; S.init(L, NMAIN, G, wg);
            EpiInMain E{(bf16_t*)(ws + OFF_R), (bf16_t*)(ws + OFF_PG)};
            pg8::gemm_phase(lds, g, S, E);
        }
        xcd_barrier(xb);
#ifndef NO_PREP
        phase_prep(p, l, lds);
        xcd_barrier(xb);
        {
            pg8::Gemm g{(const bf16_t*)(ws + OFF_XL), (const bf16_t*)(ws + OFF_WL), L, 2560, 512}; pg8::StaticOrder S; S.init(L, 2560, G, wg);
            EpiLora E{(bf16_t*)(ws + OFF_B), (bf16_t*)(ws + OFF_RWG), p.in[I_RWW0] + (size_t)l * 1024, p.in[I_RWA0] + (size_t)l * 1024};
            pg8::gemm_phase(lds, g, S, E);
        }
#endif
        xcd_barrier(xb);
#ifndef NO_SCAN
        if (wg < 128) scan_rwkv(p, l, wg, lds);
        else if (wg < 160) scan_gla(p, l, wg - 128, lds);
        else if (wg < 224) scan_gdn(p, l, wg - 160, lds);
#endif
        xcd_barrier(xb);
#ifndef NO_POST
        phase_post(p, l, lds);
#endif
        xcd_barrier(xb);
        {
            convert_T(p.in[I_WBR] + (size_t)l * 3 * 512 * 1024, 1024, 512, 0, 1024, (bf16_t*)(ws + OFF_WBR), (LAS float*)lds, wg, G);
            convert_T(p.in[I_WBR] + (size_t)l * 3 * 512 * 1024 + (size_t)512 * 1024, 1024, 512, 0, 1024, (bf16_t*)(ws + OFF_WBR) + (size_t)1024 * 512, (LAS float*)lds, (wg + 128) % G, G);
            convert_T(p.in[I_WBR] + (size_t)l * 3 * 512 * 1024 + (size_t)2 * 512 * 1024, 1024, 512, 0, 1024, (bf16_t*)(ws + OFF_WBR) + (size_t)2 * 1024 * 512, (LAS float*)lds, wg, G);
            convert_T(p.in[I_WOUT] + (size_t)l * 1024 * 1024, 1024, 1024, 0, 1024, (bf16_t*)(ws + OFF_WOUT), (LAS float*)lds, wg, G);
            convert_T(p.in[I_W1] + (size_t)l * 1024 * 4096, 4096, 1024, 0, 4096, (bf16_t*)(ws + OFF_W1), (LAS float*)lds, wg, G);
            convert_T(p.in[I_W2] + (size_t)l * 4096 * 1024, 1024, 4096, 0, 1024, (bf16_t*)(ws + OFF_W2), (LAS float*)lds, wg, G);
            pg8::Gemm g{HN, WIN + (size_t)NMAIN * 1024, L, 3072, 1024}; pg8::StaticOrder S; S.init(L, 3072, G, wg);
            EpiGates E{(bf16_t*)(ws + OFF_B)};
            pg8::gemm_phase(lds, g, S, E);
        }
        xcd_barrier(xb);
        {
            const bf16_t* YC = (const bf16_t*)(ws + OFF_GDNC); const bf16_t* WBR = (const bf16_t*)(ws + OFF_WBR);
            pg8::StaticOrder S; S.init(L, 1024, G, wg);
            { pg8::Gemm g{YC, WBR, L, 1024, 512}; EpiBranch<0> E{(const bf16_t*)(ws + OFF_B), (float*)(ws + OFF_PG), HN}; pg8::gemm_phase(lds, g, S, E); }
            { pg8::Gemm g{YC + (size_t)L * 512, WBR + (size_t)1024 * 512, L, 1024, 512}; EpiBranch<1> E{(const bf16_t*)(ws + OFF_B), (float*)(ws + OFF_PG), HN}; pg8::gemm_phase(lds, g, S, E); }
            { pg8::Gemm g{YC + (size_t)2 * L * 512, WBR + (size_t)2 * 1024 * 512, L, 1024, 512}; EpiBranch<2> E{(const bf16_t*)(ws + OFF_B), (float*)(ws + OFF_PG), HN}; pg8::gemm_phase(lds, g, S, E); }
        }
        xcd_barrier(xb);
        {
            pg8::Gemm g{HN, (const bf16_t*)(ws + OFF_WOUT), L, 1024, 1024}; pg8::StaticOrder S; S.init(L, 1024, G, wg);
            EpiResid E{H, MOD + 2 * 1024, MOD + 6144 + 2 * 1024};
            pg8::gemm_phase(lds, g, S, E);
        }
        xcd_barrier(xb);
        phase_norm<false>(p, l, p.in[I_N2G] + l * 1024, 3, 4);
        xcd_barrier(xb);
        {
            pg8::Gemm g{HN, (const bf16_t*)(ws + OFF_W1), L, 4096, 1024}; pg8::StaticOrder S; S.init(L, 4096, G, wg);
            EpiMlp1 E{(bf16_t*)(ws + OFF_B)};
            pg8::gemm_phase(lds, g, S, E);
        }
        xcd_barrier(xb);
        {
            pg8::Gemm g{(const bf16_t*)(ws + OFF_B), (const bf16_t*)(ws + OFF_W2), L, 1024, 4096}; pg8::StaticOrder S; S.init(L, 1024, G, wg);
            EpiResid E{H, MOD + 5 * 1024, MOD + 6144 + 5 * 1024};
            pg8::gemm_phase(lds, g, S, E);
        }
        xcd_barrier(xb);
    }
    phase_final(p);
}

extern "C" void kernel_launch(void* const* d_in, const int* in_sizes, int n_in, void* d_out, int out_size, void* d_ws, size_t ws_size, hipStream_t stream) {
    static int grid_blocks = 0;
    if (n_in != 32 || ws_size < WS_END || out_size != NLAT * DM) {
        fprintf(stderr, "kernel_launch: unexpected shapes / workspace (n_in %d, ws %zu need %zu, out %d)\n", n_in, ws_size, (size_t)WS_END, out_size);
        hipMemsetAsync(d_out, 0xFF, (size_t)out_size * 4, stream);
        return;
    }
    if (!grid_blocks) {
        int dev = 0, cus = 0, per_cu = 0;
        hipGetDevice(&dev);
        hipDeviceGetAttribute(&cus, hipDeviceAttributeMultiprocessorCount, dev);
        hipFuncSetAttribute((const void*)fwd_megakernel, hipFuncAttributeMaxDynamicSharedMemorySize, LDS_BYTES);
        hipOccupancyMaxActiveBlocksPerMultiprocessor(&per_cu, (const void*)fwd_megakernel, 512, LDS_BYTES);
        if (per_cu < 1) per_cu = 1;
        grid_blocks = cus * 1;
        (void)hipGetLastError();
    }
    P p{};
    for (int i = 0; i < 32; ++i) p.in[i] = (const float*)d_in[i];
    p.out = (float*)d_out; p.ws = (unsigned char*)d_ws;
    (void)hipMemsetAsync((unsigned char*)d_ws + OFF_BAR, 0, 16384, stream);
    void* args[] = {&p};
    hipError_t e = hipLaunchCooperativeKernel((const void*)fwd_megakernel, dim3(grid_blocks), dim3(512), args, LDS_BYTES, stream);
    if (e != hipSuccess) fprintf(stderr, "cooperative launch failed: %s (grid %d)\n", hipGetErrorString(e), grid_blocks);
}
```

```cpp
#include <hip/hip_runtime.h>
#include <hip/hip_cooperative_groups.h>
#include <cstdio>
#include <cstdint>
namespace cg = cooperative_groups;

#define LAS __attribute__((address_space(3)))
typedef unsigned short bf16_t;
typedef short bf16x8 __attribute__((ext_vector_type(8)));
typedef float f32x4 __attribute__((ext_vector_type(4)));
typedef float f32x2 __attribute__((ext_vector_type(2)));
typedef unsigned u32x4 __attribute__((ext_vector_type(4)));
typedef unsigned u32x2 __attribute__((ext_vector_type(2)));

constexpr int L = 16640, NCTX = 256, NLAT = 16384, DM = 1024, BW = 512, DEPTH = 4;
constexpr int IN_COLS = 8624;
constexpr int NMAIN = 5888;
constexpr int NWIN = 8960;
constexpr int R_LD = 2048, PG_LD = 3840;
constexpr int GLA_Q = 0, GLA_K = 256, GLA_V = 512, GLA_OG = 1024, GLA_AL = 1536;
constexpr int GDN_QKV = 1568, GDN_ZG = 3104, GDN_A = 3616, GDN_B = 3624;
constexpr int YRW_COL = 1568;

constexpr size_t al256(size_t x) { return (x + 255) & ~(size_t)255; }
constexpr size_t OFF_MOD = 0;
constexpr size_t OFF_H = al256(OFF_MOD + (size_t)4 * 2 * 6144 * 4);
constexpr size_t OFF_HN = OFF_H + (size_t)L * 1024 * 4;
constexpr size_t OFF_WIN = OFF_HN + (size_t)L * 1024 * 2;
constexpr size_t OFF_R = OFF_WIN + (size_t)NWIN * 1024 * 2;
constexpr size_t OFF_PG = OFF_R + (size_t)L * R_LD * 2;
constexpr size_t OFF_B = OFF_PG + (size_t)L * PG_LD * 2;
constexpr size_t OFF_RWG = OFF_B + (size_t)L * 4096 * 2;
constexpr size_t OFF_BONUS = OFF_RWG + (size_t)L * 512 * 2;
constexpr size_t OFF_GLAD = OFF_BONUS + (size_t)L * 8 * 4;
constexpr size_t OFF_GDNC = OFF_GLAD + (size_t)L * 512 * 2;
constexpr size_t OFF_GDNGB = OFF_GDNC + (size_t)L * 1536 * 2;
constexpr size_t OFF_XL = OFF_GDNGB + (size_t)L * 16 * 4;
constexpr size_t OFF_WL = OFF_XL + (size_t)L * 512 * 2;
constexpr size_t OFF_BAR = OFF_WL + (size_t)2560 * 512 * 2;
constexpr size_t WS_END = OFF_BAR + 16384;
constexpr size_t OFF_WBR = OFF_R;
constexpr size_t OFF_WOUT = OFF_WBR + (size_t)3 * 1024 * 512 * 2;
constexpr size_t OFF_W1 = OFF_WOUT + (size_t)1024 * 1024 * 2;
constexpr size_t OFF_W2 = OFF_W1 + (size_t)4096 * 1024 * 2;

constexpr int LDS_BYTES = 131072 + 16;

struct P { const float* in[32]; float* out; unsigned char* ws; };
enum { I_X = 0, I_C, I_CTX, I_CCTX, I_WMOD, I_BMOD, I_N1G, I_WIN, I_RWMU, I_RWW0, I_RWW2, I_RWA0, I_RWA2, I_RWG2, I_RWKK, I_RWKA, I_RWRK,
       I_RWLNW, I_RWLNB, I_GLAA2, I_GLAAB, I_GLANG, I_GDNCONV, I_GDNALOG, I_GDNDT, I_GDNNG, I_WBR, I_WOUT, I_N2G, I_W1, I_W2, I_FINALG };

__device__ __forceinline__ float bf2f(bf16_t b) { return __uint_as_float(((unsigned)b) << 16); }
__device__ __forceinline__ unsigned pk2(float lo, float hi) { unsigned r; asm("v_cvt_pk_bf16_f32 %0, %1, %2" : "=v"(r) : "v"(lo), "v"(hi)); return r; }
__device__ __forceinline__ bf16_t f2bf(float f) { return (bf16_t)(pk2(f, 0.f) & 0xffffu); }
__device__ __forceinline__ float sigmoid_(float x) { return 1.f / (1.f + __expf(-x)); }
__device__ __forceinline__ float silu_(float x) { return x / (1.f + __expf(-x)); }
__device__ __forceinline__ float softplus_(float x) { return fmaxf(x, 0.f) + log1pf(__expf(-fabsf(x))); }
template <int CTRL> __device__ __forceinline__ float dpp_(float x) { return __int_as_float(__builtin_amdgcn_update_dpp(0, __float_as_int(x), CTRL, 0xF, 0xF, true)); }
__device__ __forceinline__ float reduce8(float x) { x += dpp_<0xB1>(x); x += dpp_<0x4E>(x); x += dpp_<0x141>(x); return x; }
__device__ __forceinline__ float reduce16(float x) { x = reduce8(x); x += dpp_<0x140>(x); return x; }
__device__ __forceinline__ float wave_sum(float v) {
    v = reduce16(v);
    const float r0 = __int_as_float(__builtin_amdgcn_readlane(__float_as_int(v), 0)), r1 = __int_as_float(__builtin_amdgcn_readlane(__float_as_int(v), 16));
    const float r2 = __int_as_float(__builtin_amdgcn_readlane(__float_as_int(v), 32)), r3 = __int_as_float(__builtin_amdgcn_readlane(__float_as_int(v), 48));
    return (r0 + r1) + (r2 + r3);
}

__device__ __forceinline__ int otid() { int t = threadIdx.x; asm volatile("" : "+v"(t)); return t; }
__device__ __forceinline__ int osgpr(int x) { asm volatile("" : "+s"(x)); return x; }
namespace pg8 {
constexpr int BM = 256, BK = 64, HALF = 128, HTB = HALF * BK * 2, STAGE_BYTES = 8 * HTB, NXCD = 8, WGM = 8;
__host__ __device__ __forceinline__ int lds_byte(int r, int c) { const int st = (r >> 4) * 2 + (c >> 5), rr = r & 15, cc = c & 31, ob = rr * 64 + cc * 2; return st * 1024 + (ob ^ (((ob >> 9) & 1) << 5)); }
__host__ __device__ __forceinline__ void stage_rc(int b, int& R, int& C) { const int st = b / 1024, sb = b % 1024, swz = sb ^ (((sb >> 9) & 1) << 5); R = (st >> 1) * 16 + swz / 64; C = (st & 1) * 32 + (swz % 64) / 2; }
struct Unit { int pm, pn; };
struct Gemm { const bf16_t* A; const bf16_t* Bt; int M, N, K; };
struct StaticOrder {
    int nM, nN, nwg, G, c;
    __host__ __device__ void init(int M, int N, int G_, int c_) { nM = M / BM; nN = N / BM; nwg = nM * nN; G = G_; c = c_; }
    __host__ __device__ bool next(int i, Unit& u) const {
        const long Lx = (long)i * G + c; if (Lx >= nwg) return false;
        int wgid = (int)Lx; { const int q = nwg / NXCD, r = nwg % NXCD, xcd = wgid % NXCD, off = wgid / NXCD; wgid = (xcd < r ? xcd * (q + 1) : r * (q + 1) + (xcd - r) * q) + off; }
        const int nig = WGM * nN, gid = wgid / nig, fm = gid * WGM, gsz = (nM - fm) < WGM ? (nM - fm) : WGM;
        u.pm = fm + ((wgid % nig) % gsz); u.pn = (wgid % nig) / gsz; return true;
    }
};
template <class Epi>
__device__ __forceinline__ void gemm_phase(LAS unsigned char* lds, const Gemm g, const StaticOrder& S, const Epi& E) {
#ifdef NO_GEMM
    return;
#endif
    const int tid = otid(), wid = __builtin_amdgcn_readfirstlane(tid >> 6), lane = tid & 63, wr = wid >> 2, wc = wid & 3, fr = lane & 15, fq = lane >> 4;
    const int K = g.K, nt = K / BK;
    unsigned voffA[2];
#pragma unroll
    for (int i = 0; i < 2; ++i) { int R, C; stage_rc(tid * 16 + i * 8192, R, C); voffA[i] = (unsigned)(R * K + C) * 2u; }
    const size_t kstep = (size_t)(BK * 2);
    const size_t hstep = (size_t)HALF * K * 2;
    const size_t tstep = 2 * hstep;
    const unsigned ldsw = (unsigned)wid * 1024u;
    const int aoff = lds_byte(wr * 64 + fr, fq * 8), boff = lds_byte(wc * 32 + fr, fq * 8);
#define PG8_SA(b, h) (((b) * 2 + (h)) * HTB)
#define PG8_SB(b, h) ((4 + (b) * 2 + (h)) * HTB)
#define PG8_STAGE(bufoff, gbase, voff) do { _Pragma("unroll") for (int _i = 0; _i < 2; ++_i) \
        __builtin_amdgcn_global_load_lds((const unsigned*)((const char*)(gbase) + (voff)[_i]), (LAS unsigned*)(lds + (bufoff) + ldsw + _i * 8192), 16, 0, 0); } while (0)
#define PG8_LDA(dst, b, h) do { _Pragma("unroll") for (int m = 0; m < 4; ++m) _Pragma("unroll") for (int k = 0; k < 2; ++k) dst[m][k] = *(const LAS bf16x8*)(lds + PG8_SA(b, h) + aoff + m * 2048 + k * 1024); } while (0)
#define PG8_LDB(dst, b, h) do { _Pragma("unroll") for (int n = 0; n < 2; ++n) _Pragma("unroll") for (int k = 0; k < 2; ++k) dst[n][k] = *(const LAS bf16x8*)(lds + PG8_SB(b, h) + boff + n * 2048 + k * 1024); } while (0)
#define PG8_MMA(ai, bj, At, Bt) do { __builtin_amdgcn_s_setprio(1); _Pragma("unroll") for (int m = 0; m < 4; ++m) _Pragma("unroll") for (int n = 0; n < 2; ++n) _Pragma("unroll") for (int k = 0; k < 2; ++k) \
        acc[ai][bj][m][n] = __builtin_amdgcn_mfma_f32_16x16x32_bf16(Bt[n][k], At[m][k], acc[ai][bj][m][n], 0, 0, 0); __builtin_amdgcn_s_setprio(0); } while (0)
#define PG8_WAIT_V(n) asm volatile("s_waitcnt vmcnt(" #n ")" ::: "memory")
#define PG8_WAIT_L(n) asm volatile("s_waitcnt lgkmcnt(" #n ")" ::: "memory")
#define PG8_BAR __builtin_amdgcn_s_barrier()
#define PG8_SCHED __builtin_amdgcn_sched_barrier(0)
    Unit cur, nxt; int ui = 0;
    if (!S.next(0, cur)) return;
    f32x4 acc[2][2][4][2];
#pragma unroll
    for (int a = 0; a < 2; ++a)
#pragma unroll
        for (int b = 0; b < 2; ++b)
#pragma unroll
            for (int m = 0; m < 4; ++m)
#pragma unroll
                for (int n = 0; n < 2; ++n) acc[a][b][m][n] = (f32x4){0.f, 0.f, 0.f, 0.f};
    bf16x8 At[4][2], B0[2][2], B1[2][2];
    const char* cA = (const char*)g.A + (size_t)cur.pm * tstep; const char* cB = (const char*)g.Bt + (size_t)cur.pn * tstep;
    PG8_STAGE(PG8_SB(0, 0), cB, voffA); PG8_STAGE(PG8_SA(0, 0), cA, voffA); PG8_STAGE(PG8_SB(0, 1), cB + hstep, voffA); PG8_STAGE(PG8_SA(0, 1), cA + hstep, voffA);
    if (wr == 1) PG8_BAR;
    PG8_WAIT_V(4); PG8_BAR;
    PG8_STAGE(PG8_SB(1, 0), cB + kstep, voffA); PG8_STAGE(PG8_SA(1, 0), cA + kstep, voffA); PG8_STAGE(PG8_SB(1, 1), cB + hstep + kstep, voffA);
    PG8_WAIT_V(6); PG8_BAR;
    for (;;) {
        const bool has_next = S.next(ui + 1, nxt);
        const char* nA = has_next ? (const char*)g.A + (size_t)nxt.pm * tstep : cA; const char* nB = has_next ? (const char*)g.Bt + (size_t)nxt.pn * tstep : cB;
        for (int t = 0; t < nt; t += 2) {
            const bool last = (t == nt - 2);
            const char* a1 = cA + (size_t)(t + 1) * kstep;
            const char* a2 = last ? nA : cA + (size_t)(t + 2) * kstep; const char* b2 = last ? nB : cB + (size_t)(t + 2) * kstep;
            const char* a3 = a2 + kstep; const char* b3 = b2 + kstep;
            PG8_LDB(B0, 0, 0); PG8_SCHED; PG8_LDA(At, 0, 0); PG8_STAGE(PG8_SA(1, 1), a1 + hstep, voffA);
            PG8_WAIT_L(8); PG8_BAR; PG8_WAIT_L(0); PG8_MMA(0, 0, At, B0); PG8_BAR; PG8_SCHED;
            PG8_LDB(B1, 0, 1); PG8_STAGE(PG8_SB(0, 0), b2, voffA);
            PG8_BAR; PG8_WAIT_L(0); PG8_MMA(0, 1, At, B1); PG8_BAR;
            PG8_LDA(At, 0, 1); PG8_STAGE(PG8_SA(0, 0), a2, voffA);
            PG8_BAR; PG8_WAIT_L(0); PG8_MMA(1, 0, At, B0); PG8_BAR; PG8_SCHED;
            PG8_STAGE(PG8_SB(0, 1), b2 + hstep, voffA);
            PG8_WAIT_V(6); PG8_BAR; PG8_MMA(1, 1, At, B1); PG8_BAR;
            PG8_LDB(B0, 1, 0); PG8_SCHED; PG8_LDA(At, 1, 0); PG8_STAGE(PG8_SA(0, 1), a2 + hstep, voffA);
            PG8_WAIT_L(8); PG8_BAR; PG8_WAIT_L(0); PG8_MMA(0, 0, At, B0); PG8_BAR; PG8_SCHED;
            PG8_LDB(B1, 1, 1); PG8_STAGE(PG8_SB(1, 0), b3, voffA);
            PG8_BAR; PG8_WAIT_L(0); PG8_MMA(0, 1, At, B1); PG8_BAR;
            PG8_LDA(At, 1, 1); PG8_STAGE(PG8_SA(1, 0), a3, voffA);
            PG8_BAR; PG8_WAIT_L(0); PG8_MMA(1, 0, At, B0); PG8_BAR; PG8_SCHED;
            PG8_STAGE(PG8_SB(1, 1), b3 + hstep, voffA);
            PG8_WAIT_V(6); PG8_BAR; PG8_MMA(1, 1, At, B1); PG8_BAR;
        }
        E(acc, cur, wr, wc, fr, fq);
        if (!has_next) break;
#pragma unroll
        for (int a = 0; a < 2; ++a)
#pragma unroll
            for (int b = 0; b < 2; ++b)
#pragma unroll
                for (int m = 0; m < 4; ++m)
#pragma unroll
                    for (int n = 0; n < 2; ++n) acc[a][b][m][n] = (f32x4){0.f, 0.f, 0.f, 0.f};
        cur = nxt; cA = nA; cB = nB; ++ui;
    }
    PG8_WAIT_V(0);
    if (wr == 0) PG8_BAR;
    PG8_BAR;
#undef PG8_SA
#undef PG8_SB
#undef PG8_STAGE
#undef PG8_LDA
#undef PG8_LDB
#undef PG8_MMA
#undef PG8_WAIT_V
#undef PG8_WAIT_L
#undef PG8_BAR
#undef PG8_SCHED
}
}
using pg8::Unit;

#define EPI_LOOP_ROWS for (int ai = 0; ai < 2; ++ai) for (int m = 0; m < 4; ++m)
#define EPI_LOOP_COLS for (int bj = 0; bj < 2; ++bj) for (int n = 0; n < 2; ++n)
struct EpiInMain {
    bf16_t* R; bf16_t* PG;
    __device__ __forceinline__ void operator()(const f32x4 (&acc)[2][2][4][2], const Unit& u, int wr, int wc, int fr, int fq) const {
        bf16_t* dst; int ld, c0;
        if (u.pn < 8) { dst = R; ld = R_LD; c0 = u.pn * 256; } else { dst = PG; ld = PG_LD; c0 = (u.pn - 8) * 256; }
        const int row0 = u.pm * 256 + wr * 64 + fr, col0 = c0 + wc * 32 + 4 * fq;
#pragma unroll
        EPI_LOOP_ROWS { bf16_t* rowp = dst + (size_t)(row0 + ai * 128 + m * 16) * ld + col0;
#pragma unroll
            EPI_LOOP_COLS { const f32x4 v = acc[ai][bj][m][n]; *(u32x2*)(rowp + bj * 128 + n * 16) = (u32x2){pk2(v[0], v[1]), pk2(v[2], v[3])}; } }
    }
};
struct EpiGates {
    bf16_t* G;
    __device__ __forceinline__ void operator()(const f32x4 (&acc)[2][2][4][2], const Unit& u, int wr, int wc, int fr, int fq) const {
        const int row0 = u.pm * 256 + wr * 64 + fr, col0 = u.pn * 256 + wc * 32 + 4 * fq;
#pragma unroll
        EPI_LOOP_ROWS { bf16_t* rowp = G + (size_t)(row0 + ai * 128 + m * 16) * 3072 + col0;
#pragma unroll
            EPI_LOOP_COLS { const f32x4 v = acc[ai][bj][m][n];
                *(u32x2*)(rowp + bj * 128 + n * 16) = (u32x2){pk2(sigmoid_(v[0]), sigmoid_(v[1])), pk2(sigmoid_(v[2]), sigmoid_(v[3]))}; } }
    }
};
template <int GI> struct EpiBranch {
    const bf16_t* G; float* MG; bf16_t* MB;
    __device__ __forceinline__ void operator()(const f32x4 (&acc)[2][2][4][2], const Unit& u, int wr, int wc, int fr, int fq) const {
        const int row0 = u.pm * 256 + wr * 64 + fr, col0 = u.pn * 256 + wc * 32 + 4 * fq;
#pragma unroll
        EPI_LOOP_ROWS { const size_t row = (size_t)(row0 + ai * 128 + m * 16);
#pragma unroll
            EPI_LOOP_COLS { const int col = col0 + bj * 128 + n * 16; const f32x4 v = acc[ai][bj][m][n];
                const u32x2 gq = *(const u32x2*)(G + row * 3072 + GI * 1024 + col);
                f32x4 gv = (f32x4){__uint_as_float(gq[0] << 16), __uint_as_float(gq[0] & 0xffff0000u), __uint_as_float(gq[1] << 16), __uint_as_float(gq[1] & 0xffff0000u)};
                f32x4 r = v * gv;
                if (GI > 0) r += *(const f32x4*)(MG + row * 1024 + col);
                if (GI < 2) *(f32x4*)(MG + row * 1024 + col) = r;
                else *(u32x2*)(MB + row * 1024 + col) = (u32x2){pk2(r[0], r[1]), pk2(r[2], r[3])}; } }
    }
};
struct EpiResid {
    float* H; const float* gate_lat; const float* gate_ctx;
    __device__ __forceinline__ void operator()(const f32x4 (&acc)[2][2][4][2], const Unit& u, int wr, int wc, int fr, int fq) const {
        const int row0 = u.pm * 256 + wr * 64 + fr, col0 = u.pn * 256 + wc * 32 + 4 * fq;
        const float* gp = (u.pm == 0) ? gate_ctx : gate_lat;
        f32x4 gv[2][2];
#pragma unroll
        EPI_LOOP_COLS gv[bj][n] = *(const f32x4*)(gp + col0 + bj * 128 + n * 16);
#pragma unroll
        EPI_LOOP_ROWS { float* rowp = H + (size_t)(row0 + ai * 128 + m * 16) * 1024 + col0;
#pragma unroll
            EPI_LOOP_COLS { f32x4* q = (f32x4*)(rowp + bj * 128 + n * 16); *q = *q + acc[ai][bj][m][n] * gv[bj][n]; } }
    }
};
struct EpiLora {
    bf16_t* B; bf16_t* RWG; const float* w0; const float* a0;
    __device__ __forceinline__ void operator()(const f32x4 (&acc)[2][2][4][2], const Unit& u, int wr, int wc, int fr, int fq) const {
        const int row0 = u.pm * 256 + wr * 64 + fr, blk = u.pn >> 1, cbase = (u.pn & 1) * 256 + wc * 32 + 4 * fq;
        f32x4 bv[2][2];
#pragma unroll
        EPI_LOOP_COLS { const int cc = cbase + bj * 128 + n * 16;
            bv[bj][n] = blk < 2 ? *(const f32x4*)(w0 + blk * 512 + cc) : (blk < 4 ? *(const f32x4*)(a0 + (blk - 2) * 512 + cc) : (f32x4){0.f, 0.f, 0.f, 0.f}); }
        bf16_t* dst; int ld;
        if (blk < 2) { dst = B + 3072 + blk * 512; ld = 4096; } else if (blk < 4) { dst = B + 2048 + (blk - 2) * 512; ld = 4096; } else { dst = RWG; ld = 512; }
#pragma unroll
        EPI_LOOP_ROWS { bf16_t* rowp = dst + (size_t)(row0 + ai * 128 + m * 16) * ld + cbase;
#pragma unroll
            EPI_LOOP_COLS { f32x4 v = acc[ai][bj][m][n] + bv[bj][n];
                if (blk < 2) {
#pragma unroll
                    for (int j = 0; j < 4; ++j) { const float x = -v[j]; const float sp = fmaxf(x, 0.f) + __logf(1.f + __expf(-fabsf(x))); v[j] = 1.f - __expf(-__expf(-sp - 0.5f)); }
                } else if (blk < 4) {
#pragma unroll
                    for (int j = 0; j < 4; ++j) v[j] = sigmoid_(v[j]);
                }
                *(u32x2*)(rowp + bj * 128 + n * 16) = (u32x2){pk2(v[0], v[1]), pk2(v[2], v[3])}; } }
    }
};
struct EpiMlp1 {
    bf16_t* U;
    __device__ __forceinline__ void operator()(const f32x4 (&acc)[2][2][4][2], const Unit& u, int wr, int wc, int fr, int fq) const {
        const int row0 = u.pm * 256 + wr * 64 + fr, col0 = u.pn * 256 + wc * 32 + 4 * fq;
#pragma unroll
        EPI_LOOP_ROWS { bf16_t* rowp = U + (size_t)(row0 + ai * 128 + m * 16) * 4096 + col0;
#pragma unroll
            EPI_LOOP_COLS { f32x4 v = acc[ai][bj][m][n];
#pragma unroll
                for (int j = 0; j < 4; ++j) { const float t = fmaxf(v[j], 0.f); v[j] = t * t; }
                *(u32x2*)(rowp + bj * 128 + n * 16) = (u32x2){pk2(v[0], v[1]), pk2(v[2], v[3])}; } }
    }
};

__device__ __forceinline__ void convert_T(const float* src, int ld, int K, int n0, int ncols, bf16_t* dst, LAS float* tile, int wg, int nwg) {
    const int ntn = (ncols + 63) >> 6, ntk = K >> 6, tid = otid();
    for (int t = wg; t < ntn * ntk; t += nwg) {
        const int tn = t / ntk, tk = t - tn * ntk, k0 = tk * 64, nb = tn * 64;
#pragma unroll
        for (int i = 0; i < 2; ++i) { const int idx = tid + i * 512, kk = idx >> 4, n4 = (idx & 15) * 4;
            f32x4 v = (f32x4){0.f, 0.f, 0.f, 0.f};
            if (nb + n4 < ncols) v = *(const f32x4*)(src + (size_t)(k0 + kk) * ld + n0 + nb + n4);
            tile[kk * 65 + n4 + 0] = v[0]; tile[kk * 65 + n4 + 1] = v[1]; tile[kk * 65 + n4 + 2] = v[2]; tile[kk * 65 + n4 + 3] = v[3]; }
        __syncthreads();
        { const int nn = tid >> 3, k8 = (tid & 7) * 8;
          if (nb + nn < ncols) { const LAS float* s = tile + k8 * 65 + nn;
              u32x4 o; o[0] = pk2(s[0], s[65]); o[1] = pk2(s[130], s[195]); o[2] = pk2(s[260], s[325]); o[3] = pk2(s[390], s[455]);
              *(u32x4*)(dst + (size_t)(nb + nn) * K + k0 + k8) = o; } }
        __syncthreads();
    }
}

__device__ __forceinline__ void phase_mod(const P& p, LAS unsigned char* lds) {
    const float* c = p.in[I_C]; const float* cc = p.in[I_CCTX]; const float* wm = p.in[I_WMOD]; const float* bm = p.in[I_BMOD];
    float* MOD = (float*)(p.ws + OFF_MOD);
    LAS float* red = (LAS float*)lds;
    const int tid = otid();
    for (int blk = blockIdx.x; blk < 256; blk += gridDim.x) {
        const int l = blk >> 6, col0 = (blk & 63) * 96;
        if (tid < 384) {
            const int cgp = tid % 24, ks = tid / 24;
            f32x4 a0 = (f32x4){0.f, 0.f, 0.f, 0.f}, a1 = a0;
            const float* w = wm + (size_t)l * 1024 * 6144 + col0 + cgp * 4;
#pragma unroll 8
            for (int k = ks * 64; k < ks * 64 + 64; ++k) {
                const f32x4 wv = *(const f32x4*)(w + (size_t)k * 6144);
                const float s0 = silu_(c[k]), s1 = silu_(cc[k]);
                a0 += wv * s0; a1 += wv * s1;
            }
            LAS f32x4* r4 = (LAS f32x4*)red;
            r4[(ks * 24 + cgp) * 2 + 0] = a0; r4[(ks * 24 + cgp) * 2 + 1] = a1;
        }
        __syncthreads();
        if (tid < 192) {
            const int col = tid % 96, s = tid / 96;
            float sum = 0.f;
#pragma unroll
            for (int k2 = 0; k2 < 16; ++k2) sum += red[((k2 * 24 + (col >> 2)) * 2 + s) * 4 + (col & 3)];
            MOD[((size_t)l * 2 + s) * 6144 + col0 + col] = sum + bm[l * 6144 + col0 + col];
        }
        __syncthreads();
    }
}

template <bool FROM_INPUT>
__device__ __forceinline__ void phase_norm(const P& p, int l, const float* gamma, int shift_idx, int scale_idx) {
    float* H = (float*)(p.ws + OFF_H); bf16_t* HN = (bf16_t*)(p.ws + OFF_HN);
    const float* MOD = (const float*)(p.ws + OFF_MOD) + (size_t)l * 2 * 6144;
    const int tid_ = otid(); const int wave = tid_ >> 6, lane = tid_ & 63;
    for (int row = blockIdx.x * 8 + wave; row < L; row += gridDim.x * 8) {
        const float* src = FROM_INPUT ? (row < NCTX ? p.in[I_CTX] + (size_t)row * 1024 : p.in[I_X] + (size_t)(row - NCTX) * 1024) : H + (size_t)row * 1024;
        f32x4 v[4]; float ss = 0.f;
#pragma unroll
        for (int j = 0; j < 4; ++j) { v[j] = *(const f32x4*)(src + j * 256 + lane * 4); ss += (v[j][0] * v[j][0] + v[j][1] * v[j][1]) + (v[j][2] * v[j][2] + v[j][3] * v[j][3]); }
        ss = wave_sum(ss);
        const float rstd = rsqrtf(ss * (1.f / 1024.f) + 1e-6f);
        const float* m = MOD + (row < NCTX ? 6144 : 0);
#pragma unroll
        for (int j = 0; j < 4; ++j) { const int col = j * 256 + lane * 4;
            const f32x4 g = *(const f32x4*)(gamma + col), sh = *(const f32x4*)(m + shift_idx * 1024 + col), sc = *(const f32x4*)(m + scale_idx * 1024 + col);
            const f32x4 o = v[j] * rstd * g * (sc + 1.f) + sh;
            *(u32x2*)(HN + (size_t)row * 1024 + col) = (u32x2){pk2(o[0], o[1]), pk2(o[2], o[3])};
            if (FROM_INPUT) *(f32x4*)(H + (size_t)row * 1024 + col) = v[j]; }
    }
}

constexpr int TT = 13;
__device__ __forceinline__ void phase_prep(const P& p, int l, LAS unsigned char* lds) {
    const bf16_t* R = (const bf16_t*)(p.ws + OFF_R); const bf16_t* PG = (const bf16_t*)(p.ws + OFF_PG);
    bf16_t* B = (bf16_t*)(p.ws + OFF_B); bf16_t* XL = (bf16_t*)(p.ws + OFF_XL);
    bf16_t* GLAD = (bf16_t*)(p.ws + OFF_GLAD); bf16_t* GDNC = (bf16_t*)(p.ws + OFF_GDNC); float* GDNGB = (float*)(p.ws + OFF_GDNGB);
    const float* mu = p.in[I_RWMU] + (size_t)l * 2 * 1920;
    const float* kkw = p.in[I_RWKK] + l * 512;
    const float* ga2 = p.in[I_GLAA2] + (size_t)l * 2 * 16 * 256; const float* gab = p.in[I_GLAAB] + l * 512;
    const float* cw = p.in[I_GDNCONV] + (size_t)l * 5 * 1536; const float* alog = p.in[I_GDNALOG] + l * 8; const float* dtb = p.in[I_GDNDT] + l * 8;
    LAS float* gal = (LAS float*)lds;
    LAS float* red = gal + TT * 32;
    const int tid = otid(), wave = tid >> 6;
    const int c = tid;
    const int gz = tid >> 8, gk = tid & 255;
    for (int tile = blockIdx.x; tile < L / TT; tile += gridDim.x) {
        const int t0 = tile * TT;
        if (tid < TT * 32) { const int tt = tid >> 5, e = tid & 31; gal[tt * 32 + e] = bf2f(PG[(size_t)(t0 + tt) * PG_LD + GLA_AL + e]); }
        {
            float xr[TT + 2], xk[TT + 2], xv[TT + 2], xe[TT + 2];
#pragma unroll
            for (int i = 0; i < TT + 2; ++i) { const int rr = t0 - 1 + i;
                if (rr >= 0 && rr < L) { const bf16_t* rp = R + (size_t)rr * R_LD + c; xr[i] = bf2f(rp[0]); xk[i] = bf2f(rp[512]); xv[i] = bf2f(rp[1024]); xe[i] = (c < 384) ? bf2f(rp[1536]) : 0.f; }
                else { xr[i] = 0.f; xk[i] = 0.f; xv[i] = 0.f; xe[i] = 0.f; } }
            const float mr0 = mu[c], mr1 = mu[1920 + c], mk0 = mu[512 + c], mk1 = mu[1920 + 512 + c], mv0 = mu[1024 + c], mv1 = mu[1920 + 1024 + c];
            const float me0 = (c < 384) ? mu[1536 + c] : 0.f, me1 = (c < 384) ? mu[1920 + 1536 + c] : 0.f;
            const float kkc = kkw[c];
#pragma unroll
            for (int tt = 0; tt < TT; ++tt) {
                const int t = t0 + tt;
                const float hp = (t != 0 && t != NCTX) ? 1.f : 0.f, hn = (t != NCTX - 1 && t != L - 1) ? 1.f : 0.f;
                const float r = mr0 * hp * xr[tt] + (1.f - mr0 - mr1) * xr[tt + 1] + mr1 * hn * xr[tt + 2];
                const float k = mk0 * hp * xk[tt] + (1.f - mk0 - mk1) * xk[tt + 1] + mk1 * hn * xk[tt + 2];
                const float v = mv0 * hp * xv[tt] + (1.f - mv0 - mv1) * xv[tt + 1] + mv1 * hn * xv[tt + 2];
                float e = me0 * hp * xe[tt] + (1.f - me0 - me1) * xe[tt + 1] + me1 * hn * xe[tt + 2];
                if (c < 128) e = tanhf(e); else if (c >= 256 && c < 384) e = sigmoid_(e); else if (c >= 384) e = 0.f;
                const float kr = k * kkc;
                const float ssq = wave_sum(kr * kr);
                bf16_t* bp = B + (size_t)t * 4096 + c;
                bp[0] = f2bf(r); bp[512] = f2bf(k); bp[1024] = f2bf(v); bp[1536] = f2bf(kr * rsqrtf(ssq + 1e-12f));
                XL[(size_t)t * 512 + c] = f2bf(e);
            }
        }
        __syncthreads();
        {
        float ga2v[16];
#pragma unroll
        for (int e = 0; e < 16; ++e) ga2v[e] = ga2[(gz * 16 + e) * 256 + gk];
        const float gabv = gab[gz * 256 + gk];
#pragma unroll
        for (int tt = 0; tt < TT; ++tt) {
            float zv = gabv;
#pragma unroll
            for (int e = 0; e < 16; ++e) zv += gal[tt * 32 + gz * 16 + e] * ga2v[e];
            const float la = -softplus_(-zv) * (1.f / 16.f);
            GLAD[(size_t)(t0 + tt) * 512 + tid] = f2bf(-expm1f(la));
        }
        }
        {
            float cwv[5], xv[TT + 4];
#pragma unroll
            for (int i = 0; i < 5; ++i) cwv[i] = cw[i * 1536 + 1024 + c];
#pragma unroll
            for (int i = 0; i < TT + 4; ++i) { const int rr = t0 - 2 + i; xv[i] = (rr >= 0 && rr < L) ? bf2f(PG[(size_t)rr * PG_LD + GDN_QKV + 1024 + c]) : 0.f; }
#pragma unroll
            for (int tt = 0; tt < TT; ++tt) { const int t = t0 + tt; float sv = 0.f;
#pragma unroll
                for (int i = 0; i < 5; ++i) { const int rr = t + i - 2; const bool ok_ = (rr >= 0) && (rr < L) && ((rr < NCTX) == (t < NCTX)); if (ok_) sv += xv[tt + i] * cwv[i]; }
                GDNC[(size_t)t * 1536 + 1024 + c] = f2bf(silu_(sv)); }
        }
        float oq[TT], ok[TT];
        {
            float cwq[5], cwk[5], xq[TT + 4], xk[TT + 4];
#pragma unroll
            for (int i = 0; i < 5; ++i) { cwq[i] = cw[i * 1536 + c]; cwk[i] = cw[i * 1536 + 512 + c]; }
#pragma unroll
            for (int i = 0; i < TT + 4; ++i) { const int rr = t0 - 2 + i;
                if (rr >= 0 && rr < L) { const bf16_t* rp = PG + (size_t)rr * PG_LD + GDN_QKV + c; xq[i] = bf2f(rp[0]); xk[i] = bf2f(rp[512]); } else { xq[i] = 0.f; xk[i] = 0.f; } }
#pragma unroll
            for (int tt = 0; tt < TT; ++tt) {
                const int t = t0 + tt; float sq = 0.f, sk = 0.f;
#pragma unroll
                for (int i = 0; i < 5; ++i) { const int rr = t + i - 2; const bool ok_ = (rr >= 0) && (rr < L) && ((rr < NCTX) == (t < NCTX));
                    if (ok_) { sq += xq[tt + i] * cwq[i]; sk += xk[tt + i] * cwk[i]; } }
                oq[tt] = silu_(sq); ok[tt] = silu_(sk);
                const float pq = wave_sum(oq[tt] * oq[tt]), pk = wave_sum(ok[tt] * ok[tt]);
                if ((tid & 63) == 0) { red[(tt * 8 + wave) * 2 + 0] = pq; red[(tt * 8 + wave) * 2 + 1] = pk; }
            }
        }
        __syncthreads();
#pragma unroll
        for (int tt = 0; tt < TT; ++tt) {
            const int w0i = (wave >> 1) * 2;
            const float ssq = red[(tt * 8 + w0i) * 2 + 0] + red[(tt * 8 + w0i + 1) * 2 + 0], ssk = red[(tt * 8 + w0i) * 2 + 1] + red[(tt * 8 + w0i + 1) * 2 + 1];
            bf16_t* gp = GDNC + (size_t)(t0 + tt) * 1536 + c;
            gp[0] = f2bf(oq[tt] * rsqrtf(ssq + 1e-12f) * 0.08838834764831845f); gp[512] = f2bf(ok[tt] * rsqrtf(ssk + 1e-12f));
        }
        if (tid < TT * 16) { const int tt = tid >> 4, j = tid & 15, t = t0 + tt;
            float o;
            if (j < 8) { const float a = bf2f(PG[(size_t)t * PG_LD + GDN_A + j]); o = __expf(-__expf(alog[j]) * softplus_(a + dtb[j])); }
            else o = sigmoid_(bf2f(PG[(size_t)t * PG_LD + GDN_B + (j - 8)]));
            GDNGB[t * 16 + j] = o; }
        __syncthreads();
    }
}
__device__ __forceinline__ void build_wl(const P& p, int l, int wg, int nwg) {
    const float* w2 = p.in[I_RWW2] + (size_t)l * 2 * 64 * 512; const float* a2 = p.in[I_RWA2] + (size_t)l * 2 * 64 * 512; const float* g2 = p.in[I_RWG2] + (size_t)l * 128 * 512;
    bf16_t* WL = (bf16_t*)(p.ws + OFF_WL);
    const int tid = otid();
    for (int it = wg * 512 + tid; it < 2560 * 64; it += nwg * 512) {
        const int kc = it / 2560, n = it - kc * 2560, k0 = kc * 8, blk = n >> 9, cc = n & 511;
        const float* src = nullptr; int kb = 0, kn = 0;
        if (blk == 0) { src = w2; kb = 0; kn = 64; } else if (blk == 1) { src = w2 + 64 * 512; kb = 64; kn = 64; }
        else if (blk == 2) { src = a2; kb = 128; kn = 64; } else if (blk == 3) { src = a2 + 64 * 512; kb = 192; kn = 64; }
        else { src = g2; kb = 256; kn = 128; }
        float v[8];
#pragma unroll
        for (int j = 0; j < 8; ++j) { const int k = k0 + j - kb; v[j] = (k >= 0 && k < kn) ? src[(size_t)k * 512 + cc] : 0.f; }
        u32x4 o; o[0] = pk2(v[0], v[1]); o[1] = pk2(v[2], v[3]); o[2] = pk2(v[4], v[5]); o[3] = pk2(v[6], v[7]);
        *(u32x4*)(WL + (size_t)n * 512 + k0) = o;
    }
}

constexpr int TB = 32, NBLK = L / TB;
__device__ __forceinline__ int tok_seq(int z, int j) { return z == 0 ? j : (j < NCTX ? NCTX - 1 - j : L - 1 - (j - NCTX)); }
__device__ __forceinline__ int tok_gla(int z, int j) {
    if (j < NCTX) return z == 0 ? j : NCTX - 1 - j;
    const int jj = j - NCTX, pp = z == 0 ? jj : NLAT - 1 - jj;
    return NCTX + (pp & 255) * 64 + (pp >> 8);
}

template <int NCW> struct ScanRole {
    bool cons, prod; int ct;
    __device__ __forceinline__ ScanRole(int tid) {
        const int w = tid >> 6, lane = tid & 63;
        if (NCW == 4) { cons = w < 4; prod = !cons; ct = tid & 255; }
        else { cons = w < 2; prod = (w & 2) != 0; ct = cons ? tid : ((((w >> 2) << 1) | (w & 1)) * 64 + lane); }
    }
};
#define SCAN_BARRIER() asm volatile("s_waitcnt lgkmcnt(0)\n\ts_barrier" ::: "memory")
__device__ __forceinline__ float bfraw2f(unsigned short b) { return __uint_as_float(((unsigned)b) << 16); }

__device__ __forceinline__ void scan_rwkv(const P& p, int l, int unit, LAS unsigned char* lds) {
    const int z = unit >> 6, h = (unit >> 3) & 7, rq = unit & 7;
    const bf16_t* B = (const bf16_t*)(p.ws + OFF_B); bf16_t* Y = (bf16_t*)(p.ws + OFF_PG) + YRW_COL + z * 512 + h * 64 + rq * 8;
    const float* kaw = p.in[I_RWKA] + l * 512 + h * 64;
    LAS float* vec = (LAS float*)lds;
    LAS float* vv = vec + 2 * TB * 320;
    LAS float* yo = vv + 2 * TB * 8;
    const int tid = otid(); const ScanRole<2> role(tid); const int ct = role.ct; const bool prod = role.prod, cons = role.cons;
    unsigned short pr[8], pk[8], pkk[8], pa[8], pw[8], pv;
    const float kac = kaw[ct & 63];
    auto p_load = [&](int blk) {
#pragma unroll
        for (int i = 0; i < 8; ++i) { const int idx = ct + i * 256, s = idx >> 6, n = idx & 63; const int t = tok_seq(z, blk * TB + s);
            const bf16_t* bp = B + (size_t)t * 4096 + h * 64 + n;
            pr[i] = bp[0]; pk[i] = bp[512]; pkk[i] = bp[1536]; pa[i] = bp[2048 + z * 512]; pw[i] = bp[3072 + z * 512]; }
        { const int s = ct >> 3, r = ct & 7; const int t = tok_seq(z, blk * TB + s); pv = B[(size_t)t * 4096 + 1024 + h * 64 + rq * 8 + r]; }
    };
    auto p_write = [&](int buf) {
#pragma unroll
        for (int i = 0; i < 8; ++i) { const int idx = ct + i * 256, s = idx >> 6, n = idx & 63;
            LAS float* d = vec + ((buf * TB + s) * 16 + (n >> 2)) * 20 + (n & 3);
            const float kk = bfraw2f(pkk[i]), a = bfraw2f(pa[i]);
            d[0] = kk; d[4] = 1.f - bfraw2f(pw[i]); d[8] = kk * a; d[12] = bfraw2f(pk[i]) * (1.f + (a - 1.f) * kac); d[16] = bfraw2f(pr[i]); }
        vv[buf * TB * 8 + ct] = bfraw2f(pv);
    };
    auto p_yout = [&](int blk) {
        const int buf = blk & 1; const int s = ct >> 3, r = ct & 7; const int t = tok_seq(z, blk * TB + s);
        Y[(size_t)t * PG_LD + r] = f2bf(yo[buf * TB * 8 + ct]);
    };
    const int irow = (ct >> 4) & 7, ks = ct & 15;
    f32x2 S0 = (f32x2){0.f, 0.f}, S1 = S0;
    struct Vx { f32x4 kk, w, b, k, r; float v; };
    auto c_ld = [&](Vx& x, int buf, int s) {
        const LAS float* d = vec + ((buf * TB + s) * 16 + ks) * 20;
        x.kk = *(const LAS f32x4*)(d); x.w = *(const LAS f32x4*)(d + 4); x.b = *(const LAS f32x4*)(d + 8); x.k = *(const LAS f32x4*)(d + 12);
        x.r = *(const LAS f32x4*)(d + 16); x.v = vv[(buf * TB + s) * 8 + irow];
    };
    float sa = 0.f;
    auto c_step = [&](const Vx& x, const f32x4& kkn, int buf, int s) {
        const f32x2 vv2 = (f32x2){x.v, x.v}, nsa = (f32x2){-sa, -sa};
        S0 = S0 * (f32x2){x.w[0], x.w[1]} + (vv2 * (f32x2){x.k[0], x.k[1]} + nsa * (f32x2){x.b[0], x.b[1]});
        S1 = S1 * (f32x2){x.w[2], x.w[3]} + (vv2 * (f32x2){x.k[2], x.k[3]} + nsa * (f32x2){x.b[2], x.b[3]});
        const f32x2 y2 = S0 * (f32x2){x.r[0], x.r[1]} + S1 * (f32x2){x.r[2], x.r[3]};
        const f32x2 s2 = S0 * (f32x2){kkn[0], kkn[1]} + S1 * (f32x2){kkn[2], kkn[3]};
        float yp = y2[0] + y2[1], sp = s2[0] + s2[1];
        yp += dpp_<0xB1>(yp); sp += dpp_<0xB1>(sp); yp += dpp_<0x4E>(yp); sp += dpp_<0x4E>(sp);
        yp += dpp_<0x141>(yp); sp += dpp_<0x141>(sp); yp += dpp_<0x140>(yp); sp += dpp_<0x140>(sp);
        sa = sp;
        yo[(buf * TB + s) * 8 + irow] = yp;
    };
    if (prod) { p_load(0); p_write(0); p_load(1); }
    SCAN_BARRIER();
    for (int b = 0; b < NBLK; ++b) {
        if (prod) {
            if (b + 1 < NBLK) p_write((b + 1) & 1);
            if (b + 2 < NBLK) p_load(b + 2);
            if (b > 0) p_yout(b - 1);
        } else if (cons) {
            const int buf = b & 1;
            Vx xa, xb;
            c_ld(xa, buf, 0);
            { const f32x2 s2 = S0 * (f32x2){xa.kk[0], xa.kk[1]} + S1 * (f32x2){xa.kk[2], xa.kk[3]}; sa = reduce16(s2[0] + s2[1]); }
#pragma unroll 2
            for (int s = 0; s < TB; s += 2) {
                c_ld(xb, buf, s + 1); c_step(xa, xb.kk, buf, s);
                c_ld(xa, buf, s + 2);
                c_step(xb, xa.kk, buf, s + 1);
            }
        }
        SCAN_BARRIER();
    }
    if (prod) p_yout(NBLK - 1);
    SCAN_BARRIER();
}

__device__ __forceinline__ void scan_gla(const P& p, int l, int unit, LAS unsigned char* lds) {
    const int z = unit >> 4, h = (unit >> 2) & 3, cb = unit & 3;
    const bf16_t* PG = (const bf16_t*)(p.ws + OFF_PG); const bf16_t* GLAD = (const bf16_t*)(p.ws + OFF_GLAD);
    bf16_t* O = (bf16_t*)(p.ws + OFF_R) + z * 512 + h * 128 + cb * 32;
    LAS float* vec = (LAS float*)lds;
    LAS float* vv = vec + 2 * TB * 192;
    LAS float* yo = vv + 2 * TB * 32;
    const int tid = otid(); const ScanRole<4> role(tid); const int ct = role.ct; const bool prod = role.prod, cons = role.cons;
    unsigned short pq[8], pk[8], pa[8], pv[4];
    auto p_load = [&](int blk) {
#pragma unroll
        for (int i = 0; i < 8; ++i) { const int idx = ct + i * 256, s = idx >> 6, n = idx & 63; const int t = tok_gla(z, blk * TB + s);
            const bf16_t* bp = PG + (size_t)t * PG_LD + h * 64 + n;
            pq[i] = bp[GLA_Q]; pk[i] = bp[GLA_K]; pa[i] = GLAD[(size_t)t * 512 + z * 256 + h * 64 + n]; }
#pragma unroll
        for (int i = 0; i < 4; ++i) { const int idx = ct + i * 256, s = idx >> 5, r = idx & 31; const int t = tok_gla(z, blk * TB + s);
            pv[i] = PG[(size_t)t * PG_LD + GLA_V + h * 128 + cb * 32 + r]; }
    };
    auto p_write = [&](int buf) {
#pragma unroll
        for (int i = 0; i < 8; ++i) { const int idx = ct + i * 256, s = idx >> 6, n = idx & 63;
            LAS float* d = vec + ((buf * TB + s) * 8 + (n >> 3)) * 24 + (n & 7);
            d[0] = bfraw2f(pq[i]) * 0.125f; d[8] = bfraw2f(pk[i]); d[16] = 1.f - bfraw2f(pa[i]); }
#pragma unroll
        for (int i = 0; i < 4; ++i) vv[buf * TB * 32 + ct + i * 256] = bfraw2f(pv[i]);
    };
    auto p_yout = [&](int blk) {
        const int buf = blk & 1;
#pragma unroll
        for (int i = 0; i < 4; ++i) { const int idx = ct + i * 256, s = idx >> 5, r = idx & 31; const int t = tok_gla(z, blk * TB + s);
            O[(size_t)t * R_LD + r] = f2bf(yo[buf * TB * 32 + idx]); }
    };
    const int icol = (ct >> 3) & 31, ks = ct & 7;
    f32x2 S[4];
#pragma unroll
    for (int j = 0; j < 4; ++j) S[j] = (f32x2){0.f, 0.f};
    struct Vx { f32x4 q0, q1, k0, k1, a0, a1; float v; };
    auto c_ld = [&](Vx& x, int buf, int s) {
        const LAS float* d = vec + ((buf * TB + s) * 8 + ks) * 24;
        x.q0 = *(const LAS f32x4*)(d); x.q1 = *(const LAS f32x4*)(d + 4); x.k0 = *(const LAS f32x4*)(d + 8); x.k1 = *(const LAS f32x4*)(d + 12);
        x.a0 = *(const LAS f32x4*)(d + 16); x.a1 = *(const LAS f32x4*)(d + 20); x.v = vv[(buf * TB + s) * 32 + icol];
    };
    auto c_upd = [&](const Vx& x) -> float {
        const f32x2 vv2 = (f32x2){x.v, x.v};
        S[0] = S[0] * (f32x2){x.a0[0], x.a0[1]} + vv2 * (f32x2){x.k0[0], x.k0[1]};
        S[1] = S[1] * (f32x2){x.a0[2], x.a0[3]} + vv2 * (f32x2){x.k0[2], x.k0[3]};
        S[2] = S[2] * (f32x2){x.a1[0], x.a1[1]} + vv2 * (f32x2){x.k1[0], x.k1[1]};
        S[3] = S[3] * (f32x2){x.a1[2], x.a1[3]} + vv2 * (f32x2){x.k1[2], x.k1[3]};
        const f32x2 y2 = (S[0] * (f32x2){x.q0[0], x.q0[1]} + S[1] * (f32x2){x.q0[2], x.q0[3]}) + (S[2] * (f32x2){x.q1[0], x.q1[1]} + S[3] * (f32x2){x.q1[2], x.q1[3]});
        return y2[0] + y2[1];
    };
    if (prod) { p_load(0); p_write(0); p_load(1); }
    SCAN_BARRIER();
    for (int b = 0; b < NBLK; ++b) {
        if (prod) {
            if (b + 1 < NBLK) p_write((b + 1) & 1);
            if (b + 2 < NBLK) p_load(b + 2);
            if (b > 0) p_yout(b - 1);
        } else if (cons) {
            const int buf = b & 1;
            Vx xa, xb;
            c_ld(xa, buf, 0);
#pragma unroll 2
            for (int s = 0; s < TB; s += 2) {
                c_ld(xb, buf, s + 1);
                float ya = c_upd(xa);
                c_ld(xa, buf, s + 2);
                float yb = c_upd(xb);
                ya += dpp_<0xB1>(ya); yb += dpp_<0xB1>(yb); ya += dpp_<0x4E>(ya); yb += dpp_<0x4E>(yb); ya += dpp_<0x141>(ya); yb += dpp_<0x141>(yb);
                yo[(buf * TB + s) * 32 + icol] = ya; yo[(buf * TB + s + 1) * 32 + icol] = yb;
            }
        }
        SCAN_BARRIER();
    }
    if (prod) p_yout(NBLK - 1);
    SCAN_BARRIER();
}

__device__ __forceinline__ void scan_gdn(const P& p, int l, int unit, LAS unsigned char* lds) {
    const int z = unit >> 5, h = (unit >> 3) & 3, cb = unit & 7;
    const bf16_t* GDNC = (const bf16_t*)(p.ws + OFF_GDNC); const float* GDNGB = (const float*)(p.ws + OFF_GDNGB);
    bf16_t* O = (bf16_t*)(p.ws + OFF_R) + 1024 + z * 512 + h * 128 + cb * 16;
    LAS float* vec = (LAS float*)lds;
    LAS float* vv = vec + 2 * TB * 320;
    LAS float* sc = vv + 2 * TB * 16;
    LAS float* yo = sc + 2 * TB * 2;
    const int tid = otid(); const ScanRole<4> role(tid); const int ct = role.ct; const bool prod = role.prod, cons = role.cons;
    unsigned short pq[16], pk[16], pv[2]; float psc = 0.f;
    auto p_load = [&](int blk) {
#pragma unroll
        for (int i = 0; i < 16; ++i) { const int idx = ct + i * 256, s = idx >> 7, n = idx & 127; const int t = tok_seq(z, blk * TB + s);
            const bf16_t* bp = GDNC + (size_t)t * 1536 + h * 128 + n;
            pq[i] = bp[0]; pk[i] = bp[512]; }
#pragma unroll
        for (int i = 0; i < 2; ++i) { const int idx = ct + i * 256, s = idx >> 4, r = idx & 15; const int t = tok_seq(z, blk * TB + s);
            pv[i] = GDNC[(size_t)t * 1536 + 1024 + h * 128 + cb * 16 + r]; }
        if (ct < 64) { const int s = ct >> 1, w = ct & 1; const int t = tok_seq(z, blk * TB + s); psc = GDNGB[t * 16 + w * 8 + z * 4 + h]; }
    };
    auto p_write = [&](int buf) {
#pragma unroll
        for (int i = 0; i < 16; ++i) { const int idx = ct + i * 256, s = idx >> 7, n = idx & 127;
            LAS float* d = vec + ((buf * TB + s) * 16 + (n >> 3)) * 20 + (n & 7);
            d[0] = bfraw2f(pq[i]); d[8] = bfraw2f(pk[i]); }
#pragma unroll
        for (int i = 0; i < 2; ++i) vv[buf * TB * 16 + ct + i * 256] = bfraw2f(pv[i]);
        if (ct < 64) sc[buf * TB * 2 + ct] = psc;
    };
    auto p_yout = [&](int blk) {
        const int buf = blk & 1;
#pragma unroll
        for (int i = 0; i < 2; ++i) { const int idx = ct + i * 256, s = idx >> 4, r = idx & 15; const int t = tok_seq(z, blk * TB + s);
            O[(size_t)t * R_LD + r] = f2bf(yo[buf * TB * 16 + idx]); }
    };
    const int icol = (ct >> 4) & 15, ks = ct & 15;
    f32x2 S[4];
#pragma unroll
    for (int j = 0; j < 4; ++j) S[j] = (f32x2){0.f, 0.f};
    struct Vx { f32x4 q0, q1, k0, k1; float v; f32x2 gb; };
    auto c_ld = [&](Vx& x, int buf, int s) {
        const LAS float* d = vec + ((buf * TB + s) * 16 + ks) * 20;
        x.q0 = *(const LAS f32x4*)(d); x.q1 = *(const LAS f32x4*)(d + 4); x.k0 = *(const LAS f32x4*)(d + 8); x.k1 = *(const LAS f32x4*)(d + 12);
        x.v = vv[(buf * TB + s) * 16 + icol]; x.gb = *(const LAS f32x2*)(sc + (buf * TB + s) * 2);
    };
    float dd = 0.f;
    auto c_step = [&](const Vx& x, const f32x4& kn0, const f32x4& kn1, int buf, int s) {
        const float eg = x.gb[0];
        const float cc = x.gb[1] * (x.v - eg * dd);
        const f32x2 eg2 = (f32x2){eg, eg}, cc2 = (f32x2){cc, cc};
        S[0] = S[0] * eg2 + cc2 * (f32x2){x.k0[0], x.k0[1]};
        S[1] = S[1] * eg2 + cc2 * (f32x2){x.k0[2], x.k0[3]};
        S[2] = S[2] * eg2 + cc2 * (f32x2){x.k1[0], x.k1[1]};
        S[3] = S[3] * eg2 + cc2 * (f32x2){x.k1[2], x.k1[3]};
        const f32x2 y2 = (S[0] * (f32x2){x.q0[0], x.q0[1]} + S[1] * (f32x2){x.q0[2], x.q0[3]}) + (S[2] * (f32x2){x.q1[0], x.q1[1]} + S[3] * (f32x2){x.q1[2], x.q1[3]});
        const f32x2 d2 = (S[0] * (f32x2){kn0[0], kn0[1]} + S[1] * (f32x2){kn0[2], kn0[3]}) + (S[2] * (f32x2){kn1[0], kn1[1]} + S[3] * (f32x2){kn1[2], kn1[3]});
        float yp = y2[0] + y2[1], dp = d2[0] + d2[1];
        yp += dpp_<0xB1>(yp); dp += dpp_<0xB1>(dp); yp += dpp_<0x4E>(yp); dp += dpp_<0x4E>(dp);
        yp += dpp_<0x141>(yp); dp += dpp_<0x141>(dp); yp += dpp_<0x140>(yp); dp += dpp_<0x140>(dp);
        dd = dp;
        yo[(buf * TB + s) * 16 + icol] = yp;
    };
    if (prod) { p_load(0); p_write(0); p_load(1); }
    SCAN_BARRIER();
    for (int b = 0; b < NBLK; ++b) {
        if (prod) {
            if (b + 1 < NBLK) p_write((b + 1) & 1);
            if (b + 2 < NBLK) p_load(b + 2);
            if (b > 0) p_yout(b - 1);
        } else if (cons) {
            const int buf = b & 1;
            Vx xa, xb;
            c_ld(xa, buf, 0);
            { const f32x2 d2 = (S[0] * (f32x2){xa.k0[0], xa.k0[1]} + S[1] * (f32x2){xa.k0[2], xa.k0[3]}) + (S[2] * (f32x2){xa.k1[0], xa.k1[1]} + S[3] * (f32x2){xa.k1[2], xa.k1[3]});
              dd = reduce16(d2[0] + d2[1]); }
#pragma unroll 2
            for (int s = 0; s < TB; s += 2) {
                c_ld(xb, buf, s + 1); c_step(xa, xb.k0, xb.k1, buf, s);
                c_ld(xa, buf, s + 2);
                c_step(xb, xa.k0, xa.k1, buf, s + 1);
            }
        }
        SCAN_BARRIER();
    }
    if (prod) p_yout(NBLK - 1);
    SCAN_BARRIER();
}

__device__ __forceinline__ void phase_post(const P& p, int l, LAS unsigned char* lds) {
    const bf16_t* PG = (const bf16_t*)(p.ws + OFF_PG); const bf16_t* Rb = (const bf16_t*)(p.ws + OFF_R); const bf16_t* B = (const bf16_t*)(p.ws + OFF_B);
    const bf16_t* RWG = (const bf16_t*)(p.ws + OFF_RWG);
    bf16_t* YC = (bf16_t*)(p.ws + OFF_GDNC);
    const int tid = otid(), wave = tid >> 6, c = tid;
    const float lnw = p.in[I_RWLNW][l * 512 + c], lnb = p.in[I_RWLNB][l * 512 + c], kac = p.in[I_RWKA][l * 512 + c], rkc = p.in[I_RWRK][l * 512 + c];
    const float gng = p.in[I_GLANG][l * 128 + (c & 127)], dng = p.in[I_GDNNG][l * 128 + (c & 127)];
    LAS float* red = (LAS float*)lds;
    for (int tile = blockIdx.x; tile < L / TT; tile += gridDim.x) {
        const int t0 = tile * TT;
        float og[TT], od[TT];
#pragma unroll
        for (int tt = 0; tt < TT; ++tt) {
            const int t = t0 + tt;
            const float y = bf2f(PG[(size_t)t * PG_LD + YRW_COL + c]) + bf2f(PG[(size_t)t * PG_LD + YRW_COL + 512 + c]);
            const float mean = wave_sum(y) * (1.f / 64.f);
            const float dy = y - mean;
            const float var = wave_sum(dy * dy) * (1.f / 64.f);
            const float yn = dy * rsqrtf(var + 64e-5f) * lnw + lnb;
            const bf16_t* bp = B + (size_t)t * 4096 + c;
            const float v = bf2f(bp[1024]), rr_ = bf2f(bp[0]), kk_ = bf2f(bp[512]), az0 = bf2f(bp[2048]), az1 = bf2f(bp[2560]);
            const float bon = wave_sum(rr_ * rkc * (kk_ * (1.f + (az0 - 1.f) * kac) + kk_ * (1.f + (az1 - 1.f) * kac)));
            const float o = (yn + bon * v) * bf2f(RWG[(size_t)t * 512 + c]);
            YC[(size_t)t * 512 + c] = f2bf(o);
            og[tt] = bf2f(Rb[(size_t)t * R_LD + c]) + bf2f(Rb[(size_t)t * R_LD + 512 + c]);
            od[tt] = bf2f(Rb[(size_t)t * R_LD + 1024 + c]) + bf2f(Rb[(size_t)t * R_LD + 1536 + c]);
            const float pg_ = wave_sum(og[tt] * og[tt]), pd_ = wave_sum(od[tt] * od[tt]);
            if ((tid & 63) == 0) { red[(tt * 8 + wave) * 2 + 0] = pg_; red[(tt * 8 + wave) * 2 + 1] = pd_; }
        }
        __syncthreads();
#pragma unroll
        for (int tt = 0; tt < TT; ++tt) {
            const int t = t0 + tt, w0i = (wave >> 1) * 2;
            const float sg = red[(tt * 8 + w0i) * 2 + 0] + red[(tt * 8 + w0i + 1) * 2 + 0], sd = red[(tt * 8 + w0i) * 2 + 1] + red[(tt * 8 + w0i + 1) * 2 + 1];
            const float gate_g = silu_(bf2f(PG[(size_t)t * PG_LD + GLA_OG + c])), gate_d = silu_(bf2f(PG[(size_t)t * PG_LD + GDN_ZG + c]));
            YC[(size_t)L * 512 + (size_t)t * 512 + c] = f2bf(og[tt] * rsqrtf(sg * (1.f / 128.f) + 1e-6f) * gng * gate_g);
            YC[(size_t)2 * L * 512 + (size_t)t * 512 + c] = f2bf(od[tt] * rsqrtf(sd * (1.f / 128.f) + 1e-6f) * dng * gate_d);
        }
        __syncthreads();
    }
}

__device__ __forceinline__ void phase_final(const P& p) {
    const float* H = (const float*)(p.ws + OFF_H); const float* gamma = p.in[I_FINALG];
    const int tid_ = otid(); const int wave = tid_ >> 6, lane = tid_ & 63;
    for (int row = blockIdx.x * 8 + wave; row < NLAT; row += gridDim.x * 8) {
        const float* src = H + (size_t)(row + NCTX) * 1024;
        f32x4 v[4]; float ss = 0.f;
#pragma unroll
        for (int j = 0; j < 4; ++j) { v[j] = *(const f32x4*)(src + j * 256 + lane * 4); ss += (v[j][0] * v[j][0] + v[j][1] * v[j][1]) + (v[j][2] * v[j][2] + v[j][3] * v[j][3]); }
        ss = wave_sum(ss);
        const float rstd = rsqrtf(ss * (1.f / 1024.f) + 1e-6f);
#pragma unroll
        for (int j = 0; j < 4; ++j) { const int col = j * 256 + lane * 4; const f32x4 g = *(const f32x4*)(gamma + col);
            *(f32x4*)(p.out + (size_t)row * 1024 + col) = v[j] * rstd * g; }
    }
}


#define XB_TMO      128
#define XB_XCNT(j)  (256  + 64 * (j))
#define XB_XSUB(j)  (1280 + 64 * (j))
#define XB_XGEN(j)  (2304 + 64 * (j))
#define XB_TOP      3328
#define XB_TOPGEN   3392
#define XCD_BAR_WORDS 3456
#define XB_SPIN_CAP (1u << 18)
__device__ __forceinline__ unsigned xb_ld(unsigned* p)              { return __hip_atomic_load(p, __ATOMIC_RELAXED, __HIP_MEMORY_SCOPE_AGENT); }
__device__ __forceinline__ unsigned xb_add(unsigned* p, unsigned v) { return __hip_atomic_fetch_add(p, v, __ATOMIC_RELAXED, __HIP_MEMORY_SCOPE_AGENT); }
__device__ __forceinline__ unsigned xb_xcc_id() { return (unsigned)__builtin_amdgcn_s_getreg((3 << 11) | 20) & 0xFu; }
#define XB_SPIN(cond, bar) do { unsigned _sp = 0; while (cond) { __builtin_amdgcn_s_sleep(1); \
    if ((++_sp & 255u) == 0u) { if (xb_ld(&(bar)[XB_TMO])) break; if (_sp > XB_SPIN_CAP) { atomicAdd(&(bar)[XB_TMO], 1u); break; } } } } while (0)
struct XcdBarrier { unsigned* bar; unsigned x; volatile LAS unsigned* st; };
__device__ __forceinline__ XcdBarrier xcd_barrier_post(unsigned* bar, volatile LAS unsigned* st) {
    XcdBarrier b; b.bar = bar; b.x = xb_xcc_id(); b.st = st;
    if (threadIdx.x == 0) (void)xb_add(&bar[XB_XCNT(b.x)], 1u);
    return b;
}
__device__ __forceinline__ void xcd_barrier_complete(unsigned* bar, unsigned x, unsigned& nloc, unsigned& nx) {
    const unsigned G = gridDim.x * gridDim.y * gridDim.z;
    unsigned sum, cnt, mine, sp = 0u;
    for (;;) {
        sum = 0u; cnt = 0u; mine = 0u;
#pragma unroll
        for (unsigned j = 0; j < 16; ++j) { const unsigned c = xb_ld(&bar[XB_XCNT(j)]); sum += c; cnt += (c > 0u) ? 1u : 0u; mine = (j == x) ? c : mine; }
        if (sum == G) break;
        __builtin_amdgcn_s_sleep(1);
        if ((++sp & 255u) == 0u) { if (xb_ld(&bar[XB_TMO])) break; if (sp > XB_SPIN_CAP) { atomicAdd(&bar[XB_TMO], 1u); break; } }
    }
    nloc = mine > 0u ? mine : 1u; nx = cnt > 0u ? cnt : 1u;
}
__device__ __forceinline__ void xcd_barrier(const XcdBarrier& b) {
    asm volatile("s_waitcnt vmcnt(0)" ::: "memory");
    __syncthreads();
    if (threadIdx.x == 0) {
        unsigned* bar = b.bar;
        __builtin_amdgcn_s_waitcnt(0);
        unsigned nloc = b.st[0], nx = b.st[1];
        if (nloc == 0u) { xcd_barrier_complete(bar, b.x, nloc, nx); b.st[0] = nloc; b.st[1] = nx; }
        const unsigned old = xb_add(&bar[XB_XSUB(b.x)], 1u);
        const unsigned gen = old / nloc;
        if (old + 1u == (gen + 1u) * nloc) {
            __builtin_amdgcn_fence(__ATOMIC_RELEASE, "agent");
            asm volatile("s_waitcnt vmcnt(0)" ::: "memory");
            const unsigned og = xb_add(&bar[XB_TOP], 1u);
            const unsigned tg = og / nx;
            if (og + 1u == (tg + 1u) * nx) xb_add(&bar[XB_TOPGEN], 1u);
            else XB_SPIN(xb_ld(&bar[XB_TOPGEN]) == tg, bar);
            __builtin_amdgcn_fence(__ATOMIC_ACQUIRE, "agent");
            xb_add(&bar[XB_XGEN(b.x)], 1u);
            asm volatile("s_waitcnt vmcnt(0)" ::: "memory");
        } else {
            XB_SPIN(xb_ld(&bar[XB_XGEN(b.x)]) == gen, bar);
            __builtin_amdgcn_fence(__ATOMIC_ACQUIRE, "agent");
            asm volatile("s_waitcnt vmcnt(0)" ::: "memory");
        }
    }
    __syncthreads();
}

__global__ void __launch_bounds__(512, 2) fwd_megakernel(P p) {
    extern __shared__ __attribute__((aligned(16))) unsigned char shm_raw[];
    LAS unsigned char* lds = (LAS unsigned char*)shm_raw;
    cg::grid_group grid = cg::this_grid();
    const int G = gridDim.x, wg = blockIdx.x;
    unsigned char* ws = p.ws;
    float* H = (float*)(ws + OFF_H); bf16_t* HN = (bf16_t*)(ws + OFF_HN); bf16_t* WIN = (bf16_t*)(ws + OFF_WIN);
    const float* MODall = (const float*)(ws + OFF_MOD);

    volatile LAS unsigned* xbst = (volatile LAS unsigned*)(lds + 131072);
    if (threadIdx.x == 0) { xbst[0] = 0u; xbst[1] = 0u; xbst[2] = 0u; xbst[3] = 0u; }
    __syncthreads();
    const XcdBarrier xb = xcd_barrier_post((unsigned*)(ws + OFF_BAR), xbst);
    phase_mod(p, lds);
    grid.sync();
    for (int l = 0; l < DEPTH; ++l) {
        const float* MOD = MODall + (size_t)l * 2 * 6144;
        if (l == 0) phase_norm<true>(p, l, p.in[I_N1G] + l * 1024, 0, 1); else phase_norm<false>(p, l, p.in[I_N1G] + l * 1024, 0, 1);
        {
            const float* win = p.in[I_WIN] + (size_t)l * 1024 * IN_COLS;
            convert_T(win, IN_COLS, 1024, 0, 1920, WIN, (LAS float*)lds, wg, G);
            convert_T(win, IN_COLS, 1024, 1920, 3632, WIN + (size_t)2048 * 1024, (LAS float*)lds, (wg + 64) % G, G);
            convert_T(win, IN_COLS, 1024, 5552, 3072, WIN + (size_t)NMAIN * 1024, (LAS float*)lds, (wg + 128) % G, G);
            build_wl(p, l, wg, G);
        }
        xcd_barrier(xb);
        {
            pg8::Gemm g{HN, WIN, L, NMAIN, 1024}; pg8::StaticOrder S; S.init(L, NMAIN, G, wg);
            EpiInMain E{(bf16_t*)(ws + OFF_R), (bf16_t*)(ws + OFF_PG)};
            pg8::gemm_phase(lds, g, S, E);
        }
        xcd_barrier(xb);
#ifndef NO_PREP
        phase_prep(p, l, lds);
        xcd_barrier(xb);
        {
            pg8::Gemm g{(const bf16_t*)(ws + OFF_XL), (const bf16_t*)(ws + OFF_WL), L, 2560, 512}; pg8::StaticOrder S; S.init(L, 2560, G, wg);
            EpiLora E{(bf16_t*)(ws + OFF_B), (bf16_t*)(ws + OFF_RWG), p.in[I_RWW0] + (size_t)l * 1024, p.in[I_RWA0] + (size_t)l * 1024};
            pg8::gemm_phase(lds, g, S, E);
        }
#endif
        xcd_barrier(xb);
#ifndef NO_SCAN
        if (wg < 128) scan_rwkv(p, l, wg, lds);
        else if (wg < 160) scan_gla(p, l, wg - 128, lds);
        else if (wg < 224) scan_gdn(p, l, wg - 160, lds);
#endif
        xcd_barrier(xb);
#ifndef NO_POST
        phase_post(p, l, lds);
#endif
        xcd_barrier(xb);
        {
            convert_T(p.in[I_WBR] + (size_t)l * 3 * 512 * 1024, 1024, 512, 0, 1024, (bf16_t*)(ws + OFF_WBR), (LAS float*)lds, wg, G);
            convert_T(p.in[I_WBR] + (size_t)l * 3 * 512 * 1024 + (size_t)512 * 1024, 1024, 512, 0, 1024, (bf16_t*)(ws + OFF_WBR) + (size_t)1024 * 512, (LAS float*)lds, (wg + 128) % G, G);
            convert_T(p.in[I_WBR] + (size_t)l * 3 * 512 * 1024 + (size_t)2 * 512 * 1024, 1024, 512, 0, 1024, (bf16_t*)(ws + OFF_WBR) + (size_t)2 * 1024 * 512, (LAS float*)lds, wg, G);
            convert_T(p.in[I_WOUT] + (size_t)l * 1024 * 1024, 1024, 1024, 0, 1024, (bf16_t*)(ws + OFF_WOUT), (LAS float*)lds, wg, G);
            convert_T(p.in[I_W1] + (size_t)l * 1024 * 4096, 4096, 1024, 0, 4096, (bf16_t*)(ws + OFF_W1), (LAS float*)lds, wg, G);
            convert_T(p.in[I_W2] + (size_t)l * 4096 * 1024, 1024, 4096, 0, 1024, (bf16_t*)(ws + OFF_W2), (LAS float*)lds, wg, G);
            pg8::Gemm g{HN, WIN + (size_t)NMAIN * 1024, L, 3072, 1024}; pg8::StaticOrder S; S.init(L, 3072, G, wg);
            EpiGates E{(bf16_t*)(ws + OFF_B)};
            pg8::gemm_phase(lds, g, S, E);
        }
        xcd_barrier(xb);
        {
            const bf16_t* YC = (const bf16_t*)(ws + OFF_GDNC); const bf16_t* WBR = (const bf16_t*)(ws + OFF_WBR);
            pg8::StaticOrder S; S.init(L, 1024, G, wg);
            { pg8::Gemm g{YC, WBR, L, 1024, 512}; EpiBranch<0> E{(const bf16_t*)(ws + OFF_B), (float*)(ws + OFF_PG), HN}; pg8::gemm_phase(lds, g, S, E); }
            { pg8::Gemm g{YC + (size_t)L * 512, WBR + (size_t)1024 * 512, L, 1024, 512}; EpiBranch<1> E{(const bf16_t*)(ws + OFF_B), (float*)(ws + OFF_PG), HN}; pg8::gemm_phase(lds, g, S, E); }
            { pg8::Gemm g{YC + (size_t)2 * L * 512, WBR + (size_t)2 * 1024 * 512, L, 1024, 512}; EpiBranch<2> E{(const bf16_t*)(ws + OFF_B), (float*)(ws + OFF_PG), HN}; pg8::gemm_phase(lds, g, S, E); }
        }
        xcd_barrier(xb);
        {
            pg8::Gemm g{HN, (const bf16_t*)(ws + OFF_WOUT), L, 1024, 1024}; pg8::StaticOrder S; S.init(L, 1024, G, wg);
            EpiResid E{H, MOD + 2 * 1024, MOD + 6144 + 2 * 1024};
            pg8::gemm_phase(lds, g, S, E);
        }
        xcd_barrier(xb);
        phase_norm<false>(p, l, p.in[I_N2G] + l * 1024, 3, 4);
        xcd_barrier(xb);
        {
            pg8::Gemm g{HN, (const bf16_t*)(ws + OFF_W1), L, 4096, 1024}; pg8::StaticOrder S; S.init(L, 4096, G, wg);
            EpiMlp1 E{(bf16_t*)(ws + OFF_B)};
            pg8::gemm_phase(lds, g, S, E);
        }
        xcd_barrier(xb);
        {
            pg8::Gemm g{(const bf16_t*)(ws + OFF_B), (const bf16_t*)(ws + OFF_W2), L, 1024, 4096}; pg8::StaticOrder S; S.init(L, 1024, G, wg);
            EpiResid E{H, MOD + 5 * 1024, MOD + 6144 + 5 * 1024};
            pg8::gemm_phase(lds, g, S, E);
        }
        xcd_barrier(xb);
    }
    phase_final(p);
}

extern "C" void kernel_launch(void* const* d_in, const int* in_sizes, int n_in, void* d_out, int out_size, void* d_ws, size_t ws_size, hipStream_t stream) {
    static int grid_blocks = 0;
    if (n_in != 32 || ws_size < WS_END || out_size != NLAT * DM) {
        fprintf(stderr, "kernel_launch: unexpected shapes / workspace (n_in %d, ws %zu need %zu, out %d)\n", n_in, ws_size, (size_t)WS_END, out_size);
        hipMemsetAsync(d_out, 0xFF, (size_t)out_size * 4, stream);
        return;
    }
    if (!grid_blocks) {
        int dev = 0, cus = 0, per_cu = 0;
        hipGetDevice(&dev);
        hipDeviceGetAttribute(&cus, hipDeviceAttributeMultiprocessorCount, dev);
        hipFuncSetAttribute((const void*)fwd_megakernel, hipFuncAttributeMaxDynamicSharedMemorySize, LDS_BYTES);
        hipOccupancyMaxActiveBlocksPerMultiprocessor(&per_cu, (const void*)fwd_megakernel, 512, LDS_BYTES);
        if (per_cu < 1) per_cu = 1;
        grid_blocks = cus * 1;
        (void)hipGetLastError();
    }
    P p{};
    for (int i = 0; i < 32; ++i) p.in[i] = (const float*)d_in[i];
    p.out = (float*)d_out; p.ws = (unsigned char*)d_ws;
    (void)hipMemsetAsync((unsigned char*)d_ws + OFF_BAR, 0, 16384, stream);
    void* args[] = {&p};
    hipError_t e = hipLaunchCooperativeKernel((const void*)fwd_megakernel, dim3(grid_blocks), dim3(512), args, LDS_BYTES, stream);
    if (e != hipSuccess) fprintf(stderr, "cooperative launch failed: %s (grid %d)\n", hipGetErrorString(e), grid_blocks);
}
```

```cpp
#include <hip/hip_runtime.h>
#include <hip/hip_cooperative_groups.h>
#include <cstdio>
#include <cstdint>
namespace cg = cooperative_groups;

#define LAS __attribute__((address_space(3)))
typedef unsigned short bf16_t;
typedef short bf16x8 __attribute__((ext_vector_type(8)));
typedef float f32x4 __attribute__((ext_vector_type(4)));
typedef float f32x2 __attribute__((ext_vector_type(2)));
typedef unsigned u32x4 __attribute__((ext_vector_type(4)));
typedef unsigned u32x2 __attribute__((ext_vector_type(2)));

constexpr int L = 16640, NCTX = 256, NLAT = 16384, DM = 1024, BW = 512, DEPTH = 4;
constexpr int IN_COLS = 8624;
constexpr int NMAIN = 5888;
constexpr int NWIN = 8960;
constexpr int R_LD = 2048, PG_LD = 3840;
constexpr int GLA_Q = 0, GLA_K = 256, GLA_V = 512, GLA_OG = 1024, GLA_AL = 1536;
constexpr int GDN_QKV = 1568, GDN_ZG = 3104, GDN_A = 3616, GDN_B = 3624;
constexpr int YRW_COL = 1568;

constexpr size_t al256(size_t x) { return (x + 255) & ~(size_t)255; }
constexpr size_t OFF_MOD = 0;
constexpr size_t OFF_H = al256(OFF_MOD + (size_t)4 * 2 * 6144 * 4);
constexpr size_t OFF_HN = OFF_H + (size_t)L * 1024 * 4;
constexpr size_t OFF_WIN = OFF_HN + (size_t)L * 1024 * 2;
constexpr size_t OFF_R = OFF_WIN + (size_t)NWIN * 1024 * 2;
constexpr size_t OFF_PG = OFF_R + (size_t)L * R_LD * 2;
constexpr size_t OFF_B = OFF_PG + (size_t)L * PG_LD * 2;
constexpr size_t OFF_RWG = OFF_B + (size_t)L * 4096 * 2;
constexpr size_t OFF_BONUS = OFF_RWG + (size_t)L * 512 * 2;
constexpr size_t OFF_GLAD = OFF_BONUS + (size_t)L * 8 * 4;
constexpr size_t OFF_GDNC = OFF_GLAD + (size_t)L * 512 * 2;
constexpr size_t OFF_GDNGB = OFF_GDNC + (size_t)L * 1536 * 2;
constexpr size_t OFF_XL = OFF_GDNGB + (size_t)L * 16 * 4;
constexpr size_t OFF_WL = OFF_XL + (size_t)L * 512 * 2;
constexpr size_t OFF_BAR = OFF_WL + (size_t)2560 * 512 * 2;
constexpr size_t WS_END = OFF_BAR + 16384;
constexpr size_t OFF_WBR = OFF_R;
constexpr size_t OFF_WOUT = OFF_WBR + (size_t)3 * 1024 * 512 * 2;
constexpr size_t OFF_W1 = OFF_WOUT + (size_t)1024 * 1024 * 2;
constexpr size_t OFF_W2 = OFF_W1 + (size_t)4096 * 1024 * 2;

constexpr int LDS_BYTES = 131072 + 16;

struct P { const float* in[32]; float* out; unsigned char* ws; };
enum { I_X = 0, I_C, I_CTX, I_CCTX, I_WMOD, I_BMOD, I_N1G, I_WIN, I_RWMU, I_RWW0, I_RWW2, I_RWA0, I_RWA2, I_RWG2, I_RWKK, I_RWKA, I_RWRK,
       I_RWLNW, I_RWLNB, I_GLAA2, I_GLAAB, I_GLANG, I_GDNCONV, I_GDNALOG, I_GDNDT, I_GDNNG, I_WBR, I_WOUT, I_N2G, I_W1, I_W2, I_FINALG };

__device__ __forceinline__ float bf2f(bf16_t b) { return __uint_as_float(((unsigned)b) << 16); }
__device__ __forceinline__ unsigned pk2(float lo, float hi) { unsigned r; asm("v_cvt_pk_bf16_f32 %0, %1, %2" : "=v"(r) : "v"(lo), "v"(hi)); return r; }
__device__ __forceinline__ bf16_t f2bf(float f) { return (bf16_t)(pk2(f, 0.f) & 0xffffu); }
__device__ __forceinline__ float sigmoid_(float x) { return 1.f / (1.f + __expf(-x)); }
__device__ __forceinline__ float silu_(float x) { return x / (1.f + __expf(-x)); }
__device__ __forceinline__ float softplus_(float x) { return fmaxf(x, 0.f) + log1pf(__expf(-fabsf(x))); }
template <int CTRL> __device__ __forceinline__ float dpp_(float x) { return __int_as_float(__builtin_amdgcn_update_dpp(0, __float_as_int(x), CTRL, 0xF, 0xF, true)); }
__device__ __forceinline__ float reduce8(float x) { x += dpp_<0xB1>(x); x += dpp_<0x4E>(x); x += dpp_<0x141>(x); return x; }
__device__ __forceinline__ float reduce16(float x) { x = reduce8(x); x += dpp_<0x140>(x); return x; }
__device__ __forceinline__ float wave_sum(float v) {
    v = reduce16(v);
    const float r0 = __int_as_float(__builtin_amdgcn_readlane(__float_as_int(v), 0)), r1 = __int_as_float(__builtin_amdgcn_readlane(__float_as_int(v), 16));
    const float r2 = __int_as_float(__builtin_amdgcn_readlane(__float_as_int(v), 32)), r3 = __int_as_float(__builtin_amdgcn_readlane(__float_as_int(v), 48));
    return (r0 + r1) + (r2 + r3);
}

__device__ __forceinline__ int otid() { int t = threadIdx.x; asm volatile("" : "+v"(t)); return t; }
__device__ __forceinline__ int osgpr(int x) { asm volatile("" : "+s"(x)); return x; }
namespace pg8 {
constexpr int BM = 256, BK = 64, HALF = 128, HTB = HALF * BK * 2, STAGE_BYTES = 8 * HTB, NXCD = 8, WGM = 8;
__host__ __device__ __forceinline__ int lds_byte(int r, int c) { const int st = (r >> 4) * 2 + (c >> 5), rr = r & 15, cc = c & 31, ob = rr * 64 + cc * 2; return st * 1024 + (ob ^ (((ob >> 9) & 1) << 5)); }
__host__ __device__ __forceinline__ void stage_rc(int b, int& R, int& C) { const int st = b / 1024, sb = b % 1024, swz = sb ^ (((sb >> 9) & 1) << 5); R = (st >> 1) * 16 + swz / 64; C = (st & 1) * 32 + (swz % 64) / 2; }
struct Unit { int pm, pn, k0; };
struct Gemm { const bf16_t* A; const bf16_t* Bt; int M, N, K, nt; };
struct StaticOrder {
    int nM, nN, nwg, G, c, pm0;
    __host__ __device__ void init(int M, int N, int G_, int c_, int pm0_ = 0) { nM = M / BM; nN = N / BM; nwg = nM * nN; G = G_; c = c_; pm0 = pm0_; }
    __host__ __device__ bool next(int i, Unit& u) const {
        const long Lx = (long)i * G + c; if (Lx >= nwg) return false;
        int wgid = (int)Lx; { const int q = nwg / NXCD, r = nwg % NXCD, xcd = wgid % NXCD, off = wgid / NXCD; wgid = (xcd < r ? xcd * (q + 1) : r * (q + 1) + (xcd - r) * q) + off; }
        const int nig = WGM * nN, gid = wgid / nig, fm = gid * WGM, gsz = (nM - fm) < WGM ? (nM - fm) : WGM;
        u.pm = pm0 + fm + ((wgid % nig) % gsz); u.pn = (wgid % nig) / gsz; u.k0 = 0; return true;
    }
};
struct SplitOrder {
    int nN, nunits, G, c, nt;
    __host__ __device__ void init(int N, int K, int nt_, int G_, int c_) { nN = N / BM; nt = nt_; nunits = nN * (K / BK / nt_); G = G_; c = c_; }
    __host__ __device__ bool next(int i, Unit& u) const {
        const int idx = i * G + c; if (idx >= nunits) return false;
        u.pm = 0; u.pn = idx % nN; u.k0 = (idx / nN) * nt; return true;
    }
};
template <class Epi, class Ord>
__device__ __forceinline__ void gemm_phase(LAS unsigned char* lds, const Gemm g, const Ord& S, const Epi& E) {
#ifdef NO_GEMM
    return;
#endif
    const int tid = otid(), wid = __builtin_amdgcn_readfirstlane(tid >> 6), lane = tid & 63, wr = wid >> 2, wc = wid & 3, fr = lane & 15, fq = lane >> 4;
    const int K = g.K, nt = g.nt;
    unsigned voffA[2];
#pragma unroll
    for (int i = 0; i < 2; ++i) { int R, C; stage_rc(tid * 16 + i * 8192, R, C); voffA[i] = (unsigned)(R * K + C) * 2u; }
    const size_t kstep = (size_t)(BK * 2);
    const size_t hstep = (size_t)HALF * K * 2;
    const size_t tstep = 2 * hstep;
    const unsigned ldsw = (unsigned)wid * 1024u;
    const int aoff = lds_byte(wr * 64 + fr, fq * 8), boff = lds_byte(wc * 32 + fr, fq * 8);
#define PG8_SA(b, h) (((b) * 2 + (h)) * HTB)
#define PG8_SB(b, h) ((4 + (b) * 2 + (h)) * HTB)
#define PG8_STAGE(bufoff, gbase, voff) do { _Pragma("unroll") for (int _i = 0; _i < 2; ++_i) \
        __builtin_amdgcn_global_load_lds((const unsigned*)((const char*)(gbase) + (voff)[_i]), (LAS unsigned*)(lds + (bufoff) + ldsw + _i * 8192), 16, 0, 0); } while (0)
#define PG8_LDA(dst, b, h) do { _Pragma("unroll") for (int m = 0; m < 4; ++m) _Pragma("unroll") for (int k = 0; k < 2; ++k) dst[m][k] = *(const LAS bf16x8*)(lds + PG8_SA(b, h) + aoff + m * 2048 + k * 1024); } while (0)
#define PG8_LDB(dst, b, h) do { _Pragma("unroll") for (int n = 0; n < 2; ++n) _Pragma("unroll") for (int k = 0; k < 2; ++k) dst[n][k] = *(const LAS bf16x8*)(lds + PG8_SB(b, h) + boff + n * 2048 + k * 1024); } while (0)
#define PG8_MMA(ai, bj, At, Bt) do { __builtin_amdgcn_s_setprio(1); _Pragma("unroll") for (int m = 0; m < 4; ++m) _Pragma("unroll") for (int n = 0; n < 2; ++n) _Pragma("unroll") for (int k = 0; k < 2; ++k) \
        acc[ai][bj][m][n] = __builtin_amdgcn_mfma_f32_16x16x32_bf16(Bt[n][k], At[m][k], acc[ai][bj][m][n], 0, 0, 0); __builtin_amdgcn_s_setprio(0); } while (0)
#define PG8_WAIT_V(n) asm volatile("s_waitcnt vmcnt(" #n ")" ::: "memory")
#define PG8_WAIT_L(n) asm volatile("s_waitcnt lgkmcnt(" #n ")" ::: "memory")
#define PG8_BAR __builtin_amdgcn_s_barrier()
#define PG8_SCHED __builtin_amdgcn_sched_barrier(0)
    Unit cur, nxt; int ui = 0;
    if (!S.next(0, cur)) return;
    f32x4 acc[2][2][4][2];
#pragma unroll
    for (int a = 0; a < 2; ++a)
#pragma unroll
        for (int b = 0; b < 2; ++b)
#pragma unroll
            for (int m = 0; m < 4; ++m)
#pragma unroll
                for (int n = 0; n < 2; ++n) acc[a][b][m][n] = (f32x4){0.f, 0.f, 0.f, 0.f};
    bf16x8 At[4][2], B0[2][2], B1[2][2];
    const size_t kstep0 = (size_t)(BK * 2);
    const char* cA = (const char*)g.A + (size_t)cur.pm * tstep + (size_t)cur.k0 * kstep0; const char* cB = (const char*)g.Bt + (size_t)cur.pn * tstep + (size_t)cur.k0 * kstep0;
    PG8_STAGE(PG8_SB(0, 0), cB, voffA); PG8_STAGE(PG8_SA(0, 0), cA, voffA); PG8_STAGE(PG8_SB(0, 1), cB + hstep, voffA); PG8_STAGE(PG8_SA(0, 1), cA + hstep, voffA);
    if (wr == 1) PG8_BAR;
    PG8_WAIT_V(4); PG8_BAR;
    PG8_STAGE(PG8_SB(1, 0), cB + kstep, voffA); PG8_STAGE(PG8_SA(1, 0), cA + kstep, voffA); PG8_STAGE(PG8_SB(1, 1), cB + hstep + kstep, voffA);
    PG8_WAIT_V(6); PG8_BAR;
    for (;;) {
        const bool has_next = S.next(ui + 1, nxt);
        const char* nA = has_next ? (const char*)g.A + (size_t)nxt.pm * tstep + (size_t)nxt.k0 * kstep0 : cA; const char* nB = has_next ? (const char*)g.Bt + (size_t)nxt.pn * tstep + (size_t)nxt.k0 * kstep0 : cB;
        for (int t = 0; t < nt; t += 2) {
            const bool last = (t == nt - 2);
            const char* a1 = cA + (size_t)(t + 1) * kstep;
            const char* a2 = last ? nA : cA + (size_t)(t + 2) * kstep; const char* b2 = last ? nB : cB + (size_t)(t + 2) * kstep;
            const char* a3 = a2 + kstep; const char* b3 = b2 + kstep;
            PG8_LDB(B0, 0, 0); PG8_SCHED; PG8_LDA(At, 0, 0); PG8_STAGE(PG8_SA(1, 1), a1 + hstep, voffA);
            PG8_WAIT_L(8); PG8_BAR; PG8_WAIT_L(0); PG8_MMA(0, 0, At, B0); PG8_BAR; PG8_SCHED;
            PG8_LDB(B1, 0, 1); PG8_STAGE(PG8_SB(0, 0), b2, voffA);
            PG8_BAR; PG8_WAIT_L(0); PG8_MMA(0, 1, At, B1); PG8_BAR;
            PG8_LDA(At, 0, 1); PG8_STAGE(PG8_SA(0, 0), a2, voffA);
            PG8_BAR; PG8_WAIT_L(0); PG8_MMA(1, 0, At, B0); PG8_BAR; PG8_SCHED;
            PG8_STAGE(PG8_SB(0, 1), b2 + hstep, voffA);
            PG8_WAIT_V(6); PG8_BAR; PG8_MMA(1, 1, At, B1); PG8_BAR;
            PG8_LDB(B0, 1, 0); PG8_SCHED; PG8_LDA(At, 1, 0); PG8_STAGE(PG8_SA(0, 1), a2 + hstep, voffA);
            PG8_WAIT_L(8); PG8_BAR; PG8_WAIT_L(0); PG8_MMA(0, 0, At, B0); PG8_BAR; PG8_SCHED;
            PG8_LDB(B1, 1, 1); PG8_STAGE(PG8_SB(1, 0), b3, voffA);
            PG8_BAR; PG8_WAIT_L(0); PG8_MMA(0, 1, At, B1); PG8_BAR;
            PG8_LDA(At, 1, 1); PG8_STAGE(PG8_SA(1, 0), a3, voffA);
            PG8_BAR; PG8_WAIT_L(0); PG8_MMA(1, 0, At, B0); PG8_BAR; PG8_SCHED;
            PG8_STAGE(PG8_SB(1, 1), b3 + hstep, voffA);
            PG8_WAIT_V(6); PG8_BAR; PG8_MMA(1, 1, At, B1); PG8_BAR;
        }
        E(acc, cur, wr, wc, fr, fq);
        if (!has_next) break;
#pragma unroll
        for (int a = 0; a < 2; ++a)
#pragma unroll
            for (int b = 0; b < 2; ++b)
#pragma unroll
                for (int m = 0; m < 4; ++m)
#pragma unroll
                    for (int n = 0; n < 2; ++n) acc[a][b][m][n] = (f32x4){0.f, 0.f, 0.f, 0.f};
        cur = nxt; cA = nA; cB = nB; ++ui;
    }
    PG8_WAIT_V(0);
    if (wr == 0) PG8_BAR;
    PG8_BAR;
#undef PG8_SA
#undef PG8_SB
#undef PG8_STAGE
#undef PG8_LDA
#undef PG8_LDB
#undef PG8_MMA
#undef PG8_WAIT_V
#undef PG8_WAIT_L
#undef PG8_BAR
#undef PG8_SCHED
}
}
using pg8::Unit;

#define EPI_LOOP_ROWS for (int ai = 0; ai < 2; ++ai) for (int m = 0; m < 4; ++m)
#define EPI_LOOP_COLS for (int bj = 0; bj < 2; ++bj) for (int n = 0; n < 2; ++n)
struct EpiInMain {
    bf16_t* R; bf16_t* PG;
    __device__ __forceinline__ void operator()(const f32x4 (&acc)[2][2][4][2], const Unit& u, int wr, int wc, int fr, int fq) const {
        bf16_t* dst; int ld, c0;
        if (u.pn < 8) { dst = R; ld = R_LD; c0 = u.pn * 256; } else { dst = PG; ld = PG_LD; c0 = (u.pn - 8) * 256; }
        const int row0 = u.pm * 256 + wr * 64 + fr, col0 = c0 + wc * 32 + 4 * fq;
#pragma unroll
        EPI_LOOP_ROWS { bf16_t* rowp = dst + (size_t)(row0 + ai * 128 + m * 16) * ld + col0;
#pragma unroll
            EPI_LOOP_COLS { const f32x4 v = acc[ai][bj][m][n]; *(u32x2*)(rowp + bj * 128 + n * 16) = (u32x2){pk2(v[0], v[1]), pk2(v[2], v[3])}; } }
    }
};
struct EpiGates {
    bf16_t* G;
    __device__ __forceinline__ void operator()(const f32x4 (&acc)[2][2][4][2], const Unit& u, int wr, int wc, int fr, int fq) const {
        const int row0 = u.pm * 256 + wr * 64 + fr, col0 = u.pn * 256 + wc * 32 + 4 * fq;
#pragma unroll
        EPI_LOOP_ROWS { bf16_t* rowp = G + (size_t)(row0 + ai * 128 + m * 16) * 3072 + col0;
#pragma unroll
            EPI_LOOP_COLS { const f32x4 v = acc[ai][bj][m][n];
                *(u32x2*)(rowp + bj * 128 + n * 16) = (u32x2){pk2(sigmoid_(v[0]), sigmoid_(v[1])), pk2(sigmoid_(v[2]), sigmoid_(v[3]))}; } }
    }
};
template <int GI> struct EpiBranch {
    const bf16_t* G; float* MG; bf16_t* MB;
    __device__ __forceinline__ void operator()(const f32x4 (&acc)[2][2][4][2], const Unit& u, int wr, int wc, int fr, int fq) const {
        const int row0 = u.pm * 256 + wr * 64 + fr, col0 = u.pn * 256 + wc * 32 + 4 * fq;
#pragma unroll
        EPI_LOOP_ROWS { const size_t row = (size_t)(row0 + ai * 128 + m * 16);
#pragma unroll
            EPI_LOOP_COLS { const int col = col0 + bj * 128 + n * 16; const f32x4 v = acc[ai][bj][m][n];
                const u32x2 gq = *(const u32x2*)(G + row * 3072 + GI * 1024 + col);
                f32x4 gv = (f32x4){__uint_as_float(gq[0] << 16), __uint_as_float(gq[0] & 0xffff0000u), __uint_as_float(gq[1] << 16), __uint_as_float(gq[1] & 0xffff0000u)};
                f32x4 r = v * gv;
                if (GI > 0) r += *(const f32x4*)(MG + row * 1024 + col);
                if (GI < 2) *(f32x4*)(MG + row * 1024 + col) = r;
                else *(u32x2*)(MB + row * 1024 + col) = (u32x2){pk2(r[0], r[1]), pk2(r[2], r[3])}; } }
    }
};
struct EpiResid {
    float* H; const float* gate_lat; const float* gate_ctx;
    __device__ __forceinline__ void operator()(const f32x4 (&acc)[2][2][4][2], const Unit& u, int wr, int wc, int fr, int fq) const {
        const int row0 = u.pm * 256 + wr * 64 + fr, col0 = u.pn * 256 + wc * 32 + 4 * fq;
        const float* gp = (u.pm == 0) ? gate_ctx : gate_lat;
        f32x4 gv[2][2];
#pragma unroll
        EPI_LOOP_COLS gv[bj][n] = *(const f32x4*)(gp + col0 + bj * 128 + n * 16);
#pragma unroll
        EPI_LOOP_ROWS { float* rowp = H + (size_t)(row0 + ai * 128 + m * 16) * 1024 + col0;
#pragma unroll
            EPI_LOOP_COLS { f32x4* q = (f32x4*)(rowp + bj * 128 + n * 16); *q = *q + acc[ai][bj][m][n] * gv[bj][n]; } }
    }
};
struct EpiLora {
    bf16_t* B; bf16_t* RWG; const float* w0; const float* a0;
    __device__ __forceinline__ void operator()(const f32x4 (&acc)[2][2][4][2], const Unit& u, int wr, int wc, int fr, int fq) const {
        const int row0 = u.pm * 256 + wr * 64 + fr, blk = u.pn >> 1, cbase = (u.pn & 1) * 256 + wc * 32 + 4 * fq;
        f32x4 bv[2][2];
#pragma unroll
        EPI_LOOP_COLS { const int cc = cbase + bj * 128 + n * 16;
            bv[bj][n] = blk < 2 ? *(const f32x4*)(w0 + blk * 512 + cc) : (blk < 4 ? *(const f32x4*)(a0 + (blk - 2) * 512 + cc) : (f32x4){0.f, 0.f, 0.f, 0.f}); }
        bf16_t* dst; int ld;
        if (blk < 2) { dst = B + 3072 + blk * 512; ld = 4096; } else if (blk < 4) { dst = B + 2048 + (blk - 2) * 512; ld = 4096; } else { dst = RWG; ld = 512; }
#pragma unroll
        EPI_LOOP_ROWS { bf16_t* rowp = dst + (size_t)(row0 + ai * 128 + m * 16) * ld + cbase;
#pragma unroll
            EPI_LOOP_COLS { f32x4 v = acc[ai][bj][m][n] + bv[bj][n];
                if (blk < 2) {
#pragma unroll
                    for (int j = 0; j < 4; ++j) { const float x = -v[j]; const float sp = fmaxf(x, 0.f) + __logf(1.f + __expf(-fabsf(x))); v[j] = 1.f - __expf(-__expf(-sp - 0.5f)); }
                } else if (blk < 4) {
#pragma unroll
                    for (int j = 0; j < 4; ++j) v[j] = sigmoid_(v[j]);
                }
                *(u32x2*)(rowp + bj * 128 + n * 16) = (u32x2){pk2(v[0], v[1]), pk2(v[2], v[3])}; } }
    }
};
struct EpiResidAtomic {
    float* H; const float* gate_ctx;
    __device__ __forceinline__ void operator()(const f32x4 (&acc)[2][2][4][2], const Unit& u, int wr, int wc, int fr, int fq) const {
        const int row0 = u.pm * 256 + wr * 64 + fr, col0 = u.pn * 256 + wc * 32 + 4 * fq;
        const float* gp = gate_ctx + col0;
#pragma unroll
        EPI_LOOP_ROWS { float* rowp = H + (size_t)(row0 + ai * 128 + m * 16) * 1024 + col0;
#pragma unroll
            EPI_LOOP_COLS { const f32x4 v = acc[ai][bj][m][n] * *(const f32x4*)(gp + bj * 128 + n * 16); float* q = rowp + bj * 128 + n * 16;
                unsafeAtomicAdd(q, v[0]); unsafeAtomicAdd(q + 1, v[1]); unsafeAtomicAdd(q + 2, v[2]); unsafeAtomicAdd(q + 3, v[3]); }
            asm volatile("" ::: "memory"); }
    }
};
struct EpiMlp1 {
    bf16_t* U;
    __device__ __forceinline__ void operator()(const f32x4 (&acc)[2][2][4][2], const Unit& u, int wr, int wc, int fr, int fq) const {
        const int row0 = u.pm * 256 + wr * 64 + fr, col0 = u.pn * 256 + wc * 32 + 4 * fq;
#pragma unroll
        EPI_LOOP_ROWS { bf16_t* rowp = U + (size_t)(row0 + ai * 128 + m * 16) * 4096 + col0;
#pragma unroll
            EPI_LOOP_COLS { f32x4 v = acc[ai][bj][m][n];
#pragma unroll
                for (int j = 0; j < 4; ++j) { const float t = fmaxf(v[j], 0.f); v[j] = t * t; }
                *(u32x2*)(rowp + bj * 128 + n * 16) = (u32x2){pk2(v[0], v[1]), pk2(v[2], v[3])}; } }
    }
};

__device__ __forceinline__ void convert_T(const float* src, int ld, int K, int n0, int ncols, bf16_t* dst, LAS float* tile, int wg, int nwg) {
    const int ntn = (ncols + 63) >> 6, ntk = K >> 6, tid = otid();
    for (int t = wg; t < ntn * ntk; t += nwg) {
        const int tn = t / ntk, tk = t - tn * ntk, k0 = tk * 64, nb = tn * 64;
#pragma unroll
        for (int i = 0; i < 2; ++i) { const int idx = tid + i * 512, kk = idx >> 4, n4 = (idx & 15) * 4;
            f32x4 v = (f32x4){0.f, 0.f, 0.f, 0.f};
            if (nb + n4 < ncols) v = *(const f32x4*)(src + (size_t)(k0 + kk) * ld + n0 + nb + n4);
            tile[kk * 65 + n4 + 0] = v[0]; tile[kk * 65 + n4 + 1] = v[1]; tile[kk * 65 + n4 + 2] = v[2]; tile[kk * 65 + n4 + 3] = v[3]; }
        __syncthreads();
        { const int nn = tid >> 3, k8 = (tid & 7) * 8;
          if (nb + nn < ncols) { const LAS float* s = tile + k8 * 65 + nn;
              u32x4 o; o[0] = pk2(s[0], s[65]); o[1] = pk2(s[130], s[195]); o[2] = pk2(s[260], s[325]); o[3] = pk2(s[390], s[455]);
              *(u32x4*)(dst + (size_t)(nb + nn) * K + k0 + k8) = o; } }
        __syncthreads();
    }
}

__device__ __forceinline__ void phase_mod(const P& p, LAS unsigned char* lds) {
    const float* c = p.in[I_C]; const float* cc = p.in[I_CCTX]; const float* wm = p.in[I_WMOD]; const float* bm = p.in[I_BMOD];
    float* MOD = (float*)(p.ws + OFF_MOD);
    LAS float* red = (LAS float*)lds;
    const int tid = otid();
    for (int blk = blockIdx.x; blk < 256; blk += gridDim.x) {
        const int l = blk >> 6, col0 = (blk & 63) * 96;
        if (tid < 384) {
            const int cgp = tid % 24, ks = tid / 24;
            f32x4 a0 = (f32x4){0.f, 0.f, 0.f, 0.f}, a1 = a0;
            const float* w = wm + (size_t)l * 1024 * 6144 + col0 + cgp * 4;
#pragma unroll 8
            for (int k = ks * 64; k < ks * 64 + 64; ++k) {
                const f32x4 wv = *(const f32x4*)(w + (size_t)k * 6144);
                const float s0 = silu_(c[k]), s1 = silu_(cc[k]);
                a0 += wv * s0; a1 += wv * s1;
            }
            LAS f32x4* r4 = (LAS f32x4*)red;
            r4[(ks * 24 + cgp) * 2 + 0] = a0; r4[(ks * 24 + cgp) * 2 + 1] = a1;
        }
        __syncthreads();
        if (tid < 192) {
            const int col = tid % 96, s = tid / 96;
            float sum = 0.f;
#pragma unroll
            for (int k2 = 0; k2 < 16; ++k2) sum += red[((k2 * 24 + (col >> 2)) * 2 + s) * 4 + (col & 3)];
            MOD[((size_t)l * 2 + s) * 6144 + col0 + col] = sum + bm[l * 6144 + col0 + col];
        }
        __syncthreads();
    }
}

template <bool FROM_INPUT>
__device__ __forceinline__ void phase_norm(const P& p, int l, const float* gamma, int shift_idx, int scale_idx) {
    float* H = (float*)(p.ws + OFF_H); bf16_t* HN = (bf16_t*)(p.ws + OFF_HN);
    const float* MOD = (const float*)(p.ws + OFF_MOD) + (size_t)l * 2 * 6144;
    const int tid_ = otid(); const int wave = tid_ >> 6, lane = tid_ & 63;
    for (int row = blockIdx.x * 8 + wave; row < L; row += gridDim.x * 8) {
        const float* src = FROM_INPUT ? (row < NCTX ? p.in[I_CTX] + (size_t)row * 1024 : p.in[I_X] + (size_t)(row - NCTX) * 1024) : H + (size_t)row * 1024;
        f32x4 v[4]; float ss = 0.f;
#pragma unroll
        for (int j = 0; j < 4; ++j) { v[j] = *(const f32x4*)(src + j * 256 + lane * 4); ss += (v[j][0] * v[j][0] + v[j][1] * v[j][1]) + (v[j][2] * v[j][2] + v[j][3] * v[j][3]); }
        ss = wave_sum(ss);
        const float rstd = rsqrtf(ss * (1.f / 1024.f) + 1e-6f);
        const float* m = MOD + (row < NCTX ? 6144 : 0);
#pragma unroll
        for (int j = 0; j < 4; ++j) { const int col = j * 256 + lane * 4;
            const f32x4 g = *(const f32x4*)(gamma + col), sh = *(const f32x4*)(m + shift_idx * 1024 + col), sc = *(const f32x4*)(m + scale_idx * 1024 + col);
            const f32x4 o = v[j] * rstd * g * (sc + 1.f) + sh;
            *(u32x2*)(HN + (size_t)row * 1024 + col) = (u32x2){pk2(o[0], o[1]), pk2(o[2], o[3])};
            if (FROM_INPUT) *(f32x4*)(H + (size_t)row * 1024 + col) = v[j]; }
    }
}

constexpr int TT = 13;
__device__ __forceinline__ void phase_prep(const P& p, int l, LAS unsigned char* lds) {
    const bf16_t* R = (const bf16_t*)(p.ws + OFF_R); const bf16_t* PG = (const bf16_t*)(p.ws + OFF_PG);
    bf16_t* B = (bf16_t*)(p.ws + OFF_B); bf16_t* XL = (bf16_t*)(p.ws + OFF_XL);
    bf16_t* GLAD = (bf16_t*)(p.ws + OFF_GLAD); bf16_t* GDNC = (bf16_t*)(p.ws + OFF_GDNC); float* GDNGB = (float*)(p.ws + OFF_GDNGB);
    const float* mu = p.in[I_RWMU] + (size_t)l * 2 * 1920;
    const float* kkw = p.in[I_RWKK] + l * 512;
    const float* ga2 = p.in[I_GLAA2] + (size_t)l * 2 * 16 * 256; const float* gab = p.in[I_GLAAB] + l * 512;
    const float* cw = p.in[I_GDNCONV] + (size_t)l * 5 * 1536; const float* alog = p.in[I_GDNALOG] + l * 8; const float* dtb = p.in[I_GDNDT] + l * 8;
    LAS float* gal = (LAS float*)lds;
    LAS float* red = gal + TT * 32;
    const int tid = otid(), wave = tid >> 6;
    const int c = tid;
    const int gz = tid >> 8, gk = tid & 255;
    for (int tile = blockIdx.x; tile < L / TT; tile += gridDim.x) {
        const int t0 = tile * TT;
        if (tid < TT * 32) { const int tt = tid >> 5, e = tid & 31; gal[tt * 32 + e] = bf2f(PG[(size_t)(t0 + tt) * PG_LD + GLA_AL + e]); }
        {
            float xr[TT + 2], xk[TT + 2], xv[TT + 2], xe[TT + 2];
#pragma unroll
            for (int i = 0; i < TT + 2; ++i) { const int rr = t0 - 1 + i;
                if (rr >= 0 && rr < L) { const bf16_t* rp = R + (size_t)rr * R_LD + c; xr[i] = bf2f(rp[0]); xk[i] = bf2f(rp[512]); xv[i] = bf2f(rp[1024]); xe[i] = (c < 384) ? bf2f(rp[1536]) : 0.f; }
                else { xr[i] = 0.f; xk[i] = 0.f; xv[i] = 0.f; xe[i] = 0.f; } }
            const float mr0 = mu[c], mr1 = mu[1920 + c], mk0 = mu[512 + c], mk1 = mu[1920 + 512 + c], mv0 = mu[1024 + c], mv1 = mu[1920 + 1024 + c];
            const float me0 = (c < 384) ? mu[1536 + c] : 0.f, me1 = (c < 384) ? mu[1920 + 1536 + c] : 0.f;
            const float kkc = kkw[c];
#pragma unroll
            for (int tt = 0; tt < TT; ++tt) {
                const int t = t0 + tt;
                const float hp = (t != 0 && t != NCTX) ? 1.f : 0.f, hn = (t != NCTX - 1 && t != L - 1) ? 1.f : 0.f;
                const float r = mr0 * hp * xr[tt] + (1.f - mr0 - mr1) * xr[tt + 1] + mr1 * hn * xr[tt + 2];
                const float k = mk0 * hp * xk[tt] + (1.f - mk0 - mk1) * xk[tt + 1] + mk1 * hn * xk[tt + 2];
                const float v = mv0 * hp * xv[tt] + (1.f - mv0 - mv1) * xv[tt + 1] + mv1 * hn * xv[tt + 2];
                float e = me0 * hp * xe[tt] + (1.f - me0 - me1) * xe[tt + 1] + me1 * hn * xe[tt + 2];
                if (c < 128) e = tanhf(e); else if (c >= 256 && c < 384) e = sigmoid_(e); else if (c >= 384) e = 0.f;
                const float kr = k * kkc;
                const float ssq = wave_sum(kr * kr);
                bf16_t* bp = B + (size_t)t * 4096 + c;
                bp[0] = f2bf(r); bp[512] = f2bf(k); bp[1024] = f2bf(v); bp[1536] = f2bf(kr * rsqrtf(ssq + 1e-12f));
                XL[(size_t)t * 512 + c] = f2bf(e);
            }
        }
        __syncthreads();
        {
        float ga2v[16];
#pragma unroll
        for (int e = 0; e < 16; ++e) ga2v[e] = ga2[(gz * 16 + e) * 256 + gk];
        const float gabv = gab[gz * 256 + gk];
#pragma unroll
        for (int tt = 0; tt < TT; ++tt) {
            float zv = gabv;
#pragma unroll
            for (int e = 0; e < 16; ++e) zv += gal[tt * 32 + gz * 16 + e] * ga2v[e];
            const float la = -softplus_(-zv) * (1.f / 16.f);
            GLAD[(size_t)(t0 + tt) * 512 + tid] = f2bf(-expm1f(la));
        }
        }
        {
            float cwv[5], xv[TT + 4];
#pragma unroll
            for (int i = 0; i < 5; ++i) cwv[i] = cw[i * 1536 + 1024 + c];
#pragma unroll
            for (int i = 0; i < TT + 4; ++i) { const int rr = t0 - 2 + i; xv[i] = (rr >= 0 && rr < L) ? bf2f(PG[(size_t)rr * PG_LD + GDN_QKV + 1024 + c]) : 0.f; }
#pragma unroll
            for (int tt = 0; tt < TT; ++tt) { const int t = t0 + tt; float sv = 0.f;
#pragma unroll
                for (int i = 0; i < 5; ++i) { const int rr = t + i - 2; const bool ok_ = (rr >= 0) && (rr < L) && ((rr < NCTX) == (t < NCTX)); if (ok_) sv += xv[tt + i] * cwv[i]; }
                GDNC[(size_t)t * 1536 + 1024 + c] = f2bf(silu_(sv)); }
        }
        float oq[TT], ok[TT];
        {
            float cwq[5], cwk[5], xq[TT + 4], xk[TT + 4];
#pragma unroll
            for (int i = 0; i < 5; ++i) { cwq[i] = cw[i * 1536 + c]; cwk[i] = cw[i * 1536 + 512 + c]; }
#pragma unroll
            for (int i = 0; i < TT + 4; ++i) { const int rr = t0 - 2 + i;
                if (rr >= 0 && rr < L) { const bf16_t* rp = PG + (size_t)rr * PG_LD + GDN_QKV + c; xq[i] = bf2f(rp[0]); xk[i] = bf2f(rp[512]); } else { xq[i] = 0.f; xk[i] = 0.f; } }
#pragma unroll
            for (int tt = 0; tt < TT; ++tt) {
                const int t = t0 + tt; float sq = 0.f, sk = 0.f;
#pragma unroll
                for (int i = 0; i < 5; ++i) { const int rr = t + i - 2; const bool ok_ = (rr >= 0) && (rr < L) && ((rr < NCTX) == (t < NCTX));
                    if (ok_) { sq += xq[tt + i] * cwq[i]; sk += xk[tt + i] * cwk[i]; } }
                oq[tt] = silu_(sq); ok[tt] = silu_(sk);
                const float pq = wave_sum(oq[tt] * oq[tt]), pk = wave_sum(ok[tt] * ok[tt]);
                if ((tid & 63) == 0) { red[(tt * 8 + wave) * 2 + 0] = pq; red[(tt * 8 + wave) * 2 + 1] = pk; }
            }
        }
        __syncthreads();
#pragma unroll
        for (int tt = 0; tt < TT; ++tt) {
            const int w0i = (wave >> 1) * 2;
            const float ssq = red[(tt * 8 + w0i) * 2 + 0] + red[(tt * 8 + w0i + 1) * 2 + 0], ssk = red[(tt * 8 + w0i) * 2 + 1] + red[(tt * 8 + w0i + 1) * 2 + 1];
            bf16_t* gp = GDNC + (size_t)(t0 + tt) * 1536 + c;
            gp[0] = f2bf(oq[tt] * rsqrtf(ssq + 1e-12f) * 0.08838834764831845f); gp[512] = f2bf(ok[tt] * rsqrtf(ssk + 1e-12f));
        }
        if (tid < TT * 16) { const int tt = tid >> 4, j = tid & 15, t = t0 + tt;
            float o;
            if (j < 8) { const float a = bf2f(PG[(size_t)t * PG_LD + GDN_A + j]); o = __expf(-__expf(alog[j]) * softplus_(a + dtb[j])); }
            else o = sigmoid_(bf2f(PG[(size_t)t * PG_LD + GDN_B + (j - 8)]));
            GDNGB[t * 16 + j] = o; }
        __syncthreads();
    }
}
__device__ __forceinline__ void build_wl(const P& p, int l, int wg, int nwg) {
    const float* w2 = p.in[I_RWW2] + (size_t)l * 2 * 64 * 512; const float* a2 = p.in[I_RWA2] + (size_t)l * 2 * 64 * 512; const float* g2 = p.in[I_RWG2] + (size_t)l * 128 * 512;
    bf16_t* WL = (bf16_t*)(p.ws + OFF_WL);
    const int tid = otid();
    for (int it = wg * 512 + tid; it < 2560 * 64; it += nwg * 512) {
        const int kc = it / 2560, n = it - kc * 2560, k0 = kc * 8, blk = n >> 9, cc = n & 511;
        const float* src = nullptr; int kb = 0, kn = 0;
        if (blk == 0) { src = w2; kb = 0; kn = 64; } else if (blk == 1) { src = w2 + 64 * 512; kb = 64; kn = 64; }
        else if (blk == 2) { src = a2; kb = 128; kn = 64; } else if (blk == 3) { src = a2 + 64 * 512; kb = 192; kn = 64; }
        else { src = g2; kb = 256; kn = 128; }
        float v[8];
#pragma unroll
        for (int j = 0; j < 8; ++j) { const int k = k0 + j - kb; v[j] = (k >= 0 && k < kn) ? src[(size_t)k * 512 + cc] : 0.f; }
        u32x4 o; o[0] = pk2(v[0], v[1]); o[1] = pk2(v[2], v[3]); o[2] = pk2(v[4], v[5]); o[3] = pk2(v[6], v[7]);
        *(u32x4*)(WL + (size_t)n * 512 + k0) = o;
    }
}

constexpr int TB = 32, NBLK = L / TB;
__device__ __forceinline__ int tok_seq(int z, int j) { return z == 0 ? j : (j < NCTX ? NCTX - 1 - j : L - 1 - (j - NCTX)); }
__device__ __forceinline__ int tok_gla(int z, int j) {
    if (j < NCTX) return z == 0 ? j : NCTX - 1 - j;
    const int jj = j - NCTX, pp = z == 0 ? jj : NLAT - 1 - jj;
    return NCTX + (pp & 255) * 64 + (pp >> 8);
}

template <int NCW> struct ScanRole {
    bool cons, prod; int ct;
    __device__ __forceinline__ ScanRole(int tid) {
        const int w = tid >> 6, lane = tid & 63;
        if (NCW == 4) { cons = w < 4; prod = !cons; ct = tid & 255; }
        else { cons = w < 2; prod = (w & 2) != 0; ct = cons ? tid : ((((w >> 2) << 1) | (w & 1)) * 64 + lane); }
    }
};
#define SCAN_BARRIER() asm volatile("s_waitcnt lgkmcnt(0)\n\ts_barrier" ::: "memory")
__device__ __forceinline__ float bfraw2f(unsigned short b) { return __uint_as_float(((unsigned)b) << 16); }

__device__ __forceinline__ void scan_rwkv(const P& p, int l, int unit, LAS unsigned char* lds) {
    const int z = unit >> 6, h = (unit >> 3) & 7, rq = unit & 7;
    const bf16_t* B = (const bf16_t*)(p.ws + OFF_B); bf16_t* Y = (bf16_t*)(p.ws + OFF_PG) + YRW_COL + z * 512 + h * 64 + rq * 8;
    const float* kaw = p.in[I_RWKA] + l * 512 + h * 64;
    LAS float* vec = (LAS float*)lds;
    LAS float* vv = vec + 2 * TB * 320;
    LAS float* yo = vv + 2 * TB * 8;
    const int tid = otid(); const ScanRole<2> role(tid); const int ct = role.ct; const bool prod = role.prod, cons = role.cons;
    unsigned short pr[8], pk[8], pkk[8], pa[8], pw[8], pv;
    const float kac = kaw[ct & 63];
    auto p_load = [&](int blk) {
#pragma unroll
        for (int i = 0; i < 8; ++i) { const int idx = ct + i * 256, s = idx >> 6, n = idx & 63; const int t = tok_seq(z, blk * TB + s);
            const bf16_t* bp = B + (size_t)t * 4096 + h * 64 + n;
            pr[i] = bp[0]; pk[i] = bp[512]; pkk[i] = bp[1536]; pa[i] = bp[2048 + z * 512]; pw[i] = bp[3072 + z * 512]; }
        { const int s = ct >> 3, r = ct & 7; const int t = tok_seq(z, blk * TB + s); pv = B[(size_t)t * 4096 + 1024 + h * 64 + rq * 8 + r]; }
    };
    auto p_write = [&](int buf) {
#pragma unroll
        for (int i = 0; i < 8; ++i) { const int idx = ct + i * 256, s = idx >> 6, n = idx & 63;
            LAS float* d = vec + ((buf * TB + s) * 16 + (n >> 2)) * 20 + (n & 3);
            const float kk = bfraw2f(pkk[i]), a = bfraw2f(pa[i]);
            d[0] = kk; d[4] = 1.f - bfraw2f(pw[i]); d[8] = kk * a; d[12] = bfraw2f(pk[i]) * (1.f + (a - 1.f) * kac); d[16] = bfraw2f(pr[i]); }
        vv[buf * TB * 8 + ct] = bfraw2f(pv);
    };
    auto p_yout = [&](int blk) {
        const int buf = blk & 1; const int s = ct >> 3, r = ct & 7; const int t = tok_seq(z, blk * TB + s);
        Y[(size_t)t * PG_LD + r] = f2bf(yo[buf * TB * 8 + ct]);
    };
    const int irow = (ct >> 4) & 7, ks = ct & 15;
    f32x2 S0 = (f32x2){0.f, 0.f}, S1 = S0;
    struct Vx { f32x4 kk, w, b, k, r; float v; };
    auto c_ld = [&](Vx& x, int buf, int s) {
        const LAS float* d = vec + ((buf * TB + s) * 16 + ks) * 20;
        x.kk = *(const LAS f32x4*)(d); x.w = *(const LAS f32x4*)(d + 4); x.b = *(const LAS f32x4*)(d + 8); x.k = *(const LAS f32x4*)(d + 12);
        x.r = *(const LAS f32x4*)(d + 16); x.v = vv[(buf * TB + s) * 8 + irow];
    };
    float sa = 0.f;
    auto c_step = [&](const Vx& x, const f32x4& kkn, int buf, int s) {
        const f32x2 vv2 = (f32x2){x.v, x.v}, nsa = (f32x2){-sa, -sa};
        S0 = S0 * (f32x2){x.w[0], x.w[1]} + (vv2 * (f32x2){x.k[0], x.k[1]} + nsa * (f32x2){x.b[0], x.b[1]});
        S1 = S1 * (f32x2){x.w[2], x.w[3]} + (vv2 * (f32x2){x.k[2], x.k[3]} + nsa * (f32x2){x.b[2], x.b[3]});
        const f32x2 y2 = S0 * (f32x2){x.r[0], x.r[1]} + S1 * (f32x2){x.r[2], x.r[3]};
        const f32x2 s2 = S0 * (f32x2){kkn[0], kkn[1]} + S1 * (f32x2){kkn[2], kkn[3]};
        float yp = y2[0] + y2[1], sp = s2[0] + s2[1];
        yp += dpp_<0xB1>(yp); sp += dpp_<0xB1>(sp); yp += dpp_<0x4E>(yp); sp += dpp_<0x4E>(sp);
        yp += dpp_<0x141>(yp); sp += dpp_<0x141>(sp); yp += dpp_<0x140>(yp); sp += dpp_<0x140>(sp);
        sa = sp;
        yo[(buf * TB + s) * 8 + irow] = yp;
    };
    if (prod) { p_load(0); p_write(0); p_load(1); }
    SCAN_BARRIER();
    for (int b = 0; b < NBLK; ++b) {
        if (prod) {
            if (b + 1 < NBLK) p_write((b + 1) & 1);
            if (b + 2 < NBLK) p_load(b + 2);
            if (b > 0) p_yout(b - 1);
        } else if (cons) {
            const int buf = b & 1;
            Vx xa, xb;
            c_ld(xa, buf, 0);
            { const f32x2 s2 = S0 * (f32x2){xa.kk[0], xa.kk[1]} + S1 * (f32x2){xa.kk[2], xa.kk[3]}; sa = reduce16(s2[0] + s2[1]); }
#pragma unroll
            for (int s = 0; s < TB; s += 2) {
                c_ld(xb, buf, s + 1); c_step(xa, xb.kk, buf, s);
                c_ld(xa, buf, s + 2);
                c_step(xb, xa.kk, buf, s + 1);
            }
        }
        SCAN_BARRIER();
    }
    if (prod) p_yout(NBLK - 1);
    SCAN_BARRIER();
}

__device__ __forceinline__ void scan_gla(const P& p, int l, int unit, LAS unsigned char* lds) {
    const int z = unit >> 4, h = (unit >> 2) & 3, cb = unit & 3;
    const bf16_t* PG = (const bf16_t*)(p.ws + OFF_PG); const bf16_t* GLAD = (const bf16_t*)(p.ws + OFF_GLAD);
    bf16_t* O = (bf16_t*)(p.ws + OFF_R) + z * 512 + h * 128 + cb * 32;
    LAS float* vec = (LAS float*)lds;
    LAS float* vv = vec + 2 * TB * 192;
    LAS float* yo = vv + 2 * TB * 32;
    const int tid = otid(); const ScanRole<4> role(tid); const int ct = role.ct; const bool prod = role.prod, cons = role.cons;
    unsigned short pq[8], pk[8], pa[8], pv[4];
    auto p_load = [&](int blk) {
#pragma unroll
        for (int i = 0; i < 8; ++i) { const int idx = ct + i * 256, s = idx >> 6, n = idx & 63; const int t = tok_gla(z, blk * TB + s);
            const bf16_t* bp = PG + (size_t)t * PG_LD + h * 64 + n;
            pq[i] = bp[GLA_Q]; pk[i] = bp[GLA_K]; pa[i] = GLAD[(size_t)t * 512 + z * 256 + h * 64 + n]; }
#pragma unroll
        for (int i = 0; i < 4; ++i) { const int idx = ct + i * 256, s = idx >> 5, r = idx & 31; const int t = tok_gla(z, blk * TB + s);
            pv[i] = PG[(size_t)t * PG_LD + GLA_V + h * 128 + cb * 32 + r]; }
    };
    auto p_write = [&](int buf) {
#pragma unroll
        for (int i = 0; i < 8; ++i) { const int idx = ct + i * 256, s = idx >> 6, n = idx & 63;
            LAS float* d = vec + ((buf * TB + s) * 8 + (n >> 3)) * 24 + (n & 7);
            d[0] = bfraw2f(pq[i]) * 0.125f; d[8] = bfraw2f(pk[i]); d[16] = 1.f - bfraw2f(pa[i]); }
#pragma unroll
        for (int i = 0; i < 4; ++i) vv[buf * TB * 32 + ct + i * 256] = bfraw2f(pv[i]);
    };
    auto p_yout = [&](int blk) {
        const int buf = blk & 1;
#pragma unroll
        for (int i = 0; i < 4; ++i) { const int idx = ct + i * 256, s = idx >> 5, r = idx & 31; const int t = tok_gla(z, blk * TB + s);
            O[(size_t)t * R_LD + r] = f2bf(yo[buf * TB * 32 + idx]); }
    };
    const int icol = (ct >> 3) & 31, ks = ct & 7;
    f32x2 S[4];
#pragma unroll
    for (int j = 0; j < 4; ++j) S[j] = (f32x2){0.f, 0.f};
    struct Vx { f32x4 q0, q1, k0, k1, a0, a1; float v; };
    auto c_ld = [&](Vx& x, int buf, int s) {
        const LAS float* d = vec + ((buf * TB + s) * 8 + ks) * 24;
        x.q0 = *(const LAS f32x4*)(d); x.q1 = *(const LAS f32x4*)(d + 4); x.k0 = *(const LAS f32x4*)(d + 8); x.k1 = *(const LAS f32x4*)(d + 12);
        x.a0 = *(const LAS f32x4*)(d + 16); x.a1 = *(const LAS f32x4*)(d + 20); x.v = vv[(buf * TB + s) * 32 + icol];
    };
    auto c_upd = [&](const Vx& x) -> float {
        const f32x2 vv2 = (f32x2){x.v, x.v};
        S[0] = S[0] * (f32x2){x.a0[0], x.a0[1]} + vv2 * (f32x2){x.k0[0], x.k0[1]};
        S[1] = S[1] * (f32x2){x.a0[2], x.a0[3]} + vv2 * (f32x2){x.k0[2], x.k0[3]};
        S[2] = S[2] * (f32x2){x.a1[0], x.a1[1]} + vv2 * (f32x2){x.k1[0], x.k1[1]};
        S[3] = S[3] * (f32x2){x.a1[2], x.a1[3]} + vv2 * (f32x2){x.k1[2], x.k1[3]};
        const f32x2 y2 = (S[0] * (f32x2){x.q0[0], x.q0[1]} + S[1] * (f32x2){x.q0[2], x.q0[3]}) + (S[2] * (f32x2){x.q1[0], x.q1[1]} + S[3] * (f32x2){x.q1[2], x.q1[3]});
        return y2[0] + y2[1];
    };
    if (prod) { p_load(0); p_write(0); p_load(1); }
    SCAN_BARRIER();
    for (int b = 0; b < NBLK; ++b) {
        if (prod) {
            if (b + 1 < NBLK) p_write((b + 1) & 1);
            if (b + 2 < NBLK) p_load(b + 2);
            if (b > 0) p_yout(b - 1);
        } else if (cons) {
            const int buf = b & 1;
            Vx xa, xb;
            c_ld(xa, buf, 0);
#pragma unroll
            for (int s = 0; s < TB; s += 2) {
                c_ld(xb, buf, s + 1);
                float ya = c_upd(xa);
                c_ld(xa, buf, s + 2);
                float yb = c_upd(xb);
                ya += dpp_<0xB1>(ya); yb += dpp_<0xB1>(yb); ya += dpp_<0x4E>(ya); yb += dpp_<0x4E>(yb); ya += dpp_<0x141>(ya); yb += dpp_<0x141>(yb);
                yo[(buf * TB + s) * 32 + icol] = ya; yo[(buf * TB + s + 1) * 32 + icol] = yb;
            }
        }
        SCAN_BARRIER();
    }
    if (prod) p_yout(NBLK - 1);
    SCAN_BARRIER();
}

__device__ __forceinline__ void scan_gdn(const P& p, int l, int unit, LAS unsigned char* lds) {
    const int z = unit >> 5, h = (unit >> 3) & 3, cb = unit & 7;
    const bf16_t* GDNC = (const bf16_t*)(p.ws + OFF_GDNC); const float* GDNGB = (const float*)(p.ws + OFF_GDNGB);
    bf16_t* O = (bf16_t*)(p.ws + OFF_R) + 1024 + z * 512 + h * 128 + cb * 16;
    LAS float* vec = (LAS float*)lds;
    LAS float* vv = vec + 2 * TB * 320;
    LAS float* sc = vv + 2 * TB * 16;
    LAS float* yo = sc + 2 * TB * 2;
    const int tid = otid(); const ScanRole<4> role(tid); const int ct = role.ct; const bool prod = role.prod, cons = role.cons;
    unsigned short pq[16], pk[16], pv[2]; float psc = 0.f;
    auto p_load = [&](int blk) {
#pragma unroll
        for (int i = 0; i < 16; ++i) { const int idx = ct + i * 256, s = idx >> 7, n = idx & 127; const int t = tok_seq(z, blk * TB + s);
            const bf16_t* bp = GDNC + (size_t)t * 1536 + h * 128 + n;
            pq[i] = bp[0]; pk[i] = bp[512]; }
#pragma unroll
        for (int i = 0; i < 2; ++i) { const int idx = ct + i * 256, s = idx >> 4, r = idx & 15; const int t = tok_seq(z, blk * TB + s);
            pv[i] = GDNC[(size_t)t * 1536 + 1024 + h * 128 + cb * 16 + r]; }
        if (ct < 64) { const int s = ct >> 1, w = ct & 1; const int t = tok_seq(z, blk * TB + s); psc = GDNGB[t * 16 + w * 8 + z * 4 + h]; }
    };
    auto p_write = [&](int buf) {
#pragma unroll
        for (int i = 0; i < 16; ++i) { const int idx = ct + i * 256, s = idx >> 7, n = idx & 127;
            LAS float* d = vec + ((buf * TB + s) * 16 + (n >> 3)) * 20 + (n & 7);
            d[0] = bfraw2f(pq[i]); d[8] = bfraw2f(pk[i]); }
#pragma unroll
        for (int i = 0; i < 2; ++i) vv[buf * TB * 16 + ct + i * 256] = bfraw2f(pv[i]);
        if (ct < 64) sc[buf * TB * 2 + ct] = psc;
    };
    auto p_yout = [&](int blk) {
        const int buf = blk & 1;
#pragma unroll
        for (int i = 0; i < 2; ++i) { const int idx = ct + i * 256, s = idx >> 4, r = idx & 15; const int t = tok_seq(z, blk * TB + s);
            O[(size_t)t * R_LD + r] = f2bf(yo[buf * TB * 16 + idx]); }
    };
    const int icol = (ct >> 4) & 15, ks = ct & 15;
    f32x2 S[4];
#pragma unroll
    for (int j = 0; j < 4; ++j) S[j] = (f32x2){0.f, 0.f};
    struct Vx { f32x4 q0, q1, k0, k1; float v; f32x2 gb; };
    auto c_ld = [&](Vx& x, int buf, int s) {
        const LAS float* d = vec + ((buf * TB + s) * 16 + ks) * 20;
        x.q0 = *(const LAS f32x4*)(d); x.q1 = *(const LAS f32x4*)(d + 4); x.k0 = *(const LAS f32x4*)(d + 8); x.k1 = *(const LAS f32x4*)(d + 12);
        x.v = vv[(buf * TB + s) * 16 + icol]; x.gb = *(const LAS f32x2*)(sc + (buf * TB + s) * 2);
    };
    float dd = 0.f;
    auto c_step = [&](const Vx& x, const f32x4& kn0, const f32x4& kn1, int buf, int s) {
        const float eg = x.gb[0];
        const float cc = x.gb[1] * (x.v - eg * dd);
        const f32x2 eg2 = (f32x2){eg, eg}, cc2 = (f32x2){cc, cc};
        S[0] = S[0] * eg2 + cc2 * (f32x2){x.k0[0], x.k0[1]};
        S[1] = S[1] * eg2 + cc2 * (f32x2){x.k0[2], x.k0[3]};
        S[2] = S[2] * eg2 + cc2 * (f32x2){x.k1[0], x.k1[1]};
        S[3] = S[3] * eg2 + cc2 * (f32x2){x.k1[2], x.k1[3]};
        f32x2 y2 = S[0] * (f32x2){x.q0[0], x.q0[1]}; y2 = S[1] * (f32x2){x.q0[2], x.q0[3]} + y2; y2 = S[2] * (f32x2){x.q1[0], x.q1[1]} + y2; y2 = S[3] * (f32x2){x.q1[2], x.q1[3]} + y2;
        f32x2 d2 = S[0] * (f32x2){kn0[0], kn0[1]}; d2 = S[1] * (f32x2){kn0[2], kn0[3]} + d2; d2 = S[2] * (f32x2){kn1[0], kn1[1]} + d2; d2 = S[3] * (f32x2){kn1[2], kn1[3]} + d2;
        float yp = y2[0] + y2[1], dp = d2[0] + d2[1];
        yp += dpp_<0xB1>(yp); dp += dpp_<0xB1>(dp); yp += dpp_<0x4E>(yp); dp += dpp_<0x4E>(dp);
        yp += dpp_<0x141>(yp); dp += dpp_<0x141>(dp); yp += dpp_<0x140>(yp); dp += dpp_<0x140>(dp);
        dd = dp;
        yo[(buf * TB + s) * 16 + icol] = yp;
    };
    if (prod) { p_load(0); p_write(0); p_load(1); }
    SCAN_BARRIER();
    for (int b = 0; b < NBLK; ++b) {
        if (prod) {
            if (b + 1 < NBLK) p_write((b + 1) & 1);
            if (b + 2 < NBLK) p_load(b + 2);
            if (b > 0) p_yout(b - 1);
        } else if (cons) {
            const int buf = b & 1;
            Vx xa, xb;
            c_ld(xa, buf, 0);
            { const f32x2 d2 = (S[0] * (f32x2){xa.k0[0], xa.k0[1]} + S[1] * (f32x2){xa.k0[2], xa.k0[3]}) + (S[2] * (f32x2){xa.k1[0], xa.k1[1]} + S[3] * (f32x2){xa.k1[2], xa.k1[3]});
              dd = reduce16(d2[0] + d2[1]); }
#pragma unroll
            for (int s = 0; s < TB; s += 2) {
                c_ld(xb, buf, s + 1); c_step(xa, xb.k0, xb.k1, buf, s);
                c_ld(xa, buf, s + 2);
                c_step(xb, xa.k0, xa.k1, buf, s + 1);
            }
        }
        SCAN_BARRIER();
    }
    if (prod) p_yout(NBLK - 1);
    SCAN_BARRIER();
}

__device__ __forceinline__ void phase_post(const P& p, int l, LAS unsigned char* lds) {
    const bf16_t* PG = (const bf16_t*)(p.ws + OFF_PG); const bf16_t* Rb = (const bf16_t*)(p.ws + OFF_R); const bf16_t* B = (const bf16_t*)(p.ws + OFF_B);
    const bf16_t* RWG = (const bf16_t*)(p.ws + OFF_RWG);
    bf16_t* YC = (bf16_t*)(p.ws + OFF_GDNC);
    const int tid = otid(), wave = tid >> 6, c = tid;
    const float lnw = p.in[I_RWLNW][l * 512 + c], lnb = p.in[I_RWLNB][l * 512 + c], kac = p.in[I_RWKA][l * 512 + c], rkc = p.in[I_RWRK][l * 512 + c];
    const float gng = p.in[I_GLANG][l * 128 + (c & 127)], dng = p.in[I_GDNNG][l * 128 + (c & 127)];
    LAS float* red = (LAS float*)lds;
    for (int tile = blockIdx.x; tile < L / TT; tile += gridDim.x) {
        const int t0 = tile * TT;
        float og[TT], od[TT];
#pragma unroll
        for (int tt = 0; tt < TT; ++tt) {
            const int t = t0 + tt;
            const float y = bf2f(PG[(size_t)t * PG_LD + YRW_COL + c]) + bf2f(PG[(size_t)t * PG_LD + YRW_COL + 512 + c]);
            const float mean = wave_sum(y) * (1.f / 64.f);
            const float dy = y - mean;
            const float var = wave_sum(dy * dy) * (1.f / 64.f);
            const float yn = dy * rsqrtf(var + 64e-5f) * lnw + lnb;
            const bf16_t* bp = B + (size_t)t * 4096 + c;
            const float v = bf2f(bp[1024]), rr_ = bf2f(bp[0]), kk_ = bf2f(bp[512]), az0 = bf2f(bp[2048]), az1 = bf2f(bp[2560]);
            const float bon = wave_sum(rr_ * rkc * (kk_ * (1.f + (az0 - 1.f) * kac) + kk_ * (1.f + (az1 - 1.f) * kac)));
            const float o = (yn + bon * v) * bf2f(RWG[(size_t)t * 512 + c]);
            YC[(size_t)t * 512 + c] = f2bf(o);
            og[tt] = bf2f(Rb[(size_t)t * R_LD + c]) + bf2f(Rb[(size_t)t * R_LD + 512 + c]);
            od[tt] = bf2f(Rb[(size_t)t * R_LD + 1024 + c]) + bf2f(Rb[(size_t)t * R_LD + 1536 + c]);
            const float pg_ = wave_sum(og[tt] * og[tt]), pd_ = wave_sum(od[tt] * od[tt]);
            if ((tid & 63) == 0) { red[(tt * 8 + wave) * 2 + 0] = pg_; red[(tt * 8 + wave) * 2 + 1] = pd_; }
        }
        __syncthreads();
#pragma unroll
        for (int tt = 0; tt < TT; ++tt) {
            const int t = t0 + tt, w0i = (wave >> 1) * 2;
            const float sg = red[(tt * 8 + w0i) * 2 + 0] + red[(tt * 8 + w0i + 1) * 2 + 0], sd = red[(tt * 8 + w0i) * 2 + 1] + red[(tt * 8 + w0i + 1) * 2 + 1];
            const float gate_g = silu_(bf2f(PG[(size_t)t * PG_LD + GLA_OG + c])), gate_d = silu_(bf2f(PG[(size_t)t * PG_LD + GDN_ZG + c]));
            YC[(size_t)L * 512 + (size_t)t * 512 + c] = f2bf(og[tt] * rsqrtf(sg * (1.f / 128.f) + 1e-6f) * gng * gate_g);
            YC[(size_t)2 * L * 512 + (size_t)t * 512 + c] = f2bf(od[tt] * rsqrtf(sd * (1.f / 128.f) + 1e-6f) * dng * gate_d);
        }
        __syncthreads();
    }
}

__device__ __forceinline__ void phase_final(const P& p) {
    const float* H = (const float*)(p.ws + OFF_H); const float* gamma = p.in[I_FINALG];
    const int tid_ = otid(); const int wave = tid_ >> 6, lane = tid_ & 63;
    for (int row = blockIdx.x * 8 + wave; row < NLAT; row += gridDim.x * 8) {
        const float* src = H + (size_t)(row + NCTX) * 1024;
        f32x4 v[4]; float ss = 0.f;
#pragma unroll
        for (int j = 0; j < 4; ++j) { v[j] = *(const f32x4*)(src + j * 256 + lane * 4); ss += (v[j][0] * v[j][0] + v[j][1] * v[j][1]) + (v[j][2] * v[j][2] + v[j][3] * v[j][3]); }
        ss = wave_sum(ss);
        const float rstd = rsqrtf(ss * (1.f / 1024.f) + 1e-6f);
#pragma unroll
        for (int j = 0; j < 4; ++j) { const int col = j * 256 + lane * 4; const f32x4 g = *(const f32x4*)(gamma + col);
            *(f32x4*)(p.out + (size_t)row * 1024 + col) = v[j] * rstd * g; }
    }
}


#define XB_TMO      128
#define XB_XCNT(j)  (256  + 64 * (j))
#define XB_XSUB(j)  (1280 + 64 * (j))
#define XB_XGEN(j)  (2304 + 64 * (j))
#define XB_TOP      3328
#define XB_TOPGEN   3392
#define XCD_BAR_WORDS 3456
#define XB_SPIN_CAP (1u << 18)
__device__ __forceinline__ unsigned xb_ld(unsigned* p)              { return __hip_atomic_load(p, __ATOMIC_RELAXED, __HIP_MEMORY_SCOPE_AGENT); }
__device__ __forceinline__ unsigned xb_add(unsigned* p, unsigned v) { return __hip_atomic_fetch_add(p, v, __ATOMIC_RELAXED, __HIP_MEMORY_SCOPE_AGENT); }
__device__ __forceinline__ unsigned xb_xcc_id() { return (unsigned)__builtin_amdgcn_s_getreg((3 << 11) | 20) & 0xFu; }
#define XB_SPIN(cond, bar) do { unsigned _sp = 0; while (cond) { __builtin_amdgcn_s_sleep(1); \
    if ((++_sp & 255u) == 0u) { if (xb_ld(&(bar)[XB_TMO])) break; if (_sp > XB_SPIN_CAP) { atomicAdd(&(bar)[XB_TMO], 1u); break; } } } } while (0)
struct XcdBarrier { unsigned* bar; unsigned x; volatile LAS unsigned* st; };
__device__ __forceinline__ XcdBarrier xcd_barrier_post(unsigned* bar, volatile LAS unsigned* st) {
    XcdBarrier b; b.bar = bar; b.x = xb_xcc_id(); b.st = st;
    if (threadIdx.x == 0) (void)xb_add(&bar[XB_XCNT(b.x)], 1u);
    return b;
}
__device__ __forceinline__ void xcd_barrier_complete(unsigned* bar, unsigned x, unsigned& nloc, unsigned& nx) {
    const unsigned G = gridDim.x * gridDim.y * gridDim.z;
    unsigned sum, cnt, mine, sp = 0u;
    for (;;) {
        sum = 0u; cnt = 0u; mine = 0u;
#pragma unroll
        for (unsigned j = 0; j < 16; ++j) { const unsigned c = xb_ld(&bar[XB_XCNT(j)]); sum += c; cnt += (c > 0u) ? 1u : 0u; mine = (j == x) ? c : mine; }
        if (sum == G) break;
        __builtin_amdgcn_s_sleep(1);
        if ((++sp & 255u) == 0u) { if (xb_ld(&bar[XB_TMO])) break; if (sp > XB_SPIN_CAP) { atomicAdd(&bar[XB_TMO], 1u); break; } }
    }
    nloc = mine > 0u ? mine : 1u; nx = cnt > 0u ? cnt : 1u;
}
__device__ __forceinline__ void xcd_barrier(const XcdBarrier& b) {
    asm volatile("s_waitcnt vmcnt(0)" ::: "memory");
    __syncthreads();
    if (threadIdx.x == 0) {
        unsigned* bar = b.bar;
        __builtin_amdgcn_s_waitcnt(0);
        unsigned nloc = b.st[0], nx = b.st[1];
        if (nloc == 0u) { xcd_barrier_complete(bar, b.x, nloc, nx); b.st[0] = nloc; b.st[1] = nx; }
        const unsigned old = xb_add(&bar[XB_XSUB(b.x)], 1u);
        const unsigned gen = old / nloc;
        if (old + 1u == (gen + 1u) * nloc) {
            __builtin_amdgcn_fence(__ATOMIC_RELEASE, "agent");
            asm volatile("s_waitcnt vmcnt(0)" ::: "memory");
            const unsigned og = xb_add(&bar[XB_TOP], 1u);
            const unsigned tg = og / nx;
            if (og + 1u == (tg + 1u) * nx) xb_add(&bar[XB_TOPGEN], 1u);
            else XB_SPIN(xb_ld(&bar[XB_TOPGEN]) == tg, bar);
            __builtin_amdgcn_fence(__ATOMIC_ACQUIRE, "agent");
            xb_add(&bar[XB_XGEN(b.x)], 1u);
            asm volatile("s_waitcnt vmcnt(0)" ::: "memory");
        } else {
            XB_SPIN(xb_ld(&bar[XB_XGEN(b.x)]) == gen, bar);
            __builtin_amdgcn_fence(__ATOMIC_ACQUIRE, "agent");
            asm volatile("s_waitcnt vmcnt(0)" ::: "memory");
        }
    }
    __syncthreads();
}

__global__ void __launch_bounds__(512, 2) fwd_megakernel(P p) {
    extern __shared__ __attribute__((aligned(16))) unsigned char shm_raw[];
    LAS unsigned char* lds = (LAS unsigned char*)shm_raw;
    cg::grid_group grid = cg::this_grid();
    const int G = gridDim.x, wg = blockIdx.x;
    unsigned char* ws = p.ws;
    float* H = (float*)(ws + OFF_H); bf16_t* HN = (bf16_t*)(ws + OFF_HN); bf16_t* WIN = (bf16_t*)(ws + OFF_WIN);
    const float* MODall = (const float*)(ws + OFF_MOD);

    volatile LAS unsigned* xbst = (volatile LAS unsigned*)(lds + 131072);
    if (threadIdx.x == 0) { xbst[0] = 0u; xbst[1] = 0u; xbst[2] = 0u; xbst[3] = 0u; }
    __syncthreads();
    const XcdBarrier xb = xcd_barrier_post((unsigned*)(ws + OFF_BAR), xbst);
    phase_mod(p, lds);
    grid.sync();
    for (int l = 0; l < DEPTH; ++l) {
        const float* MOD = MODall + (size_t)l * 2 * 6144;
        const bool lastl = (l == DEPTH - 1);
        const int Mg = lastl ? NLAT : L, pm0 = lastl ? 1 : 0;
        if (l == 0) phase_norm<true>(p, l, p.in[I_N1G] + l * 1024, 0, 1); else phase_norm<false>(p, l, p.in[I_N1G] + l * 1024, 0, 1);
        {
            const float* win = p.in[I_WIN] + (size_t)l * 1024 * IN_COLS;
            convert_T(win, IN_COLS, 1024, 0, 1920, WIN, (LAS float*)lds, wg, G);
            convert_T(win, IN_COLS, 1024, 1920, 3632, WIN + (size_t)2048 * 1024, (LAS float*)lds, (wg + 64) % G, G);
            convert_T(win, IN_COLS, 1024, 5552, 3072, WIN + (size_t)NMAIN * 1024, (LAS float*)lds, (wg + 128) % G, G);
            build_wl(p, l, wg, G);
        }
        xcd_barrier(xb);
        {
            pg8::Gemm g{HN, WIN, L, NMAIN, 1024, 16}; pg8::StaticOrder S; S.init(L, NMAIN, G, wg);
            EpiInMain E{(bf16_t*)(ws + OFF_R), (bf16_t*)(ws + OFF_PG)};
            pg8::gemm_phase(lds, g, S, E);
        }
        xcd_barrier(xb);
#ifndef NO_PREP
        phase_prep(p, l, lds);
        xcd_barrier(xb);
        {
            pg8::Gemm g{(const bf16_t*)(ws + OFF_XL), (const bf16_t*)(ws + OFF_WL), L, 2560, 512, 8}; pg8::StaticOrder S; S.init(L, 2560, G, wg);
            EpiLora E{(bf16_t*)(ws + OFF_B), (bf16_t*)(ws + OFF_RWG), p.in[I_RWW0] + (size_t)l * 1024, p.in[I_RWA0] + (size_t)l * 1024};
            pg8::gemm_phase(lds, g, S, E);
        }
#endif
        xcd_barrier(xb);
#ifndef NO_SCAN
        if (wg < 128) scan_rwkv(p, l, wg, lds);
        else if (wg < 160) scan_gla(p, l, wg - 128, lds);
        else if (wg < 224) scan_gdn(p, l, wg - 160, lds);
#endif
        xcd_barrier(xb);
#ifndef NO_POST
        phase_post(p, l, lds);
#endif
        xcd_barrier(xb);
        {
            convert_T(p.in[I_WBR] + (size_t)l * 3 * 512 * 1024, 1024, 512, 0, 1024, (bf16_t*)(ws + OFF_WBR), (LAS float*)lds, wg, G);
            convert_T(p.in[I_WBR] + (size_t)l * 3 * 512 * 1024 + (size_t)512 * 1024, 1024, 512, 0, 1024, (bf16_t*)(ws + OFF_WBR) + (size_t)1024 * 512, (LAS float*)lds, (wg + 128) % G, G);
            convert_T(p.in[I_WBR] + (size_t)l * 3 * 512 * 1024 + (size_t)2 * 512 * 1024, 1024, 512, 0, 1024, (bf16_t*)(ws + OFF_WBR) + (size_t)2 * 1024 * 512, (LAS float*)lds, wg, G);
            convert_T(p.in[I_WOUT] + (size_t)l * 1024 * 1024, 1024, 1024, 0, 1024, (bf16_t*)(ws + OFF_WOUT), (LAS float*)lds, wg, G);
            convert_T(p.in[I_W1] + (size_t)l * 1024 * 4096, 4096, 1024, 0, 4096, (bf16_t*)(ws + OFF_W1), (LAS float*)lds, wg, G);
            convert_T(p.in[I_W2] + (size_t)l * 4096 * 1024, 1024, 4096, 0, 1024, (bf16_t*)(ws + OFF_W2), (LAS float*)lds, wg, G);
            pg8::Gemm g{HN, WIN + (size_t)NMAIN * 1024, L, 3072, 1024, 16}; pg8::StaticOrder S; S.init(Mg, 3072, G, wg, pm0);
            EpiGates E{(bf16_t*)(ws + OFF_B)};
            pg8::gemm_phase(lds, g, S, E);
        }
        xcd_barrier(xb);
        {
            const bf16_t* YC = (const bf16_t*)(ws + OFF_GDNC); const bf16_t* WBR = (const bf16_t*)(ws + OFF_WBR);
            pg8::StaticOrder S; S.init(Mg, 1024, G, wg, pm0);
            { pg8::Gemm g{YC, WBR, L, 1024, 512, 8}; EpiBranch<0> E{(const bf16_t*)(ws + OFF_B), (float*)(ws + OFF_PG), HN}; pg8::gemm_phase(lds, g, S, E); }
            { pg8::Gemm g{YC + (size_t)L * 512, WBR + (size_t)1024 * 512, L, 1024, 512, 8}; EpiBranch<1> E{(const bf16_t*)(ws + OFF_B), (float*)(ws + OFF_PG), HN}; pg8::gemm_phase(lds, g, S, E); }
            { pg8::Gemm g{YC + (size_t)2 * L * 512, WBR + (size_t)2 * 1024 * 512, L, 1024, 512, 8}; EpiBranch<2> E{(const bf16_t*)(ws + OFF_B), (float*)(ws + OFF_PG), HN}; pg8::gemm_phase(lds, g, S, E); }
        }
        xcd_barrier(xb);
        {
            pg8::Gemm g{HN, (const bf16_t*)(ws + OFF_WOUT), L, 1024, 1024, 16}; pg8::StaticOrder S; S.init(Mg, 1024, G, wg, pm0);
            EpiResid E{H, MOD + 2 * 1024, MOD + 6144 + 2 * 1024};
            pg8::gemm_phase(lds, g, S, E);
        }
        xcd_barrier(xb);
        phase_norm<false>(p, l, p.in[I_N2G] + l * 1024, 3, 4);
        xcd_barrier(xb);
        {
            pg8::Gemm g{HN, (const bf16_t*)(ws + OFF_W1), L, 4096, 1024, 16}; pg8::StaticOrder S; S.init(Mg, 4096, G, wg, pm0);
            EpiMlp1 E{(bf16_t*)(ws + OFF_B)};
            pg8::gemm_phase(lds, g, S, E);
        }
        xcd_barrier(xb);
        {
            pg8::Gemm g{(const bf16_t*)(ws + OFF_B), (const bf16_t*)(ws + OFF_W2), L, 1024, 4096, 64}; pg8::StaticOrder S; S.init(Mg, 1024, G, wg, pm0);
            EpiResid E{H, MOD + 5 * 1024, MOD + 6144 + 5 * 1024};
            pg8::gemm_phase(lds, g, S, E);
        }
        xcd_barrier(xb);
    }
    phase_final(p);
}

extern "C" void kernel_launch(void* const* d_in, const int* in_sizes, int n_in, void* d_out, int out_size, void* d_ws, size_t ws_size, hipStream_t stream) {
    static int grid_blocks = 0;
    if (n_in != 32 || ws_size < WS_END || out_size != NLAT * DM) {
        fprintf(stderr, "kernel_launch: unexpected shapes / workspace (n_in %d, ws %zu need %zu, out %d)\n", n_in, ws_size, (size_t)WS_END, out_size);
        hipMemsetAsync(d_out, 0xFF, (size_t)out_size * 4, stream);
        return;
    }
    if (!grid_blocks) {
        int dev = 0, cus = 0, per_cu = 0;
        hipGetDevice(&dev);
        hipDeviceGetAttribute(&cus, hipDeviceAttributeMultiprocessorCount, dev);
        hipFuncSetAttribute((const void*)fwd_megakernel, hipFuncAttributeMaxDynamicSharedMemorySize, LDS_BYTES);
        hipOccupancyMaxActiveBlocksPerMultiprocessor(&per_cu, (const void*)fwd_megakernel, 512, LDS_BYTES);
        if (per_cu < 1) per_cu = 1;
        grid_blocks = cus * 1;
        (void)hipGetLastError();
    }
    P p{};
    for (int i = 0; i < 32; ++i) p.in[i] = (const float*)d_in[i];
    p.out = (float*)d_out; p.ws = (unsigned char*)d_ws;
    (void)hipMemsetAsync((unsigned char*)d_ws + OFF_BAR, 0, 16384, stream);
    void* args[] = {&p};
    hipError_t e = hipLaunchCooperativeKernel((const void*)fwd_megakernel, dim3(grid_blocks), dim3(512), args, LDS_BYTES, stream);
    if (e != hipSuccess) fprintf(stderr, "cooperative launch failed: %s (grid %d)\n", hipGetErrorString(e), grid_blocks);
}
```

```cpp
#include <hip/hip_runtime.h>
#include <hip/hip_cooperative_groups.h>
#include <cstdio>
#include <cstdint>
namespace cg = cooperative_groups;

#define LAS __attribute__((address_space(3)))
typedef unsigned short bf16_t;
typedef short bf16x8 __attribute__((ext_vector_type(8)));
typedef float f32x4 __attribute__((ext_vector_type(4)));
typedef float f32x2 __attribute__((ext_vector_type(2)));
typedef unsigned u32x4 __attribute__((ext_vector_type(4)));
typedef unsigned u32x2 __attribute__((ext_vector_type(2)));

constexpr int L = 16640, NCTX = 256, NLAT = 16384, DM = 1024, BW = 512, DEPTH = 4;
constexpr int IN_COLS = 8624;
constexpr int NMAIN = 5888;
constexpr int NWIN = 8960;
constexpr int R_LD = 2048, PG_LD = 3840;
constexpr int GLA_Q = 0, GLA_K = 256, GLA_V = 512, GLA_OG = 1024, GLA_AL = 1536;
constexpr int GDN_QKV = 1568, GDN_ZG = 3104, GDN_A = 3616, GDN_B = 3624;
constexpr int YRW_COL = 1568;

constexpr size_t al256(size_t x) { return (x + 255) & ~(size_t)255; }
constexpr size_t OFF_MOD = 0;
constexpr size_t OFF_H = al256(OFF_MOD + (size_t)4 * 2 * 6144 * 4);
constexpr size_t OFF_HN = OFF_H + (size_t)L * 1024 * 4;
constexpr size_t OFF_WIN = OFF_HN + (size_t)L * 1024 * 2;
constexpr size_t OFF_R = OFF_WIN + (size_t)NWIN * 1024 * 2;
constexpr size_t OFF_PG = OFF_R + (size_t)L * R_LD * 2;
constexpr size_t OFF_B = OFF_PG + (size_t)L * PG_LD * 2;
constexpr size_t OFF_RWG = OFF_B + (size_t)L * 4096 * 2;
constexpr size_t OFF_BONUS = OFF_RWG + (size_t)L * 512 * 2;
constexpr size_t OFF_GLAD = OFF_BONUS + (size_t)L * 8 * 4;
constexpr size_t OFF_GDNC = OFF_GLAD + (size_t)L * 512 * 2;
constexpr size_t OFF_GDNGB = OFF_GDNC + (size_t)L * 1536 * 2;
constexpr size_t OFF_XL = OFF_GDNGB + (size_t)L * 16 * 4;
constexpr size_t OFF_WL = OFF_XL + (size_t)L * 512 * 2;
constexpr size_t OFF_BAR = OFF_WL + (size_t)2560 * 512 * 2;
constexpr size_t WS_END = OFF_BAR + 16384;
constexpr size_t OFF_WBR = OFF_R;
constexpr size_t OFF_WOUT = OFF_WBR + (size_t)3 * 1024 * 512 * 2;
constexpr size_t OFF_W1 = OFF_WOUT + (size_t)1024 * 1024 * 2;
constexpr size_t OFF_W2 = OFF_W1 + (size_t)4096 * 1024 * 2;

constexpr int LDS_BYTES = 131072 + 16;

struct P { const float* in[32]; float* out; unsigned char* ws; };
enum { I_X = 0, I_C, I_CTX, I_CCTX, I_WMOD, I_BMOD, I_N1G, I_WIN, I_RWMU, I_RWW0, I_RWW2, I_RWA0, I_RWA2, I_RWG2, I_RWKK, I_RWKA, I_RWRK,
       I_RWLNW, I_RWLNB, I_GLAA2, I_GLAAB, I_GLANG, I_GDNCONV, I_GDNALOG, I_GDNDT, I_GDNNG, I_WBR, I_WOUT, I_N2G, I_W1, I_W2, I_FINALG };

__device__ __forceinline__ float bf2f(bf16_t b) { return __uint_as_float(((unsigned)b) << 16); }
__device__ __forceinline__ unsigned pk2(float lo, float hi) { unsigned r; asm("v_cvt_pk_bf16_f32 %0, %1, %2" : "=v"(r) : "v"(lo), "v"(hi)); return r; }
__device__ __forceinline__ bf16_t f2bf(float f) { return (bf16_t)(pk2(f, 0.f) & 0xffffu); }
__device__ __forceinline__ float sigmoid_(float x) { return 1.f / (1.f + __expf(-x)); }
__device__ __forceinline__ float silu_(float x) { return x / (1.f + __expf(-x)); }
__device__ __forceinline__ float softplus_(float x) { return fmaxf(x, 0.f) + log1pf(__expf(-fabsf(x))); }
template <int CTRL> __device__ __forceinline__ float dpp_(float x) { return __int_as_float(__builtin_amdgcn_update_dpp(0, __float_as_int(x), CTRL, 0xF, 0xF, true)); }
__device__ __forceinline__ float reduce8(float x) { x += dpp_<0xB1>(x); x += dpp_<0x4E>(x); x += dpp_<0x141>(x); return x; }
__device__ __forceinline__ float reduce16(float x) { x = reduce8(x); x += dpp_<0x140>(x); return x; }
__device__ __forceinline__ float wave_sum(float v) {
    v = reduce16(v);
    const float r0 = __int_as_float(__builtin_amdgcn_readlane(__float_as_int(v), 0)), r1 = __int_as_float(__builtin_amdgcn_readlane(__float_as_int(v), 16));
    const float r2 = __int_as_float(__builtin_amdgcn_readlane(__float_as_int(v), 32)), r3 = __int_as_float(__builtin_amdgcn_readlane(__float_as_int(v), 48));
    return (r0 + r1) + (r2 + r3);
}

__device__ __forceinline__ int otid() { int t = threadIdx.x; asm volatile("" : "+v"(t)); return t; }
__device__ __forceinline__ int osgpr(int x) { asm volatile("" : "+s"(x)); return x; }
namespace pg8 {
constexpr int BM = 256, BK = 64, HALF = 128, HTB = HALF * BK * 2, STAGE_BYTES = 8 * HTB, NXCD = 8, WGM = 8;
__host__ __device__ __forceinline__ int lds_byte(int r, int c) { const int st = (r >> 4) * 2 + (c >> 5), rr = r & 15, cc = c & 31, ob = rr * 64 + cc * 2; return st * 1024 + (ob ^ (((ob >> 9) & 1) << 5)); }
__host__ __device__ __forceinline__ void stage_rc(int b, int& R, int& C) { const int st = b / 1024, sb = b % 1024, swz = sb ^ (((sb >> 9) & 1) << 5); R = (st >> 1) * 16 + swz / 64; C = (st & 1) * 32 + (swz % 64) / 2; }
struct Unit { int pm, pn, k0; };
struct Gemm { const bf16_t* A; const bf16_t* Bt; int M, N, K, nt; };
struct StaticOrder {
    int nM, nN, nwg, G, c, pm0;
    __host__ __device__ void init(int M, int N, int G_, int c_, int pm0_ = 0) { nM = M / BM; nN = N / BM; nwg = nM * nN; G = G_; c = c_; pm0 = pm0_; }
    __host__ __device__ bool next(int i, Unit& u) const {
        const long Lx = (long)i * G + c; if (Lx >= nwg) return false;
        int wgid = (int)Lx; { const int q = nwg / NXCD, r = nwg % NXCD, xcd = wgid % NXCD, off = wgid / NXCD; wgid = (xcd < r ? xcd * (q + 1) : r * (q + 1) + (xcd - r) * q) + off; }
        const int nig = WGM * nN, gid = wgid / nig, fm = gid * WGM, gsz = (nM - fm) < WGM ? (nM - fm) : WGM;
        u.pm = pm0 + fm + ((wgid % nig) % gsz); u.pn = (wgid % nig) / gsz; u.k0 = 0; return true;
    }
};
struct SplitOrder {
    int nN, nunits, G, c, nt;
    __host__ __device__ void init(int N, int K, int nt_, int G_, int c_) { nN = N / BM; nt = nt_; nunits = nN * (K / BK / nt_); G = G_; c = c_; }
    __host__ __device__ bool next(int i, Unit& u) const {
        const int idx = i * G + c; if (idx >= nunits) return false;
        u.pm = 0; u.pn = idx % nN; u.k0 = (idx / nN) * nt; return true;
    }
};
template <class Epi, class Ord>
__device__ __forceinline__ void gemm_phase(LAS unsigned char* lds, const Gemm g, const Ord& S, const Epi& E) {
#ifdef NO_GEMM
    return;
#endif
    const int tid = otid(), wid = __builtin_amdgcn_readfirstlane(tid >> 6), lane = tid & 63, wr = wid >> 2, wc = wid & 3, fr = lane & 15, fq = lane >> 4;
    const int K = g.K, nt = g.nt;
    unsigned voffA[2];
#pragma unroll
    for (int i = 0; i < 2; ++i) { int R, C; stage_rc(tid * 16 + i * 8192, R, C); voffA[i] = (unsigned)(R * K + C) * 2u; }
    const size_t kstep = (size_t)(BK * 2);
    const size_t hstep = (size_t)HALF * K * 2;
    const size_t tstep = 2 * hstep;
    const unsigned ldsw = (unsigned)wid * 1024u;
    const int aoff = lds_byte(wr * 64 + fr, fq * 8), boff = lds_byte(wc * 32 + fr, fq * 8);
#define PG8_SA(b, h) (((b) * 2 + (h)) * HTB)
#define PG8_SB(b, h) ((4 + (b) * 2 + (h)) * HTB)
#define PG8_STAGE(bufoff, gbase, voff) do { _Pragma("unroll") for (int _i = 0; _i < 2; ++_i) \
        __builtin_amdgcn_global_load_lds((const unsigned*)((const char*)(gbase) + (voff)[_i]), (LAS unsigned*)(lds + (bufoff) + ldsw + _i * 8192), 16, 0, 0); } while (0)
#define PG8_LDA(dst, b, h) do { _Pragma("unroll") for (int m = 0; m < 4; ++m) _Pragma("unroll") for (int k = 0; k < 2; ++k) dst[m][k] = *(const LAS bf16x8*)(lds + PG8_SA(b, h) + aoff + m * 2048 + k * 1024); } while (0)
#define PG8_LDB(dst, b, h) do { _Pragma("unroll") for (int n = 0; n < 2; ++n) _Pragma("unroll") for (int k = 0; k < 2; ++k) dst[n][k] = *(const LAS bf16x8*)(lds + PG8_SB(b, h) + boff + n * 2048 + k * 1024); } while (0)
#define PG8_MMA(ai, bj, At, Bt) do { __builtin_amdgcn_s_setprio(1); _Pragma("unroll") for (int m = 0; m < 4; ++m) _Pragma("unroll") for (int n = 0; n < 2; ++n) _Pragma("unroll") for (int k = 0; k < 2; ++k) \
        acc[ai][bj][m][n] = __builtin_amdgcn_mfma_f32_16x16x32_bf16(Bt[n][k], At[m][k], acc[ai][bj][m][n], 0, 0, 0); __builtin_amdgcn_s_setprio(0); } while (0)
#define PG8_WAIT_V(n) asm volatile("s_waitcnt vmcnt(" #n ")" ::: "memory")
#define PG8_WAIT_L(n) asm volatile("s_waitcnt lgkmcnt(" #n ")" ::: "memory")
#define PG8_BAR __builtin_amdgcn_s_barrier()
#define PG8_SCHED __builtin_amdgcn_sched_barrier(0)
    Unit cur, nxt; int ui = 0;
    if (!S.next(0, cur)) return;
    f32x4 acc[2][2][4][2];
#pragma unroll
    for (int a = 0; a < 2; ++a)
#pragma unroll
        for (int b = 0; b < 2; ++b)
#pragma unroll
            for (int m = 0; m < 4; ++m)
#pragma unroll
                for (int n = 0; n < 2; ++n) acc[a][b][m][n] = (f32x4){0.f, 0.f, 0.f, 0.f};
    bf16x8 At[4][2], B0[2][2], B1[2][2];
    const size_t kstep0 = (size_t)(BK * 2);
    const char* cA = (const char*)g.A + (size_t)cur.pm * tstep + (size_t)cur.k0 * kstep0; const char* cB = (const char*)g.Bt + (size_t)cur.pn * tstep + (size_t)cur.k0 * kstep0;
    PG8_STAGE(PG8_SB(0, 0), cB, voffA); PG8_STAGE(PG8_SA(0, 0), cA, voffA); PG8_STAGE(PG8_SB(0, 1), cB + hstep, voffA); PG8_STAGE(PG8_SA(0, 1), cA + hstep, voffA);
    if (wr == 1) PG8_BAR;
    PG8_WAIT_V(4); PG8_BAR;
    PG8_STAGE(PG8_SB(1, 0), cB + kstep, voffA); PG8_STAGE(PG8_SA(1, 0), cA + kstep, voffA); PG8_STAGE(PG8_SB(1, 1), cB + hstep + kstep, voffA);
    PG8_WAIT_V(6); PG8_BAR;
    for (;;) {
        const bool has_next = S.next(ui + 1, nxt);
        const char* nA = has_next ? (const char*)g.A + (size_t)nxt.pm * tstep + (size_t)nxt.k0 * kstep0 : cA; const char* nB = has_next ? (const char*)g.Bt + (size_t)nxt.pn * tstep + (size_t)nxt.k0 * kstep0 : cB;
        for (int t = 0; t < nt; t += 2) {
            const bool last = (t == nt - 2);
            const char* a1 = cA + (size_t)(t + 1) * kstep;
            const char* a2 = last ? nA : cA + (size_t)(t + 2) * kstep; const char* b2 = last ? nB : cB + (size_t)(t + 2) * kstep;
            const char* a3 = a2 + kstep; const char* b3 = b2 + kstep;
            PG8_LDB(B0, 0, 0); PG8_SCHED; PG8_LDA(At, 0, 0); PG8_STAGE(PG8_SA(1, 1), a1 + hstep, voffA);
            PG8_WAIT_L(8); PG8_BAR; PG8_WAIT_L(0); PG8_MMA(0, 0, At, B0); PG8_BAR; PG8_SCHED;
            PG8_LDB(B1, 0, 1); PG8_STAGE(PG8_SB(0, 0), b2, voffA);
            PG8_BAR; PG8_WAIT_L(0); PG8_MMA(0, 1, At, B1); PG8_BAR;
            PG8_LDA(At, 0, 1); PG8_STAGE(PG8_SA(0, 0), a2, voffA);
            PG8_BAR; PG8_WAIT_L(0); PG8_MMA(1, 0, At, B0); PG8_BAR; PG8_SCHED;
            PG8_STAGE(PG8_SB(0, 1), b2 + hstep, voffA);
            PG8_WAIT_V(6); PG8_BAR; PG8_MMA(1, 1, At, B1); PG8_BAR;
            PG8_LDB(B0, 1, 0); PG8_SCHED; PG8_LDA(At, 1, 0); PG8_STAGE(PG8_SA(0, 1), a2 + hstep, voffA);
            PG8_WAIT_L(8); PG8_BAR; PG8_WAIT_L(0); PG8_MMA(0, 0, At, B0); PG8_BAR; PG8_SCHED;
            PG8_LDB(B1, 1, 1); PG8_STAGE(PG8_SB(1, 0), b3, voffA);
            PG8_BAR; PG8_WAIT_L(0); PG8_MMA(0, 1, At, B1); PG8_BAR;
            PG8_LDA(At, 1, 1); PG8_STAGE(PG8_SA(1, 0), a3, voffA);
            PG8_BAR; PG8_WAIT_L(0); PG8_MMA(1, 0, At, B0); PG8_BAR; PG8_SCHED;
            PG8_STAGE(PG8_SB(1, 1), b3 + hstep, voffA);
            PG8_WAIT_V(6); PG8_BAR; PG8_MMA(1, 1, At, B1); PG8_BAR;
        }
        E(acc, cur, wr, wc, fr, fq);
        if (!has_next) break;
#pragma unroll
        for (int a = 0; a < 2; ++a)
#pragma unroll
            for (int b = 0; b < 2; ++b)
#pragma unroll
                for (int m = 0; m < 4; ++m)
#pragma unroll
                    for (int n = 0; n < 2; ++n) acc[a][b][m][n] = (f32x4){0.f, 0.f, 0.f, 0.f};
        cur = nxt; cA = nA; cB = nB; ++ui;
    }
    PG8_WAIT_V(0);
    if (wr == 0) PG8_BAR;
    PG8_BAR;
#undef PG8_SA
#undef PG8_SB
#undef PG8_STAGE
#undef PG8_LDA
#undef PG8_LDB
#undef PG8_MMA
#undef PG8_WAIT_V
#undef PG8_WAIT_L
#undef PG8_BAR
#undef PG8_SCHED
}
}
using pg8::Unit;

#define EPI_LOOP_ROWS for (int ai = 0; ai < 2; ++ai) for (int m = 0; m < 4; ++m)
#define EPI_LOOP_COLS for (int bj = 0; bj < 2; ++bj) for (int n = 0; n < 2; ++n)
struct EpiInMain {
    bf16_t* R; bf16_t* PG;
    __device__ __forceinline__ void operator()(const f32x4 (&acc)[2][2][4][2], const Unit& u, int wr, int wc, int fr, int fq) const {
        bf16_t* dst; int ld, c0;
        if (u.pn < 8) { dst = R; ld = R_LD; c0 = u.pn * 256; } else { dst = PG; ld = PG_LD; c0 = (u.pn - 8) * 256; }
        const int row0 = u.pm * 256 + wr * 64 + fr, col0 = c0 + wc * 32 + 4 * fq;
#pragma unroll
        EPI_LOOP_ROWS { bf16_t* rowp = dst + (size_t)(row0 + ai * 128 + m * 16) * ld + col0;
#pragma unroll
            EPI_LOOP_COLS { const f32x4 v = acc[ai][bj][m][n]; *(u32x2*)(rowp + bj * 128 + n * 16) = (u32x2){pk2(v[0], v[1]), pk2(v[2], v[3])}; } }
    }
};
struct EpiGates {
    bf16_t* G;
    __device__ __forceinline__ void operator()(const f32x4 (&acc)[2][2][4][2], const Unit& u, int wr, int wc, int fr, int fq) const {
        const int row0 = u.pm * 256 + wr * 64 + fr, col0 = u.pn * 256 + wc * 32 + 4 * fq;
#pragma unroll
        EPI_LOOP_ROWS { bf16_t* rowp = G + (size_t)(row0 + ai * 128 + m * 16) * 3072 + col0;
#pragma unroll
            EPI_LOOP_COLS { const f32x4 v = acc[ai][bj][m][n];
                *(u32x2*)(rowp + bj * 128 + n * 16) = (u32x2){pk2(sigmoid_(v[0]), sigmoid_(v[1])), pk2(sigmoid_(v[2]), sigmoid_(v[3]))}; } }
    }
};
template <int GI> struct EpiBranch {
    const bf16_t* G; float* MG; bf16_t* MB;
    __device__ __forceinline__ void operator()(const f32x4 (&acc)[2][2][4][2], const Unit& u, int wr, int wc, int fr, int fq) const {
        const int row0 = u.pm * 256 + wr * 64 + fr, col0 = u.pn * 256 + wc * 32 + 4 * fq;
#pragma unroll
        EPI_LOOP_ROWS { const size_t row = (size_t)(row0 + ai * 128 + m * 16);
#pragma unroll
            EPI_LOOP_COLS { const int col = col0 + bj * 128 + n * 16; const f32x4 v = acc[ai][bj][m][n];
                const u32x2 gq = *(const u32x2*)(G + row * 3072 + GI * 1024 + col);
                f32x4 gv = (f32x4){__uint_as_float(gq[0] << 16), __uint_as_float(gq[0] & 0xffff0000u), __uint_as_float(gq[1] << 16), __uint_as_float(gq[1] & 0xffff0000u)};
                f32x4 r = v * gv;
                if (GI > 0) r += *(const f32x4*)(MG + row * 1024 + col);
                if (GI < 2) *(f32x4*)(MG + row * 1024 + col) = r;
                else *(u32x2*)(MB + row * 1024 + col) = (u32x2){pk2(r[0], r[1]), pk2(r[2], r[3])}; } }
    }
};
struct EpiResid {
    float* H; const float* gate_lat; const float* gate_ctx;
    __device__ __forceinline__ void operator()(const f32x4 (&acc)[2][2][4][2], const Unit& u, int wr, int wc, int fr, int fq) const {
        const int row0 = u.pm * 256 + wr * 64 + fr, col0 = u.pn * 256 + wc * 32 + 4 * fq;
        const float* gp = (u.pm == 0) ? gate_ctx : gate_lat;
        f32x4 gv[2][2];
#pragma unroll
        EPI_LOOP_COLS gv[bj][n] = *(const f32x4*)(gp + col0 + bj * 128 + n * 16);
#pragma unroll
        EPI_LOOP_ROWS { float* rowp = H + (size_t)(row0 + ai * 128 + m * 16) * 1024 + col0;
#pragma unroll
            EPI_LOOP_COLS { f32x4* q = (f32x4*)(rowp + bj * 128 + n * 16); *q = *q + acc[ai][bj][m][n] * gv[bj][n]; } }
    }
};
struct EpiLora {
    bf16_t* B; bf16_t* RWG; const float* w0; const float* a0;
    __device__ __forceinline__ void operator()(const f32x4 (&acc)[2][2][4][2], const Unit& u, int wr, int wc, int fr, int fq) const {
        const int row0 = u.pm * 256 + wr * 64 + fr, blk = u.pn >> 1, cbase = (u.pn & 1) * 256 + wc * 32 + 4 * fq;
        f32x4 bv[2][2];
#pragma unroll
        EPI_LOOP_COLS { const int cc = cbase + bj * 128 + n * 16;
            bv[bj][n] = blk < 2 ? *(const f32x4*)(w0 + blk * 512 + cc) : (blk < 4 ? *(const f32x4*)(a0 + (blk - 2) * 512 + cc) : (f32x4){0.f, 0.f, 0.f, 0.f}); }
        bf16_t* dst; int ld;
        if (blk < 2) { dst = B + 3072 + blk * 512; ld = 4096; } else if (blk < 4) { dst = B + 2048 + (blk - 2) * 512; ld = 4096; } else { dst = RWG; ld = 512; }
#pragma unroll
        EPI_LOOP_ROWS { bf16_t* rowp = dst + (size_t)(row0 + ai * 128 + m * 16) * ld + cbase;
#pragma unroll
            EPI_LOOP_COLS { f32x4 v = acc[ai][bj][m][n] + bv[bj][n];
                if (blk < 2) {
#pragma unroll
                    for (int j = 0; j < 4; ++j) { const float x = -v[j]; const float sp = fmaxf(x, 0.f) + __logf(1.f + __expf(-fabsf(x))); v[j] = 1.f - __expf(-__expf(-sp - 0.5f)); }
                } else if (blk < 4) {
#pragma unroll
                    for (int j = 0; j < 4; ++j) v[j] = sigmoid_(v[j]);
                }
                *(u32x2*)(rowp + bj * 128 + n * 16) = (u32x2){pk2(v[0], v[1]), pk2(v[2], v[3])}; } }
    }
};
struct EpiResidAtomic {
    float* H; const float* gate_ctx;
    __device__ __forceinline__ void operator()(const f32x4 (&acc)[2][2][4][2], const Unit& u, int wr, int wc, int fr, int fq) const {
        const int row0 = u.pm * 256 + wr * 64 + fr, col0 = u.pn * 256 + wc * 32 + 4 * fq;
        const float* gp = gate_ctx + col0;
#pragma unroll
        EPI_LOOP_ROWS { float* rowp = H + (size_t)(row0 + ai * 128 + m * 16) * 1024 + col0;
#pragma unroll
            EPI_LOOP_COLS { const f32x4 v = acc[ai][bj][m][n] * *(const f32x4*)(gp + bj * 128 + n * 16); float* q = rowp + bj * 128 + n * 16;
                unsafeAtomicAdd(q, v[0]); unsafeAtomicAdd(q + 1, v[1]); unsafeAtomicAdd(q + 2, v[2]); unsafeAtomicAdd(q + 3, v[3]); }
            asm volatile("" ::: "memory"); }
    }
};
struct EpiMlp1 {
    bf16_t* U;
    __device__ __forceinline__ void operator()(const f32x4 (&acc)[2][2][4][2], const Unit& u, int wr, int wc, int fr, int fq) const {
        const int row0 = u.pm * 256 + wr * 64 + fr, col0 = u.pn * 256 + wc * 32 + 4 * fq;
#pragma unroll
        EPI_LOOP_ROWS { bf16_t* rowp = U + (size_t)(row0 + ai * 128 + m * 16) * 4096 + col0;
#pragma unroll
            EPI_LOOP_COLS { f32x4 v = acc[ai][bj][m][n];
#pragma unroll
                for (int j = 0; j < 4; ++j) { const float t = fmaxf(v[j], 0.f); v[j] = t * t; }
                *(u32x2*)(rowp + bj * 128 + n * 16) = (u32x2){pk2(v[0], v[1]), pk2(v[2], v[3])}; } }
    }
};

__device__ __forceinline__ void convert_T(const float* src, int ld, int K, int n0, int ncols, bf16_t* dst, LAS float* tile, int wg, int nwg) {
    const int ntn = (ncols + 63) >> 6, ntk = K >> 6, tid = otid();
    for (int t = wg; t < ntn * ntk; t += nwg) {
        const int tn = t / ntk, tk = t - tn * ntk, k0 = tk * 64, nb = tn * 64;
#pragma unroll
        for (int i = 0; i < 2; ++i) { const int idx = tid + i * 512, kk = idx >> 4, n4 = (idx & 15) * 4;
            f32x4 v = (f32x4){0.f, 0.f, 0.f, 0.f};
            if (nb + n4 < ncols) v = *(const f32x4*)(src + (size_t)(k0 + kk) * ld + n0 + nb + n4);
            tile[kk * 65 + n4 + 0] = v[0]; tile[kk * 65 + n4 + 1] = v[1]; tile[kk * 65 + n4 + 2] = v[2]; tile[kk * 65 + n4 + 3] = v[3]; }
        __syncthreads();
        { const int nn = tid >> 3, k8 = (tid & 7) * 8;
          if (nb + nn < ncols) { const LAS float* s = tile + k8 * 65 + nn;
              u32x4 o; o[0] = pk2(s[0], s[65]); o[1] = pk2(s[130], s[195]); o[2] = pk2(s[260], s[325]); o[3] = pk2(s[390], s[455]);
              *(u32x4*)(dst + (size_t)(nb + nn) * K + k0 + k8) = o; } }
        __syncthreads();
    }
}

__device__ __forceinline__ void phase_mod(const P& p, LAS unsigned char* lds) {
    const float* c = p.in[I_C]; const float* cc = p.in[I_CCTX]; const float* wm = p.in[I_WMOD]; const float* bm = p.in[I_BMOD];
    float* MOD = (float*)(p.ws + OFF_MOD);
    LAS float* red = (LAS float*)lds;
    const int tid = otid();
    for (int blk = blockIdx.x; blk < 256; blk += gridDim.x) {
        const int l = blk >> 6, col0 = (blk & 63) * 96;
        if (tid < 384) {
            const int cgp = tid % 24, ks = tid / 24;
            f32x4 a0 = (f32x4){0.f, 0.f, 0.f, 0.f}, a1 = a0;
            const float* w = wm + (size_t)l * 1024 * 6144 + col0 + cgp * 4;
#pragma unroll 8
            for (int k = ks * 64; k < ks * 64 + 64; ++k) {
                const f32x4 wv = *(const f32x4*)(w + (size_t)k * 6144);
                const float s0 = silu_(c[k]), s1 = silu_(cc[k]);
                a0 += wv * s0; a1 += wv * s1;
            }
            LAS f32x4* r4 = (LAS f32x4*)red;
            r4[(ks * 24 + cgp) * 2 + 0] = a0; r4[(ks * 24 + cgp) * 2 + 1] = a1;
        }
        __syncthreads();
        if (tid < 192) {
            const int col = tid % 96, s = tid / 96;
            float sum = 0.f;
#pragma unroll
            for (int k2 = 0; k2 < 16; ++k2) sum += red[((k2 * 24 + (col >> 2)) * 2 + s) * 4 + (col & 3)];
            MOD[((size_t)l * 2 + s) * 6144 + col0 + col] = sum + bm[l * 6144 + col0 + col];
        }
        __syncthreads();
    }
}

template <bool FROM_INPUT>
__device__ __forceinline__ void phase_norm(const P& p, int l, const float* gamma, int shift_idx, int scale_idx) {
    float* H = (float*)(p.ws + OFF_H); bf16_t* HN = (bf16_t*)(p.ws + OFF_HN);
    const float* MOD = (const float*)(p.ws + OFF_MOD) + (size_t)l * 2 * 6144;
    const int tid_ = otid(); const int wave = tid_ >> 6, lane = tid_ & 63;
    for (int row = blockIdx.x * 8 + wave; row < L; row += gridDim.x * 8) {
        const float* src = FROM_INPUT ? (row < NCTX ? p.in[I_CTX] + (size_t)row * 1024 : p.in[I_X] + (size_t)(row - NCTX) * 1024) : H + (size_t)row * 1024;
        f32x4 v[4]; float ss = 0.f;
#pragma unroll
        for (int j = 0; j < 4; ++j) { v[j] = *(const f32x4*)(src + j * 256 + lane * 4); ss += (v[j][0] * v[j][0] + v[j][1] * v[j][1]) + (v[j][2] * v[j][2] + v[j][3] * v[j][3]); }
        ss = wave_sum(ss);
        const float rstd = rsqrtf(ss * (1.f / 1024.f) + 1e-6f);
        const float* m = MOD + (row < NCTX ? 6144 : 0);
#pragma unroll
        for (int j = 0; j < 4; ++j) { const int col = j * 256 + lane * 4;
            const f32x4 g = *(const f32x4*)(gamma + col), sh = *(const f32x4*)(m + shift_idx * 1024 + col), sc = *(const f32x4*)(m + scale_idx * 1024 + col);
            const f32x4 o = v[j] * rstd * g * (sc + 1.f) + sh;
            *(u32x2*)(HN + (size_t)row * 1024 + col) = (u32x2){pk2(o[0], o[1]), pk2(o[2], o[3])};
            if (FROM_INPUT) *(f32x4*)(H + (size_t)row * 1024 + col) = v[j]; }
    }
}

constexpr int TT = 13;
__device__ __forceinline__ void phase_prep(const P& p, int l, LAS unsigned char* lds) {
    const bf16_t* R = (const bf16_t*)(p.ws + OFF_R); const bf16_t* PG = (const bf16_t*)(p.ws + OFF_PG);
    bf16_t* B = (bf16_t*)(p.ws + OFF_B); bf16_t* XL = (bf16_t*)(p.ws + OFF_XL);
    bf16_t* GLAD = (bf16_t*)(p.ws + OFF_GLAD); bf16_t* GDNC = (bf16_t*)(p.ws + OFF_GDNC); float* GDNGB = (float*)(p.ws + OFF_GDNGB);
    const float* mu = p.in[I_RWMU] + (size_t)l * 2 * 1920;
    const float* kkw = p.in[I_RWKK] + l * 512;
    const float* ga2 = p.in[I_GLAA2] + (size_t)l * 2 * 16 * 256; const float* gab = p.in[I_GLAAB] + l * 512;
    const float* cw = p.in[I_GDNCONV] + (size_t)l * 5 * 1536; const float* alog = p.in[I_GDNALOG] + l * 8; const float* dtb = p.in[I_GDNDT] + l * 8;
    LAS float* gal = (LAS float*)lds;
    LAS float* red = gal + TT * 32;
    const int tid = otid(), wave = tid >> 6;
    const int c = tid;
    const int gz = tid >> 8, gk = tid & 255;
    for (int tile = blockIdx.x; tile < L / TT; tile += gridDim.x) {
        const int t0 = tile * TT;
        if (tid < TT * 32) { const int tt = tid >> 5, e = tid & 31; gal[tt * 32 + e] = bf2f(PG[(size_t)(t0 + tt) * PG_LD + GLA_AL + e]); }
        {
            float xr[TT + 2], xk[TT + 2], xv[TT + 2], xe[TT + 2];
#pragma unroll
            for (int i = 0; i < TT + 2; ++i) { const int rr = t0 - 1 + i;
                if (rr >= 0 && rr < L) { const bf16_t* rp = R + (size_t)rr * R_LD + c; xr[i] = bf2f(rp[0]); xk[i] = bf2f(rp[512]); xv[i] = bf2f(rp[1024]); xe[i] = (c < 384) ? bf2f(rp[1536]) : 0.f; }
                else { xr[i] = 0.f; xk[i] = 0.f; xv[i] = 0.f; xe[i] = 0.f; } }
            const float mr0 = mu[c], mr1 = mu[1920 + c], mk0 = mu[512 + c], mk1 = mu[1920 + 512 + c], mv0 = mu[1024 + c], mv1 = mu[1920 + 1024 + c];
            const float me0 = (c < 384) ? mu[1536 + c] : 0.f, me1 = (c < 384) ? mu[1920 + 1536 + c] : 0.f;
            const float kkc = kkw[c];
#pragma unroll
            for (int tt = 0; tt < TT; ++tt) {
                const int t = t0 + tt;
                const float hp = (t != 0 && t != NCTX) ? 1.f : 0.f, hn = (t != NCTX - 1 && t != L - 1) ? 1.f : 0.f;
                const float r = mr0 * hp * xr[tt] + (1.f - mr0 - mr1) * xr[tt + 1] + mr1 * hn * xr[tt + 2];
                const float k = mk0 * hp * xk[tt] + (1.f - mk0 - mk1) * xk[tt + 1] + mk1 * hn * xk[tt + 2];
                const float v = mv0 * hp * xv[tt] + (1.f - mv0 - mv1) * xv[tt + 1] + mv1 * hn * xv[tt + 2];
                float e = me0 * hp * xe[tt] + (1.f - me0 - me1) * xe[tt + 1] + me1 * hn * xe[tt + 2];
                if (c < 128) e = tanhf(e); else if (c >= 256 && c < 384) e = sigmoid_(e); else if (c >= 384) e = 0.f;
                const float kr = k * kkc;
                const float ssq = wave_sum(kr * kr);
                bf16_t* bp = B + (size_t)t * 4096 + c;
                bp[0] = f2bf(r); bp[512] = f2bf(k); bp[1024] = f2bf(v); bp[1536] = f2bf(kr * rsqrtf(ssq + 1e-12f));
                XL[(size_t)t * 512 + c] = f2bf(e);
            }
        }
        __syncthreads();
        {
        float ga2v[16];
#pragma unroll
        for (int e = 0; e < 16; ++e) ga2v[e] = ga2[(gz * 16 + e) * 256 + gk];
        const float gabv = gab[gz * 256 + gk];
#pragma unroll
        for (int tt = 0; tt < TT; ++tt) {
            float zv = gabv;
#pragma unroll
            for (int e = 0; e < 16; ++e) zv += gal[tt * 32 + gz * 16 + e] * ga2v[e];
            const float la = -softplus_(-zv) * (1.f / 16.f);
            GLAD[(size_t)(t0 + tt) * 512 + tid] = f2bf(-expm1f(la));
        }
        }
        {
            float cwv[5], xv[TT + 4];
#pragma unroll
            for (int i = 0; i < 5; ++i) cwv[i] = cw[i * 1536 + 1024 + c];
#pragma unroll
            for (int i = 0; i < TT + 4; ++i) { const int rr = t0 - 2 + i; xv[i] = (rr >= 0 && rr < L) ? bf2f(PG[(size_t)rr * PG_LD + GDN_QKV + 1024 + c]) : 0.f; }
#pragma unroll
            for (int tt = 0; tt < TT; ++tt) { const int t = t0 + tt; float sv = 0.f;
#pragma unroll
                for (int i = 0; i < 5; ++i) { const int rr = t + i - 2; const bool ok_ = (rr >= 0) && (rr < L) && ((rr < NCTX) == (t < NCTX)); if (ok_) sv += xv[tt + i] * cwv[i]; }
                GDNC[(size_t)t * 1536 + 1024 + c] = f2bf(silu_(sv)); }
        }
        float oq[TT], ok[TT];
        {
            float cwq[5], cwk[5], xq[TT + 4], xk[TT + 4];
#pragma unroll
            for (int i = 0; i < 5; ++i) { cwq[i] = cw[i * 1536 + c]; cwk[i] = cw[i * 1536 + 512 + c]; }
#pragma unroll
            for (int i = 0; i < TT + 4; ++i) { const int rr = t0 - 2 + i;
                if (rr >= 0 && rr < L) { const bf16_t* rp = PG + (size_t)rr * PG_LD + GDN_QKV + c; xq[i] = bf2f(rp[0]); xk[i] = bf2f(rp[512]); } else { xq[i] = 0.f; xk[i] = 0.f; } }
#pragma unroll
            for (int tt = 0; tt < TT; ++tt) {
                const int t = t0 + tt; float sq = 0.f, sk = 0.f;
#pragma unroll
                for (int i = 0; i < 5; ++i) { const int rr = t + i - 2; const bool ok_ = (rr >= 0) && (rr < L) && ((rr < NCTX) == (t < NCTX));
                    if (ok_) { sq += xq[tt + i] * cwq[i]; sk += xk[tt + i] * cwk[i]; } }
                oq[tt] = silu_(sq); ok[tt] = silu_(sk);
                const float pq = wave_sum(oq[tt] * oq[tt]), pk = wave_sum(ok[tt] * ok[tt]);
                if ((tid & 63) == 0) { red[(tt * 8 + wave) * 2 + 0] = pq; red[(tt * 8 + wave) * 2 + 1] = pk; }
            }
        }
        __syncthreads();
#pragma unroll
        for (int tt = 0; tt < TT; ++tt) {
            const int w0i = (wave >> 1) * 2;
            const float ssq = red[(tt * 8 + w0i) * 2 + 0] + red[(tt * 8 + w0i + 1) * 2 + 0], ssk = red[(tt * 8 + w0i) * 2 + 1] + red[(tt * 8 + w0i + 1) * 2 + 1];
            bf16_t* gp = GDNC + (size_t)(t0 + tt) * 1536 + c;
            gp[0] = f2bf(oq[tt] * rsqrtf(ssq + 1e-12f) * 0.08838834764831845f); gp[512] = f2bf(ok[tt] * rsqrtf(ssk + 1e-12f));
        }
        if (tid < TT * 16) { const int tt = tid >> 4, j = tid & 15, t = t0 + tt;
            float o;
            if (j < 8) { const float a = bf2f(PG[(size_t)t * PG_LD + GDN_A + j]); o = __expf(-__expf(alog[j]) * softplus_(a + dtb[j])); }
            else o = sigmoid_(bf2f(PG[(size_t)t * PG_LD + GDN_B + (j - 8)]));
            GDNGB[t * 16 + j] = o; }
        __syncthreads();
    }
}
__device__ __forceinline__ void build_wl(const P& p, int l, int wg, int nwg) {
    const float* w2 = p.in[I_RWW2] + (size_t)l * 2 * 64 * 512; const float* a2 = p.in[I_RWA2] + (size_t)l * 2 * 64 * 512; const float* g2 = p.in[I_RWG2] + (size_t)l * 128 * 512;
    bf16_t* WL = (bf16_t*)(p.ws + OFF_WL);
    const int tid = otid();
    for (int it = wg * 512 + tid; it < 2560 * 64; it += nwg * 512) {
        const int kc = it / 2560, n = it - kc * 2560, k0 = kc * 8, blk = n >> 9, cc = n & 511;
        const float* src = nullptr; int kb = 0, kn = 0;
        if (blk == 0) { src = w2; kb = 0; kn = 64; } else if (blk == 1) { src = w2 + 64 * 512; kb = 64; kn = 64; }
        else if (blk == 2) { src = a2; kb = 128; kn = 64; } else if (blk == 3) { src = a2 + 64 * 512; kb = 192; kn = 64; }
        else { src = g2; kb = 256; kn = 128; }
        float v[8];
#pragma unroll
        for (int j = 0; j < 8; ++j) { const int k = k0 + j - kb; v[j] = (k >= 0 && k < kn) ? src[(size_t)k * 512 + cc] : 0.f; }
        u32x4 o; o[0] = pk2(v[0], v[1]); o[1] = pk2(v[2], v[3]); o[2] = pk2(v[4], v[5]); o[3] = pk2(v[6], v[7]);
        *(u32x4*)(WL + (size_t)n * 512 + k0) = o;
    }
}

constexpr int TB = 32, NBLK = L / TB;
__device__ __forceinline__ int tok_seq(int z, int j) { return z == 0 ? j : (j < NCTX ? NCTX - 1 - j : L - 1 - (j - NCTX)); }
__device__ __forceinline__ int tok_gla(int z, int j) {
    if (j < NCTX) return z == 0 ? j : NCTX - 1 - j;
    const int jj = j - NCTX, pp = z == 0 ? jj : NLAT - 1 - jj;
    return NCTX + (pp & 255) * 64 + (pp >> 8);
}

template <int NCW> struct ScanRole {
    bool cons, prod; int ct;
    __device__ __forceinline__ ScanRole(int tid) {
        const int w = tid >> 6, lane = tid & 63;
        if (NCW == 4) { cons = w < 4; prod = !cons; ct = tid & 255; }
        else { cons = w < 2; prod = (w & 2) != 0; ct = cons ? tid : ((((w >> 2) << 1) | (w & 1)) * 64 + lane); }
    }
};
__device__ __forceinline__ float rowpair_sum(float x) {
    const unsigned u = __float_as_uint(x); auto r = __builtin_amdgcn_permlane16_swap(u, u, false, false);
    return __uint_as_float(r[0]) + __uint_as_float(r[1]);
}
#define SCAN_BARRIER() asm volatile("s_waitcnt lgkmcnt(0)\n\ts_barrier" ::: "memory")
__device__ __forceinline__ float bfraw2f(unsigned short b) { return __uint_as_float(((unsigned)b) << 16); }

__device__ __forceinline__ void scan_rwkv(const P& p, int l, int unit, LAS unsigned char* lds) {
    const int z = unit >> 5, h = (unit >> 2) & 7, rq = unit & 3;
    const bf16_t* B = (const bf16_t*)(p.ws + OFF_B); bf16_t* Y = (bf16_t*)(p.ws + OFF_PG) + YRW_COL + z * 512 + h * 64 + rq * 16;
    const float* kaw = p.in[I_RWKA] + l * 512 + h * 64;
    LAS float* vec = (LAS float*)lds;
    LAS float* vv = vec + 2 * TB * 320;
    LAS float* yo = vv + 2 * TB * 16;
    const int tid = otid(); const ScanRole<4> role(tid); const int ct = role.ct; const bool prod = role.prod, cons = role.cons;
    unsigned short pr[8], pk[8], pkk[8], pa[8], pw[8], pv[2];
    const float kac = kaw[ct & 63];
    auto p_load = [&](int blk) {
#pragma unroll
        for (int i = 0; i < 8; ++i) { const int idx = ct + i * 256, s = idx >> 6, n = idx & 63; const int t = tok_seq(z, blk * TB + s);
            const bf16_t* bp = B + (size_t)t * 4096 + h * 64 + n;
            pr[i] = bp[0]; pk[i] = bp[512]; pkk[i] = bp[1536]; pa[i] = bp[2048 + z * 512]; pw[i] = bp[3072 + z * 512]; }
#pragma unroll
        for (int i = 0; i < 2; ++i) { const int idx = ct + i * 256, s = idx >> 4, r = idx & 15; const int t = tok_seq(z, blk * TB + s); pv[i] = B[(size_t)t * 4096 + 1024 + h * 64 + rq * 16 + r]; }
    };
    auto p_write = [&](int buf) {
#pragma unroll
        for (int i = 0; i < 8; ++i) { const int idx = ct + i * 256, s = idx >> 6, n = idx & 63;
            LAS float* d = vec + ((buf * TB + s) * 16 + (n >> 2)) * 20 + (n & 3);
            const float kk = bfraw2f(pkk[i]), a = bfraw2f(pa[i]);
            d[0] = kk; d[4] = 1.f - bfraw2f(pw[i]); d[8] = kk * a; d[12] = bfraw2f(pk[i]) * (1.f + (a - 1.f) * kac); d[16] = bfraw2f(pr[i]); }
#pragma unroll
        for (int i = 0; i < 2; ++i) vv[buf * TB * 16 + ct + i * 256] = bfraw2f(pv[i]);
    };
    auto p_yout = [&](int blk) {
        const int buf = blk & 1;
#pragma unroll
        for (int i = 0; i < 2; ++i) { const int idx = ct + i * 256, s = idx >> 4, r = idx & 15; const int t = tok_seq(z, blk * TB + s);
            Y[(size_t)t * PG_LD + r] = f2bf(yo[buf * TB * 16 + idx]); }
    };
    const int irow = (ct >> 4) & 15, ks = ct & 15;
    f32x2 S0 = (f32x2){0.f, 0.f}, S1 = S0;
    struct Vx { f32x4 kk, w, b, k, r; float v; };
    auto c_ld = [&](Vx& x, int buf, int s) {
        const LAS float* d = vec + ((buf * TB + s) * 16 + ks) * 20;
        x.kk = *(const LAS f32x4*)(d); x.w = *(const LAS f32x4*)(d + 4); x.b = *(const LAS f32x4*)(d + 8); x.k = *(const LAS f32x4*)(d + 12);
        x.r = *(const LAS f32x4*)(d + 16); x.v = vv[(buf * TB + s) * 16 + irow];
    };
    float sa = 0.f;
    auto c_step = [&](const Vx& x, const f32x4& kkn, int buf, int s) {
        const f32x2 vv2 = (f32x2){x.v, x.v}, nsa = (f32x2){-sa, -sa};
        S0 = S0 * (f32x2){x.w[0], x.w[1]} + (vv2 * (f32x2){x.k[0], x.k[1]} + nsa * (f32x2){x.b[0], x.b[1]});
        S1 = S1 * (f32x2){x.w[2], x.w[3]} + (vv2 * (f32x2){x.k[2], x.k[3]} + nsa * (f32x2){x.b[2], x.b[3]});
        const f32x2 y2 = S0 * (f32x2){x.r[0], x.r[1]} + S1 * (f32x2){x.r[2], x.r[3]};
        const f32x2 s2 = S0 * (f32x2){kkn[0], kkn[1]} + S1 * (f32x2){kkn[2], kkn[3]};
        float yp = y2[0] + y2[1], sp = s2[0] + s2[1];
        yp += dpp_<0xB1>(yp); sp += dpp_<0xB1>(sp); yp += dpp_<0x4E>(yp); sp += dpp_<0x4E>(sp);
        yp += dpp_<0x141>(yp); sp += dpp_<0x141>(sp); yp += dpp_<0x140>(yp); sp += dpp_<0x140>(sp);
        sa = sp;
        yo[(buf * TB + s) * 16 + irow] = yp;
    };
    if (prod) { p_load(0); p_write(0); p_load(1); }
    SCAN_BARRIER();
    for (int b = 0; b < NBLK; ++b) {
        if (prod) {
            if (b + 1 < NBLK) p_write((b + 1) & 1);
            if (b + 2 < NBLK) p_load(b + 2);
            if (b > 0) p_yout(b - 1);
        } else if (cons) {
            const int buf = b & 1;
            Vx xa, xb;
            c_ld(xa, buf, 0);
            { const f32x2 s2 = S0 * (f32x2){xa.kk[0], xa.kk[1]} + S1 * (f32x2){xa.kk[2], xa.kk[3]}; sa = reduce16(s2[0] + s2[1]); }
#pragma unroll
            for (int s = 0; s < TB; s += 2) {
                c_ld(xb, buf, s + 1); c_step(xa, xb.kk, buf, s);
                c_ld(xa, buf, s + 2);
                c_step(xb, xa.kk, buf, s + 1);
            }
        }
        SCAN_BARRIER();
    }
    if (prod) p_yout(NBLK - 1);
    SCAN_BARRIER();
}

__device__ __forceinline__ void scan_gla(const P& p, int l, int unit, LAS unsigned char* lds) {
    const int z = unit >> 4, h = (unit >> 2) & 3, cb = unit & 3;
    const bf16_t* PG = (const bf16_t*)(p.ws + OFF_PG); const bf16_t* GLAD = (const bf16_t*)(p.ws + OFF_GLAD);
    bf16_t* O = (bf16_t*)(p.ws + OFF_R) + z * 512 + h * 128 + cb * 32;
    LAS float* vec = (LAS float*)lds;
    LAS float* vv = vec + 2 * TB * 192;
    LAS float* yo = vv + 2 * TB * 32;
    const int tid = otid(); const ScanRole<4> role(tid); const int ct = role.ct; const bool prod = role.prod, cons = role.cons;
    unsigned short pq[8], pk[8], pa[8], pv[4];
    auto p_load = [&](int blk) {
#pragma unroll
        for (int i = 0; i < 8; ++i) { const int idx = ct + i * 256, s = idx >> 6, n = idx & 63; const int t = tok_gla(z, blk * TB + s);
            const bf16_t* bp = PG + (size_t)t * PG_LD + h * 64 + n;
            pq[i] = bp[GLA_Q]; pk[i] = bp[GLA_K]; pa[i] = GLAD[(size_t)t * 512 + z * 256 + h * 64 + n]; }
#pragma unroll
        for (int i = 0; i < 4; ++i) { const int idx = ct + i * 256, s = idx >> 5, r = idx & 31; const int t = tok_gla(z, blk * TB + s);
            pv[i] = PG[(size_t)t * PG_LD + GLA_V + h * 128 + cb * 32 + r]; }
    };
    auto p_write = [&](int buf) {
#pragma unroll
        for (int i = 0; i < 8; ++i) { const int idx = ct + i * 256, s = idx >> 6, n = idx & 63;
            LAS float* d = vec + ((buf * TB + s) * 8 + (n >> 3)) * 24 + (n & 7);
            d[0] = bfraw2f(pq[i]) * 0.125f; d[8] = bfraw2f(pk[i]); d[16] = 1.f - bfraw2f(pa[i]); }
#pragma unroll
        for (int i = 0; i < 4; ++i) vv[buf * TB * 32 + ct + i * 256] = bfraw2f(pv[i]);
    };
    auto p_yout = [&](int blk) {
        const int buf = blk & 1;
#pragma unroll
        for (int i = 0; i < 4; ++i) { const int idx = ct + i * 256, s = idx >> 5, r = idx & 31; const int t = tok_gla(z, blk * TB + s);
            O[(size_t)t * R_LD + r] = f2bf(yo[buf * TB * 32 + idx]); }
    };
    const int icol = (ct >> 3) & 31, ks = ct & 7;
    f32x2 S[4];
#pragma unroll
    for (int j = 0; j < 4; ++j) S[j] = (f32x2){0.f, 0.f};
    struct Vx { f32x4 q0, q1, k0, k1, a0, a1; float v; };
    auto c_ld = [&](Vx& x, int buf, int s) {
        const LAS float* d = vec + ((buf * TB + s) * 8 + ks) * 24;
        x.q0 = *(const LAS f32x4*)(d); x.q1 = *(const LAS f32x4*)(d + 4); x.k0 = *(const LAS f32x4*)(d + 8); x.k1 = *(const LAS f32x4*)(d + 12);
        x.a0 = *(const LAS f32x4*)(d + 16); x.a1 = *(const LAS f32x4*)(d + 20); x.v = vv[(buf * TB + s) * 32 + icol];
    };
    auto c_upd = [&](const Vx& x) -> float {
        const f32x2 vv2 = (f32x2){x.v, x.v};
        S[0] = S[0] * (f32x2){x.a0[0], x.a0[1]} + vv2 * (f32x2){x.k0[0], x.k0[1]};
        S[1] = S[1] * (f32x2){x.a0[2], x.a0[3]} + vv2 * (f32x2){x.k0[2], x.k0[3]};
        S[2] = S[2] * (f32x2){x.a1[0], x.a1[1]} + vv2 * (f32x2){x.k1[0], x.k1[1]};
        S[3] = S[3] * (f32x2){x.a1[2], x.a1[3]} + vv2 * (f32x2){x.k1[2], x.k1[3]};
        const f32x2 y2 = (S[0] * (f32x2){x.q0[0], x.q0[1]} + S[1] * (f32x2){x.q0[2], x.q0[3]}) + (S[2] * (f32x2){x.q1[0], x.q1[1]} + S[3] * (f32x2){x.q1[2], x.q1[3]});
        return y2[0] + y2[1];
    };
    if (prod) { p_load(0); p_write(0); p_load(1); }
    SCAN_BARRIER();
    for (int b = 0; b < NBLK; ++b) {
        if (prod) {
            if (b + 1 < NBLK) p_write((b + 1) & 1);
            if (b + 2 < NBLK) p_load(b + 2);
            if (b > 0) p_yout(b - 1);
        } else if (cons) {
            const int buf = b & 1;
            Vx xa, xb;
            c_ld(xa, buf, 0);
#pragma unroll
            for (int s = 0; s < TB; s += 2) {
                c_ld(xb, buf, s + 1);
                float ya = c_upd(xa);
                c_ld(xa, buf, s + 2);
                float yb = c_upd(xb);
                ya += dpp_<0xB1>(ya); yb += dpp_<0xB1>(yb); ya += dpp_<0x4E>(ya); yb += dpp_<0x4E>(yb); ya += dpp_<0x141>(ya); yb += dpp_<0x141>(yb);
                yo[(buf * TB + s) * 32 + icol] = ya; yo[(buf * TB + s + 1) * 32 + icol] = yb;
            }
        }
        SCAN_BARRIER();
    }
    if (prod) p_yout(NBLK - 1);
    SCAN_BARRIER();
}

__device__ __forceinline__ void scan_gdn(const P& p, int l, int unit, LAS unsigned char* lds) {
    const int z = unit >> 6, h = (unit >> 4) & 3, cb = unit & 15;
    const bf16_t* GDNC = (const bf16_t*)(p.ws + OFF_GDNC); const float* GDNGB = (const float*)(p.ws + OFF_GDNGB);
    bf16_t* O = (bf16_t*)(p.ws + OFF_R) + 1024 + z * 512 + h * 128 + cb * 8;
    LAS float* vec = (LAS float*)lds;
    LAS float* vv = vec + 2 * TB * 384;
    LAS float* sc = vv + 2 * TB * 8;
    LAS float* yo = sc + 2 * TB * 2;
    const int tid = otid(); const ScanRole<4> role(tid); const int ct = role.ct; const bool prod = role.prod, cons = role.cons;
    unsigned short pq[16], pk[16], pv; float psc = 0.f;
    auto p_load = [&](int blk) {
#pragma unroll
        for (int i = 0; i < 16; ++i) { const int idx = ct + i * 256, s = idx >> 7, n = idx & 127; const int t = tok_seq(z, blk * TB + s);
            const bf16_t* bp = GDNC + (size_t)t * 1536 + h * 128 + n;
            pq[i] = bp[0]; pk[i] = bp[512]; }
        { const int s = ct >> 3, r = ct & 7; const int t = tok_seq(z, blk * TB + s); pv = GDNC[(size_t)t * 1536 + 1024 + h * 128 + cb * 8 + r]; }
        if (ct < 64) { const int s = ct >> 1, w = ct & 1; const int t = tok_seq(z, blk * TB + s); psc = GDNGB[t * 16 + w * 8 + z * 4 + h]; }
    };
    auto p_write = [&](int buf) {
#pragma unroll
        for (int i = 0; i < 16; ++i) { const int idx = ct + i * 256, s = idx >> 7, n = idx & 127;
            LAS float* d = vec + ((buf * TB + s) * 32 + (n >> 2)) * 12 + (n & 3);
            d[0] = bfraw2f(pq[i]); d[4] = bfraw2f(pk[i]); }
        vv[buf * TB * 8 + ct] = bfraw2f(pv);
        if (ct < 64) sc[buf * TB * 2 + ct] = psc;
    };
    auto p_yout = [&](int blk) {
        const int buf = blk & 1; const int s = ct >> 3, r = ct & 7; const int t = tok_seq(z, blk * TB + s);
        O[(size_t)t * R_LD + r] = f2bf(yo[buf * TB * 8 + ct]);
    };
    const int icol = (ct >> 5) & 7, ks = ct & 31;
    f32x2 S0 = (f32x2){0.f, 0.f}, S1 = S0;
    struct Vx { f32x4 q, k; float v; f32x2 gb; };
    auto c_ld = [&](Vx& x, int buf, int s) {
        const LAS float* d = vec + ((buf * TB + s) * 32 + ks) * 12;
        x.q = *(const LAS f32x4*)(d); x.k = *(const LAS f32x4*)(d + 4);
        x.v = vv[(buf * TB + s) * 8 + icol]; x.gb = *(const LAS f32x2*)(sc + (buf * TB + s) * 2);
    };
    float dd = 0.f;
    auto c_step = [&](const Vx& x, const f32x4& kn, int buf, int s) {
        const float eg = x.gb[0];
        const float cc = x.gb[1] * (x.v - eg * dd);
        const f32x2 eg2 = (f32x2){eg, eg}, cc2 = (f32x2){cc, cc};
        S0 = S0 * eg2 + cc2 * (f32x2){x.k[0], x.k[1]};
        S1 = S1 * eg2 + cc2 * (f32x2){x.k[2], x.k[3]};
        const f32x2 y2 = S0 * (f32x2){x.q[0], x.q[1]} + S1 * (f32x2){x.q[2], x.q[3]};
        const f32x2 d2 = S0 * (f32x2){kn[0], kn[1]} + S1 * (f32x2){kn[2], kn[3]};
        float yp = y2[0] + y2[1], dp = d2[0] + d2[1];
        yp += dpp_<0xB1>(yp); dp += dpp_<0xB1>(dp); yp += dpp_<0x4E>(yp); dp += dpp_<0x4E>(dp);
        yp += dpp_<0x141>(yp); dp += dpp_<0x141>(dp); yp += dpp_<0x140>(yp); dp += dpp_<0x140>(dp);
        dp = rowpair_sum(dp); yp = rowpair_sum(yp);
        dd = dp;
        yo[(buf * TB + s) * 8 + icol] = yp;
    };
    if (prod) { p_load(0); p_write(0); p_load(1); }
    SCAN_BARRIER();
    for (int b = 0; b < NBLK; ++b) {
        if (prod) {
            if (b + 1 < NBLK) p_write((b + 1) & 1);
            if (b + 2 < NBLK) p_load(b + 2);
            if (b > 0) p_yout(b - 1);
        } else if (cons) {
            const int buf = b & 1;
            Vx xa, xb;
            c_ld(xa, buf, 0);
            { const f32x2 d2 = S0 * (f32x2){xa.k[0], xa.k[1]} + S1 * (f32x2){xa.k[2], xa.k[3]}; dd = rowpair_sum(reduce16(d2[0] + d2[1])); }
#pragma unroll
            for (int s = 0; s < TB; s += 2) {
                c_ld(xb, buf, s + 1); c_step(xa, xb.k, buf, s);
                c_ld(xa, buf, s + 2);
                c_step(xb, xa.k, buf, s + 1);
            }
        }
        SCAN_BARRIER();
    }
    if (prod) p_yout(NBLK - 1);
    SCAN_BARRIER();
}

__device__ __forceinline__ void phase_post(const P& p, int l, LAS unsigned char* lds) {
    const bf16_t* PG = (const bf16_t*)(p.ws + OFF_PG); const bf16_t* Rb = (const bf16_t*)(p.ws + OFF_R); const bf16_t* B = (const bf16_t*)(p.ws + OFF_B);
    const bf16_t* RWG = (const bf16_t*)(p.ws + OFF_RWG);
    bf16_t* YC = (bf16_t*)(p.ws + OFF_GDNC);
    const int tid = otid(), wave = tid >> 6, c = tid;
    const float lnw = p.in[I_RWLNW][l * 512 + c], lnb = p.in[I_RWLNB][l * 512 + c], kac = p.in[I_RWKA][l * 512 + c], rkc = p.in[I_RWRK][l * 512 + c];
    const float gng = p.in[I_GLANG][l * 128 + (c & 127)], dng = p.in[I_GDNNG][l * 128 + (c & 127)];
    LAS float* red = (LAS float*)lds;
    for (int tile = blockIdx.x; tile < L / TT; tile += gridDim.x) {
        const int t0 = tile * TT;
        float og[TT], od[TT];
#pragma unroll
        for (int tt = 0; tt < TT; ++tt) {
            const int t = t0 + tt;
            const float y = bf2f(PG[(size_t)t * PG_LD + YRW_COL + c]) + bf2f(PG[(size_t)t * PG_LD + YRW_COL + 512 + c]);
            const float mean = wave_sum(y) * (1.f / 64.f);
            const float dy = y - mean;
            const float var = wave_sum(dy * dy) * (1.f / 64.f);
            const float yn = dy * rsqrtf(var + 64e-5f) * lnw + lnb;
            const bf16_t* bp = B + (size_t)t * 4096 + c;
            const float v = bf2f(bp[1024]), rr_ = bf2f(bp[0]), kk_ = bf2f(bp[512]), az0 = bf2f(bp[2048]), az1 = bf2f(bp[2560]);
            const float bon = wave_sum(rr_ * rkc * (kk_ * (1.f + (az0 - 1.f) * kac) + kk_ * (1.f + (az1 - 1.f) * kac)));
            const float o = (yn + bon * v) * bf2f(RWG[(size_t)t * 512 + c]);
            YC[(size_t)t * 512 + c] = f2bf(o);
            og[tt] = bf2f(Rb[(size_t)t * R_LD + c]) + bf2f(Rb[(size_t)t * R_LD + 512 + c]);
            od[tt] = bf2f(Rb[(size_t)t * R_LD + 1024 + c]) + bf2f(Rb[(size_t)t * R_LD + 1536 + c]);
            const float pg_ = wave_sum(og[tt] * og[tt]), pd_ = wave_sum(od[tt] * od[tt]);
            if ((tid & 63) == 0) { red[(tt * 8 + wave) * 2 + 0] = pg_; red[(tt * 8 + wave) * 2 + 1] = pd_; }
        }
        __syncthreads();
#pragma unroll
        for (int tt = 0; tt < TT; ++tt) {
            const int t = t0 + tt, w0i = (wave >> 1) * 2;
            const float sg = red[(tt * 8 + w0i) * 2 + 0] + red[(tt * 8 + w0i + 1) * 2 + 0], sd = red[(tt * 8 + w0i) * 2 + 1] + red[(tt * 8 + w0i + 1) * 2 + 1];
            const float gate_g = silu_(bf2f(PG[(size_t)t * PG_LD + GLA_OG + c])), gate_d = silu_(bf2f(PG[(size_t)t * PG_LD + GDN_ZG + c]));
            YC[(size_t)L * 512 + (size_t)t * 512 + c] = f2bf(og[tt] * rsqrtf(sg * (1.f / 128.f) + 1e-6f) * gng * gate_g);
            YC[(size_t)2 * L * 512 + (size_t)t * 512 + c] = f2bf(od[tt] * rsqrtf(sd * (1.f / 128.f) + 1e-6f) * dng * gate_d);
        }
        __syncthreads();
    }
}

__device__ __forceinline__ void phase_final(const P& p) {
    const float* H = (const float*)(p.ws + OFF_H); const float* gamma = p.in[I_FINALG];
    const int tid_ = otid(); const int wave = tid_ >> 6, lane = tid_ & 63;
    for (int row = blockIdx.x * 8 + wave; row < NLAT; row += gridDim.x * 8) {
        const float* src = H + (size_t)(row + NCTX) * 1024;
        f32x4 v[4]; float ss = 0.f;
#pragma unroll
        for (int j = 0; j < 4; ++j) { v[j] = *(const f32x4*)(src + j * 256 + lane * 4); ss += (v[j][0] * v[j][0] + v[j][1] * v[j][1]) + (v[j][2] * v[j][2] + v[j][3] * v[j][3]); }
        ss = wave_sum(ss);
        const float rstd = rsqrtf(ss * (1.f / 1024.f) + 1e-6f);
#pragma unroll
        for (int j = 0; j < 4; ++j) { const int col = j * 256 + lane * 4; const f32x4 g = *(const f32x4*)(gamma + col);
            *(f32x4*)(p.out + (size_t)row * 1024 + col) = v[j] * rstd * g; }
    }
}


#define XB_TMO      128
#define XB_XCNT(j)  (256  + 64 * (j))
#define XB_XSUB(j)  (1280 + 64 * (j))
#define XB_XGEN(j)  (2304 + 64 * (j))
#define XB_TOP      3328
#define XB_TOPGEN   3392
#define XCD_BAR_WORDS 3456
#define XB_SPIN_CAP (1u << 18)
__device__ __forceinline__ unsigned xb_ld(unsigned* p)              { return __hip_atomic_load(p, __ATOMIC_RELAXED, __HIP_MEMORY_SCOPE_AGENT); }
__device__ __forceinline__ unsigned xb_add(unsigned* p, unsigned v) { return __hip_atomic_fetch_add(p, v, __ATOMIC_RELAXED, __HIP_MEMORY_SCOPE_AGENT); }
__device__ __forceinline__ unsigned xb_xcc_id() { return (unsigned)__builtin_amdgcn_s_getreg((3 << 11) | 20) & 0xFu; }
#define XB_SPIN(cond, bar) do { unsigned _sp = 0; while (cond) { __builtin_amdgcn_s_sleep(1); \
    if ((++_sp & 255u) == 0u) { if (xb_ld(&(bar)[XB_TMO])) break; if (_sp > XB_SPIN_CAP) { atomicAdd(&(bar)[XB_TMO], 1u); break; } } } } while (0)
struct XcdBarrier { unsigned* bar; unsigned x; volatile LAS unsigned* st; };
__device__ __forceinline__ XcdBarrier xcd_barrier_post(unsigned* bar, volatile LAS unsigned* st) {
    XcdBarrier b; b.bar = bar; b.x = xb_xcc_id(); b.st = st;
    if (threadIdx.x == 0) (void)xb_add(&bar[XB_XCNT(b.x)], 1u);
    return b;
}
__device__ __forceinline__ void xcd_barrier_complete(unsigned* bar, unsigned x, unsigned& nloc, unsigned& nx) {
    const unsigned G = gridDim.x * gridDim.y * gridDim.z;
    unsigned sum, cnt, mine, sp = 0u;
    for (;;) {
        sum = 0u; cnt = 0u; mine = 0u;
#pragma unroll
        for (unsigned j = 0; j < 16; ++j) { const unsigned c = xb_ld(&bar[XB_XCNT(j)]); sum += c; cnt += (c > 0u) ? 1u : 0u; mine = (j == x) ? c : mine; }
        if (sum == G) break;
        __builtin_amdgcn_s_sleep(1);
        if ((++sp & 255u) == 0u) { if (xb_ld(&bar[XB_TMO])) break; if (sp > XB_SPIN_CAP) { atomicAdd(&bar[XB_TMO], 1u); break; } }
    }
    nloc = mine > 0u ? mine : 1u; nx = cnt > 0u ? cnt : 1u;
}
__device__ __forceinline__ void xcd_barrier(const XcdBarrier& b) {
    asm volatile("s_waitcnt vmcnt(0)" ::: "memory");
    __syncthreads();
    if (threadIdx.x == 0) {
        unsigned* bar = b.bar;
        __builtin_amdgcn_s_waitcnt(0);
        unsigned nloc = b.st[0], nx = b.st[1];
        if (nloc == 0u) { xcd_barrier_complete(bar, b.x, nloc, nx); b.st[0] = nloc; b.st[1] = nx; }
        const unsigned old = xb_add(&bar[XB_XSUB(b.x)], 1u);
        const unsigned gen = old / nloc;
        if (old + 1u == (gen + 1u) * nloc) {
            __builtin_amdgcn_fence(__ATOMIC_RELEASE, "agent");
            asm volatile("s_waitcnt vmcnt(0)" ::: "memory");
            const unsigned og = xb_add(&bar[XB_TOP], 1u);
            const unsigned tg = og / nx;
            if (og + 1u == (tg + 1u) * nx) xb_add(&bar[XB_TOPGEN], 1u);
            else XB_SPIN(xb_ld(&bar[XB_TOPGEN]) == tg, bar);
            __builtin_amdgcn_fence(__ATOMIC_ACQUIRE, "agent");
            xb_add(&bar[XB_XGEN(b.x)], 1u);
            asm volatile("s_waitcnt vmcnt(0)" ::: "memory");
        } else {
            XB_SPIN(xb_ld(&bar[XB_XGEN(b.x)]) == gen, bar);
            __builtin_amdgcn_fence(__ATOMIC_ACQUIRE, "agent");
            asm volatile("s_waitcnt vmcnt(0)" ::: "memory");
        }
    }
    __syncthreads();
}

__global__ void __launch_bounds__(512, 2) fwd_megakernel(P p) {
    extern __shared__ __attribute__((aligned(16))) unsigned char shm_raw[];
    LAS unsigned char* lds = (LAS unsigned char*)shm_raw;
    cg::grid_group grid = cg::this_grid();
    const int G = gridDim.x, wg = blockIdx.x;
    unsigned char* ws = p.ws;
    float* H = (float*)(ws + OFF_H); bf16_t* HN = (bf16_t*)(ws + OFF_HN); bf16_t* WIN = (bf16_t*)(ws + OFF_WIN);
    const float* MODall = (const float*)(ws + OFF_MOD);

    volatile LAS unsigned* xbst = (volatile LAS unsigned*)(lds + 131072);
    if (threadIdx.x == 0) { xbst[0] = 0u; xbst[1] = 0u; xbst[2] = 0u; xbst[3] = 0u; }
    __syncthreads();
    const XcdBarrier xb = xcd_barrier_post((unsigned*)(ws + OFF_BAR), xbst);
    phase_mod(p, lds);
    grid.sync();
    for (int l = 0; l < DEPTH; ++l) {
        const float* MOD = MODall + (size_t)l * 2 * 6144;
        const bool lastl = (l == DEPTH - 1);
        const int Mg = lastl ? NLAT : L, pm0 = lastl ? 1 : 0;
        if (l == 0) phase_norm<true>(p, l, p.in[I_N1G] + l * 1024, 0, 1); else phase_norm<false>(p, l, p.in[I_N1G] + l * 1024, 0, 1);
        {
            const float* win = p.in[I_WIN] + (size_t)l * 1024 * IN_COLS;
            convert_T(win, IN_COLS, 1024, 0, 1920, WIN, (LAS float*)lds, wg, G);
            convert_T(win, IN_COLS, 1024, 1920, 3632, WIN + (size_t)2048 * 1024, (LAS float*)lds, (wg + 64) % G, G);
            convert_T(win, IN_COLS, 1024, 5552, 3072, WIN + (size_t)NMAIN * 1024, (LAS float*)lds, (wg + 128) % G, G);
            build_wl(p, l, wg, G);
        }
        xcd_barrier(xb);
        {
            pg8::Gemm g{HN, WIN, L, NMAIN, 1024, 16}; pg8::StaticOrder S; S.init(L, NMAIN, G, wg);
            EpiInMain E{(bf16_t*)(ws + OFF_R), (bf16_t*)(ws + OFF_PG)};
            pg8::gemm_phase(lds, g, S, E);
        }
        xcd_barrier(xb);
#ifndef NO_PREP
        phase_prep(p, l, lds);
        xcd_barrier(xb);
        {
            pg8::Gemm g{(const bf16_t*)(ws + OFF_XL), (const bf16_t*)(ws + OFF_WL), L, 2560, 512, 8}; pg8::StaticOrder S; S.init(L, 2560, G, wg);
            EpiLora E{(bf16_t*)(ws + OFF_B), (bf16_t*)(ws + OFF_RWG), p.in[I_RWW0] + (size_t)l * 1024, p.in[I_RWA0] + (size_t)l * 1024};
            pg8::gemm_phase(lds, g, S, E);
        }
#endif
        xcd_barrier(xb);
#ifndef NO_SCAN
        if (wg < 64) scan_rwkv(p, l, wg, lds);
        else if (wg < 96) scan_gla(p, l, wg - 64, lds);
        else if (wg < 224) scan_gdn(p, l, wg - 96, lds);
#endif
        xcd_barrier(xb);
#ifndef NO_POST
        phase_post(p, l, lds);
#endif
        xcd_barrier(xb);
        {
            convert_T(p.in[I_WBR] + (size_t)l * 3 * 512 * 1024, 1024, 512, 0, 1024, (bf16_t*)(ws + OFF_WBR), (LAS float*)lds, wg, G);
            convert_T(p.in[I_WBR] + (size_t)l * 3 * 512 * 1024 + (size_t)512 * 1024, 1024, 512, 0, 1024, (bf16_t*)(ws + OFF_WBR) + (size_t)1024 * 512, (LAS float*)lds, (wg + 128) % G, G);
            convert_T(p.in[I_WBR] + (size_t)l * 3 * 512 * 1024 + (size_t)2 * 512 * 1024, 1024, 512, 0, 1024, (bf16_t*)(ws + OFF_WBR) + (size_t)2 * 1024 * 512, (LAS float*)lds, wg, G);
            convert_T(p.in[I_WOUT] + (size_t)l * 1024 * 1024, 1024, 1024, 0, 1024, (bf16_t*)(ws + OFF_WOUT), (LAS float*)lds, wg, G);
            convert_T(p.in[I_W1] + (size_t)l * 1024 * 4096, 4096, 1024, 0, 4096, (bf16_t*)(ws + OFF_W1), (LAS float*)lds, wg, G);
            convert_T(p.in[I_W2] + (size_t)l * 4096 * 1024, 1024, 4096, 0, 1024, (bf16_t*)(ws + OFF_W2), (LAS float*)lds, wg, G);
            pg8::Gemm g{HN, WIN + (size_t)NMAIN * 1024, L, 3072, 1024, 16}; pg8::StaticOrder S; S.init(Mg, 3072, G, wg, pm0);
            EpiGates E{(bf16_t*)(ws + OFF_B)};
            pg8::gemm_phase(lds, g, S, E);
        }
        xcd_barrier(xb);
        {
            const bf16_t* YC = (const bf16_t*)(ws + OFF_GDNC); const bf16_t* WBR = (const bf16_t*)(ws + OFF_WBR);
            pg8::StaticOrder S; S.init(Mg, 1024, G, wg, pm0);
            { pg8::Gemm g{YC, WBR, L, 1024, 512, 8}; EpiBranch<0> E{(const bf16_t*)(ws + OFF_B), (float*)(ws + OFF_PG), HN}; pg8::gemm_phase(lds, g, S, E); }
            { pg8::Gemm g{YC + (size_t)L * 512, WBR + (size_t)1024 * 512, L, 1024, 512, 8}; EpiBranch<1> E{(const bf16_t*)(ws + OFF_B), (float*)(ws + OFF_PG), HN}; pg8::gemm_phase(lds, g, S, E); }
            { pg8::Gemm g{YC + (size_t)2 * L * 512, WBR + (size_t)2 * 1024 * 512, L, 1024, 512, 8}; EpiBranch<2> E{(const bf16_t*)(ws + OFF_B), (float*)(ws + OFF_PG), HN}; pg8::gemm_phase(lds, g, S, E); }
        }
        xcd_barrier(xb);
        {
            pg8::Gemm g{HN, (const bf16_t*)(ws + OFF_WOUT), L, 1024, 1024, 16}; pg8::StaticOrder S; S.init(Mg, 1024, G, wg, pm0);
            EpiResid E{H, MOD + 2 * 1024, MOD + 6144 + 2 * 1024};
            pg8::gemm_phase(lds, g, S, E);
        }
        xcd_barrier(xb);
        phase_norm<false>(p, l, p.in[I_N2G] + l * 1024, 3, 4);
        xcd_barrier(xb);
        {
            pg8::Gemm g{HN, (const bf16_t*)(ws + OFF_W1), L, 4096, 1024, 16}; pg8::StaticOrder S; S.init(Mg, 4096, G, wg, pm0);
            EpiMlp1 E{(bf16_t*)(ws + OFF_B)};
            pg8::gemm_phase(lds, g, S, E);
        }
        xcd_barrier(xb);
        {
            pg8::Gemm g{(const bf16_t*)(ws + OFF_B), (const bf16_t*)(ws + OFF_W2), L, 1024, 4096, 64}; pg8::StaticOrder S; S.init(Mg, 1024, G, wg, pm0);
            EpiResid E{H, MOD + 5 * 1024, MOD + 6144 + 5 * 1024};
            pg8::gemm_phase(lds, g, S, E);
        }
        xcd_barrier(xb);
    }
    phase_final(p);
}

extern "C" void kernel_launch(void* const* d_in, const int* in_sizes, int n_in, void* d_out, int out_size, void* d_ws, size_t ws_size, hipStream_t stream) {
    static int grid_blocks = 0;
    if (n_in != 32 || ws_size < WS_END || out_size != NLAT * DM) {
        fprintf(stderr, "kernel_launch: unexpected shapes / workspace (n_in %d, ws %zu need %zu, out %d)\n", n_in, ws_size, (size_t)WS_END, out_size);
        hipMemsetAsync(d_out, 0xFF, (size_t)out_size * 4, stream);
        return;
    }
    if (!grid_blocks) {
        int dev = 0, cus = 0, per_cu = 0;
        hipGetDevice(&dev);
        hipDeviceGetAttribute(&cus, hipDeviceAttributeMultiprocessorCount, dev);
        hipFuncSetAttribute((const void*)fwd_megakernel, hipFuncAttributeMaxDynamicSharedMemorySize, LDS_BYTES);
        hipOccupancyMaxActiveBlocksPerMultiprocessor(&per_cu, (const void*)fwd_megakernel, 512, LDS_BYTES);
        if (per_cu < 1) per_cu = 1;
        grid_blocks = cus * 1;
        (void)hipGetLastError();
    }
    P p{};
    for (int i = 0; i < 32; ++i) p.in[i] = (const float*)d_in[i];
    p.out = (float*)d_out; p.ws = (unsigned char*)d_ws;
    (void)hipMemsetAsync((unsigned char*)d_ws + OFF_BAR, 0, 16384, stream);
    void* args[] = {&p};
    hipError_t e = hipLaunchCooperativeKernel((const void*)fwd_megakernel, dim3(grid_blocks), dim3(512), args, LDS_BYTES, stream);
    if (e != hipSuccess) fprintf(stderr, "cooperative launch failed: %s (grid %d)\n", hipGetErrorString(e), grid_blocks);
}
```

```cpp
#include <hip/hip_runtime.h>
#include <hip/hip_cooperative_groups.h>
#include <cstdio>
#include <cstdint>
namespace cg = cooperative_groups;

#define LAS __attribute__((address_space(3)))
typedef unsigned short bf16_t;
typedef short bf16x8 __attribute__((ext_vector_type(8)));
typedef float f32x4 __attribute__((ext_vector_type(4)));
typedef float f32x2 __attribute__((ext_vector_type(2)));
typedef unsigned u32x4 __attribute__((ext_vector_type(4)));
typedef unsigned u32x2 __attribute__((ext_vector_type(2)));

constexpr int L = 16640, NCTX = 256, NLAT = 16384, DM = 1024, BW = 512, DEPTH = 4;
constexpr int IN_COLS = 8624;
constexpr int NMAIN = 5888;
constexpr int NWIN = 8960;
constexpr int R_LD = 2048, PG_LD = 3840;
constexpr int GLA_Q = 0, GLA_K = 256, GLA_V = 512, GLA_OG = 1024, GLA_AL = 1536;
constexpr int GDN_QKV = 1568, GDN_ZG = 3104, GDN_A = 3616, GDN_B = 3624;
constexpr int YRW_COL = 1568;

constexpr size_t al256(size_t x) { return (x + 255) & ~(size_t)255; }
constexpr size_t OFF_MOD = 0;
constexpr size_t OFF_H = al256(OFF_MOD + (size_t)4 * 2 * 6144 * 4);
constexpr size_t OFF_HN = OFF_H + (size_t)L * 1024 * 4;
constexpr size_t OFF_WIN = OFF_HN + (size_t)L * 1024 * 2;
constexpr size_t OFF_R = OFF_WIN + (size_t)NWIN * 1024 * 2;
constexpr size_t OFF_PG = OFF_R + (size_t)L * R_LD * 2;
constexpr size_t OFF_B = OFF_PG + (size_t)L * PG_LD * 2;
constexpr size_t OFF_RWG = OFF_B + (size_t)L * 4096 * 2;
constexpr size_t OFF_BONUS = OFF_RWG + (size_t)L * 512 * 2;
constexpr size_t OFF_GLAD = OFF_BONUS + (size_t)L * 8 * 4;
constexpr size_t OFF_GDNC = OFF_GLAD + (size_t)L * 512 * 2;
constexpr size_t OFF_GDNGB = OFF_GDNC + (size_t)L * 1536 * 2;
constexpr size_t OFF_XL = OFF_GDNGB + (size_t)L * 16 * 4;
constexpr size_t OFF_WL = OFF_XL + (size_t)L * 512 * 2;
constexpr size_t OFF_BAR = OFF_WL + (size_t)2560 * 512 * 2;
constexpr size_t WS_END = OFF_BAR + 16384;
constexpr size_t OFF_WBR = OFF_R;
constexpr size_t OFF_WOUT = OFF_WBR + (size_t)3 * 1024 * 512 * 2;
constexpr size_t OFF_W1 = OFF_WOUT + (size_t)1024 * 1024 * 2;
constexpr size_t OFF_W2 = OFF_W1 + (size_t)4096 * 1024 * 2;

constexpr int LDS_BYTES = 131072 + 16;

struct P { const float* in[32]; float* out; unsigned char* ws; };
enum { I_X = 0, I_C, I_CTX, I_CCTX, I_WMOD, I_BMOD, I_N1G, I_WIN, I_RWMU, I_RWW0, I_RWW2, I_RWA0, I_RWA2, I_RWG2, I_RWKK, I_RWKA, I_RWRK,
       I_RWLNW, I_RWLNB, I_GLAA2, I_GLAAB, I_GLANG, I_GDNCONV, I_GDNALOG, I_GDNDT, I_GDNNG, I_WBR, I_WOUT, I_N2G, I_W1, I_W2, I_FINALG };

__device__ __forceinline__ float bf2f(bf16_t b) { return __uint_as_float(((unsigned)b) << 16); }
__device__ __forceinline__ unsigned pk2(float lo, float hi) { unsigned r; asm("v_cvt_pk_bf16_f32 %0, %1, %2" : "=v"(r) : "v"(lo), "v"(hi)); return r; }
__device__ __forceinline__ bf16_t f2bf(float f) { return (bf16_t)(pk2(f, 0.f) & 0xffffu); }
__device__ __forceinline__ float sigmoid_(float x) { return 1.f / (1.f + __expf(-x)); }
__device__ __forceinline__ float silu_(float x) { return x / (1.f + __expf(-x)); }
__device__ __forceinline__ float softplus_(float x) { return fmaxf(x, 0.f) + log1pf(__expf(-fabsf(x))); }
template <int CTRL> __device__ __forceinline__ float dpp_(float x) { return __int_as_float(__builtin_amdgcn_update_dpp(0, __float_as_int(x), CTRL, 0xF, 0xF, true)); }
__device__ __forceinline__ float reduce8(float x) { x += dpp_<0xB1>(x); x += dpp_<0x4E>(x); x += dpp_<0x141>(x); return x; }
__device__ __forceinline__ float reduce16(float x) { x = reduce8(x); x += dpp_<0x140>(x); return x; }
__device__ __forceinline__ float wave_sum(float v) {
    v = reduce16(v);
    const float r0 = __int_as_float(__builtin_amdgcn_readlane(__float_as_int(v), 0)), r1 = __int_as_float(__builtin_amdgcn_readlane(__float_as_int(v), 16));
    const float r2 = __int_as_float(__builtin_amdgcn_readlane(__float_as_int(v), 32)), r3 = __int_as_float(__builtin_amdgcn_readlane(__float_as_int(v), 48));
    return (r0 + r1) + (r2 + r3);
}

__device__ __forceinline__ int otid() { int t = threadIdx.x; asm volatile("" : "+v"(t)); return t; }
__device__ __forceinline__ int osgpr(int x) { asm volatile("" : "+s"(x)); return x; }
namespace pg8 {
constexpr int BM = 256, BK = 64, HALF = 128, HTB = HALF * BK * 2, STAGE_BYTES = 8 * HTB, NXCD = 8, WGM = 8;
__host__ __device__ __forceinline__ int lds_byte(int r, int c) { const int st = (r >> 4) * 2 + (c >> 5), rr = r & 15, cc = c & 31, ob = rr * 64 + cc * 2; return st * 1024 + (ob ^ (((ob >> 9) & 1) << 5)); }
__host__ __device__ __forceinline__ void stage_rc(int b, int& R, int& C) { const int st = b / 1024, sb = b % 1024, swz = sb ^ (((sb >> 9) & 1) << 5); R = (st >> 1) * 16 + swz / 64; C = (st & 1) * 32 + (swz % 64) / 2; }
struct Unit { int pm, pn, k0; };
struct Gemm { const bf16_t* A; const bf16_t* Bt; int M, N, K, nt; };
struct StaticOrder {
    int nM, nN, nwg, G, c, pm0;
    __host__ __device__ void init(int M, int N, int G_, int c_, int pm0_ = 0) { nM = M / BM; nN = N / BM; nwg = nM * nN; G = G_; c = c_; pm0 = pm0_; }
    __host__ __device__ bool next(int i, Unit& u) const {
        const long Lx = (long)i * G + c; if (Lx >= nwg) return false;
        int wgid = (int)Lx; { const int q = nwg / NXCD, r = nwg % NXCD, xcd = wgid % NXCD, off = wgid / NXCD; wgid = (xcd < r ? xcd * (q + 1) : r * (q + 1) + (xcd - r) * q) + off; }
        const int nig = WGM * nN, gid = wgid / nig, fm = gid * WGM, gsz = (nM - fm) < WGM ? (nM - fm) : WGM;
        u.pm = pm0 + fm + ((wgid % nig) % gsz); u.pn = (wgid % nig) / gsz; u.k0 = 0; return true;
    }
};
struct SplitOrder {
    int nN, nunits, G, c, nt;
    __host__ __device__ void init(int N, int K, int nt_, int G_, int c_) { nN = N / BM; nt = nt_; nunits = nN * (K / BK / nt_); G = G_; c = c_; }
    __host__ __device__ bool next(int i, Unit& u) const {
        const int idx = i * G + c; if (idx >= nunits) return false;
        u.pm = 0; u.pn = idx % nN; u.k0 = (idx / nN) * nt; return true;
    }
};
template <class Epi, class Ord>
__device__ __forceinline__ void gemm_phase(LAS unsigned char* lds, const Gemm g, const Ord& S, const Epi& E) {
#ifdef NO_GEMM
    return;
#endif
    const int tid = otid(), wid = __builtin_amdgcn_readfirstlane(tid >> 6), lane = tid & 63, wr = wid >> 2, wc = wid & 3, fr = lane & 15, fq = lane >> 4;
    const int K = g.K, nt = g.nt;
    unsigned voffA[2];
#pragma unroll
    for (int i = 0; i < 2; ++i) { int R, C; stage_rc(tid * 16 + i * 8192, R, C); voffA[i] = (unsigned)(R * K + C) * 2u; }
    const size_t kstep = (size_t)(BK * 2);
    const size_t hstep = (size_t)HALF * K * 2;
    const size_t tstep = 2 * hstep;
    const unsigned ldsw = (unsigned)wid * 1024u;
    const int aoff = lds_byte(wr * 64 + fr, fq * 8), boff = lds_byte(wc * 32 + fr, fq * 8);
#define PG8_SA(b, h) (((b) * 2 + (h)) * HTB)
#define PG8_SB(b, h) ((4 + (b) * 2 + (h)) * HTB)
#define PG8_STAGE(bufoff, gbase, voff) do { _Pragma("unroll") for (int _i = 0; _i < 2; ++_i) \
        __builtin_amdgcn_global_load_lds((const unsigned*)((const char*)(gbase) + (voff)[_i]), (LAS unsigned*)(lds + (bufoff) + ldsw + _i * 8192), 16, 0, 0); } while (0)
#define PG8_LDA(dst, b, h) do { _Pragma("unroll") for (int m = 0; m < 4; ++m) _Pragma("unroll") for (int k = 0; k < 2; ++k) dst[m][k] = *(const LAS bf16x8*)(lds + PG8_SA(b, h) + aoff + m * 2048 + k * 1024); } while (0)
#define PG8_LDB(dst, b, h) do { _Pragma("unroll") for (int n = 0; n < 2; ++n) _Pragma("unroll") for (int k = 0; k < 2; ++k) dst[n][k] = *(const LAS bf16x8*)(lds + PG8_SB(b, h) + boff + n * 2048 + k * 1024); } while (0)
#define PG8_MMA(ai, bj, At, Bt) do { __builtin_amdgcn_s_setprio(1); _Pragma("unroll") for (int m = 0; m < 4; ++m) _Pragma("unroll") for (int n = 0; n < 2; ++n) _Pragma("unroll") for (int k = 0; k < 2; ++k) \
        acc[ai][bj][m][n] = __builtin_amdgcn_mfma_f32_16x16x32_bf16(Bt[n][k], At[m][k], acc[ai][bj][m][n], 0, 0, 0); __builtin_amdgcn_s_setprio(0); } while (0)
#define PG8_WAIT_V(n) asm volatile("s_waitcnt vmcnt(" #n ")" ::: "memory")
#define PG8_WAIT_L(n) asm volatile("s_waitcnt lgkmcnt(" #n ")" ::: "memory")
#define PG8_BAR __builtin_amdgcn_s_barrier()
#define PG8_SCHED __builtin_amdgcn_sched_barrier(0)
    Unit cur, nxt; int ui = 0;
    if (!S.next(0, cur)) return;
    f32x4 acc[2][2][4][2];
#pragma unroll
    for (int a = 0; a < 2; ++a)
#pragma unroll
        for (int b = 0; b < 2; ++b)
#pragma unroll
            for (int m = 0; m < 4; ++m)
#pragma unroll
                for (int n = 0; n < 2; ++n) acc[a][b][m][n] = (f32x4){0.f, 0.f, 0.f, 0.f};
    bf16x8 At[4][2], B0[2][2], B1[2][2];
    const size_t kstep0 = (size_t)(BK * 2);
    const char* cA = (const char*)g.A + (size_t)cur.pm * tstep + (size_t)cur.k0 * kstep0; const char* cB = (const char*)g.Bt + (size_t)cur.pn * tstep + (size_t)cur.k0 * kstep0;
    PG8_STAGE(PG8_SB(0, 0), cB, voffA); PG8_STAGE(PG8_SA(0, 0), cA, voffA); PG8_STAGE(PG8_SB(0, 1), cB + hstep, voffA); PG8_STAGE(PG8_SA(0, 1), cA + hstep, voffA);
    if (wr == 1) PG8_BAR;
    PG8_WAIT_V(4); PG8_BAR;
    PG8_STAGE(PG8_SB(1, 0), cB + kstep, voffA); PG8_STAGE(PG8_SA(1, 0), cA + kstep, voffA); PG8_STAGE(PG8_SB(1, 1), cB + hstep + kstep, voffA);
    PG8_WAIT_V(6); PG8_BAR;
    for (;;) {
        const bool has_next = S.next(ui + 1, nxt);
        const char* nA = has_next ? (const char*)g.A + (size_t)nxt.pm * tstep + (size_t)nxt.k0 * kstep0 : cA; const char* nB = has_next ? (const char*)g.Bt + (size_t)nxt.pn * tstep + (size_t)nxt.k0 * kstep0 : cB;
        for (int t = 0; t < nt; t += 2) {
            const bool last = (t == nt - 2);
            const char* a1 = cA + (size_t)(t + 1) * kstep;
            const char* a2 = last ? nA : cA + (size_t)(t + 2) * kstep; const char* b2 = last ? nB : cB + (size_t)(t + 2) * kstep;
            const char* a3 = a2 + kstep; const char* b3 = b2 + kstep;
            PG8_LDB(B0, 0, 0); PG8_SCHED; PG8_LDA(At, 0, 0); PG8_STAGE(PG8_SA(1, 1), a1 + hstep, voffA);
            PG8_WAIT_L(8); PG8_BAR; PG8_WAIT_L(0); PG8_MMA(0, 0, At, B0); PG8_BAR; PG8_SCHED;
            PG8_LDB(B1, 0, 1); PG8_STAGE(PG8_SB(0, 0), b2, voffA);
            PG8_BAR; PG8_WAIT_L(0); PG8_MMA(0, 1, At, B1); PG8_BAR;
            PG8_LDA(At, 0, 1); PG8_STAGE(PG8_SA(0, 0), a2, voffA);
            PG8_BAR; PG8_WAIT_L(0); PG8_MMA(1, 0, At, B0); PG8_BAR; PG8_SCHED;
            PG8_STAGE(PG8_SB(0, 1), b2 + hstep, voffA);
            PG8_WAIT_V(6); PG8_BAR; PG8_MMA(1, 1, At, B1); PG8_BAR;
            PG8_LDB(B0, 1, 0); PG8_SCHED; PG8_LDA(At, 1, 0); PG8_STAGE(PG8_SA(0, 1), a2 + hstep, voffA);
            PG8_WAIT_L(8); PG8_BAR; PG8_WAIT_L(0); PG8_MMA(0, 0, At, B0); PG8_BAR; PG8_SCHED;
            PG8_LDB(B1, 1, 1); PG8_STAGE(PG8_SB(1, 0), b3, voffA);
            PG8_BAR; PG8_WAIT_L(0); PG8_MMA(0, 1, At, B1); PG8_BAR;
            PG8_LDA(At, 1, 1); PG8_STAGE(PG8_SA(1, 0), a3, voffA);
            PG8_BAR; PG8_WAIT_L(0); PG8_MMA(1, 0, At, B0); PG8_BAR; PG8_SCHED;
            PG8_STAGE(PG8_SB(1, 1), b3 + hstep, voffA);
            PG8_WAIT_V(6); PG8_BAR; PG8_MMA(1, 1, At, B1); PG8_BAR;
        }
        E(acc, cur, wr, wc, fr, fq);
        if (!has_next) break;
#pragma unroll
        for (int a = 0; a < 2; ++a)
#pragma unroll
            for (int b = 0; b < 2; ++b)
#pragma unroll
                for (int m = 0; m < 4; ++m)
#pragma unroll
                    for (int n = 0; n < 2; ++n) acc[a][b][m][n] = (f32x4){0.f, 0.f, 0.f, 0.f};
        cur = nxt; cA = nA; cB = nB; ++ui;
    }
    PG8_WAIT_V(0);
    if (wr == 0) PG8_BAR;
    PG8_BAR;
#undef PG8_SA
#undef PG8_SB
#undef PG8_STAGE
#undef PG8_LDA
#undef PG8_LDB
#undef PG8_MMA
#undef PG8_WAIT_V
#undef PG8_WAIT_L
#undef PG8_BAR
#undef PG8_SCHED
}
}
using pg8::Unit;

#define EPI_LOOP_ROWS for (int ai = 0; ai < 2; ++ai) for (int m = 0; m < 4; ++m)
#define EPI_LOOP_COLS for (int bj = 0; bj < 2; ++bj) for (int n = 0; n < 2; ++n)
struct EpiInMain {
    bf16_t* R; bf16_t* PG;
    __device__ __forceinline__ void operator()(const f32x4 (&acc)[2][2][4][2], const Unit& u, int wr, int wc, int fr, int fq) const {
        bf16_t* dst; int ld, c0;
        if (u.pn < 8) { dst = R; ld = R_LD; c0 = u.pn * 256; } else { dst = PG; ld = PG_LD; c0 = (u.pn - 8) * 256; }
        const int row0 = u.pm * 256 + wr * 64 + fr, col0 = c0 + wc * 32 + 4 * fq;
#pragma unroll
        EPI_LOOP_ROWS { bf16_t* rowp = dst + (size_t)(row0 + ai * 128 + m * 16) * ld + col0;
#pragma unroll
            EPI_LOOP_COLS { const f32x4 v = acc[ai][bj][m][n]; *(u32x2*)(rowp + bj * 128 + n * 16) = (u32x2){pk2(v[0], v[1]), pk2(v[2], v[3])}; } }
    }
};
struct EpiGates {
    bf16_t* G;
    __device__ __forceinline__ void operator()(const f32x4 (&acc)[2][2][4][2], const Unit& u, int wr, int wc, int fr, int fq) const {
        const int row0 = u.pm * 256 + wr * 64 + fr, col0 = u.pn * 256 + wc * 32 + 4 * fq;
#pragma unroll
        EPI_LOOP_ROWS { bf16_t* rowp = G + (size_t)(row0 + ai * 128 + m * 16) * 3072 + col0;
#pragma unroll
            EPI_LOOP_COLS { const f32x4 v = acc[ai][bj][m][n];
                *(u32x2*)(rowp + bj * 128 + n * 16) = (u32x2){pk2(sigmoid_(v[0]), sigmoid_(v[1])), pk2(sigmoid_(v[2]), sigmoid_(v[3]))}; } }
    }
};
template <int GI> struct EpiBranch {
    const bf16_t* G; float* MG; bf16_t* MB;
    __device__ __forceinline__ void operator()(const f32x4 (&acc)[2][2][4][2], const Unit& u, int wr, int wc, int fr, int fq) const {
        const int row0 = u.pm * 256 + wr * 64 + fr, col0 = u.pn * 256 + wc * 32 + 4 * fq;
#pragma unroll
        EPI_LOOP_ROWS { const size_t row = (size_t)(row0 + ai * 128 + m * 16);
#pragma unroll
            EPI_LOOP_COLS { const int col = col0 + bj * 128 + n * 16; const f32x4 v = acc[ai][bj][m][n];
                const u32x2 gq = *(const u32x2*)(G + row * 3072 + GI * 1024 + col);
                f32x4 gv = (f32x4){__uint_as_float(gq[0] << 16), __uint_as_float(gq[0] & 0xffff0000u), __uint_as_float(gq[1] << 16), __uint_as_float(gq[1] & 0xffff0000u)};
                f32x4 r = v * gv;
                if (GI > 0) r += *(const f32x4*)(MG + row * 1024 + col);
                if (GI < 2) *(f32x4*)(MG + row * 1024 + col) = r;
                else *(u32x2*)(MB + row * 1024 + col) = (u32x2){pk2(r[0], r[1]), pk2(r[2], r[3])}; } }
    }
};
struct EpiResid {
    float* H; const float* gate_lat; const float* gate_ctx;
    __device__ __forceinline__ void operator()(const f32x4 (&acc)[2][2][4][2], const Unit& u, int wr, int wc, int fr, int fq) const {
        const int row0 = u.pm * 256 + wr * 64 + fr, col0 = u.pn * 256 + wc * 32 + 4 * fq;
        const float* gp = (u.pm == 0) ? gate_ctx : gate_lat;
        f32x4 gv[2][2];
#pragma unroll
        EPI_LOOP_COLS gv[bj][n] = *(const f32x4*)(gp + col0 + bj * 128 + n * 16);
#pragma unroll
        EPI_LOOP_ROWS { float* rowp = H + (size_t)(row0 + ai * 128 + m * 16) * 1024 + col0;
#pragma unroll
            EPI_LOOP_COLS { f32x4* q = (f32x4*)(rowp + bj * 128 + n * 16); *q = *q + acc[ai][bj][m][n] * gv[bj][n]; } }
    }
};
struct EpiLora {
    bf16_t* B; bf16_t* RWG; const float* w0; const float* a0;
    __device__ __forceinline__ void operator()(const f32x4 (&acc)[2][2][4][2], const Unit& u, int wr, int wc, int fr, int fq) const {
        const int row0 = u.pm * 256 + wr * 64 + fr, blk = u.pn >> 1, cbase = (u.pn & 1) * 256 + wc * 32 + 4 * fq;
        f32x4 bv[2][2];
#pragma unroll
        EPI_LOOP_COLS { const int cc = cbase + bj * 128 + n * 16;
            bv[bj][n] = blk < 2 ? *(const f32x4*)(w0 + blk * 512 + cc) : (blk < 4 ? *(const f32x4*)(a0 + (blk - 2) * 512 + cc) : (f32x4){0.f, 0.f, 0.f, 0.f}); }
        bf16_t* dst; int ld;
        if (blk < 2) { dst = B + 3072 + blk * 512; ld = 4096; } else if (blk < 4) { dst = B + 2048 + (blk - 2) * 512; ld = 4096; } else { dst = RWG; ld = 512; }
#pragma unroll
        EPI_LOOP_ROWS { bf16_t* rowp = dst + (size_t)(row0 + ai * 128 + m * 16) * ld + cbase;
#pragma unroll
            EPI_LOOP_COLS { f32x4 v = acc[ai][bj][m][n] + bv[bj][n];
                if (blk < 2) {
#pragma unroll
                    for (int j = 0; j < 4; ++j) { const float x = -v[j]; const float sp = fmaxf(x, 0.f) + __logf(1.f + __expf(-fabsf(x))); v[j] = 1.f - __expf(-__expf(-sp - 0.5f)); }
                } else if (blk < 4) {
#pragma unroll
                    for (int j = 0; j < 4; ++j) v[j] = sigmoid_(v[j]);
                }
                *(u32x2*)(rowp + bj * 128 + n * 16) = (u32x2){pk2(v[0], v[1]), pk2(v[2], v[3])}; } }
    }
};
struct EpiResidAtomic {
    float* H; const float* gate_ctx;
    __device__ __forceinline__ void operator()(const f32x4 (&acc)[2][2][4][2], const Unit& u, int wr, int wc, int fr, int fq) const {
        const int row0 = u.pm * 256 + wr * 64 + fr, col0 = u.pn * 256 + wc * 32 + 4 * fq;
        const float* gp = gate_ctx + col0;
#pragma unroll
        EPI_LOOP_ROWS { float* rowp = H + (size_t)(row0 + ai * 128 + m * 16) * 1024 + col0;
#pragma unroll
            EPI_LOOP_COLS { const f32x4 v = acc[ai][bj][m][n] * *(const f32x4*)(gp + bj * 128 + n * 16); float* q = rowp + bj * 128 + n * 16;
                unsafeAtomicAdd(q, v[0]); unsafeAtomicAdd(q + 1, v[1]); unsafeAtomicAdd(q + 2, v[2]); unsafeAtomicAdd(q + 3, v[3]); }
            asm volatile("" ::: "memory"); }
    }
};
struct EpiMlp1 {
    bf16_t* U;
    __device__ __forceinline__ void operator()(const f32x4 (&acc)[2][2][4][2], const Unit& u, int wr, int wc, int fr, int fq) const {
        const int row0 = u.pm * 256 + wr * 64 + fr, col0 = u.pn * 256 + wc * 32 + 4 * fq;
#pragma unroll
        EPI_LOOP_ROWS { bf16_t* rowp = U + (size_t)(row0 + ai * 128 + m * 16) * 4096 + col0;
#pragma unroll
            EPI_LOOP_COLS { f32x4 v = acc[ai][bj][m][n];
#pragma unroll
                for (int j = 0; j < 4; ++j) { const float t = fmaxf(v[j], 0.f); v[j] = t * t; }
                *(u32x2*)(rowp + bj * 128 + n * 16) = (u32x2){pk2(v[0], v[1]), pk2(v[2], v[3])}; } }
    }
};

__device__ __forceinline__ void convert_T(const float* src, int ld, int K, int n0, int ncols, bf16_t* dst, LAS float* tile, int wg, int nwg) {
    const int ntn = (ncols + 63) >> 6, ntk = K >> 6, tid = otid();
    for (int t = wg; t < ntn * ntk; t += nwg) {
        const int tn = t / ntk, tk = t - tn * ntk, k0 = tk * 64, nb = tn * 64;
#pragma unroll
        for (int i = 0; i < 2; ++i) { const int idx = tid + i * 512, kk = idx >> 4, n4 = (idx & 15) * 4;
            f32x4 v = (f32x4){0.f, 0.f, 0.f, 0.f};
            if (nb + n4 < ncols) v = *(const f32x4*)(src + (size_t)(k0 + kk) * ld + n0 + nb + n4);
            tile[kk * 65 + n4 + 0] = v[0]; tile[kk * 65 + n4 + 1] = v[1]; tile[kk * 65 + n4 + 2] = v[2]; tile[kk * 65 + n4 + 3] = v[3]; }
        __syncthreads();
        { const int nn = tid >> 3, k8 = (tid & 7) * 8;
          if (nb + nn < ncols) { const LAS float* s = tile + k8 * 65 + nn;
              u32x4 o; o[0] = pk2(s[0], s[65]); o[1] = pk2(s[130], s[195]); o[2] = pk2(s[260], s[325]); o[3] = pk2(s[390], s[455]);
              *(u32x4*)(dst + (size_t)(nb + nn) * K + k0 + k8) = o; } }
        __syncthreads();
    }
}

__device__ __forceinline__ void phase_mod(const P& p, LAS unsigned char* lds) {
    const float* c = p.in[I_C]; const float* cc = p.in[I_CCTX]; const float* wm = p.in[I_WMOD]; const float* bm = p.in[I_BMOD];
    float* MOD = (float*)(p.ws + OFF_MOD);
    LAS float* red = (LAS float*)lds;
    const int tid = otid();
    for (int blk = blockIdx.x; blk < 256; blk += gridDim.x) {
        const int l = blk >> 6, col0 = (blk & 63) * 96;
        if (tid < 384) {
            const int cgp = tid % 24, ks = tid / 24;
            f32x4 a0 = (f32x4){0.f, 0.f, 0.f, 0.f}, a1 = a0;
            const float* w = wm + (size_t)l * 1024 * 6144 + col0 + cgp * 4;
#pragma unroll 8
            for (int k = ks * 64; k < ks * 64 + 64; ++k) {
                const f32x4 wv = *(const f32x4*)(w + (size_t)k * 6144);
                const float s0 = silu_(c[k]), s1 = silu_(cc[k]);
                a0 += wv * s0; a1 += wv * s1;
            }
            LAS f32x4* r4 = (LAS f32x4*)red;
            r4[(ks * 24 + cgp) * 2 + 0] = a0; r4[(ks * 24 + cgp) * 2 + 1] = a1;
        }
        __syncthreads();
        if (tid < 192) {
            const int col = tid % 96, s = tid / 96;
            float sum = 0.f;
#pragma unroll
            for (int k2 = 0; k2 < 16; ++k2) sum += red[((k2 * 24 + (col >> 2)) * 2 + s) * 4 + (col & 3)];
            MOD[((size_t)l * 2 + s) * 6144 + col0 + col] = sum + bm[l * 6144 + col0 + col];
        }
        __syncthreads();
    }
}

template <bool FROM_INPUT>
__device__ __forceinline__ void phase_norm(const P& p, int l, const float* gamma, int shift_idx, int scale_idx) {
    float* H = (float*)(p.ws + OFF_H); bf16_t* HN = (bf16_t*)(p.ws + OFF_HN);
    const float* MOD = (const float*)(p.ws + OFF_MOD) + (size_t)l * 2 * 6144;
    const int tid_ = otid(); const int wave = tid_ >> 6, lane = tid_ & 63;
    for (int row = blockIdx.x * 8 + wave; row < L; row += gridDim.x * 8) {
        const float* src = FROM_INPUT ? (row < NCTX ? p.in[I_CTX] + (size_t)row * 1024 : p.in[I_X] + (size_t)(row - NCTX) * 1024) : H + (size_t)row * 1024;
        f32x4 v[4]; float ss = 0.f;
#pragma unroll
        for (int j = 0; j < 4; ++j) { v[j] = *(const f32x4*)(src + j * 256 + lane * 4); ss += (v[j][0] * v[j][0] + v[j][1] * v[j][1]) + (v[j][2] * v[j][2] + v[j][3] * v[j][3]); }
        ss = wave_sum(ss);
        const float rstd = rsqrtf(ss * (1.f / 1024.f) + 1e-6f);
        const float* m = MOD + (row < NCTX ? 6144 : 0);
#pragma unroll
        for (int j = 0; j < 4; ++j) { const int col = j * 256 + lane * 4;
            const f32x4 g = *(const f32x4*)(gamma + col), sh = *(const f32x4*)(m + shift_idx * 1024 + col), sc = *(const f32x4*)(m + scale_idx * 1024 + col);
            const f32x4 o = v[j] * rstd * g * (sc + 1.f) + sh;
            *(u32x2*)(HN + (size_t)row * 1024 + col) = (u32x2){pk2(o[0], o[1]), pk2(o[2], o[3])};
            if (FROM_INPUT) *(f32x4*)(H + (size_t)row * 1024 + col) = v[j]; }
    }
}

constexpr int TT = 13;
__device__ __forceinline__ void phase_prep(const P& p, int l, LAS unsigned char* lds) {
    const bf16_t* R = (const bf16_t*)(p.ws + OFF_R); const bf16_t* PG = (const bf16_t*)(p.ws + OFF_PG);
    bf16_t* B = (bf16_t*)(p.ws + OFF_B); bf16_t* XL = (bf16_t*)(p.ws + OFF_XL);
    bf16_t* GLAD = (bf16_t*)(p.ws + OFF_GLAD); bf16_t* GDNC = (bf16_t*)(p.ws + OFF_GDNC); float* GDNGB = (float*)(p.ws + OFF_GDNGB);
    const float* mu = p.in[I_RWMU] + (size_t)l * 2 * 1920;
    const float* kkw = p.in[I_RWKK] + l * 512;
    const float* ga2 = p.in[I_GLAA2] + (size_t)l * 2 * 16 * 256; const float* gab = p.in[I_GLAAB] + l * 512;
    const float* cw = p.in[I_GDNCONV] + (size_t)l * 5 * 1536; const float* alog = p.in[I_GDNALOG] + l * 8; const float* dtb = p.in[I_GDNDT] + l * 8;
    LAS float* gal = (LAS float*)lds;
    LAS float* red = gal + TT * 32;
    const int tid = otid(), wave = tid >> 6;
    const int c = tid;
    const int gz = tid >> 8, gk = tid & 255;
    for (int tile = blockIdx.x; tile < L / TT; tile += gridDim.x) {
        const int t0 = tile * TT;
        if (tid < TT * 32) { const int tt = tid >> 5, e = tid & 31; gal[tt * 32 + e] = bf2f(PG[(size_t)(t0 + tt) * PG_LD + GLA_AL + e]); }
        {
            float xr[TT + 2], xk[TT + 2], xv[TT + 2], xe[TT + 2];
#pragma unroll
            for (int i = 0; i < TT + 2; ++i) { const int rr = t0 - 1 + i;
                if (rr >= 0 && rr < L) { const bf16_t* rp = R + (size_t)rr * R_LD + c; xr[i] = bf2f(rp[0]); xk[i] = bf2f(rp[512]); xv[i] = bf2f(rp[1024]); xe[i] = (c < 384) ? bf2f(rp[1536]) : 0.f; }
                else { xr[i] = 0.f; xk[i] = 0.f; xv[i] = 0.f; xe[i] = 0.f; } }
            const float mr0 = mu[c], mr1 = mu[1920 + c], mk0 = mu[512 + c], mk1 = mu[1920 + 512 + c], mv0 = mu[1024 + c], mv1 = mu[1920 + 1024 + c];
            const float me0 = (c < 384) ? mu[1536 + c] : 0.f, me1 = (c < 384) ? mu[1920 + 1536 + c] : 0.f;
            const float kkc = kkw[c];
#pragma unroll
            for (int tt = 0; tt < TT; ++tt) {
                const int t = t0 + tt;
                const float hp = (t != 0 && t != NCTX) ? 1.f : 0.f, hn = (t != NCTX - 1 && t != L - 1) ? 1.f : 0.f;
                const float r = mr0 * hp * xr[tt] + (1.f - mr0 - mr1) * xr[tt + 1] + mr1 * hn * xr[tt + 2];
                const float k = mk0 * hp * xk[tt] + (1.f - mk0 - mk1) * xk[tt + 1] + mk1 * hn * xk[tt + 2];
                const float v = mv0 * hp * xv[tt] + (1.f - mv0 - mv1) * xv[tt + 1] + mv1 * hn * xv[tt + 2];
                float e = me0 * hp * xe[tt] + (1.f - me0 - me1) * xe[tt + 1] + me1 * hn * xe[tt + 2];
                if (c < 128) e = tanhf(e); else if (c >= 256 && c < 384) e = sigmoid_(e); else if (c >= 384) e = 0.f;
                const float kr = k * kkc;
                const float ssq = wave_sum(kr * kr);
                bf16_t* bp = B + (size_t)t * 4096 + c;
                bp[0] = f2bf(r); bp[512] = f2bf(k); bp[1024] = f2bf(v); bp[1536] = f2bf(kr * rsqrtf(ssq + 1e-12f));
                XL[(size_t)t * 512 + c] = f2bf(e);
            }
        }
        __syncthreads();
        {
        float ga2v[16];
#pragma unroll
        for (int e = 0; e < 16; ++e) ga2v[e] = ga2[(gz * 16 + e) * 256 + gk];
        const float gabv = gab[gz * 256 + gk];
#pragma unroll
        for (int tt = 0; tt < TT; ++tt) {
            float zv = gabv;
#pragma unroll
            for (int e = 0; e < 16; ++e) zv += gal[tt * 32 + gz * 16 + e] * ga2v[e];
            const float la = -softplus_(-zv) * (1.f / 16.f);
            GLAD[(size_t)(t0 + tt) * 512 + tid] = f2bf(-expm1f(la));
        }
        }
        {
            float cwv[5], xv[TT + 4];
#pragma unroll
            for (int i = 0; i < 5; ++i) cwv[i] = cw[i * 1536 + 1024 + c];
#pragma unroll
            for (int i = 0; i < TT + 4; ++i) { const int rr = t0 - 2 + i; xv[i] = (rr >= 0 && rr < L) ? bf2f(PG[(size_t)rr * PG_LD + GDN_QKV + 1024 + c]) : 0.f; }
#pragma unroll
            for (int tt = 0; tt < TT; ++tt) { const int t = t0 + tt; float sv = 0.f;
#pragma unroll
                for (int i = 0; i < 5; ++i) { const int rr = t + i - 2; const bool ok_ = (rr >= 0) && (rr < L) && ((rr < NCTX) == (t < NCTX)); if (ok_) sv += xv[tt + i] * cwv[i]; }
                GDNC[(size_t)t * 1536 + 1024 + c] = f2bf(silu_(sv)); }
        }
        float oq[TT], ok[TT];
        {
            float cwq[5], cwk[5], xq[TT + 4], xk[TT + 4];
#pragma unroll
            for (int i = 0; i < 5; ++i) { cwq[i] = cw[i * 1536 + c]; cwk[i] = cw[i * 1536 + 512 + c]; }
#pragma unroll
            for (int i = 0; i < TT + 4; ++i) { const int rr = t0 - 2 + i;
                if (rr >= 0 && rr < L) { const bf16_t* rp = PG + (size_t)rr * PG_LD + GDN_QKV + c; xq[i] = bf2f(rp[0]); xk[i] = bf2f(rp[512]); } else { xq[i] = 0.f; xk[i] = 0.f; } }
#pragma unroll
            for (int tt = 0; tt < TT; ++tt) {
                const int t = t0 + tt; float sq = 0.f, sk = 0.f;
#pragma unroll
                for (int i = 0; i < 5; ++i) { const int rr = t + i - 2; const bool ok_ = (rr >= 0) && (rr < L) && ((rr < NCTX) == (t < NCTX));
                    if (ok_) { sq += xq[tt + i] * cwq[i]; sk += xk[tt + i] * cwk[i]; } }
                oq[tt] = silu_(sq); ok[tt] = silu_(sk);
                const float pq = wave_sum(oq[tt] * oq[tt]), pk = wave_sum(ok[tt] * ok[tt]);
                if ((tid & 63) == 0) { red[(tt * 8 + wave) * 2 + 0] = pq; red[(tt * 8 + wave) * 2 + 1] = pk; }
            }
        }
        __syncthreads();
#pragma unroll
        for (int tt = 0; tt < TT; ++tt) {
            const int w0i = (wave >> 1) * 2;
            const float ssq = red[(tt * 8 + w0i) * 2 + 0] + red[(tt * 8 + w0i + 1) * 2 + 0], ssk = red[(tt * 8 + w0i) * 2 + 1] + red[(tt * 8 + w0i + 1) * 2 + 1];
            bf16_t* gp = GDNC + (size_t)(t0 + tt) * 1536 + c;
            gp[0] = f2bf(oq[tt] * rsqrtf(ssq + 1e-12f) * 0.08838834764831845f); gp[512] = f2bf(ok[tt] * rsqrtf(ssk + 1e-12f));
        }
        if (tid < TT * 16) { const int tt = tid >> 4, j = tid & 15, t = t0 + tt;
            float o;
            if (j < 8) { const float a = bf2f(PG[(size_t)t * PG_LD + GDN_A + j]); o = __expf(-__expf(alog[j]) * softplus_(a + dtb[j])); }
            else o = sigmoid_(bf2f(PG[(size_t)t * PG_LD + GDN_B + (j - 8)]));
            GDNGB[t * 16 + j] = o; }
        __syncthreads();
    }
}
__device__ __forceinline__ void build_wl(const P& p, int l, int wg, int nwg) {
    const float* w2 = p.in[I_RWW2] + (size_t)l * 2 * 64 * 512; const float* a2 = p.in[I_RWA2] + (size_t)l * 2 * 64 * 512; const float* g2 = p.in[I_RWG2] + (size_t)l * 128 * 512;
    bf16_t* WL = (bf16_t*)(p.ws + OFF_WL);
    const int tid = otid();
    for (int it = wg * 512 + tid; it < 2560 * 64; it += nwg * 512) {
        const int kc = it / 2560, n = it - kc * 2560, k0 = kc * 8, blk = n >> 9, cc = n & 511;
        const float* src = nullptr; int kb = 0, kn = 0;
        if (blk == 0) { src = w2; kb = 0; kn = 64; } else if (blk == 1) { src = w2 + 64 * 512; kb = 64; kn = 64; }
        else if (blk == 2) { src = a2; kb = 128; kn = 64; } else if (blk == 3) { src = a2 + 64 * 512; kb = 192; kn = 64; }
        else { src = g2; kb = 256; kn = 128; }
        float v[8];
#pragma unroll
        for (int j = 0; j < 8; ++j) { const int k = k0 + j - kb; v[j] = (k >= 0 && k < kn) ? src[(size_t)k * 512 + cc] : 0.f; }
        u32x4 o; o[0] = pk2(v[0], v[1]); o[1] = pk2(v[2], v[3]); o[2] = pk2(v[4], v[5]); o[3] = pk2(v[6], v[7]);
        *(u32x4*)(WL + (size_t)n * 512 + k0) = o;
    }
}

constexpr int TB = 32, NBLK = L / TB;
__device__ __forceinline__ int tok_seq(int z, int j) { return z == 0 ? j : (j < NCTX ? NCTX - 1 - j : L - 1 - (j - NCTX)); }
__device__ __forceinline__ int tok_gla(int z, int j) {
    if (j < NCTX) return z == 0 ? j : NCTX - 1 - j;
    const int jj = j - NCTX, pp = z == 0 ? jj : NLAT - 1 - jj;
    return NCTX + (pp & 255) * 64 + (pp >> 8);
}

template <int NCW> struct ScanRole {
    bool cons, prod; int ct;
    __device__ __forceinline__ ScanRole(int tid) {
        const int w = tid >> 6, lane = tid & 63;
        if (NCW == 4) { cons = w < 4; prod = !cons; ct = tid & 255; }
        else { cons = w < 2; prod = (w & 2) != 0; ct = cons ? tid : ((((w >> 2) << 1) | (w & 1)) * 64 + lane); }
    }
};
__device__ __forceinline__ float rowpair_sum(float x) {
    const unsigned u = __float_as_uint(x); auto r = __builtin_amdgcn_permlane16_swap(u, u, false, false);
    return __uint_as_float(r[0]) + __uint_as_float(r[1]);
}
#define SCAN_BARRIER() asm volatile("s_waitcnt lgkmcnt(0)\n\ts_barrier" ::: "memory")
__device__ __forceinline__ float bfraw2f(unsigned short b) { return __uint_as_float(((unsigned)b) << 16); }
__device__ __forceinline__ f32x4 bf4(u32x2 r) { return (f32x4){__uint_as_float(r[0] << 16), __uint_as_float(r[0] & 0xffff0000u), __uint_as_float(r[1] << 16), __uint_as_float(r[1] & 0xffff0000u)}; }

__device__ __forceinline__ void scan_rwkv(const P& p, int l, int unit, LAS unsigned char* lds) {
    const int z = unit >> 5, h = (unit >> 2) & 7, rq = unit & 3;
    const bf16_t* B = (const bf16_t*)(p.ws + OFF_B); bf16_t* Y = (bf16_t*)(p.ws + OFF_PG) + YRW_COL + z * 512 + h * 64 + rq * 16;
    const float* kaw = p.in[I_RWKA] + l * 512 + h * 64;
    LAS float* vec = (LAS float*)lds;
    LAS float* vv = vec + 2 * TB * 320;
    LAS float* yo = vv + 2 * TB * 16;
    const int tid = otid(); const ScanRole<4> role(tid); const int ct = role.ct; const bool prod = role.prod, cons = role.cons;
    u32x2 pr[2], pk[2], pkk[2], pa[2], pw[2]; unsigned short pv[2];
    const f32x4 kac4 = *(const f32x4*)(kaw + (ct & 15) * 4);
    auto p_load = [&](int blk) {
#pragma unroll
        for (int i = 0; i < 2; ++i) { const int idx = ct + i * 256, s = idx >> 4, n4 = idx & 15; const int t = tok_seq(z, blk * TB + s);
            const bf16_t* bp = B + (size_t)t * 4096 + h * 64 + n4 * 4;
            pr[i] = *(const u32x2*)(bp); pk[i] = *(const u32x2*)(bp + 512); pkk[i] = *(const u32x2*)(bp + 1536); pa[i] = *(const u32x2*)(bp + 2048 + z * 512); pw[i] = *(const u32x2*)(bp + 3072 + z * 512); }
#pragma unroll
        for (int i = 0; i < 2; ++i) { const int idx = ct + i * 256, s = idx >> 4, r = idx & 15; const int t = tok_seq(z, blk * TB + s); pv[i] = B[(size_t)t * 4096 + 1024 + h * 64 + rq * 16 + r]; }
    };
    auto p_write = [&](int buf) {
#pragma unroll
        for (int i = 0; i < 2; ++i) { const int idx = ct + i * 256, s = idx >> 4, n4 = idx & 15;
            LAS float* d = vec + ((buf * TB + s) * 16 + n4) * 20;
            const f32x4 kk = bf4(pkk[i]), a = bf4(pa[i]);
            *(LAS f32x4*)(d) = kk; *(LAS f32x4*)(d + 4) = 1.f - bf4(pw[i]); *(LAS f32x4*)(d + 8) = kk * a;
            *(LAS f32x4*)(d + 12) = bf4(pk[i]) * ((a - 1.f) * kac4 + 1.f); *(LAS f32x4*)(d + 16) = bf4(pr[i]); }
#pragma unroll
        for (int i = 0; i < 2; ++i) vv[buf * TB * 16 + ct + i * 256] = bfraw2f(pv[i]);
    };
    auto p_yout = [&](int blk) {
        const int buf = blk & 1;
#pragma unroll
        for (int i = 0; i < 2; ++i) { const int idx = ct + i * 256, s = idx >> 4, r = idx & 15; const int t = tok_seq(z, blk * TB + s);
            const f32x4 y0 = *(const LAS f32x4*)(yo + (buf * TB * 16 + idx) * 8), y1 = *(const LAS f32x4*)(yo + (buf * TB * 16 + idx) * 8 + 4);
            Y[(size_t)t * PG_LD + r] = f2bf(((y0[0] + y0[1]) + (y0[2] + y0[3])) + ((y1[0] + y1[1]) + (y1[2] + y1[3]))); }
    };
    const int irow = (ct >> 4) & 15, ks = ct & 15;
    f32x2 S0 = (f32x2){0.f, 0.f}, S1 = S0;
    struct Vx { f32x4 kk, w, b, k, r; float v; };
    auto c_ld = [&](Vx& x, int buf, int s) {
        const LAS float* d = vec + ((buf * TB + s) * 16 + ks) * 20;
        x.kk = *(const LAS f32x4*)(d); x.w = *(const LAS f32x4*)(d + 4); x.b = *(const LAS f32x4*)(d + 8); x.k = *(const LAS f32x4*)(d + 12);
        x.r = *(const LAS f32x4*)(d + 16); x.v = vv[(buf * TB + s) * 16 + irow];
    };
    float sa = 0.f;
    auto c_step = [&](const Vx& x, const f32x4& kkn, int buf, int s) {
        const f32x2 vv2 = (f32x2){x.v, x.v}, nsa = (f32x2){-sa, -sa};
        S0 = S0 * (f32x2){x.w[0], x.w[1]} + (vv2 * (f32x2){x.k[0], x.k[1]} + nsa * (f32x2){x.b[0], x.b[1]});
        S1 = S1 * (f32x2){x.w[2], x.w[3]} + (vv2 * (f32x2){x.k[2], x.k[3]} + nsa * (f32x2){x.b[2], x.b[3]});
        const f32x2 y2 = S0 * (f32x2){x.r[0], x.r[1]} + S1 * (f32x2){x.r[2], x.r[3]};
        const f32x2 s2 = S0 * (f32x2){kkn[0], kkn[1]} + S1 * (f32x2){kkn[2], kkn[3]};
        float yp = y2[0] + y2[1], sp = s2[0] + s2[1];
        yp += dpp_<0xB1>(yp); sp += dpp_<0xB1>(sp); sp += dpp_<0x4E>(sp);
        sp += dpp_<0x141>(sp); sp += dpp_<0x140>(sp);
        sa = sp;
        yo[((buf * TB + s) * 16 + irow) * 8 + (ks >> 1)] = yp;
    };
    if (prod) { p_load(0); p_write(0); p_load(1); }
    SCAN_BARRIER();
    for (int b = 0; b < NBLK; ++b) {
        if (prod) {
            if (b + 1 < NBLK) p_write((b + 1) & 1);
            if (b + 2 < NBLK) p_load(b + 2);
            if (b > 0) p_yout(b - 1);
        } else if (cons) {
            const int buf = b & 1;
            Vx xa, xb;
            c_ld(xa, buf, 0);
            { const f32x2 s2 = S0 * (f32x2){xa.kk[0], xa.kk[1]} + S1 * (f32x2){xa.kk[2], xa.kk[3]}; sa = reduce16(s2[0] + s2[1]); }
#pragma unroll
            for (int s = 0; s < TB; s += 2) {
                c_ld(xb, buf, s + 1); c_step(xa, xb.kk, buf, s);
                c_ld(xa, buf, s + 2);
                c_step(xb, xa.kk, buf, s + 1);
            }
        }
        SCAN_BARRIER();
    }
    if (prod) p_yout(NBLK - 1);
    SCAN_BARRIER();
}

__device__ __forceinline__ void scan_gla(const P& p, int l, int unit, LAS unsigned char* lds) {
    const int z = unit >> 4, h = (unit >> 2) & 3, cb = unit & 3;
    const bf16_t* PG = (const bf16_t*)(p.ws + OFF_PG); const bf16_t* GLAD = (const bf16_t*)(p.ws + OFF_GLAD);
    bf16_t* O = (bf16_t*)(p.ws + OFF_R) + z * 512 + h * 128 + cb * 32;
    LAS float* vec = (LAS float*)lds;
    LAS float* vv = vec + 2 * TB * 192;
    LAS float* yo = vv + 2 * TB * 32;
    const int tid = otid(); const ScanRole<4> role(tid); const int ct = role.ct; const bool prod = role.prod, cons = role.cons;
    unsigned short pq[8], pk[8], pa[8], pv[4];
    auto p_load = [&](int blk) {
#pragma unroll
        for (int i = 0; i < 8; ++i) { const int idx = ct + i * 256, s = idx >> 6, n = idx & 63; const int t = tok_gla(z, blk * TB + s);
            const bf16_t* bp = PG + (size_t)t * PG_LD + h * 64 + n;
            pq[i] = bp[GLA_Q]; pk[i] = bp[GLA_K]; pa[i] = GLAD[(size_t)t * 512 + z * 256 + h * 64 + n]; }
#pragma unroll
        for (int i = 0; i < 4; ++i) { const int idx = ct + i * 256, s = idx >> 5, r = idx & 31; const int t = tok_gla(z, blk * TB + s);
            pv[i] = PG[(size_t)t * PG_LD + GLA_V + h * 128 + cb * 32 + r]; }
    };
    auto p_write = [&](int buf) {
#pragma unroll
        for (int i = 0; i < 8; ++i) { const int idx = ct + i * 256, s = idx >> 6, n = idx & 63;
            LAS float* d = vec + ((buf * TB + s) * 8 + (n >> 3)) * 24 + (n & 7);
            d[0] = bfraw2f(pq[i]) * 0.125f; d[8] = bfraw2f(pk[i]); d[16] = 1.f - bfraw2f(pa[i]); }
#pragma unroll
        for (int i = 0; i < 4; ++i) vv[buf * TB * 32 + ct + i * 256] = bfraw2f(pv[i]);
    };
    auto p_yout = [&](int blk) {
        const int buf = blk & 1;
#pragma unroll
        for (int i = 0; i < 4; ++i) { const int idx = ct + i * 256, s = idx >> 5, r = idx & 31; const int t = tok_gla(z, blk * TB + s);
            const f32x4 y0 = *(const LAS f32x4*)(yo + (buf * TB * 32 + idx) * 4);
            O[(size_t)t * R_LD + r] = f2bf((y0[0] + y0[1]) + (y0[2] + y0[3])); }
    };
    const int icol = (ct >> 3) & 31, ks = ct & 7;
    f32x2 S[4];
#pragma unroll
    for (int j = 0; j < 4; ++j) S[j] = (f32x2){0.f, 0.f};
    struct Vx { f32x4 q0, q1, k0, k1, a0, a1; float v; };
    auto c_ld = [&](Vx& x, int buf, int s) {
        const LAS float* d = vec + ((buf * TB + s) * 8 + ks) * 24;
        x.q0 = *(const LAS f32x4*)(d); x.q1 = *(const LAS f32x4*)(d + 4); x.k0 = *(const LAS f32x4*)(d + 8); x.k1 = *(const LAS f32x4*)(d + 12);
        x.a0 = *(const LAS f32x4*)(d + 16); x.a1 = *(const LAS f32x4*)(d + 20); x.v = vv[(buf * TB + s) * 32 + icol];
    };
    auto c_upd = [&](const Vx& x) -> float {
        const f32x2 vv2 = (f32x2){x.v, x.v};
        S[0] = S[0] * (f32x2){x.a0[0], x.a0[1]} + vv2 * (f32x2){x.k0[0], x.k0[1]};
        S[1] = S[1] * (f32x2){x.a0[2], x.a0[3]} + vv2 * (f32x2){x.k0[2], x.k0[3]};
        S[2] = S[2] * (f32x2){x.a1[0], x.a1[1]} + vv2 * (f32x2){x.k1[0], x.k1[1]};
        S[3] = S[3] * (f32x2){x.a1[2], x.a1[3]} + vv2 * (f32x2){x.k1[2], x.k1[3]};
        const f32x2 y2 = (S[0] * (f32x2){x.q0[0], x.q0[1]} + S[1] * (f32x2){x.q0[2], x.q0[3]}) + (S[2] * (f32x2){x.q1[0], x.q1[1]} + S[3] * (f32x2){x.q1[2], x.q1[3]});
        return y2[0] + y2[1];
    };
    if (prod) { p_load(0); p_write(0); p_load(1); }
    SCAN_BARRIER();
    for (int b = 0; b < NBLK; ++b) {
        if (prod) {
            if (b + 1 < NBLK) p_write((b + 1) & 1);
            if (b + 2 < NBLK) p_load(b + 2);
            if (b > 0) p_yout(b - 1);
        } else if (cons) {
            const int buf = b & 1;
            Vx xa, xb;
            c_ld(xa, buf, 0);
#pragma unroll
            for (int s = 0; s < TB; s += 2) {
                c_ld(xb, buf, s + 1);
                float ya = c_upd(xa);
                c_ld(xa, buf, s + 2);
                float yb = c_upd(xb);
                ya += dpp_<0xB1>(ya); yb += dpp_<0xB1>(yb);
                yo[((buf * TB + s) * 32 + icol) * 4 + (ks >> 1)] = ya; yo[((buf * TB + s + 1) * 32 + icol) * 4 + (ks >> 1)] = yb;
            }
        }
        SCAN_BARRIER();
    }
    if (prod) p_yout(NBLK - 1);
    SCAN_BARRIER();
}

__device__ __forceinline__ void scan_gdn(const P& p, int l, int unit, LAS unsigned char* lds) {
    const int z = unit >> 6, h = (unit >> 4) & 3, cb = unit & 15;
    const bf16_t* GDNC = (const bf16_t*)(p.ws + OFF_GDNC); const float* GDNGB = (const float*)(p.ws + OFF_GDNGB);
    bf16_t* O = (bf16_t*)(p.ws + OFF_R) + 1024 + z * 512 + h * 128 + cb * 8;
    LAS float* vec = (LAS float*)lds;
    LAS float* vv = vec + 2 * TB * 384;
    LAS float* sc = vv + 2 * TB * 8;
    LAS float* yo = sc + 2 * TB * 2;
    const int tid = otid(); const ScanRole<4> role(tid); const int ct = role.ct; const bool prod = role.prod, cons = role.cons;
    u32x2 pq[4], pk[4]; unsigned short pv; float psc = 0.f;
    auto p_load = [&](int blk) {
#pragma unroll
        for (int i = 0; i < 4; ++i) { const int idx = ct + i * 256, s = idx >> 5, n4 = idx & 31; const int t = tok_seq(z, blk * TB + s);
            const bf16_t* bp = GDNC + (size_t)t * 1536 + h * 128 + n4 * 4;
            pq[i] = *(const u32x2*)(bp); pk[i] = *(const u32x2*)(bp + 512); }
        { const int s = ct >> 3, r = ct & 7; const int t = tok_seq(z, blk * TB + s); pv = GDNC[(size_t)t * 1536 + 1024 + h * 128 + cb * 8 + r]; }
        if (ct < 64) { const int s = ct >> 1, w = ct & 1; const int t = tok_seq(z, blk * TB + s); psc = GDNGB[t * 16 + w * 8 + z * 4 + h]; }
    };
    auto p_write = [&](int buf) {
#pragma unroll
        for (int i = 0; i < 4; ++i) { const int idx = ct + i * 256, s = idx >> 5, n4 = idx & 31;
            LAS float* d = vec + ((buf * TB + s) * 32 + n4) * 12;
            *(LAS f32x4*)(d) = bf4(pq[i]); *(LAS f32x4*)(d + 4) = bf4(pk[i]); }
        vv[buf * TB * 8 + ct] = bfraw2f(pv);
        if (ct < 64) sc[buf * TB * 2 + ct] = psc;
    };
    auto p_yout = [&](int blk) {
        const int buf = blk & 1; const int s = ct >> 3, r = ct & 7; const int t = tok_seq(z, blk * TB + s);
        const f32x4 y0 = *(const LAS f32x4*)(yo + (buf * TB * 8 + ct) * 8), y1 = *(const LAS f32x4*)(yo + (buf * TB * 8 + ct) * 8 + 4);
        O[(size_t)t * R_LD + r] = f2bf(((y0[0] + y0[1]) + (y0[2] + y0[3])) + ((y1[0] + y1[1]) + (y1[2] + y1[3])));
    };
    const int icol = (ct >> 5) & 7, ks = ct & 31;
    f32x2 S0 = (f32x2){0.f, 0.f}, S1 = S0;
    struct Vx { f32x4 q, k; float v; f32x2 gb; };
    auto c_ld = [&](Vx& x, int buf, int s) {
        const LAS float* d = vec + ((buf * TB + s) * 32 + ks) * 12;
        x.q = *(const LAS f32x4*)(d); x.k = *(const LAS f32x4*)(d + 4);
        x.v = vv[(buf * TB + s) * 8 + icol]; x.gb = *(const LAS f32x2*)(sc + (buf * TB + s) * 2);
    };
    float dd = 0.f;
    auto c_step = [&](const Vx& x, const f32x4& kn, int buf, int s) {
        const float eg = x.gb[0];
        const float cc = x.gb[1] * (x.v - eg * dd);
        const f32x2 eg2 = (f32x2){eg, eg}, cc2 = (f32x2){cc, cc};
        S0 = S0 * eg2 + cc2 * (f32x2){x.k[0], x.k[1]};
        S1 = S1 * eg2 + cc2 * (f32x2){x.k[2], x.k[3]};
        const f32x2 y2 = S0 * (f32x2){x.q[0], x.q[1]} + S1 * (f32x2){x.q[2], x.q[3]};
        const f32x2 d2 = S0 * (f32x2){kn[0], kn[1]} + S1 * (f32x2){kn[2], kn[3]};
        float yp = y2[0] + y2[1], dp = d2[0] + d2[1];
        yp += dpp_<0xB1>(yp); dp += dpp_<0xB1>(dp); yp += dpp_<0x4E>(yp); dp += dpp_<0x4E>(dp);
        dp += dpp_<0x141>(dp); dp += dpp_<0x140>(dp);
        dp = rowpair_sum(dp);
        dd = dp;
        yo[((buf * TB + s) * 8 + icol) * 8 + (ks >> 2)] = yp;
    };
    if (prod) { p_load(0); p_write(0); p_load(1); }
    SCAN_BARRIER();
    for (int b = 0; b < NBLK; ++b) {
        if (prod) {
            if (b + 1 < NBLK) p_write((b + 1) & 1);
            if (b + 2 < NBLK) p_load(b + 2);
            if (b > 0) p_yout(b - 1);
        } else if (cons) {
            const int buf = b & 1;
            Vx xa, xb;
            c_ld(xa, buf, 0);
            { const f32x2 d2 = S0 * (f32x2){xa.k[0], xa.k[1]} + S1 * (f32x2){xa.k[2], xa.k[3]}; dd = rowpair_sum(reduce16(d2[0] + d2[1])); }
#pragma unroll
            for (int s = 0; s < TB; s += 2) {
                c_ld(xb, buf, s + 1); c_step(xa, xb.k, buf, s);
                c_ld(xa, buf, s + 2);
                c_step(xb, xa.k, buf, s + 1);
            }
        }
        SCAN_BARRIER();
    }
    if (prod) p_yout(NBLK - 1);
    SCAN_BARRIER();
}

__device__ __forceinline__ void unpack8(const u32x4 r, float (&f)[8]) {
#pragma unroll
    for (int j = 0; j < 4; ++j) { f[2 * j] = __uint_as_float(r[j] << 16); f[2 * j + 1] = __uint_as_float(r[j] & 0xffff0000u); }
}
__device__ __forceinline__ u32x4 pack8(const float (&f)[8]) { u32x4 o; o[0] = pk2(f[0], f[1]); o[1] = pk2(f[2], f[3]); o[2] = pk2(f[4], f[5]); o[3] = pk2(f[6], f[7]); return o; }
__device__ __forceinline__ void phase_post(const P& p, int l, LAS unsigned char* lds) {
    const bf16_t* PG = (const bf16_t*)(p.ws + OFF_PG); const bf16_t* Rb = (const bf16_t*)(p.ws + OFF_R); const bf16_t* B = (const bf16_t*)(p.ws + OFF_B);
    const bf16_t* RWG = (const bf16_t*)(p.ws + OFF_RWG);
    bf16_t* YC = (bf16_t*)(p.ws + OFF_GDNC);
    const int tid = otid(), wave = tid >> 6, lane = tid & 63, c0 = lane * 8;
    float lnw[8], lnb[8], kac[8], rkc[8], gng[8], dng[8];
#pragma unroll
    for (int j = 0; j < 8; ++j) { lnw[j] = p.in[I_RWLNW][l * 512 + c0 + j]; lnb[j] = p.in[I_RWLNB][l * 512 + c0 + j]; kac[j] = p.in[I_RWKA][l * 512 + c0 + j]; rkc[j] = p.in[I_RWRK][l * 512 + c0 + j];
        gng[j] = p.in[I_GLANG][l * 128 + ((c0 + j) & 127)]; dng[j] = p.in[I_GDNNG][l * 128 + ((c0 + j) & 127)]; }
#pragma unroll 1
    for (int t = blockIdx.x * 8 + wave; t < L; t += gridDim.x * 8) {
        const bf16_t* pgr = PG + (size_t)t * PG_LD; const bf16_t* br = B + (size_t)t * 4096 + c0; const bf16_t* rr = Rb + (size_t)t * R_LD + c0;
        const u32x4 qy0 = *(const u32x4*)(pgr + YRW_COL + c0), qy1 = *(const u32x4*)(pgr + YRW_COL + 512 + c0);
        const u32x4 qr = *(const u32x4*)(br), qk = *(const u32x4*)(br + 512), qv = *(const u32x4*)(br + 1024), qa0 = *(const u32x4*)(br + 2048), qa1 = *(const u32x4*)(br + 2560);
        const u32x4 qg = *(const u32x4*)(RWG + (size_t)t * 512 + c0);
        const u32x4 qo0 = *(const u32x4*)(rr), qo1 = *(const u32x4*)(rr + 512), qd0 = *(const u32x4*)(rr + 1024), qd1 = *(const u32x4*)(rr + 1536);
        const u32x4 qog = *(const u32x4*)(pgr + GLA_OG + c0), qzg = *(const u32x4*)(pgr + GDN_ZG + c0);
        float a[8], b[8], o[8];
        unpack8(qy0, a); unpack8(qy1, b);
        float s = 0.f;
#pragma unroll
        for (int j = 0; j < 8; ++j) { a[j] += b[j]; s += a[j]; }
        const float mean = reduce8(s) * (1.f / 64.f);
        float s2 = 0.f;
#pragma unroll
        for (int j = 0; j < 8; ++j) { a[j] -= mean; s2 += a[j] * a[j]; }
        const float rstd = rsqrtf(reduce8(s2) * (1.f / 64.f) + 64e-5f);
        {
            float r[8], k[8], z0[8], z1[8];
            unpack8(qr, r); unpack8(qk, k); unpack8(qa0, z0); unpack8(qa1, z1);
            float sb = 0.f;
#pragma unroll
            for (int j = 0; j < 8; ++j) sb += r[j] * rkc[j] * (k[j] * (1.f + (z0[j] - 1.f) * kac[j]) + k[j] * (1.f + (z1[j] - 1.f) * kac[j]));
            const float bon = reduce8(sb);
            unpack8(qv, r); unpack8(qg, k);
#pragma unroll
            for (int j = 0; j < 8; ++j) o[j] = (a[j] * rstd * lnw[j] + lnb[j] + bon * r[j]) * k[j];
            *(u32x4*)(YC + (size_t)t * 512 + c0) = pack8(o);
        }
        unpack8(qo0, a); unpack8(qo1, b);
        s = 0.f;
#pragma unroll
        for (int j = 0; j < 8; ++j) { a[j] += b[j]; s += a[j] * a[j]; }
        float rs = rsqrtf(reduce16(s) * (1.f / 128.f) + 1e-6f);
        unpack8(qog, b);
#pragma unroll
        for (int j = 0; j < 8; ++j) o[j] = a[j] * rs * gng[j] * silu_(b[j]);
        *(u32x4*)(YC + (size_t)L * 512 + (size_t)t * 512 + c0) = pack8(o);
        unpack8(qd0, a); unpack8(qd1, b);
        s = 0.f;
#pragma unroll
        for (int j = 0; j < 8; ++j) { a[j] += b[j]; s += a[j] * a[j]; }
        rs = rsqrtf(reduce16(s) * (1.f / 128.f) + 1e-6f);
        unpack8(qzg, b);
#pragma unroll
        for (int j = 0; j < 8; ++j) o[j] = a[j] * rs * dng[j] * silu_(b[j]);
        *(u32x4*)(YC + (size_t)2 * L * 512 + (size_t)t * 512 + c0) = pack8(o);
    }
}

__device__ __forceinline__ void phase_final(const P& p) {
    const float* H = (const float*)(p.ws + OFF_H); const float* gamma = p.in[I_FINALG];
    const int tid_ = otid(); const int wave = tid_ >> 6, lane = tid_ & 63;
    for (int row = blockIdx.x * 8 + wave; row < NLAT; row += gridDim.x * 8) {
        const float* src = H + (size_t)(row + NCTX) * 1024;
        f32x4 v[4]; float ss = 0.f;
#pragma unroll
        for (int j = 0; j < 4; ++j) { v[j] = *(const f32x4*)(src + j * 256 + lane * 4); ss += (v[j][0] * v[j][0] + v[j][1] * v[j][1]) + (v[j][2] * v[j][2] + v[j][3] * v[j][3]); }
        ss = wave_sum(ss);
        const float rstd = rsqrtf(ss * (1.f / 1024.f) + 1e-6f);
#pragma unroll
        for (int j = 0; j < 4; ++j) { const int col = j * 256 + lane * 4; const f32x4 g = *(const f32x4*)(gamma + col);
            *(f32x4*)(p.out + (size_t)row * 1024 + col) = v[j] * rstd * g; }
    }
}


#define XB_TMO      128
#define XB_XCNT(j)  (256  + 64 * (j))
#define XB_XSUB(j)  (1280 + 64 * (j))
#define XB_XGEN(j)  (2304 + 64 * (j))
#define XB_TOP      3328
#define XB_TOPGEN   3392
#define XCD_BAR_WORDS 3456
#define XB_SPIN_CAP (1u << 18)
__device__ __forceinline__ unsigned xb_ld(unsigned* p)              { return __hip_atomic_load(p, __ATOMIC_RELAXED, __HIP_MEMORY_SCOPE_AGENT); }
__device__ __forceinline__ unsigned xb_add(unsigned* p, unsigned v) { return __hip_atomic_fetch_add(p, v, __ATOMIC_RELAXED, __HIP_MEMORY_SCOPE_AGENT); }
__device__ __forceinline__ unsigned xb_xcc_id() { return (unsigned)__builtin_amdgcn_s_getreg((3 << 11) | 20) & 0xFu; }
#define XB_SPIN(cond, bar) do { unsigned _sp = 0; while (cond) { __builtin_amdgcn_s_sleep(1); \
    if ((++_sp & 255u) == 0u) { if (xb_ld(&(bar)[XB_TMO])) break; if (_sp > XB_SPIN_CAP) { atomicAdd(&(bar)[XB_TMO], 1u); break; } } } } while (0)
struct XcdBarrier { unsigned* bar; unsigned x; volatile LAS unsigned* st; };
__device__ __forceinline__ XcdBarrier xcd_barrier_post(unsigned* bar, volatile LAS unsigned* st) {
    XcdBarrier b; b.bar = bar; b.x = xb_xcc_id(); b.st = st;
    if (threadIdx.x == 0) (void)xb_add(&bar[XB_XCNT(b.x)], 1u);
    return b;
}
__device__ __forceinline__ void xcd_barrier_complete(unsigned* bar, unsigned x, unsigned& nloc, unsigned& nx) {
    const unsigned G = gridDim.x * gridDim.y * gridDim.z;
    unsigned sum, cnt, mine, sp = 0u;
    for (;;) {
        sum = 0u; cnt = 0u; mine = 0u;
#pragma unroll
        for (unsigned j = 0; j < 16; ++j) { const unsigned c = xb_ld(&bar[XB_XCNT(j)]); sum += c; cnt += (c > 0u) ? 1u : 0u; mine = (j == x) ? c : mine; }
        if (sum == G) break;
        __builtin_amdgcn_s_sleep(1);
        if ((++sp & 255u) == 0u) { if (xb_ld(&bar[XB_TMO])) break; if (sp > XB_SPIN_CAP) { atomicAdd(&bar[XB_TMO], 1u); break; } }
    }
    nloc = mine > 0u ? mine : 1u; nx = cnt > 0u ? cnt : 1u;
}
__device__ __forceinline__ void xcd_barrier(const XcdBarrier& b) {
    asm volatile("s_waitcnt vmcnt(0)" ::: "memory");
    __syncthreads();
    if (threadIdx.x == 0) {
        unsigned* bar = b.bar;
        __builtin_amdgcn_s_waitcnt(0);
        unsigned nloc = b.st[0], nx = b.st[1];
        if (nloc == 0u) { xcd_barrier_complete(bar, b.x, nloc, nx); b.st[0] = nloc; b.st[1] = nx; }
        const unsigned old = xb_add(&bar[XB_XSUB(b.x)], 1u);
        const unsigned gen = old / nloc;
        if (old + 1u == (gen + 1u) * nloc) {
            __builtin_amdgcn_fence(__ATOMIC_RELEASE, "agent");
            asm volatile("s_waitcnt vmcnt(0)" ::: "memory");
            const unsigned og = xb_add(&bar[XB_TOP], 1u);
            const unsigned tg = og / nx;
            if (og + 1u == (tg + 1u) * nx) xb_add(&bar[XB_TOPGEN], 1u);
            else XB_SPIN(xb_ld(&bar[XB_TOPGEN]) == tg, bar);
            __builtin_amdgcn_fence(__ATOMIC_ACQUIRE, "agent");
            xb_add(&bar[XB_XGEN(b.x)], 1u);
            asm volatile("s_waitcnt vmcnt(0)" ::: "memory");
        } else {
            XB_SPIN(xb_ld(&bar[XB_XGEN(b.x)]) == gen, bar);
            __builtin_amdgcn_fence(__ATOMIC_ACQUIRE, "agent");
            asm volatile("s_waitcnt vmcnt(0)" ::: "memory");
        }
    }
    __syncthreads();
}

__global__ void __launch_bounds__(512, 2) fwd_megakernel(P p) {
    extern __shared__ __attribute__((aligned(16))) unsigned char shm_raw[];
    LAS unsigned char* lds = (LAS unsigned char*)shm_raw;
    cg::grid_group grid = cg::this_grid();
    const int G = gridDim.x, wg = blockIdx.x;
    unsigned char* ws = p.ws;
    float* H = (float*)(ws + OFF_H); bf16_t* HN = (bf16_t*)(ws + OFF_HN); bf16_t* WIN = (bf16_t*)(ws + OFF_WIN);
    const float* MODall = (const float*)(ws + OFF_MOD);

    volatile LAS unsigned* xbst = (volatile LAS unsigned*)(lds + 131072);
    if (threadIdx.x == 0) { xbst[0] = 0u; xbst[1] = 0u; xbst[2] = 0u; xbst[3] = 0u; }
    __syncthreads();
    const XcdBarrier xb = xcd_barrier_post((unsigned*)(ws + OFF_BAR), xbst);
    phase_mod(p, lds);
    grid.sync();
    for (int l = 0; l < DEPTH; ++l) {
        const float* MOD = MODall + (size_t)l * 2 * 6144;
        const bool lastl = (l == DEPTH - 1);
        const int Mg = lastl ? NLAT : L, pm0 = lastl ? 1 : 0;
        if (l == 0) phase_norm<true>(p, l, p.in[I_N1G] + l * 1024, 0, 1); else phase_norm<false>(p, l, p.in[I_N1G] + l * 1024, 0, 1);
        {
            const float* win = p.in[I_WIN] + (size_t)l * 1024 * IN_COLS;
            convert_T(win, IN_COLS, 1024, 0, 1920, WIN, (LAS float*)lds, wg, G);
            convert_T(win, IN_COLS, 1024, 1920, 3632, WIN + (size_t)2048 * 1024, (LAS float*)lds, (wg + 64) % G, G);
            convert_T(win, IN_COLS, 1024, 5552, 3072, WIN + (size_t)NMAIN * 1024, (LAS float*)lds, (wg + 128) % G, G);
            build_wl(p, l, wg, G);
        }
        xcd_barrier(xb);
        {
            pg8::Gemm g{HN, WIN, L, NMAIN, 1024, 16}; pg8::StaticOrder S; S.init(L, NMAIN, G, wg);
            EpiInMain E{(bf16_t*)(ws + OFF_R), (bf16_t*)(ws + OFF_PG)};
            pg8::gemm_phase(lds, g, S, E);
        }
        xcd_barrier(xb);
#ifndef NO_PREP
        phase_prep(p, l, lds);
        xcd_barrier(xb);
        {
            pg8::Gemm g{(const bf16_t*)(ws + OFF_XL), (const bf16_t*)(ws + OFF_WL), L, 2560, 512, 8}; pg8::StaticOrder S; S.init(L, 2560, G, wg);
            EpiLora E{(bf16_t*)(ws + OFF_B), (bf16_t*)(ws + OFF_RWG), p.in[I_RWW0] + (size_t)l * 1024, p.in[I_RWA0] + (size_t)l * 1024};
            pg8::gemm_phase(lds, g, S, E);
        }
#endif
        xcd_barrier(xb);
#ifndef NO_SCAN
        if (wg < 64) scan_rwkv(p, l, wg, lds);
        else if (wg < 96) scan_gla(p, l, wg - 64, lds);
        else if (wg < 224) scan_gdn(p, l, wg - 96, lds);
#endif
        xcd_barrier(xb);
#ifndef NO_POST
        phase_post(p, l, lds);
#endif
        xcd_barrier(xb);
        {
            convert_T(p.in[I_WBR] + (size_t)l * 3 * 512 * 1024, 1024, 512, 0, 1024, (bf16_t*)(ws + OFF_WBR), (LAS float*)lds, wg, G);
            convert_T(p.in[I_WBR] + (size_t)l * 3 * 512 * 1024 + (size_t)512 * 1024, 1024, 512, 0, 1024, (bf16_t*)(ws + OFF_WBR) + (size_t)1024 * 512, (LAS float*)lds, (wg + 128) % G, G);
            convert_T(p.in[I_WBR] + (size_t)l * 3 * 512 * 1024 + (size_t)2 * 512 * 1024, 1024, 512, 0, 1024, (bf16_t*)(ws + OFF_WBR) + (size_t)2 * 1024 * 512, (LAS float*)lds, wg, G);
            convert_T(p.in[I_WOUT] + (size_t)l * 1024 * 1024, 1024, 1024, 0, 1024, (bf16_t*)(ws + OFF_WOUT), (LAS float*)lds, wg, G);
            convert_T(p.in[I_W1] + (size_t)l * 1024 * 4096, 4096, 1024, 0, 4096, (bf16_t*)(ws + OFF_W1), (LAS float*)lds, wg, G);
            convert_T(p.in[I_W2] + (size_t)l * 4096 * 1024, 1024, 4096, 0, 1024, (bf16_t*)(ws + OFF_W2), (LAS float*)lds, wg, G);
            pg8::Gemm g{HN, WIN + (size_t)NMAIN * 1024, L, 3072, 1024, 16}; pg8::StaticOrder S; S.init(Mg, 3072, G, wg, pm0);
            EpiGates E{(bf16_t*)(ws + OFF_B)};
            pg8::gemm_phase(lds, g, S, E);
        }
        xcd_barrier(xb);
        {
            const bf16_t* YC = (const bf16_t*)(ws + OFF_GDNC); const bf16_t* WBR = (const bf16_t*)(ws + OFF_WBR);
            pg8::StaticOrder S; S.init(Mg, 1024, G, wg, pm0);
            { pg8::Gemm g{YC, WBR, L, 1024, 512, 8}; EpiBranch<0> E{(const bf16_t*)(ws + OFF_B), (float*)(ws + OFF_PG), HN}; pg8::gemm_phase(lds, g, S, E); }
            { pg8::Gemm g{YC + (size_t)L * 512, WBR + (size_t)1024 * 512, L, 1024, 512, 8}; EpiBranch<1> E{(const bf16_t*)(ws + OFF_B), (float*)(ws + OFF_PG), HN}; pg8::gemm_phase(lds, g, S, E); }
            { pg8::Gemm g{YC + (size_t)2 * L * 512, WBR + (size_t)2 * 1024 * 512, L, 1024, 512, 8}; EpiBranch<2> E{(const bf16_t*)(ws + OFF_B), (float*)(ws + OFF_PG), HN}; pg8::gemm_phase(lds, g, S, E); }
        }
        xcd_barrier(xb);
        {
            pg8::Gemm g{HN, (const bf16_t*)(ws + OFF_WOUT), L, 1024, 1024, 16}; pg8::StaticOrder S; S.init(Mg, 1024, G, wg, pm0);
            EpiResid E{H, MOD + 2 * 1024, MOD + 6144 + 2 * 1024};
            pg8::gemm_phase(lds, g, S, E);
        }
        xcd_barrier(xb);
        phase_norm<false>(p, l, p.in[I_N2G] + l * 1024, 3, 4);
        xcd_barrier(xb);
        {
            pg8::Gemm g{HN, (const bf16_t*)(ws + OFF_W1), L, 4096, 1024, 16}; pg8::StaticOrder S; S.init(Mg, 4096, G, wg, pm0);
            EpiMlp1 E{(bf16_t*)(ws + OFF_B)};
            pg8::gemm_phase(lds, g, S, E);
        }
        xcd_barrier(xb);
        {
            pg8::Gemm g{(const bf16_t*)(ws + OFF_B), (const bf16_t*)(ws + OFF_W2), L, 1024, 4096, 64}; pg8::StaticOrder S; S.init(Mg, 1024, G, wg, pm0);
            EpiResid E{H, MOD + 5 * 1024, MOD + 6144 + 5 * 1024};
            pg8::gemm_phase(lds, g, S, E);
        }
        xcd_barrier(xb);
    }
    phase_final(p);
}

extern "C" void kernel_launch(void* const* d_in, const int* in_sizes, int n_in, void* d_out, int out_size, void* d_ws, size_t ws_size, hipStream_t stream) {
    static int grid_blocks = 0;
    if (n_in != 32 || ws_size < WS_END || out_size != NLAT * DM) {
        fprintf(stderr, "kernel_launch: unexpected shapes / workspace (n_in %d, ws %zu need %zu, out %d)\n", n_in, ws_size, (size_t)WS_END, out_size);
        hipMemsetAsync(d_out, 0xFF, (size_t)out_size * 4, stream);
        return;
    }
    if (!grid_blocks) {
        int dev = 0, cus = 0, per_cu = 0;
        hipGetDevice(&dev);
        hipDeviceGetAttribute(&cus, hipDeviceAttributeMultiprocessorCount, dev);
        hipFuncSetAttribute((const void*)fwd_megakernel, hipFuncAttributeMaxDynamicSharedMemorySize, LDS_BYTES);
        hipOccupancyMaxActiveBlocksPerMultiprocessor(&per_cu, (const void*)fwd_megakernel, 512, LDS_BYTES);
        if (per_cu < 1) per_cu = 1;
        grid_blocks = cus * 1;
        (void)hipGetLastError();
    }
    P p{};
    for (int i = 0; i < 32; ++i) p.in[i] = (const float*)d_in[i];
    p.out = (float*)d_out; p.ws = (unsigned char*)d_ws;
    (void)hipMemsetAsync((unsigned char*)d_ws + OFF_BAR, 0, 16384, stream);
    void* args[] = {&p};
    hipError_t e = hipLaunchCooperativeKernel((const void*)fwd_megakernel, dim3(grid_blocks), dim3(512), args, LDS_BYTES, stream);
    if (e != hipSuccess) fprintf(stderr, "cooperative launch failed: %s (grid %d)\n", hipGetErrorString(e), grid_blocks);
}
```

```cpp
#include <hip/hip_runtime.h>
#include <hip/hip_cooperative_groups.h>
#include <cstdio>
#include <cstdint>
namespace cg = cooperative_groups;

#define LAS __attribute__((address_space(3)))
typedef unsigned short bf16_t;
typedef short bf16x8 __attribute__((ext_vector_type(8)));
typedef float f32x4 __attribute__((ext_vector_type(4)));
typedef float f32x2 __attribute__((ext_vector_type(2)));
typedef unsigned u32x4 __attribute__((ext_vector_type(4)));
typedef unsigned u32x2 __attribute__((ext_vector_type(2)));

constexpr int L = 16640, NCTX = 256, NLAT = 16384, DM = 1024, BW = 512, DEPTH = 4;
constexpr int IN_COLS = 8624;
constexpr int NMAIN = 5888;
constexpr int NWIN = 8960;
constexpr int R_LD = 2048, PG_LD = 3840;
constexpr int GLA_Q = 0, GLA_K = 256, GLA_V = 512, GLA_OG = 1024, GLA_AL = 1536;
constexpr int GDN_QKV = 1568, GDN_ZG = 3104, GDN_A = 3616, GDN_B = 3624;
constexpr int YRW_COL = 1568;

constexpr size_t al256(size_t x) { return (x + 255) & ~(size_t)255; }
constexpr size_t OFF_MOD = 0;
constexpr size_t OFF_H = al256(OFF_MOD + (size_t)4 * 2 * 6144 * 4);
constexpr size_t OFF_HN = OFF_H + (size_t)L * 1024 * 4;
constexpr size_t OFF_WIN = OFF_HN + (size_t)L * 1024 * 2;
constexpr size_t OFF_R = OFF_WIN + (size_t)NWIN * 1024 * 2;
constexpr size_t OFF_PG = OFF_R + (size_t)L * R_LD * 2;
constexpr size_t OFF_B = OFF_PG + (size_t)L * PG_LD * 2;
constexpr size_t OFF_RWG = OFF_B + (size_t)L * 4096 * 2;
constexpr size_t OFF_BONUS = OFF_RWG + (size_t)L * 512 * 2;
constexpr size_t OFF_GLAD = OFF_BONUS + (size_t)L * 8 * 4;
constexpr size_t OFF_GDNC = OFF_GLAD + (size_t)L * 512 * 2;
constexpr size_t OFF_GDNGB = OFF_GDNC + (size_t)L * 1536 * 2;
constexpr size_t OFF_XL = OFF_GDNGB + (size_t)L * 16 * 4;
constexpr size_t OFF_WL = OFF_XL + (size_t)L * 512 * 2;
constexpr size_t OFF_BAR = OFF_WL + (size_t)2560 * 512 * 2;
constexpr size_t WS_END = OFF_BAR + 16384;
constexpr size_t OFF_WBR = OFF_R;
constexpr size_t OFF_WOUT = OFF_WBR + (size_t)3 * 1024 * 512 * 2;
constexpr size_t OFF_W1 = OFF_WOUT + (size_t)1024 * 1024 * 2;
constexpr size_t OFF_W2 = OFF_W1 + (size_t)4096 * 1024 * 2;

constexpr int LDS_BYTES = 131072 + 16;

struct P { const float* in[32]; float* out; unsigned char* ws; };
enum { I_X = 0, I_C, I_CTX, I_CCTX, I_WMOD, I_BMOD, I_N1G, I_WIN, I_RWMU, I_RWW0, I_RWW2, I_RWA0, I_RWA2, I_RWG2, I_RWKK, I_RWKA, I_RWRK,
       I_RWLNW, I_RWLNB, I_GLAA2, I_GLAAB, I_GLANG, I_GDNCONV, I_GDNALOG, I_GDNDT, I_GDNNG, I_WBR, I_WOUT, I_N2G, I_W1, I_W2, I_FINALG };

__device__ __forceinline__ float bf2f(bf16_t b) { return __uint_as_float(((unsigned)b) << 16); }
__device__ __forceinline__ unsigned pk2(float lo, float hi) { unsigned r; asm("v_cvt_pk_bf16_f32 %0, %1, %2" : "=v"(r) : "v"(lo), "v"(hi)); return r; }
__device__ __forceinline__ bf16_t f2bf(float f) { return (bf16_t)(pk2(f, 0.f) & 0xffffu); }
__device__ __forceinline__ float sigmoid_(float x) { return 1.f / (1.f + __expf(-x)); }
__device__ __forceinline__ float silu_(float x) { return x / (1.f + __expf(-x)); }
__device__ __forceinline__ float softplus_(float x) { return fmaxf(x, 0.f) + log1pf(__expf(-fabsf(x))); }
template <int CTRL> __device__ __forceinline__ float dpp_(float x) { return __int_as_float(__builtin_amdgcn_update_dpp(0, __float_as_int(x), CTRL, 0xF, 0xF, true)); }
__device__ __forceinline__ float reduce8(float x) { x += dpp_<0xB1>(x); x += dpp_<0x4E>(x); x += dpp_<0x141>(x); return x; }
__device__ __forceinline__ float reduce16(float x) { x = reduce8(x); x += dpp_<0x140>(x); return x; }
__device__ __forceinline__ float wave_sum(float v) {
    v = reduce16(v);
    const float r0 = __int_as_float(__builtin_amdgcn_readlane(__float_as_int(v), 0)), r1 = __int_as_float(__builtin_amdgcn_readlane(__float_as_int(v), 16));
    const float r2 = __int_as_float(__builtin_amdgcn_readlane(__float_as_int(v), 32)), r3 = __int_as_float(__builtin_amdgcn_readlane(__float_as_int(v), 48));
    return (r0 + r1) + (r2 + r3);
}

__device__ __forceinline__ int otid() { int t = threadIdx.x; asm volatile("" : "+v"(t)); return t; }
__device__ __forceinline__ int osgpr(int x) { asm volatile("" : "+s"(x)); return x; }
namespace pg8 {
constexpr int BM = 256, BK = 64, HALF = 128, HTB = HALF * BK * 2, STAGE_BYTES = 8 * HTB, NXCD = 8, WGM = 8;
__host__ __device__ __forceinline__ int lds_byte(int r, int c) { const int st = (r >> 4) * 2 + (c >> 5), rr = r & 15, cc = c & 31, ob = rr * 64 + cc * 2; return st * 1024 + (ob ^ (((ob >> 9) & 1) << 5)); }
__host__ __device__ __forceinline__ int perm32(int rho) { const int n = rho >> 4, i = rho & 15; return 8 * (i >> 2) + 4 * n + (i & 3); }
__host__ __device__ __forceinline__ void stage_rc(int b, int& R, int& C) { const int st = b / 1024, sb = b % 1024, swz = sb ^ (((sb >> 9) & 1) << 5); R = (st >> 1) * 16 + swz / 64; C = (st & 1) * 32 + (swz % 64) / 2; }
struct Unit { int pm, pn, k0; };
struct Gemm { const bf16_t* A; const bf16_t* Bt; int M, N, K, nt; };
struct StaticOrder {
    int nM, nN, nwg, G, c, pm0;
    __host__ __device__ void init(int M, int N, int G_, int c_, int pm0_ = 0) { nM = M / BM; nN = N / BM; nwg = nM * nN; G = G_; c = c_; pm0 = pm0_; }
    __host__ __device__ bool next(int i, Unit& u) const {
        const long Lx = (long)i * G + c; if (Lx >= nwg) return false;
        int wgid = (int)Lx; { const int q = nwg / NXCD, r = nwg % NXCD, xcd = wgid % NXCD, off = wgid / NXCD; wgid = (xcd < r ? xcd * (q + 1) : r * (q + 1) + (xcd - r) * q) + off; }
        const int nig = WGM * nN, gid = wgid / nig, fm = gid * WGM, gsz = (nM - fm) < WGM ? (nM - fm) : WGM;
        u.pm = pm0 + fm + ((wgid % nig) % gsz); u.pn = (wgid % nig) / gsz; u.k0 = 0; return true;
    }
};
struct SplitOrder {
    int nN, nunits, G, c, nt;
    __host__ __device__ void init(int N, int K, int nt_, int G_, int c_) { nN = N / BM; nt = nt_; nunits = nN * (K / BK / nt_); G = G_; c = c_; }
    __host__ __device__ bool next(int i, Unit& u) const {
        const int idx = i * G + c; if (idx >= nunits) return false;
        u.pm = 0; u.pn = idx % nN; u.k0 = (idx / nN) * nt; return true;
    }
};
template <class Epi, class Ord>
__device__ __forceinline__ void gemm_phase(LAS unsigned char* lds, const Gemm g, const Ord& S, const Epi& E) {
#ifdef NO_GEMM
    return;
#endif
    const int tid = otid(), wid = __builtin_amdgcn_readfirstlane(tid >> 6), lane = tid & 63, wr = wid >> 2, wc = wid & 3, fr = lane & 15, fq = lane >> 4;
    const int K = g.K, nt = g.nt;
    unsigned voffA[2], voffB[2];
#pragma unroll
    for (int i = 0; i < 2; ++i) { int R, C; stage_rc(tid * 16 + i * 8192, R, C); const int Rb = (R & ~31) + perm32(R & 31);
        voffA[i] = (unsigned)(R * K + C) * 2u; voffB[i] = (unsigned)(Rb * K + C) * 2u; }
    const size_t kstep = (size_t)(BK * 2);
    const size_t hstep = (size_t)HALF * K * 2;
    const size_t tstep = 2 * hstep;
    const unsigned ldsw = (unsigned)wid * 1024u;
    const int aoff = lds_byte(wr * 64 + fr, fq * 8), boff = lds_byte(wc * 32 + fr, fq * 8);
#define PG8_SA(b, h) (((b) * 2 + (h)) * HTB)
#define PG8_SB(b, h) ((4 + (b) * 2 + (h)) * HTB)
#define PG8_STAGE(bufoff, gbase, voff) do { _Pragma("unroll") for (int _i = 0; _i < 2; ++_i) \
        __builtin_amdgcn_global_load_lds((const unsigned*)((const char*)(gbase) + (voff)[_i]), (LAS unsigned*)(lds + (bufoff) + ldsw + _i * 8192), 16, 0, 0); } while (0)
#define PG8_LDA(dst, b, h) do { _Pragma("unroll") for (int m = 0; m < 4; ++m) _Pragma("unroll") for (int k = 0; k < 2; ++k) dst[m][k] = *(const LAS bf16x8*)(lds + PG8_SA(b, h) + aoff + m * 2048 + k * 1024); } while (0)
#define PG8_LDB(dst, b, h) do { _Pragma("unroll") for (int n = 0; n < 2; ++n) _Pragma("unroll") for (int k = 0; k < 2; ++k) dst[n][k] = *(const LAS bf16x8*)(lds + PG8_SB(b, h) + boff + n * 2048 + k * 1024); } while (0)
#define PG8_MMA(ai, bj, At, Bt) do { __builtin_amdgcn_s_setprio(1); _Pragma("unroll") for (int m = 0; m < 4; ++m) _Pragma("unroll") for (int n = 0; n < 2; ++n) _Pragma("unroll") for (int k = 0; k < 2; ++k) \
        acc[ai][bj][m][n] = __builtin_amdgcn_mfma_f32_16x16x32_bf16(Bt[n][k], At[m][k], acc[ai][bj][m][n], 0, 0, 0); __builtin_amdgcn_s_setprio(0); } while (0)
#define PG8_WAIT_V(n) asm volatile("s_waitcnt vmcnt(" #n ")" ::: "memory")
#define PG8_WAIT_L(n) asm volatile("s_waitcnt lgkmcnt(" #n ")" ::: "memory")
#define PG8_BAR __builtin_amdgcn_s_barrier()
#define PG8_SCHED __builtin_amdgcn_sched_barrier(0)
    Unit cur, nxt; int ui = 0;
    if (!S.next(0, cur)) return;
    f32x4 acc[2][2][4][2];
#pragma unroll
    for (int a = 0; a < 2; ++a)
#pragma unroll
        for (int b = 0; b < 2; ++b)
#pragma unroll
            for (int m = 0; m < 4; ++m)
#pragma unroll
                for (int n = 0; n < 2; ++n) acc[a][b][m][n] = (f32x4){0.f, 0.f, 0.f, 0.f};
    bf16x8 At[4][2], B0[2][2], B1[2][2];
    const size_t kstep0 = (size_t)(BK * 2);
    const char* cA = (const char*)g.A + (size_t)cur.pm * tstep + (size_t)cur.k0 * kstep0; const char* cB = (const char*)g.Bt + (size_t)cur.pn * tstep + (size_t)cur.k0 * kstep0;
    PG8_STAGE(PG8_SB(0, 0), cB, voffB); PG8_STAGE(PG8_SA(0, 0), cA, voffA); PG8_STAGE(PG8_SB(0, 1), cB + hstep, voffB); PG8_STAGE(PG8_SA(0, 1), cA + hstep, voffA);
    if (wr == 1) PG8_BAR;
    PG8_WAIT_V(4); PG8_BAR;
    PG8_STAGE(PG8_SB(1, 0), cB + kstep, voffB); PG8_STAGE(PG8_SA(1, 0), cA + kstep, voffA); PG8_STAGE(PG8_SB(1, 1), cB + hstep + kstep, voffB);
    PG8_WAIT_V(6); PG8_BAR;
    for (;;) {
        const bool has_next = S.next(ui + 1, nxt);
        const char* nA = has_next ? (const char*)g.A + (size_t)nxt.pm * tstep + (size_t)nxt.k0 * kstep0 : cA; const char* nB = has_next ? (const char*)g.Bt + (size_t)nxt.pn * tstep + (size_t)nxt.k0 * kstep0 : cB;
        for (int t = 0; t < nt; t += 2) {
            const bool last = (t == nt - 2);
            const char* a1 = cA + (size_t)(t + 1) * kstep;
            const char* a2 = last ? nA : cA + (size_t)(t + 2) * kstep; const char* b2 = last ? nB : cB + (size_t)(t + 2) * kstep;
            const char* a3 = a2 + kstep; const char* b3 = b2 + kstep;
            PG8_LDB(B0, 0, 0); PG8_SCHED; PG8_LDA(At, 0, 0); PG8_STAGE(PG8_SA(1, 1), a1 + hstep, voffA);
            PG8_WAIT_L(8); PG8_BAR; PG8_WAIT_L(0); PG8_MMA(0, 0, At, B0); PG8_BAR; PG8_SCHED;
            PG8_LDB(B1, 0, 1); PG8_STAGE(PG8_SB(0, 0), b2, voffB);
            PG8_BAR; PG8_WAIT_L(0); PG8_MMA(0, 1, At, B1); PG8_BAR;
            PG8_LDA(At, 0, 1); PG8_STAGE(PG8_SA(0, 0), a2, voffA);
            PG8_BAR; PG8_WAIT_L(0); PG8_MMA(1, 0, At, B0); PG8_BAR; PG8_SCHED;
            PG8_STAGE(PG8_SB(0, 1), b2 + hstep, voffB);
            PG8_WAIT_V(6); PG8_BAR; PG8_MMA(1, 1, At, B1); PG8_BAR;
            PG8_LDB(B0, 1, 0); PG8_SCHED; PG8_LDA(At, 1, 0); PG8_STAGE(PG8_SA(0, 1), a2 + hstep, voffA);
            PG8_WAIT_L(8); PG8_BAR; PG8_WAIT_L(0); PG8_MMA(0, 0, At, B0); PG8_BAR; PG8_SCHED;
            PG8_LDB(B1, 1, 1); PG8_STAGE(PG8_SB(1, 0), b3, voffB);
            PG8_BAR; PG8_WAIT_L(0); PG8_MMA(0, 1, At, B1); PG8_BAR;
            PG8_LDA(At, 1, 1); PG8_STAGE(PG8_SA(1, 0), a3, voffA);
            PG8_BAR; PG8_WAIT_L(0); PG8_MMA(1, 0, At, B0); PG8_BAR; PG8_SCHED;
            PG8_STAGE(PG8_SB(1, 1), b3 + hstep, voffB);
            PG8_WAIT_V(6); PG8_BAR; PG8_MMA(1, 1, At, B1); PG8_BAR;
        }
        E(acc, cur, wr, wc, fr, fq);
        if (!has_next) break;
#pragma unroll
        for (int a = 0; a < 2; ++a)
#pragma unroll
            for (int b = 0; b < 2; ++b)
#pragma unroll
                for (int m = 0; m < 4; ++m)
#pragma unroll
                    for (int n = 0; n < 2; ++n) acc[a][b][m][n] = (f32x4){0.f, 0.f, 0.f, 0.f};
        cur = nxt; cA = nA; cB = nB; ++ui;
    }
    PG8_WAIT_V(0);
    if (wr == 0) PG8_BAR;
    PG8_BAR;
#undef PG8_SA
#undef PG8_SB
#undef PG8_STAGE
#undef PG8_LDA
#undef PG8_LDB
#undef PG8_MMA
#undef PG8_WAIT_V
#undef PG8_WAIT_L
#undef PG8_BAR
#undef PG8_SCHED
}
}
using pg8::Unit;

#define EPI_LOOP_ROWS for (int ai = 0; ai < 2; ++ai) for (int m = 0; m < 4; ++m)
#define EPI_LOOP_COLS for (int bj = 0; bj < 2; ++bj) for (int n = 0; n < 2; ++n)
struct EpiInMain {
    bf16_t* R; bf16_t* PG;
    __device__ __forceinline__ void operator()(const f32x4 (&acc)[2][2][4][2], const Unit& u, int wr, int wc, int fr, int fq) const {
        bf16_t* dst; int ld, c0;
        if (u.pn < 8) { dst = R; ld = R_LD; c0 = u.pn * 256; } else { dst = PG; ld = PG_LD; c0 = (u.pn - 8) * 256; }
        const int row0 = u.pm * 256 + wr * 64 + fr, col0 = c0 + wc * 32 + 8 * fq;
#pragma unroll
        EPI_LOOP_ROWS { bf16_t* rowp = dst + (size_t)(row0 + ai * 128 + m * 16) * ld + col0;
#pragma unroll
            EPI_LOOP_COLS { const f32x4 v = acc[ai][bj][m][n]; *(u32x2*)(rowp + bj * 128 + n * 4) = (u32x2){pk2(v[0], v[1]), pk2(v[2], v[3])}; } }
    }
};
struct EpiGates {
    bf16_t* G;
    __device__ __forceinline__ void operator()(const f32x4 (&acc)[2][2][4][2], const Unit& u, int wr, int wc, int fr, int fq) const {
        const int row0 = u.pm * 256 + wr * 64 + fr, col0 = u.pn * 256 + wc * 32 + 8 * fq;
#pragma unroll
        EPI_LOOP_ROWS { bf16_t* rowp = G + (size_t)(row0 + ai * 128 + m * 16) * 3072 + col0;
#pragma unroll
            EPI_LOOP_COLS { const f32x4 v = acc[ai][bj][m][n];
                *(u32x2*)(rowp + bj * 128 + n * 4) = (u32x2){pk2(sigmoid_(v[0]), sigmoid_(v[1])), pk2(sigmoid_(v[2]), sigmoid_(v[3]))}; } }
    }
};
template <int GI> struct EpiBranch {
    const bf16_t* G; float* MG; bf16_t* MB;
    __device__ __forceinline__ void operator()(const f32x4 (&acc)[2][2][4][2], const Unit& u, int wr, int wc, int fr, int fq) const {
        const int row0 = u.pm * 256 + wr * 64 + fr, col0 = u.pn * 256 + wc * 32 + 8 * fq;
#pragma unroll
        EPI_LOOP_ROWS { const size_t row = (size_t)(row0 + ai * 128 + m * 16);
#pragma unroll
            EPI_LOOP_COLS { const int col = col0 + bj * 128 + n * 4; const f32x4 v = acc[ai][bj][m][n];
                const u32x2 gq = *(const u32x2*)(G + row * 3072 + GI * 1024 + col);
                f32x4 gv = (f32x4){__uint_as_float(gq[0] << 16), __uint_as_float(gq[0] & 0xffff0000u), __uint_as_float(gq[1] << 16), __uint_as_float(gq[1] & 0xffff0000u)};
                f32x4 r = v * gv;
                if (GI > 0) { const u32x2 mq = *(const u32x2*)(MB + row * 1024 + col);
                    r += (f32x4){__uint_as_float(mq[0] << 16), __uint_as_float(mq[0] & 0xffff0000u), __uint_as_float(mq[1] << 16), __uint_as_float(mq[1] & 0xffff0000u)}; }
                *(u32x2*)(MB + row * 1024 + col) = (u32x2){pk2(r[0], r[1]), pk2(r[2], r[3])}; } }
    }
};
struct EpiResid {
    float* H; const float* gate_lat; const float* gate_ctx;
    __device__ __forceinline__ void operator()(const f32x4 (&acc)[2][2][4][2], const Unit& u, int wr, int wc, int fr, int fq) const {
        const int row0 = u.pm * 256 + wr * 64 + fr, col0 = u.pn * 256 + wc * 32 + 8 * fq;
        const float* gp = (u.pm == 0) ? gate_ctx : gate_lat;
        f32x4 gv[2][2];
#pragma unroll
        EPI_LOOP_COLS gv[bj][n] = *(const f32x4*)(gp + col0 + bj * 128 + n * 4);
#pragma unroll
        EPI_LOOP_ROWS { float* rowp = H + (size_t)(row0 + ai * 128 + m * 16) * 1024 + col0;
#pragma unroll
            EPI_LOOP_COLS { f32x4* q = (f32x4*)(rowp + bj * 128 + n * 4); *q = *q + acc[ai][bj][m][n] * gv[bj][n]; } }
    }
};
struct EpiLora {
    bf16_t* B; bf16_t* RWG; const float* w0; const float* a0;
    __device__ __forceinline__ void operator()(const f32x4 (&acc)[2][2][4][2], const Unit& u, int wr, int wc, int fr, int fq) const {
        const int row0 = u.pm * 256 + wr * 64 + fr, blk = u.pn >> 1, cbase = (u.pn & 1) * 256 + wc * 32 + 8 * fq;
        f32x4 bv[2][2];
#pragma unroll
        EPI_LOOP_COLS { const int cc = cbase + bj * 128 + n * 4;
            bv[bj][n] = blk < 2 ? *(const f32x4*)(w0 + blk * 512 + cc) : (blk < 4 ? *(const f32x4*)(a0 + (blk - 2) * 512 + cc) : (f32x4){0.f, 0.f, 0.f, 0.f}); }
        bf16_t* dst; int ld;
        if (blk < 2) { dst = B + 3072 + blk * 512; ld = 4096; } else if (blk < 4) { dst = B + 2048 + (blk - 2) * 512; ld = 4096; } else { dst = RWG; ld = 512; }
#pragma unroll
        EPI_LOOP_ROWS { bf16_t* rowp = dst + (size_t)(row0 + ai * 128 + m * 16) * ld + cbase;
#pragma unroll
            EPI_LOOP_COLS { f32x4 v = acc[ai][bj][m][n] + bv[bj][n];
                if (blk < 2) {
#pragma unroll
                    for (int j = 0; j < 4; ++j) v[j] = 1.f - __expf(-0.60653066f * sigmoid_(v[j]));
                } else if (blk < 4) {
#pragma unroll
                    for (int j = 0; j < 4; ++j) v[j] = sigmoid_(v[j]);
                }
                *(u32x2*)(rowp + bj * 128 + n * 4) = (u32x2){pk2(v[0], v[1]), pk2(v[2], v[3])}; } }
    }
};
struct EpiResidAtomic {
    float* H; const float* gate_ctx;
    __device__ __forceinline__ void operator()(const f32x4 (&acc)[2][2][4][2], const Unit& u, int wr, int wc, int fr, int fq) const {
        const int row0 = u.pm * 256 + wr * 64 + fr, col0 = u.pn * 256 + wc * 32 + 8 * fq;
        const float* gp = gate_ctx + col0;
#pragma unroll
        EPI_LOOP_ROWS { float* rowp = H + (size_t)(row0 + ai * 128 + m * 16) * 1024 + col0;
#pragma unroll
            EPI_LOOP_COLS { const f32x4 v = acc[ai][bj][m][n] * *(const f32x4*)(gp + bj * 128 + n * 4); float* q = rowp + bj * 128 + n * 4;
                unsafeAtomicAdd(q, v[0]); unsafeAtomicAdd(q + 1, v[1]); unsafeAtomicAdd(q + 2, v[2]); unsafeAtomicAdd(q + 3, v[3]); }
            asm volatile("" ::: "memory"); }
    }
};
struct EpiMlp1 {
    bf16_t* U;
    __device__ __forceinline__ void operator()(const f32x4 (&acc)[2][2][4][2], const Unit& u, int wr, int wc, int fr, int fq) const {
        const int row0 = u.pm * 256 + wr * 64 + fr, col0 = u.pn * 256 + wc * 32 + 8 * fq;
#pragma unroll
        EPI_LOOP_ROWS { bf16_t* rowp = U + (size_t)(row0 + ai * 128 + m * 16) * 4096 + col0;
#pragma unroll
            EPI_LOOP_COLS { f32x4 v = acc[ai][bj][m][n];
#pragma unroll
                for (int j = 0; j < 4; ++j) { const float t = fmaxf(v[j], 0.f); v[j] = t * t; }
                *(u32x2*)(rowp + bj * 128 + n * 4) = (u32x2){pk2(v[0], v[1]), pk2(v[2], v[3])}; } }
    }
};

__device__ __forceinline__ void convert_T(const float* src, int ld, int K, int n0, int ncols, bf16_t* dst, LAS float* tile, int wg, int nwg) {
    const int ntn = (ncols + 63) >> 6, ntk = K >> 6, tid = otid();
    for (int t = wg; t < ntn * ntk; t += nwg) {
        const int tn = t / ntk, tk = t - tn * ntk, k0 = tk * 64, nb = tn * 64;
#pragma unroll
        for (int i = 0; i < 2; ++i) { const int idx = tid + i * 512, kk = idx >> 4, n4 = (idx & 15) * 4;
            f32x4 v = (f32x4){0.f, 0.f, 0.f, 0.f};
            if (nb + n4 < ncols) v = *(const f32x4*)(src + (size_t)(k0 + kk) * ld + n0 + nb + n4);
            tile[kk * 65 + n4 + 0] = v[0]; tile[kk * 65 + n4 + 1] = v[1]; tile[kk * 65 + n4 + 2] = v[2]; tile[kk * 65 + n4 + 3] = v[3]; }
        __syncthreads();
        { const int nn = tid >> 3, k8 = (tid & 7) * 8;
          if (nb + nn < ncols) { const LAS float* s = tile + k8 * 65 + nn;
              u32x4 o; o[0] = pk2(s[0], s[65]); o[1] = pk2(s[130], s[195]); o[2] = pk2(s[260], s[325]); o[3] = pk2(s[390], s[455]);
              *(u32x4*)(dst + (size_t)(nb + nn) * K + k0 + k8) = o; } }
        __syncthreads();
    }
}

__device__ __forceinline__ void phase_mod(const P& p, LAS unsigned char* lds) {
    const float* c = p.in[I_C]; const float* cc = p.in[I_CCTX]; const float* wm = p.in[I_WMOD]; const float* bm = p.in[I_BMOD];
    float* MOD = (float*)(p.ws + OFF_MOD);
    LAS float* red = (LAS float*)lds;
    const int tid = otid();
    for (int blk = blockIdx.x; blk < 256; blk += gridDim.x) {
        const int l = blk >> 6, col0 = (blk & 63) * 96;
        if (tid < 384) {
            const int cgp = tid % 24, ks = tid / 24;
            f32x4 a0 = (f32x4){0.f, 0.f, 0.f, 0.f}, a1 = a0;
            const float* w = wm + (size_t)l * 1024 * 6144 + col0 + cgp * 4;
#pragma unroll 8
            for (int k = ks * 64; k < ks * 64 + 64; ++k) {
                const f32x4 wv = *(const f32x4*)(w + (size_t)k * 6144);
                const float s0 = silu_(c[k]), s1 = silu_(cc[k]);
                a0 += wv * s0; a1 += wv * s1;
            }
            LAS f32x4* r4 = (LAS f32x4*)red;
            r4[(ks * 24 + cgp) * 2 + 0] = a0; r4[(ks * 24 + cgp) * 2 + 1] = a1;
        }
        __syncthreads();
        if (tid < 192) {
            const int col = tid % 96, s = tid / 96;
            float sum = 0.f;
#pragma unroll
            for (int k2 = 0; k2 < 16; ++k2) sum += red[((k2 * 24 + (col >> 2)) * 2 + s) * 4 + (col & 3)];
            MOD[((size_t)l * 2 + s) * 6144 + col0 + col] = sum + bm[l * 6144 + col0 + col];
        }
        __syncthreads();
    }
}

template <bool FROM_INPUT>
__device__ __forceinline__ void phase_norm(const P& p, int l, const float* gamma, int shift_idx, int scale_idx) {
    float* H = (float*)(p.ws + OFF_H); bf16_t* HN = (bf16_t*)(p.ws + OFF_HN);
    const float* MOD = (const float*)(p.ws + OFF_MOD) + (size_t)l * 2 * 6144;
    const int tid_ = otid(); const int wave = tid_ >> 6, lane = tid_ & 63;
    for (int row = blockIdx.x * 8 + wave; row < L; row += gridDim.x * 8) {
        const float* src = FROM_INPUT ? (row < NCTX ? p.in[I_CTX] + (size_t)row * 1024 : p.in[I_X] + (size_t)(row - NCTX) * 1024) : H + (size_t)row * 1024;
        f32x4 v[4]; float ss = 0.f;
#pragma unroll
        for (int j = 0; j < 4; ++j) { v[j] = *(const f32x4*)(src + j * 256 + lane * 4); ss += (v[j][0] * v[j][0] + v[j][1] * v[j][1]) + (v[j][2] * v[j][2] + v[j][3] * v[j][3]); }
        ss = wave_sum(ss);
        const float rstd = rsqrtf(ss * (1.f / 1024.f) + 1e-6f);
        const float* m = MOD + (row < NCTX ? 6144 : 0);
#pragma unroll
        for (int j = 0; j < 4; ++j) { const int col = j * 256 + lane * 4;
            const f32x4 g = *(const f32x4*)(gamma + col), sh = *(const f32x4*)(m + shift_idx * 1024 + col), sc = *(const f32x4*)(m + scale_idx * 1024 + col);
            const f32x4 o = v[j] * rstd * g * (sc + 1.f) + sh;
            *(u32x2*)(HN + (size_t)row * 1024 + col) = (u32x2){pk2(o[0], o[1]), pk2(o[2], o[3])};
            if (FROM_INPUT) *(f32x4*)(H + (size_t)row * 1024 + col) = v[j]; }
    }
}

constexpr int TT = 13;
__device__ __forceinline__ void phase_prep(const P& p, int l, LAS unsigned char* lds) {
    const bf16_t* R = (const bf16_t*)(p.ws + OFF_R); const bf16_t* PG = (const bf16_t*)(p.ws + OFF_PG);
    bf16_t* B = (bf16_t*)(p.ws + OFF_B); bf16_t* XL = (bf16_t*)(p.ws + OFF_XL);
    bf16_t* GLAD = (bf16_t*)(p.ws + OFF_GLAD); bf16_t* GDNC = (bf16_t*)(p.ws + OFF_GDNC); float* GDNGB = (float*)(p.ws + OFF_GDNGB);
    const float* mu = p.in[I_RWMU] + (size_t)l * 2 * 1920;
    const float* kkw = p.in[I_RWKK] + l * 512;
    const float* ga2 = p.in[I_GLAA2] + (size_t)l * 2 * 16 * 256; const float* gab = p.in[I_GLAAB] + l * 512;
    const float* cw = p.in[I_GDNCONV] + (size_t)l * 5 * 1536; const float* alog = p.in[I_GDNALOG] + l * 8; const float* dtb = p.in[I_GDNDT] + l * 8;
    LAS float* gal = (LAS float*)lds;
    LAS float* red = gal + TT * 32;
    const int tid = otid(), wave = tid >> 6;
    const int c = tid;
    const int gz = tid >> 8, gk = tid & 255;
    for (int tile = blockIdx.x; tile < L / TT; tile += gridDim.x) {
        const int t0 = tile * TT;
        if (tid < TT * 32) { const int tt = tid >> 5, e = tid & 31; gal[tt * 32 + e] = bf2f(PG[(size_t)(t0 + tt) * PG_LD + GLA_AL + e]); }
        {
            float xr[TT + 2], xk[TT + 2], xv[TT + 2], xe[TT + 2];
#pragma unroll
            for (int i = 0; i < TT + 2; ++i) { const int rr = t0 - 1 + i;
                if (rr >= 0 && rr < L) { const bf16_t* rp = R + (size_t)rr * R_LD + c; xr[i] = bf2f(rp[0]); xk[i] = bf2f(rp[512]); xv[i] = bf2f(rp[1024]); xe[i] = (c < 384) ? bf2f(rp[1536]) : 0.f; }
                else { xr[i] = 0.f; xk[i] = 0.f; xv[i] = 0.f; xe[i] = 0.f; } }
            const float mr0 = mu[c], mr1 = mu[1920 + c], mk0 = mu[512 + c], mk1 = mu[1920 + 512 + c], mv0 = mu[1024 + c], mv1 = mu[1920 + 1024 + c];
            const float me0 = (c < 384) ? mu[1536 + c] : 0.f, me1 = (c < 384) ? mu[1920 + 1536 + c] : 0.f;
            const float kkc = kkw[c];
#pragma unroll
            for (int tt = 0; tt < TT; ++tt) {
                const int t = t0 + tt;
                const float hp = (t != 0 && t != NCTX) ? 1.f : 0.f, hn = (t != NCTX - 1 && t != L - 1) ? 1.f : 0.f;
                const float r = mr0 * hp * xr[tt] + (1.f - mr0 - mr1) * xr[tt + 1] + mr1 * hn * xr[tt + 2];
                const float k = mk0 * hp * xk[tt] + (1.f - mk0 - mk1) * xk[tt + 1] + mk1 * hn * xk[tt + 2];
                const float v = mv0 * hp * xv[tt] + (1.f - mv0 - mv1) * xv[tt + 1] + mv1 * hn * xv[tt + 2];
                float e = me0 * hp * xe[tt] + (1.f - me0 - me1) * xe[tt + 1] + me1 * hn * xe[tt + 2];
                if (c < 128) e = 2.f * sigmoid_(2.f * e) - 1.f; else if (c >= 256 && c < 384) e = sigmoid_(e); else if (c >= 384) e = 0.f;
                const float kr = k * kkc;
                const float ssq = wave_sum(kr * kr);
                bf16_t* bp = B + (size_t)t * 4096 + c;
                bp[0] = f2bf(r); bp[512] = f2bf(k); bp[1024] = f2bf(v); bp[1536] = f2bf(kr * rsqrtf(ssq + 1e-12f));
                XL[(size_t)t * 512 + c] = f2bf(e);
            }
        }
        __syncthreads();
        {
        float ga2v[16];
#pragma unroll
        for (int e = 0; e < 16; ++e) ga2v[e] = ga2[(gz * 16 + e) * 256 + gk];
        const float gabv = gab[gz * 256 + gk];
#pragma unroll
        for (int tt = 0; tt < TT; ++tt) {
            float zv = gabv;
#pragma unroll
            for (int e = 0; e < 16; ++e) zv += gal[tt * 32 + gz * 16 + e] * ga2v[e];
            const float la = __logf(sigmoid_(zv)) * (1.f / 16.f);
            GLAD[(size_t)(t0 + tt) * 512 + tid] = f2bf(1.f - __expf(la));
        }
        }
        {
            float cwv[5], xv[TT + 4];
#pragma unroll
            for (int i = 0; i < 5; ++i) cwv[i] = cw[i * 1536 + 1024 + c];
#pragma unroll
            for (int i = 0; i < TT + 4; ++i) { const int rr = t0 - 2 + i; xv[i] = (rr >= 0 && rr < L) ? bf2f(PG[(size_t)rr * PG_LD + GDN_QKV + 1024 + c]) : 0.f; }
#pragma unroll
            for (int tt = 0; tt < TT; ++tt) { const int t = t0 + tt; float sv = 0.f;
#pragma unroll
                for (int i = 0; i < 5; ++i) { const int rr = t + i - 2; const bool ok_ = (rr >= 0) && (rr < L) && ((rr < NCTX) == (t < NCTX)); if (ok_) sv += xv[tt + i] * cwv[i]; }
                GDNC[(size_t)t * 1536 + 1024 + c] = f2bf(silu_(sv)); }
        }
        float oq[TT], ok[TT];
        {
            float cwq[5], cwk[5], xq[TT + 4], xk[TT + 4];
#pragma unroll
            for (int i = 0; i < 5; ++i) { cwq[i] = cw[i * 1536 + c]; cwk[i] = cw[i * 1536 + 512 + c]; }
#pragma unroll
            for (int i = 0; i < TT + 4; ++i) { const int rr = t0 - 2 + i;
                if (rr >= 0 && rr < L) { const bf16_t* rp = PG + (size_t)rr * PG_LD + GDN_QKV + c; xq[i] = bf2f(rp[0]); xk[i] = bf2f(rp[512]); } else { xq[i] = 0.f; xk[i] = 0.f; } }
#pragma unroll
            for (int tt = 0; tt < TT; ++tt) {
                const int t = t0 + tt; float sq = 0.f, sk = 0.f;
#pragma unroll
                for (int i = 0; i < 5; ++i) { const int rr = t + i - 2; const bool ok_ = (rr >= 0) && (rr < L) && ((rr < NCTX) == (t < NCTX));
                    if (ok_) { sq += xq[tt + i] * cwq[i]; sk += xk[tt + i] * cwk[i]; } }
                oq[tt] = silu_(sq); ok[tt] = silu_(sk);
                const float pq = wave_sum(oq[tt] * oq[tt]), pk = wave_sum(ok[tt] * ok[tt]);
                if ((tid & 63) == 0) { red[(tt * 8 + wave) * 2 + 0] = pq; red[(tt * 8 + wave) * 2 + 1] = pk; }
            }
        }
        __syncthreads();
#pragma unroll
        for (int tt = 0; tt < TT; ++tt) {
            const int w0i = (wave >> 1) * 2;
            const float ssq = red[(tt * 8 + w0i) * 2 + 0] + red[(tt * 8 + w0i + 1) * 2 + 0], ssk = red[(tt * 8 + w0i) * 2 + 1] + red[(tt * 8 + w0i + 1) * 2 + 1];
            bf16_t* gp = GDNC + (size_t)(t0 + tt) * 1536 + c;
            gp[0] = f2bf(oq[tt] * rsqrtf(ssq + 1e-12f) * 0.08838834764831845f); gp[512] = f2bf(ok[tt] * rsqrtf(ssk + 1e-12f));
        }
        if (tid < TT * 16) { const int tt = tid >> 4, j = tid & 15, t = t0 + tt;
            float o;
            if (j < 8) { const float a = bf2f(PG[(size_t)t * PG_LD + GDN_A + j]); o = __expf(-__expf(alog[j]) * softplus_(a + dtb[j])); }
            else o = sigmoid_(bf2f(PG[(size_t)t * PG_LD + GDN_B + (j - 8)]));
            GDNGB[t * 16 + j] = o; }
        __syncthreads();
    }
}
__device__ __forceinline__ void build_wl(const P& p, int l, int wg, int nwg) {
    const float* w2 = p.in[I_RWW2] + (size_t)l * 2 * 64 * 512; const float* a2 = p.in[I_RWA2] + (size_t)l * 2 * 64 * 512; const float* g2 = p.in[I_RWG2] + (size_t)l * 128 * 512;
    bf16_t* WL = (bf16_t*)(p.ws + OFF_WL);
    const int tid = otid();
    for (int it = wg * 512 + tid; it < 2560 * 64; it += nwg * 512) {
        const int kc = it / 2560, n = it - kc * 2560, k0 = kc * 8, blk = n >> 9, cc = n & 511;
        const float* src = nullptr; int kb = 0, kn = 0;
        if (blk == 0) { src = w2; kb = 0; kn = 64; } else if (blk == 1) { src = w2 + 64 * 512; kb = 64; kn = 64; }
        else if (blk == 2) { src = a2; kb = 128; kn = 64; } else if (blk == 3) { src = a2 + 64 * 512; kb = 192; kn = 64; }
        else { src = g2; kb = 256; kn = 128; }
        float v[8];
#pragma unroll
        for (int j = 0; j < 8; ++j) { const int k = k0 + j - kb; v[j] = (k >= 0 && k < kn) ? src[(size_t)k * 512 + cc] : 0.f; }
        u32x4 o; o[0] = pk2(v[0], v[1]); o[1] = pk2(v[2], v[3]); o[2] = pk2(v[4], v[5]); o[3] = pk2(v[6], v[7]);
        *(u32x4*)(WL + (size_t)n * 512 + k0) = o;
    }
}

constexpr int TB = 32, NBLK = L / TB;
__device__ __forceinline__ int tok_seq(int z, int j) { return z == 0 ? j : (j < NCTX ? NCTX - 1 - j : L - 1 - (j - NCTX)); }
__device__ __forceinline__ int tok_gla(int z, int j) {
    if (j < NCTX) return z == 0 ? j : NCTX - 1 - j;
    const int jj = j - NCTX, pp = z == 0 ? jj : NLAT - 1 - jj;
    return NCTX + (pp & 255) * 64 + (pp >> 8);
}

template <int NCW> struct ScanRole {
    bool cons, prod; int ct;
    __device__ __forceinline__ ScanRole(int tid) {
        const int w = tid >> 6, lane = tid & 63;
        if (NCW == 4) { cons = w < 4; prod = !cons; ct = tid & 255; }
        else { cons = w < 2; prod = (w & 2) != 0; ct = cons ? tid : ((((w >> 2) << 1) | (w & 1)) * 64 + lane); }
    }
};
__device__ __forceinline__ float rowpair_sum(float x) {
    const unsigned u = __float_as_uint(x); auto r = __builtin_amdgcn_permlane16_swap(u, u, false, false);
    return __uint_as_float(r[0]) + __uint_as_float(r[1]);
}
#define SCAN_BARRIER() asm volatile("s_waitcnt lgkmcnt(0)\n\ts_barrier" ::: "memory")
__device__ __forceinline__ float bfraw2f(unsigned short b) { return __uint_as_float(((unsigned)b) << 16); }
__device__ __forceinline__ f32x4 bf4(u32x2 r) { return (f32x4){__uint_as_float(r[0] << 16), __uint_as_float(r[0] & 0xffff0000u), __uint_as_float(r[1] << 16), __uint_as_float(r[1] & 0xffff0000u)}; }

__device__ __forceinline__ void scan_rwkv(const P& p, int l, int unit, LAS unsigned char* lds) {
    const int z = unit >> 5, h = (unit >> 2) & 7, rq = unit & 3;
    const bf16_t* B = (const bf16_t*)(p.ws + OFF_B); bf16_t* Y = (bf16_t*)(p.ws + OFF_PG) + YRW_COL + z * 512 + h * 64 + rq * 16;
    const float* kaw = p.in[I_RWKA] + l * 512 + h * 64;
    LAS float* vec = (LAS float*)lds;
    LAS float* vv = vec + 2 * TB * 320;
    LAS float* yo = vv + 2 * TB * 16;
    const int tid = otid(); const ScanRole<4> role(tid); const int ct = role.ct; const bool prod = role.prod, cons = role.cons;
    u32x2 pr[2], pk[2], pkk[2], pa[2], pw[2]; unsigned short pv[2];
    const f32x4 kac4 = *(const f32x4*)(kaw + (ct & 15) * 4);
    auto p_load = [&](int blk) {
#pragma unroll
        for (int i = 0; i < 2; ++i) { const int idx = ct + i * 256, s = idx >> 4, n4 = idx & 15; const int t = tok_seq(z, blk * TB + s);
            const bf16_t* bp = B + (size_t)t * 4096 + h * 64 + n4 * 4;
            pr[i] = *(const u32x2*)(bp); pk[i] = *(const u32x2*)(bp + 512); pkk[i] = *(const u32x2*)(bp + 1536); pa[i] = *(const u32x2*)(bp + 2048 + z * 512); pw[i] = *(const u32x2*)(bp + 3072 + z * 512); }
#pragma unroll
        for (int i = 0; i < 2; ++i) { const int idx = ct + i * 256, s = idx >> 4, r = idx & 15; const int t = tok_seq(z, blk * TB + s); pv[i] = B[(size_t)t * 4096 + 1024 + h * 64 + rq * 16 + r]; }
    };
    auto p_write = [&](int buf) {
#pragma unroll
        for (int i = 0; i < 2; ++i) { const int idx = ct + i * 256, s = idx >> 4, n4 = idx & 15;
            LAS float* d = vec + ((buf * TB + s) * 16 + n4) * 20;
            const f32x4 kk = bf4(pkk[i]), a = bf4(pa[i]);
            *(LAS f32x4*)(d) = kk; *(LAS f32x4*)(d + 4) = 1.f - bf4(pw[i]); *(LAS f32x4*)(d + 8) = kk * a;
            *(LAS f32x4*)(d + 12) = bf4(pk[i]) * ((a - 1.f) * kac4 + 1.f); *(LAS f32x4*)(d + 16) = bf4(pr[i]); }
#pragma unroll
        for (int i = 0; i < 2; ++i) vv[buf * TB * 16 + ct + i * 256] = bfraw2f(pv[i]);
    };
    auto p_yout = [&](int blk) {
        const int buf = blk & 1;
#pragma unroll
        for (int i = 0; i < 2; ++i) { const int idx = ct + i * 256, s = idx >> 4, r = idx & 15; const int t = tok_seq(z, blk * TB + s);
            const f32x4 y0 = *(const LAS f32x4*)(yo + (buf * TB * 16 + idx) * 8), y1 = *(const LAS f32x4*)(yo + (buf * TB * 16 + idx) * 8 + 4);
            Y[(size_t)t * PG_LD + r] = f2bf(((y0[0] + y0[1]) + (y0[2] + y0[3])) + ((y1[0] + y1[1]) + (y1[2] + y1[3]))); }
    };
    const int irow = (ct >> 4) & 15, ks = ct & 15;
    const LAS float* vbase = vec; const LAS float* vvb = vv; LAS float* yob = yo;
    f32x2 S0 = (f32x2){0.f, 0.f}, S1 = S0;
    struct Vx { f32x4 kk, w, b, k, r; float v; };
    auto c_ld = [&](Vx& x, int buf, int s) {
        const LAS float* d = vbase + s * 320;
        x.kk = *(const LAS f32x4*)(d); x.w = *(const LAS f32x4*)(d + 4); x.b = *(const LAS f32x4*)(d + 8); x.k = *(const LAS f32x4*)(d + 12);
        x.r = *(const LAS f32x4*)(d + 16); x.v = vvb[s * 16];
    };
    float sa = 0.f;
    auto c_step = [&](const Vx& x, const f32x4& kkn, int buf, int s) {
        const f32x2 vv2 = (f32x2){x.v, x.v}, nsa = (f32x2){-sa, -sa};
        S0 = S0 * (f32x2){x.w[0], x.w[1]} + (vv2 * (f32x2){x.k[0], x.k[1]} + nsa * (f32x2){x.b[0], x.b[1]});
        S1 = S1 * (f32x2){x.w[2], x.w[3]} + (vv2 * (f32x2){x.k[2], x.k[3]} + nsa * (f32x2){x.b[2], x.b[3]});
        const f32x2 y2 = S0 * (f32x2){x.r[0], x.r[1]} + S1 * (f32x2){x.r[2], x.r[3]};
        const f32x2 s2 = S0 * (f32x2){kkn[0], kkn[1]} + S1 * (f32x2){kkn[2], kkn[3]};
        float yp = y2[0] + y2[1], sp = s2[0] + s2[1];
        yp += dpp_<0xB1>(yp); sp += dpp_<0xB1>(sp); sp += dpp_<0x4E>(sp);
        sp += dpp_<0x141>(sp); sp += dpp_<0x140>(sp);
        sa = sp;
        yob[s * 128] = yp;
    };
    if (prod) { p_load(0); p_write(0); p_load(1); }
    SCAN_BARRIER();
    for (int b = 0; b < NBLK; ++b) {
        if (prod) {
            if (b + 1 < NBLK) p_write((b + 1) & 1);
            if (b + 2 < NBLK) p_load(b + 2);
            if (b > 0) p_yout(b - 1);
        } else if (cons) {
            const int buf = b & 1;
            vbase = vec + (buf * TB * 16 + ks) * 20; vvb = vv + buf * TB * 16 + irow; yob = yo + (buf * TB * 16 + irow) * 8 + (ks >> 1);
            Vx xa, xb;
            c_ld(xa, buf, 0);
            { const f32x2 s2 = S0 * (f32x2){xa.kk[0], xa.kk[1]} + S1 * (f32x2){xa.kk[2], xa.kk[3]}; sa = reduce16(s2[0] + s2[1]); }
#pragma unroll
            for (int s = 0; s < TB; s += 2) {
                c_ld(xb, buf, s + 1); c_step(xa, xb.kk, buf, s);
                c_ld(xa, buf, s + 2);
                c_step(xb, xa.kk, buf, s + 1);
            }
        }
        SCAN_BARRIER();
    }
    if (prod) p_yout(NBLK - 1);
    SCAN_BARRIER();
}

__device__ __forceinline__ void scan_gla(const P& p, int l, int unit, LAS unsigned char* lds) {
    const int z = unit >> 4, h = (unit >> 2) & 3, cb = unit & 3;
    const bf16_t* PG = (const bf16_t*)(p.ws + OFF_PG); const bf16_t* GLAD = (const bf16_t*)(p.ws + OFF_GLAD);
    bf16_t* O = (bf16_t*)(p.ws + OFF_R) + z * 512 + h * 128 + cb * 32;
    LAS float* vec = (LAS float*)lds;
    LAS float* vv = vec + 2 * TB * 192;
    LAS float* yo = vv + 2 * TB * 32;
    const int tid = otid(); const ScanRole<4> role(tid); const int ct = role.ct; const bool prod = role.prod, cons = role.cons;
    unsigned short pq[8], pk[8], pa[8], pv[4];
    auto p_load = [&](int blk) {
#pragma unroll
        for (int i = 0; i < 8; ++i) { const int idx = ct + i * 256, s = idx >> 6, n = idx & 63; const int t = tok_gla(z, blk * TB + s);
            const bf16_t* bp = PG + (size_t)t * PG_LD + h * 64 + n;
            pq[i] = bp[GLA_Q]; pk[i] = bp[GLA_K]; pa[i] = GLAD[(size_t)t * 512 + z * 256 + h * 64 + n]; }
#pragma unroll
        for (int i = 0; i < 4; ++i) { const int idx = ct + i * 256, s = idx >> 5, r = idx & 31; const int t = tok_gla(z, blk * TB + s);
            pv[i] = PG[(size_t)t * PG_LD + GLA_V + h * 128 + cb * 32 + r]; }
    };
    auto p_write = [&](int buf) {
#pragma unroll
        for (int i = 0; i < 8; ++i) { const int idx = ct + i * 256, s = idx >> 6, n = idx & 63;
            LAS float* d = vec + ((buf * TB + s) * 8 + (n >> 3)) * 24 + (n & 7);
            d[0] = bfraw2f(pq[i]) * 0.125f; d[8] = bfraw2f(pk[i]); d[16] = 1.f - bfraw2f(pa[i]); }
#pragma unroll
        for (int i = 0; i < 4; ++i) vv[buf * TB * 32 + ct + i * 256] = bfraw2f(pv[i]);
    };
    auto p_yout = [&](int blk) {
        const int buf = blk & 1;
#pragma unroll
        for (int i = 0; i < 4; ++i) { const int idx = ct + i * 256, s = idx >> 5, r = idx & 31; const int t = tok_gla(z, blk * TB + s);
            const f32x4 y0 = *(const LAS f32x4*)(yo + (buf * TB * 32 + idx) * 4);
            O[(size_t)t * R_LD + r] = f2bf((y0[0] + y0[1]) + (y0[2] + y0[3])); }
    };
    const int icol = (ct >> 3) & 31, ks = ct & 7;
    const LAS float* vbase = vec; const LAS float* vvb = vv; LAS float* yob = yo;
    f32x2 S[4];
#pragma unroll
    for (int j = 0; j < 4; ++j) S[j] = (f32x2){0.f, 0.f};
    struct Vx { f32x4 q0, q1, k0, k1, a0, a1; float v; };
    auto c_ld = [&](Vx& x, int buf, int s) {
        const LAS float* d = vbase + s * 192;
        x.q0 = *(const LAS f32x4*)(d); x.q1 = *(const LAS f32x4*)(d + 4); x.k0 = *(const LAS f32x4*)(d + 8); x.k1 = *(const LAS f32x4*)(d + 12);
        x.a0 = *(const LAS f32x4*)(d + 16); x.a1 = *(const LAS f32x4*)(d + 20); x.v = vvb[s * 32];
    };
    auto c_upd = [&](const Vx& x) -> float {
        const f32x2 vv2 = (f32x2){x.v, x.v};
        S[0] = S[0] * (f32x2){x.a0[0], x.a0[1]} + vv2 * (f32x2){x.k0[0], x.k0[1]};
        S[1] = S[1] * (f32x2){x.a0[2], x.a0[3]} + vv2 * (f32x2){x.k0[2], x.k0[3]};
        S[2] = S[2] * (f32x2){x.a1[0], x.a1[1]} + vv2 * (f32x2){x.k1[0], x.k1[1]};
        S[3] = S[3] * (f32x2){x.a1[2], x.a1[3]} + vv2 * (f32x2){x.k1[2], x.k1[3]};
        const f32x2 y2 = (S[0] * (f32x2){x.q0[0], x.q0[1]} + S[1] * (f32x2){x.q0[2], x.q0[3]}) + (S[2] * (f32x2){x.q1[0], x.q1[1]} + S[3] * (f32x2){x.q1[2], x.q1[3]});
        return y2[0] + y2[1];
    };
    if (prod) { p_load(0); p_write(0); p_load(1); }
    SCAN_BARRIER();
    for (int b = 0; b < NBLK; ++b) {
        if (prod) {
            if (b + 1 < NBLK) p_write((b + 1) & 1);
            if (b + 2 < NBLK) p_load(b + 2);
            if (b > 0) p_yout(b - 1);
        } else if (cons) {
            const int buf = b & 1;
            vbase = vec + (buf * TB * 8 + ks) * 24; vvb = vv + buf * TB * 32 + icol; yob = yo + (buf * TB * 32 + icol) * 4 + (ks >> 1);
            Vx xa, xb;
            c_ld(xa, buf, 0);
#pragma unroll
            for (int s = 0; s < TB; s += 2) {
                c_ld(xb, buf, s + 1);
                float ya = c_upd(xa);
                c_ld(xa, buf, s + 2);
                float yb = c_upd(xb);
                ya += dpp_<0xB1>(ya); yb += dpp_<0xB1>(yb);
                yob[s * 128] = ya; yob[(s + 1) * 128] = yb;
            }
        }
        SCAN_BARRIER();
    }
    if (prod) p_yout(NBLK - 1);
    SCAN_BARRIER();
}

__device__ __forceinline__ void scan_gdn(const P& p, int l, int unit, LAS unsigned char* lds) {
    const int z = unit >> 6, h = (unit >> 4) & 3, cb = unit & 15;
    const bf16_t* GDNC = (const bf16_t*)(p.ws + OFF_GDNC); const float* GDNGB = (const float*)(p.ws + OFF_GDNGB);
    bf16_t* O = (bf16_t*)(p.ws + OFF_R) + 1024 + z * 512 + h * 128 + cb * 8;
    LAS float* vec = (LAS float*)lds;
    LAS float* vv = vec + 2 * TB * 384;
    LAS float* sc = vv + 2 * TB * 8;
    LAS float* yo = sc + 2 * TB * 2;
    const int tid = otid(); const ScanRole<4> role(tid); const int ct = role.ct; const bool prod = role.prod, cons = role.cons;
    u32x2 pq[4], pk[4]; unsigned short pv; float psc = 0.f;
    auto p_load = [&](int blk) {
#pragma unroll
        for (int i = 0; i < 4; ++i) { const int idx = ct + i * 256, s = idx >> 5, n4 = idx & 31; const int t = tok_seq(z, blk * TB + s);
            const bf16_t* bp = GDNC + (size_t)t * 1536 + h * 128 + n4 * 4;
            pq[i] = *(const u32x2*)(bp); pk[i] = *(const u32x2*)(bp + 512); }
        { const int s = ct >> 3, r = ct & 7; const int t = tok_seq(z, blk * TB + s); pv = GDNC[(size_t)t * 1536 + 1024 + h * 128 + cb * 8 + r]; }
        if (ct < 64) { const int s = ct >> 1, w = ct & 1; const int t = tok_seq(z, blk * TB + s); psc = GDNGB[t * 16 + w * 8 + z * 4 + h]; }
    };
    auto p_write = [&](int buf) {
#pragma unroll
        for (int i = 0; i < 4; ++i) { const int idx = ct + i * 256, s = idx >> 5, n4 = idx & 31;
            LAS float* d = vec + ((buf * TB + s) * 32 + n4) * 12;
            *(LAS f32x4*)(d) = bf4(pq[i]); *(LAS f32x4*)(d + 4) = bf4(pk[i]); }
        vv[buf * TB * 8 + ct] = bfraw2f(pv);
        if (ct < 64) sc[buf * TB * 2 + ct] = psc;
    };
    auto p_yout = [&](int blk) {
        const int buf = blk & 1; const int s = ct >> 3, r = ct & 7; const int t = tok_seq(z, blk * TB + s);
        const f32x4 y0 = *(const LAS f32x4*)(yo + (buf * TB * 8 + ct) * 8), y1 = *(const LAS f32x4*)(yo + (buf * TB * 8 + ct) * 8 + 4);
        O[(size_t)t * R_LD + r] = f2bf(((y0[0] + y0[1]) + (y0[2] + y0[3])) + ((y1[0] + y1[1]) + (y1[2] + y1[3])));
    };
    const int icol = (ct >> 5) & 7, ks = ct & 31;
    const LAS float* vbase = vec; const LAS float* vvb = vv; const LAS float* scb = sc; LAS float* yob = yo;
    f32x2 S0 = (f32x2){0.f, 0.f}, S1 = S0;
    struct Vx { f32x4 q, k; float v; f32x2 gb; };
    auto c_ld = [&](Vx& x, int buf, int s) {
        const LAS float* d = vbase + s * 384;
        x.q = *(const LAS f32x4*)(d); x.k = *(const LAS f32x4*)(d + 4);
        x.v = vvb[s * 8]; x.gb = *(const LAS f32x2*)(scb + s * 2);
    };
    float dd = 0.f;
    auto c_step = [&](const Vx& x, const f32x4& kn, int buf, int s) {
        const float eg = x.gb[0];
        const float cc = x.gb[1] * (x.v - eg * dd);
        const f32x2 eg2 = (f32x2){eg, eg}, cc2 = (f32x2){cc, cc};
        S0 = S0 * eg2 + cc2 * (f32x2){x.k[0], x.k[1]};
        S1 = S1 * eg2 + cc2 * (f32x2){x.k[2], x.k[3]};
        const f32x2 y2 = S0 * (f32x2){x.q[0], x.q[1]} + S1 * (f32x2){x.q[2], x.q[3]};
        const f32x2 d2 = S0 * (f32x2){kn[0], kn[1]} + S1 * (f32x2){kn[2], kn[3]};
        float yp = y2[0] + y2[1], dp = d2[0] + d2[1];
        yp += dpp_<0xB1>(yp); dp += dpp_<0xB1>(dp); yp += dpp_<0x4E>(yp); dp += dpp_<0x4E>(dp);
        dp += dpp_<0x141>(dp); dp += dpp_<0x140>(dp);
        dp = rowpair_sum(dp);
        dd = dp;
        yob[s * 64] = yp;
    };
    if (prod) { p_load(0); p_write(0); p_load(1); }
    SCAN_BARRIER();
    for (int b = 0; b < NBLK; ++b) {
        if (prod) {
            if (b + 1 < NBLK) p_write((b + 1) & 1);
            if (b + 2 < NBLK) p_load(b + 2);
            if (b > 0) p_yout(b - 1);
        } else if (cons) {
            const int buf = b & 1;
            vbase = vec + (buf * TB * 32 + ks) * 12; vvb = vv + buf * TB * 8 + icol; scb = sc + buf * TB * 2; yob = yo + (buf * TB * 8 + icol) * 8 + (ks >> 2);
            Vx xa, xb;
            c_ld(xa, buf, 0);
            { const f32x2 d2 = S0 * (f32x2){xa.k[0], xa.k[1]} + S1 * (f32x2){xa.k[2], xa.k[3]}; dd = rowpair_sum(reduce16(d2[0] + d2[1])); }
#pragma unroll
            for (int s = 0; s < TB; s += 2) {
                c_ld(xb, buf, s + 1); c_step(xa, xb.k, buf, s);
                c_ld(xa, buf, s + 2);
                c_step(xb, xa.k, buf, s + 1);
            }
        }
        SCAN_BARRIER();
    }
    if (prod) p_yout(NBLK - 1);
    SCAN_BARRIER();
}

__device__ __forceinline__ void unpack8(const u32x4 r, float (&f)[8]) {
#pragma unroll
    for (int j = 0; j < 4; ++j) { f[2 * j] = __uint_as_float(r[j] << 16); f[2 * j + 1] = __uint_as_float(r[j] & 0xffff0000u); }
}
__device__ __forceinline__ u32x4 pack8(const float (&f)[8]) { u32x4 o; o[0] = pk2(f[0], f[1]); o[1] = pk2(f[2], f[3]); o[2] = pk2(f[4], f[5]); o[3] = pk2(f[6], f[7]); return o; }
__device__ __forceinline__ void phase_post(const P& p, int l, LAS unsigned char* lds) {
    const bf16_t* PG = (const bf16_t*)(p.ws + OFF_PG); const bf16_t* Rb = (const bf16_t*)(p.ws + OFF_R); const bf16_t* B = (const bf16_t*)(p.ws + OFF_B);
    const bf16_t* RWG = (const bf16_t*)(p.ws + OFF_RWG);
    bf16_t* YC = (bf16_t*)(p.ws + OFF_GDNC);
    const int tid = otid(), wave = tid >> 6, lane = tid & 63, c0 = lane * 8;
    float lnw[8], lnb[8], kac[8], rkc[8], gng[8], dng[8];
#pragma unroll
    for (int j = 0; j < 8; ++j) { lnw[j] = p.in[I_RWLNW][l * 512 + c0 + j]; lnb[j] = p.in[I_RWLNB][l * 512 + c0 + j]; kac[j] = p.in[I_RWKA][l * 512 + c0 + j]; rkc[j] = p.in[I_RWRK][l * 512 + c0 + j];
        gng[j] = p.in[I_GLANG][l * 128 + ((c0 + j) & 127)]; dng[j] = p.in[I_GDNNG][l * 128 + ((c0 + j) & 127)]; }
#pragma unroll 1
    for (int t = blockIdx.x * 8 + wave; t < L; t += gridDim.x * 8) {
        const bf16_t* pgr = PG + (size_t)t * PG_LD; const bf16_t* br = B + (size_t)t * 4096 + c0; const bf16_t* rr = Rb + (size_t)t * R_LD + c0;
        const u32x4 qy0 = *(const u32x4*)(pgr + YRW_COL + c0), qy1 = *(const u32x4*)(pgr + YRW_COL + 512 + c0);
        const u32x4 qr = *(const u32x4*)(br), qk = *(const u32x4*)(br + 512), qv = *(const u32x4*)(br + 1024), qa0 = *(const u32x4*)(br + 2048), qa1 = *(const u32x4*)(br + 2560);
        const u32x4 qg = *(const u32x4*)(RWG + (size_t)t * 512 + c0);
        const u32x4 qo0 = *(const u32x4*)(rr), qo1 = *(const u32x4*)(rr + 512), qd0 = *(const u32x4*)(rr + 1024), qd1 = *(const u32x4*)(rr + 1536);
        const u32x4 qog = *(const u32x4*)(pgr + GLA_OG + c0), qzg = *(const u32x4*)(pgr + GDN_ZG + c0);
        float a[8], b[8], o[8];
        unpack8(qy0, a); unpack8(qy1, b);
        float s = 0.f;
#pragma unroll
        for (int j = 0; j < 8; ++j) { a[j] += b[j]; s += a[j]; }
        const float mean = reduce8(s) * (1.f / 64.f);
        float s2 = 0.f;
#pragma unroll
        for (int j = 0; j < 8; ++j) { a[j] -= mean; s2 += a[j] * a[j]; }
        const float rstd = rsqrtf(reduce8(s2) * (1.f / 64.f) + 64e-5f);
        {
            float r[8], k[8], z0[8], z1[8];
            unpack8(qr, r); unpack8(qk, k); unpack8(qa0, z0); unpack8(qa1, z1);
            float sb = 0.f;
#pragma unroll
            for (int j = 0; j < 8; ++j) sb += r[j] * rkc[j] * (k[j] * (1.f + (z0[j] - 1.f) * kac[j]) + k[j] * (1.f + (z1[j] - 1.f) * kac[j]));
            const float bon = reduce8(sb);
            unpack8(qv, r); unpack8(qg, k);
#pragma unroll
            for (int j = 0; j < 8; ++j) o[j] = (a[j] * rstd * lnw[j] + lnb[j] + bon * r[j]) * k[j];
            *(u32x4*)(YC + (size_t)t * 512 + c0) = pack8(o);
        }
        unpack8(qo0, a); unpack8(qo1, b);
        s = 0.f;
#pragma unroll
        for (int j = 0; j < 8; ++j) { a[j] += b[j]; s += a[j] * a[j]; }
        float rs = rsqrtf(reduce16(s) * (1.f / 128.f) + 1e-6f);
        unpack8(qog, b);
#pragma unroll
        for (int j = 0; j < 8; ++j) o[j] = a[j] * rs * gng[j] * silu_(b[j]);
        *(u32x4*)(YC + (size_t)L * 512 + (size_t)t * 512 + c0) = pack8(o);
        unpack8(qd0, a); unpack8(qd1, b);
        s = 0.f;
#pragma unroll
        for (int j = 0; j < 8; ++j) { a[j] += b[j]; s += a[j] * a[j]; }
        rs = rsqrtf(reduce16(s) * (1.f / 128.f) + 1e-6f);
        unpack8(qzg, b);
#pragma unroll
        for (int j = 0; j < 8; ++j) o[j] = a[j] * rs * dng[j] * silu_(b[j]);
        *(u32x4*)(YC + (size_t)2 * L * 512 + (size_t)t * 512 + c0) = pack8(o);
    }
}

__device__ __forceinline__ void phase_final(const P& p) {
    const float* H = (const float*)(p.ws + OFF_H); const float* gamma = p.in[I_FINALG];
    const int tid_ = otid(); const int wave = tid_ >> 6, lane = tid_ & 63;
    for (int row = blockIdx.x * 8 + wave; row < NLAT; row += gridDim.x * 8) {
        const float* src = H + (size_t)(row + NCTX) * 1024;
        f32x4 v[4]; float ss = 0.f;
#pragma unroll
        for (int j = 0; j < 4; ++j) { v[j] = *(const f32x4*)(src + j * 256 + lane * 4); ss += (v[j][0] * v[j][0] + v[j][1] * v[j][1]) + (v[j][2] * v[j][2] + v[j][3] * v[j][3]); }
        ss = wave_sum(ss);
        const float rstd = rsqrtf(ss * (1.f / 1024.f) + 1e-6f);
#pragma unroll
        for (int j = 0; j < 4; ++j) { const int col = j * 256 + lane * 4; const f32x4 g = *(const f32x4*)(gamma + col);
            *(f32x4*)(p.out + (size_t)row * 1024 + col) = v[j] * rstd * g; }
    }
}


#define XB_TMO      128
#define XB_XCNT(j)  (256  + 64 * (j))
#define XB_XSUB(j)  (1280 + 64 * (j))
#define XB_XGEN(j)  (2304 + 64 * (j))
#define XB_TOP      3328
#define XB_TOPGEN   3392
#define XCD_BAR_WORDS 3456
#define XB_SPIN_CAP (1u << 18)
__device__ __forceinline__ unsigned xb_ld(unsigned* p)              { return __hip_atomic_load(p, __ATOMIC_RELAXED, __HIP_MEMORY_SCOPE_AGENT); }
__device__ __forceinline__ unsigned xb_add(unsigned* p, unsigned v) { return __hip_atomic_fetch_add(p, v, __ATOMIC_RELAXED, __HIP_MEMORY_SCOPE_AGENT); }
__device__ __forceinline__ unsigned xb_xcc_id() { return (unsigned)__builtin_amdgcn_s_getreg((3 << 11) | 20) & 0xFu; }
#define XB_SPIN(cond, bar) do { unsigned _sp = 0; while (cond) { __builtin_amdgcn_s_sleep(1); \
    if ((++_sp & 255u) == 0u) { if (xb_ld(&(bar)[XB_TMO])) break; if (_sp > XB_SPIN_CAP) { atomicAdd(&(bar)[XB_TMO], 1u); break; } } } } while (0)
struct XcdBarrier { unsigned* bar; unsigned x; volatile LAS unsigned* st; };
__device__ __forceinline__ XcdBarrier xcd_barrier_post(unsigned* bar, volatile LAS unsigned* st) {
    XcdBarrier b; b.bar = bar; b.x = xb_xcc_id(); b.st = st;
    if (threadIdx.x == 0) (void)xb_add(&bar[XB_XCNT(b.x)], 1u);
    return b;
}
__device__ __forceinline__ void xcd_barrier_complete(unsigned* bar, unsigned x, unsigned& nloc, unsigned& nx) {
    const unsigned G = gridDim.x * gridDim.y * gridDim.z;
    unsigned sum, cnt, mine, sp = 0u;
    for (;;) {
        sum = 0u; cnt = 0u; mine = 0u;
#pragma unroll
        for (unsigned j = 0; j < 16; ++j) { const unsigned c = xb_ld(&bar[XB_XCNT(j)]); sum += c; cnt += (c > 0u) ? 1u : 0u; mine = (j == x) ? c : mine; }
        if (sum == G) break;
        __builtin_amdgcn_s_sleep(1);
        if ((++sp & 255u) == 0u) { if (xb_ld(&bar[XB_TMO])) break; if (sp > XB_SPIN_CAP) { atomicAdd(&bar[XB_TMO], 1u); break; } }
    }
    nloc = mine > 0u ? mine : 1u; nx = cnt > 0u ? cnt : 1u;
}
__device__ __forceinline__ void xcd_barrier(const XcdBarrier& b) {
    asm volatile("s_waitcnt vmcnt(0)" ::: "memory");
    __syncthreads();
    if (threadIdx.x == 0) {
        unsigned* bar = b.bar;
        __builtin_amdgcn_s_waitcnt(0);
        unsigned nloc = b.st[0], nx = b.st[1];
        if (nloc == 0u) { xcd_barrier_complete(bar, b.x, nloc, nx); b.st[0] = nloc; b.st[1] = nx; }
        const unsigned old = xb_add(&bar[XB_XSUB(b.x)], 1u);
        const unsigned gen = old / nloc;
        if (old + 1u == (gen + 1u) * nloc) {
            __builtin_amdgcn_fence(__ATOMIC_RELEASE, "agent");
            asm volatile("s_waitcnt vmcnt(0)" ::: "memory");
            const unsigned og = xb_add(&bar[XB_TOP], 1u);
            const unsigned tg = og / nx;
            if (og + 1u == (tg + 1u) * nx) xb_add(&bar[XB_TOPGEN], 1u);
            else XB_SPIN(xb_ld(&bar[XB_TOPGEN]) == tg, bar);
            __builtin_amdgcn_fence(__ATOMIC_ACQUIRE, "agent");
            xb_add(&bar[XB_XGEN(b.x)], 1u);
            asm volatile("s_waitcnt vmcnt(0)" ::: "memory");
        } else {
            XB_SPIN(xb_ld(&bar[XB_XGEN(b.x)]) == gen, bar);
            __builtin_amdgcn_fence(__ATOMIC_ACQUIRE, "agent");
            asm volatile("s_waitcnt vmcnt(0)" ::: "memory");
        }
    }
    __syncthreads();
}

__global__ void __launch_bounds__(512, 2) fwd_megakernel(P p) {
    extern __shared__ __attribute__((aligned(16))) unsigned char shm_raw[];
    LAS unsigned char* lds = (LAS unsigned char*)shm_raw;
    cg::grid_group grid = cg::this_grid();
    const int G = gridDim.x, wg = blockIdx.x;
    unsigned char* ws = p.ws;
    float* H = (float*)(ws + OFF_H); bf16_t* HN = (bf16_t*)(ws + OFF_HN); bf16_t* WIN = (bf16_t*)(ws + OFF_WIN);
    const float* MODall = (const float*)(ws + OFF_MOD);

    volatile LAS unsigned* xbst = (volatile LAS unsigned*)(lds + 131072);
    if (threadIdx.x == 0) { xbst[0] = 0u; xbst[1] = 0u; xbst[2] = 0u; xbst[3] = 0u; }
    __syncthreads();
    const XcdBarrier xb = xcd_barrier_post((unsigned*)(ws + OFF_BAR), xbst);
    phase_mod(p, lds);
    grid.sync();
    for (int l = 0; l < DEPTH; ++l) {
        const float* MOD = MODall + (size_t)l * 2 * 6144;
        const bool lastl = (l == DEPTH - 1);
        const int Mg = lastl ? NLAT : L, pm0 = lastl ? 1 : 0;
        if (l == 0) phase_norm<true>(p, l, p.in[I_N1G] + l * 1024, 0, 1); else phase_norm<false>(p, l, p.in[I_N1G] + l * 1024, 0, 1);
        {
            const float* win = p.in[I_WIN] + (size_t)l * 1024 * IN_COLS;
            convert_T(win, IN_COLS, 1024, 0, 1920, WIN, (LAS float*)lds, wg, G);
            convert_T(win, IN_COLS, 1024, 1920, 3632, WIN + (size_t)2048 * 1024, (LAS float*)lds, (wg + 64) % G, G);
            convert_T(win, IN_COLS, 1024, 5552, 3072, WIN + (size_t)NMAIN * 1024, (LAS float*)lds, (wg + 128) % G, G);
            build_wl(p, l, wg, G);
        }
        xcd_barrier(xb);
        {
            pg8::Gemm g{HN, WIN, L, NMAIN, 1024, 16}; pg8::StaticOrder S; S.init(L, NMAIN, G, wg);
            EpiInMain E{(bf16_t*)(ws + OFF_R), (bf16_t*)(ws + OFF_PG)};
            pg8::gemm_phase(lds, g, S, E);
        }
        xcd_barrier(xb);
#ifndef NO_PREP
        phase_prep(p, l, lds);
        xcd_barrier(xb);
        {
            pg8::Gemm g{(const bf16_t*)(ws + OFF_XL), (const bf16_t*)(ws + OFF_WL), L, 2560, 512, 8}; pg8::StaticOrder S; S.init(L, 2560, G, wg);
            EpiLora E{(bf16_t*)(ws + OFF_B), (bf16_t*)(ws + OFF_RWG), p.in[I_RWW0] + (size_t)l * 1024, p.in[I_RWA0] + (size_t)l * 1024};
            pg8::gemm_phase(lds, g, S, E);
        }
#endif
        xcd_barrier(xb);
#ifndef NO_SCAN
        if (wg < 64) scan_rwkv(p, l, wg, lds);
        else if (wg < 96) scan_gla(p, l, wg - 64, lds);
        else if (wg < 224) scan_gdn(p, l, wg - 96, lds);
#endif
        xcd_barrier(xb);
#ifndef NO_POST
        phase_post(p, l, lds);
#endif
        xcd_barrier(xb);
        {
            convert_T(p.in[I_WBR] + (size_t)l * 3 * 512 * 1024, 1024, 512, 0, 1024, (bf16_t*)(ws + OFF_WBR), (LAS float*)lds, wg, G);
            convert_T(p.in[I_WBR] + (size_t)l * 3 * 512 * 1024 + (size_t)512 * 1024, 1024, 512, 0, 1024, (bf16_t*)(ws + OFF_WBR) + (size_t)1024 * 512, (LAS float*)lds, (wg + 128) % G, G);
            convert_T(p.in[I_WBR] + (size_t)l * 3 * 512 * 1024 + (size_t)2 * 512 * 1024, 1024, 512, 0, 1024, (bf16_t*)(ws + OFF_WBR) + (size_t)2 * 1024 * 512, (LAS float*)lds, wg, G);
            convert_T(p.in[I_WOUT] + (size_t)l * 1024 * 1024, 1024, 1024, 0, 1024, (bf16_t*)(ws + OFF_WOUT), (LAS float*)lds, wg, G);
            convert_T(p.in[I_W1] + (size_t)l * 1024 * 4096, 4096, 1024, 0, 4096, (bf16_t*)(ws + OFF_W1), (LAS float*)lds, wg, G);
            convert_T(p.in[I_W2] + (size_t)l * 4096 * 1024, 1024, 4096, 0, 1024, (bf16_t*)(ws + OFF_W2), (LAS float*)lds, wg, G);
            pg8::Gemm g{HN, WIN + (size_t)NMAIN * 1024, L, 3072, 1024, 16}; pg8::StaticOrder S; S.init(Mg, 3072, G, wg, pm0);
            EpiGates E{(bf16_t*)(ws + OFF_B)};
            pg8::gemm_phase(lds, g, S, E);
        }
        xcd_barrier(xb);
        {
            const bf16_t* YC = (const bf16_t*)(ws + OFF_GDNC); const bf16_t* WBR = (const bf16_t*)(ws + OFF_WBR);
            pg8::StaticOrder S; S.init(Mg, 1024, G, wg, pm0);
            { pg8::Gemm g{YC, WBR, L, 1024, 512, 8}; EpiBranch<0> E{(const bf16_t*)(ws + OFF_B), (float*)(ws + OFF_PG), HN}; pg8::gemm_phase(lds, g, S, E); }
            { pg8::Gemm g{YC + (size_t)L * 512, WBR + (size_t)1024 * 512, L, 1024, 512, 8}; EpiBranch<1> E{(const bf16_t*)(ws + OFF_B), (float*)(ws + OFF_PG), HN}; pg8::gemm_phase(lds, g, S, E); }
            { pg8::Gemm g{YC + (size_t)2 * L * 512, WBR + (size_t)2 * 1024 * 512, L, 1024, 512, 8}; EpiBranch<2> E{(const bf16_t*)(ws + OFF_B), (float*)(ws + OFF_PG), HN}; pg8::gemm_phase(lds, g, S, E); }
        }
        xcd_barrier(xb);
        {
            pg8::Gemm g{HN, (const bf16_t*)(ws + OFF_WOUT), L, 1024, 1024, 16}; pg8::StaticOrder S; S.init(Mg, 1024, G, wg, pm0);
            EpiResid E{H, MOD + 2 * 1024, MOD + 6144 + 2 * 1024};
            pg8::gemm_phase(lds, g, S, E);
        }
        xcd_barrier(xb);
        phase_norm<false>(p, l, p.in[I_N2G] + l * 1024, 3, 4);
        xcd_barrier(xb);
        {
            pg8::Gemm g{HN, (const bf16_t*)(ws + OFF_W1), L, 4096, 1024, 16}; pg8::StaticOrder S; S.init(Mg, 4096, G, wg, pm0);
            EpiMlp1 E{(bf16_t*)(ws + OFF_B)};
            pg8::gemm_phase(lds, g, S, E);
        }
        xcd_barrier(xb);
        {
            pg8::Gemm g{(const bf16_t*)(ws + OFF_B), (const bf16_t*)(ws + OFF_W2), L, 1024, 4096, 64}; pg8::StaticOrder S; S.init(Mg, 1024, G, wg, pm0);
            EpiResid E{H, MOD + 5 * 1024, MOD + 6144 + 5 * 1024};
            pg8::gemm_phase(lds, g, S, E);
        }
        xcd_barrier(xb);
    }
    phase_final(p);
}

extern "C" void kernel_launch(void* const* d_in, const int* in_sizes, int n_in, void* d_out, int out_size, void* d_ws, size_t ws_size, hipStream_t stream) {
    static int grid_blocks = 0;
    if (n_in != 32 || ws_size < WS_END || out_size != NLAT * DM) {
        fprintf(stderr, "kernel_launch: unexpected shapes / workspace (n_in %d, ws %zu need %zu, out %d)\n", n_in, ws_size, (size_t)WS_END, out_size);
        hipMemsetAsync(d_out, 0xFF, (size_t)out_size * 4, stream);
        return;
    }
    if (!grid_blocks) {
        int dev = 0, cus = 0, per_cu = 0;
        hipGetDevice(&dev);
        hipDeviceGetAttribute(&cus, hipDeviceAttributeMultiprocessorCount, dev);
        hipFuncSetAttribute((const void*)fwd_megakernel, hipFuncAttributeMaxDynamicSharedMemorySize, LDS_BYTES);
        hipOccupancyMaxActiveBlocksPerMultiprocessor(&per_cu, (const void*)fwd_megakernel, 512, LDS_BYTES);
        if (per_cu < 1) per_cu = 1;
        grid_blocks = cus * 1;
        (void)hipGetLastError();
    }
    P p{};
    for (int i = 0; i < 32; ++i) p.in[i] = (const float*)d_in[i];
    p.out = (float*)d_out; p.ws = (unsigned char*)d_ws;
    (void)hipMemsetAsync((unsigned char*)d_ws + OFF_BAR, 0, 16384, stream);
    void* args[] = {&p};
    hipError_t e = hipLaunchCooperativeKernel((const void*)fwd_megakernel, dim3(grid_blocks), dim3(512), args, LDS_BYTES, stream);
    if (e != hipSuccess) fprintf(stderr, "cooperative launch failed: %s (grid %d)\n", hipGetErrorString(e), grid_blocks);
}
```

```cpp
#include <hip/hip_runtime.h>
#include <hip/hip_cooperative_groups.h>
#include <cstdio>
#include <cstdint>
namespace cg = cooperative_groups;

#define LAS __attribute__((address_space(3)))
typedef unsigned short bf16_t;
typedef short bf16x8 __attribute__((ext_vector_type(8)));
typedef float f32x4 __attribute__((ext_vector_type(4)));
typedef float f32x2 __attribute__((ext_vector_type(2)));
typedef unsigned u32x4 __attribute__((ext_vector_type(4)));
typedef unsigned u32x2 __attribute__((ext_vector_type(2)));

constexpr int L = 16640, NCTX = 256, NLAT = 16384, DM = 1024, BW = 512, DEPTH = 4;
constexpr int IN_COLS = 8624;
constexpr int NMAIN = 5888;
constexpr int NWIN = 8960;
constexpr int R_LD = 2048, PG_LD = 3840;
constexpr int GLA_Q = 0, GLA_K = 256, GLA_V = 512, GLA_OG = 1024, GLA_AL = 1536;
constexpr int GDN_QKV = 1568, GDN_ZG = 3104, GDN_A = 3616, GDN_B = 3624;
constexpr int YRW_COL = 1568;

constexpr size_t al256(size_t x) { return (x + 255) & ~(size_t)255; }
constexpr size_t OFF_MOD = 0;
constexpr size_t OFF_H = al256(OFF_MOD + (size_t)4 * 2 * 6144 * 4);
constexpr size_t OFF_HN = OFF_H + (size_t)L * 1024 * 4;
constexpr size_t OFF_WIN = OFF_HN + (size_t)L * 1024 * 2;
constexpr size_t OFF_R = OFF_WIN + (size_t)NWIN * 1024 * 2;
constexpr size_t OFF_PG = OFF_R + (size_t)L * R_LD * 2;
constexpr size_t OFF_B = OFF_PG + (size_t)L * PG_LD * 2;
constexpr size_t OFF_RWG = OFF_B + (size_t)L * 4096 * 2;
constexpr size_t OFF_BONUS = OFF_RWG + (size_t)L * 512 * 2;
constexpr size_t OFF_GLAD = OFF_BONUS + (size_t)L * 8 * 4;
constexpr size_t OFF_GDNC = OFF_GLAD + (size_t)L * 512 * 2;
constexpr size_t OFF_GDNGB = OFF_GDNC + (size_t)L * 1536 * 2;
constexpr size_t OFF_XL = OFF_GDNGB + (size_t)L * 16 * 4;
constexpr size_t OFF_WL = OFF_XL + (size_t)L * 512 * 2;
constexpr size_t OFF_BAR = OFF_WL + (size_t)2560 * 512 * 2;
constexpr size_t WS_END = OFF_BAR + 16384;
constexpr size_t OFF_WBR = OFF_R;
constexpr size_t OFF_WOUT = OFF_WBR + (size_t)3 * 1024 * 512 * 2;
constexpr size_t OFF_W1 = OFF_WOUT + (size_t)1024 * 1024 * 2;
constexpr size_t OFF_W2 = OFF_W1 + (size_t)4096 * 1024 * 2;

constexpr int LDS_BYTES = 131072 + 16;

struct P { const float* in[32]; float* out; unsigned char* ws; };
enum { I_X = 0, I_C, I_CTX, I_CCTX, I_WMOD, I_BMOD, I_N1G, I_WIN, I_RWMU, I_RWW0, I_RWW2, I_RWA0, I_RWA2, I_RWG2, I_RWKK, I_RWKA, I_RWRK,
       I_RWLNW, I_RWLNB, I_GLAA2, I_GLAAB, I_GLANG, I_GDNCONV, I_GDNALOG, I_GDNDT, I_GDNNG, I_WBR, I_WOUT, I_N2G, I_W1, I_W2, I_FINALG };

__device__ __forceinline__ float bf2f(bf16_t b) { return __uint_as_float(((unsigned)b) << 16); }
__device__ __forceinline__ unsigned pk2(float lo, float hi) { unsigned r; asm("v_cvt_pk_bf16_f32 %0, %1, %2" : "=v"(r) : "v"(lo), "v"(hi)); return r; }
__device__ __forceinline__ bf16_t f2bf(float f) { return (bf16_t)(pk2(f, 0.f) & 0xffffu); }
__device__ __forceinline__ float sigmoid_(float x) { return 1.f / (1.f + __expf(-x)); }
__device__ __forceinline__ float silu_(float x) { return x / (1.f + __expf(-x)); }
__device__ __forceinline__ float softplus_(float x) { return fmaxf(x, 0.f) + log1pf(__expf(-fabsf(x))); }
template <int CTRL> __device__ __forceinline__ float dpp_(float x) { return __int_as_float(__builtin_amdgcn_update_dpp(0, __float_as_int(x), CTRL, 0xF, 0xF, true)); }
__device__ __forceinline__ float reduce8(float x) { x += dpp_<0xB1>(x); x += dpp_<0x4E>(x); x += dpp_<0x141>(x); return x; }
__device__ __forceinline__ float reduce16(float x) { x = reduce8(x); x += dpp_<0x140>(x); return x; }
__device__ __forceinline__ float wave_sum(float v) {
    v = reduce16(v);
    const float r0 = __int_as_float(__builtin_amdgcn_readlane(__float_as_int(v), 0)), r1 = __int_as_float(__builtin_amdgcn_readlane(__float_as_int(v), 16));
    const float r2 = __int_as_float(__builtin_amdgcn_readlane(__float_as_int(v), 32)), r3 = __int_as_float(__builtin_amdgcn_readlane(__float_as_int(v), 48));
    return (r0 + r1) + (r2 + r3);
}

__device__ __forceinline__ int otid() { int t = threadIdx.x; asm volatile("" : "+v"(t)); return t; }
__device__ __forceinline__ int osgpr(int x) { asm volatile("" : "+s"(x)); return x; }
namespace pg8 {
constexpr int BM = 256, BK = 64, HALF = 128, HTB = HALF * BK * 2, STAGE_BYTES = 8 * HTB, NXCD = 8, WGM = 8;
__host__ __device__ __forceinline__ int lds_byte(int r, int c) { const int st = (r >> 4) * 2 + (c >> 5), rr = r & 15, cc = c & 31, ob = rr * 64 + cc * 2; return st * 1024 + (ob ^ (((ob >> 9) & 1) << 5)); }
__host__ __device__ __forceinline__ int perm32(int rho) { const int n = rho >> 4, i = rho & 15; return 8 * (i >> 2) + 4 * n + (i & 3); }
__host__ __device__ __forceinline__ void stage_rc(int b, int& R, int& C) { const int st = b / 1024, sb = b % 1024, swz = sb ^ (((sb >> 9) & 1) << 5); R = (st >> 1) * 16 + swz / 64; C = (st & 1) * 32 + (swz % 64) / 2; }
struct Unit { int pm, pn, k0; };
struct Gemm { const bf16_t* A; const bf16_t* Bt; int M, N, K, nt; };
struct StaticOrder {
    int nM, nN, nwg, G, c, pm0;
    __host__ __device__ void init(int M, int N, int G_, int c_, int pm0_ = 0) { nM = M / BM; nN = N / BM; nwg = nM * nN; G = G_; c = c_; pm0 = pm0_; }
    __host__ __device__ bool next(int i, Unit& u) const {
        const long Lx = (long)i * G + c; if (Lx >= nwg) return false;
        int wgid = (int)Lx; { const int q = nwg / NXCD, r = nwg % NXCD, xcd = wgid % NXCD, off = wgid / NXCD; wgid = (xcd < r ? xcd * (q + 1) : r * (q + 1) + (xcd - r) * q) + off; }
        const int nig = WGM * nN, gid = wgid / nig, fm = gid * WGM, gsz = (nM - fm) < WGM ? (nM - fm) : WGM;
        u.pm = pm0 + fm + ((wgid % nig) % gsz); u.pn = (wgid % nig) / gsz; u.k0 = 0; return true;
    }
};
struct SplitOrder {
    int nN, nunits, G, c, nt;
    __host__ __device__ void init(int N, int K, int nt_, int G_, int c_) { nN = N / BM; nt = nt_; nunits = nN * (K / BK / nt_); G = G_; c = c_; }
    __host__ __device__ bool next(int i, Unit& u) const {
        const int idx = i * G + c; if (idx >= nunits) return false;
        u.pm = 0; u.pn = idx % nN; u.k0 = (idx / nN) * nt; return true;
    }
};
template <class Epi, class Ord>
__device__ __forceinline__ void gemm_phase(LAS unsigned char* lds, const Gemm g, const Ord& S, const Epi& E) {
#ifdef NO_GEMM
    return;
#endif
    const int tid = otid(), wid = __builtin_amdgcn_readfirstlane(tid >> 6), lane = tid & 63, wr = wid >> 2, wc = wid & 3, fr = lane & 15, fq = lane >> 4;
    const int K = g.K, nt = g.nt;
    unsigned voffA[2], voffB[2];
#pragma unroll
    for (int i = 0; i < 2; ++i) { int R, C; stage_rc(tid * 16 + i * 8192, R, C); const int Rb = (R & ~31) + perm32(R & 31);
        voffA[i] = (unsigned)(R * K + C) * 2u; voffB[i] = (unsigned)(Rb * K + C) * 2u; }
    const size_t kstep = (size_t)(BK * 2);
    const size_t hstep = (size_t)HALF * K * 2;
    const size_t tstep = 2 * hstep;
    const unsigned ldsw = (unsigned)wid * 1024u;
    const int aoff = lds_byte(wr * 64 + fr, fq * 8), boff = lds_byte(wc * 32 + fr, fq * 8);
#define PG8_SA(b, h) (((b) * 2 + (h)) * HTB)
#define PG8_SB(b, h) ((4 + (b) * 2 + (h)) * HTB)
#define PG8_STAGE(bufoff, gbase, voff) do { _Pragma("unroll") for (int _i = 0; _i < 2; ++_i) \
        __builtin_amdgcn_global_load_lds((const unsigned*)((const char*)(gbase) + (voff)[_i]), (LAS unsigned*)(lds + (bufoff) + ldsw + _i * 8192), 16, 0, 0); } while (0)
#define PG8_LDA(dst, b, h) do { _Pragma("unroll") for (int m = 0; m < 4; ++m) _Pragma("unroll") for (int k = 0; k < 2; ++k) dst[m][k] = *(const LAS bf16x8*)(lds + PG8_SA(b, h) + aoff + m * 2048 + k * 1024); } while (0)
#define PG8_LDB(dst, b, h) do { _Pragma("unroll") for (int n = 0; n < 2; ++n) _Pragma("unroll") for (int k = 0; k < 2; ++k) dst[n][k] = *(const LAS bf16x8*)(lds + PG8_SB(b, h) + boff + n * 2048 + k * 1024); } while (0)
#define PG8_MMA(ai, bj, At, Bt) do { __builtin_amdgcn_s_setprio(1); _Pragma("unroll") for (int m = 0; m < 4; ++m) _Pragma("unroll") for (int n = 0; n < 2; ++n) _Pragma("unroll") for (int k = 0; k < 2; ++k) \
        acc[ai][bj][m][n] = __builtin_amdgcn_mfma_f32_16x16x32_bf16(Bt[n][k], At[m][k], acc[ai][bj][m][n], 0, 0, 0); __builtin_amdgcn_s_setprio(0); } while (0)
#define PG8_WAIT_V(n) asm volatile("s_waitcnt vmcnt(" #n ")" ::: "memory")
#define PG8_WAIT_L(n) asm volatile("s_waitcnt lgkmcnt(" #n ")" ::: "memory")
#define PG8_BAR __builtin_amdgcn_s_barrier()
#define PG8_SCHED __builtin_amdgcn_sched_barrier(0)
    Unit cur, nxt; int ui = 0;
    if (!S.next(0, cur)) return;
    f32x4 acc[2][2][4][2];
#pragma unroll
    for (int a = 0; a < 2; ++a)
#pragma unroll
        for (int b = 0; b < 2; ++b)
#pragma unroll
            for (int m = 0; m < 4; ++m)
#pragma unroll
                for (int n = 0; n < 2; ++n) acc[a][b][m][n] = (f32x4){0.f, 0.f, 0.f, 0.f};
    bf16x8 At[4][2], B0[2][2], B1[2][2];
    const size_t kstep0 = (size_t)(BK * 2);
    const char* cA = (const char*)g.A + (size_t)cur.pm * tstep + (size_t)cur.k0 * kstep0; const char* cB = (const char*)g.Bt + (size_t)cur.pn * tstep + (size_t)cur.k0 * kstep0;
    PG8_STAGE(PG8_SB(0, 0), cB, voffB); PG8_STAGE(PG8_SA(0, 0), cA, voffA); PG8_STAGE(PG8_SB(0, 1), cB + hstep, voffB); PG8_STAGE(PG8_SA(0, 1), cA + hstep, voffA);
    if (wr == 1) PG8_BAR;
    PG8_WAIT_V(4); PG8_BAR;
    PG8_STAGE(PG8_SB(1, 0), cB + kstep, voffB); PG8_STAGE(PG8_SA(1, 0), cA + kstep, voffA); PG8_STAGE(PG8_SB(1, 1), cB + hstep + kstep, voffB);
    PG8_WAIT_V(6); PG8_BAR;
    for (;;) {
        const bool has_next = S.next(ui + 1, nxt);
        const char* nA = has_next ? (const char*)g.A + (size_t)nxt.pm * tstep + (size_t)nxt.k0 * kstep0 : cA; const char* nB = has_next ? (const char*)g.Bt + (size_t)nxt.pn * tstep + (size_t)nxt.k0 * kstep0 : cB;
        for (int t = 0; t < nt; t += 2) {
            const bool last = (t == nt - 2);
            const char* a1 = cA + (size_t)(t + 1) * kstep;
            const char* a2 = last ? nA : cA + (size_t)(t + 2) * kstep; const char* b2 = last ? nB : cB + (size_t)(t + 2) * kstep;
            const char* a3 = a2 + kstep; const char* b3 = b2 + kstep;
            PG8_LDB(B0, 0, 0); PG8_SCHED; PG8_LDA(At, 0, 0); PG8_STAGE(PG8_SA(1, 1), a1 + hstep, voffA);
            PG8_WAIT_L(8); PG8_BAR; PG8_WAIT_L(0); PG8_MMA(0, 0, At, B0); PG8_BAR; PG8_SCHED;
            PG8_LDB(B1, 0, 1); PG8_STAGE(PG8_SB(0, 0), b2, voffB);
            PG8_BAR; PG8_WAIT_L(0); PG8_MMA(0, 1, At, B1); PG8_BAR;
            PG8_LDA(At, 0, 1); PG8_STAGE(PG8_SA(0, 0), a2, voffA);
            PG8_BAR; PG8_WAIT_L(0); PG8_MMA(1, 0, At, B0); PG8_BAR; PG8_SCHED;
            PG8_STAGE(PG8_SB(0, 1), b2 + hstep, voffB);
            PG8_WAIT_V(6); PG8_BAR; PG8_MMA(1, 1, At, B1); PG8_BAR;
            PG8_LDB(B0, 1, 0); PG8_SCHED; PG8_LDA(At, 1, 0); PG8_STAGE(PG8_SA(0, 1), a2 + hstep, voffA);
            PG8_WAIT_L(8); PG8_BAR; PG8_WAIT_L(0); PG8_MMA(0, 0, At, B0); PG8_BAR; PG8_SCHED;
            PG8_LDB(B1, 1, 1); PG8_STAGE(PG8_SB(1, 0), b3, voffB);
            PG8_BAR; PG8_WAIT_L(0); PG8_MMA(0, 1, At, B1); PG8_BAR;
            PG8_LDA(At, 1, 1); PG8_STAGE(PG8_SA(1, 0), a3, voffA);
            PG8_BAR; PG8_WAIT_L(0); PG8_MMA(1, 0, At, B0); PG8_BAR; PG8_SCHED;
            PG8_STAGE(PG8_SB(1, 1), b3 + hstep, voffB);
            PG8_WAIT_V(6); PG8_BAR; PG8_MMA(1, 1, At, B1); PG8_BAR;
        }
        E(acc, cur, wr, wc, fr, fq);
        if (!has_next) break;
#pragma unroll
        for (int a = 0; a < 2; ++a)
#pragma unroll
            for (int b = 0; b < 2; ++b)
#pragma unroll
                for (int m = 0; m < 4; ++m)
#pragma unroll
                    for (int n = 0; n < 2; ++n) acc[a][b][m][n] = (f32x4){0.f, 0.f, 0.f, 0.f};
        cur = nxt; cA = nA; cB = nB; ++ui;
    }
    PG8_WAIT_V(0);
    if (wr == 0) PG8_BAR;
    PG8_BAR;
#undef PG8_SA
#undef PG8_SB
#undef PG8_STAGE
#undef PG8_LDA
#undef PG8_LDB
#undef PG8_MMA
#undef PG8_WAIT_V
#undef PG8_WAIT_L
#undef PG8_BAR
#undef PG8_SCHED
}
}
using pg8::Unit;

#define EPI_LOOP_ROWS for (int ai = 0; ai < 2; ++ai) for (int m = 0; m < 4; ++m)
#define EPI_LOOP_COLS for (int bj = 0; bj < 2; ++bj) for (int n = 0; n < 2; ++n)
struct EpiInMain {
    bf16_t* R; bf16_t* PG;
    __device__ __forceinline__ void operator()(const f32x4 (&acc)[2][2][4][2], const Unit& u, int wr, int wc, int fr, int fq) const {
        bf16_t* dst; int ld, c0;
        if (u.pn < 8) { dst = R; ld = R_LD; c0 = u.pn * 256; } else { dst = PG; ld = PG_LD; c0 = (u.pn - 8) * 256; }
        const int row0 = u.pm * 256 + wr * 64 + fr, col0 = c0 + wc * 32 + 8 * fq;
#pragma unroll
        EPI_LOOP_ROWS { bf16_t* rowp = dst + (size_t)(row0 + ai * 128 + m * 16) * ld + col0;
#pragma unroll
            EPI_LOOP_COLS { const f32x4 v = acc[ai][bj][m][n]; *(u32x2*)(rowp + bj * 128 + n * 4) = (u32x2){pk2(v[0], v[1]), pk2(v[2], v[3])}; } }
    }
};
struct EpiGates {
    bf16_t* G;
    __device__ __forceinline__ void operator()(const f32x4 (&acc)[2][2][4][2], const Unit& u, int wr, int wc, int fr, int fq) const {
        const int row0 = u.pm * 256 + wr * 64 + fr, col0 = u.pn * 256 + wc * 32 + 8 * fq;
#pragma unroll
        EPI_LOOP_ROWS { bf16_t* rowp = G + (size_t)(row0 + ai * 128 + m * 16) * 3072 + col0;
#pragma unroll
            EPI_LOOP_COLS { const f32x4 v = acc[ai][bj][m][n];
                *(u32x2*)(rowp + bj * 128 + n * 4) = (u32x2){pk2(sigmoid_(v[0]), sigmoid_(v[1])), pk2(sigmoid_(v[2]), sigmoid_(v[3]))}; } }
    }
};
template <int GI> struct EpiBranch {
    const bf16_t* G; float* MG; bf16_t* MB;
    __device__ __forceinline__ void operator()(const f32x4 (&acc)[2][2][4][2], const Unit& u, int wr, int wc, int fr, int fq) const {
        const int row0 = u.pm * 256 + wr * 64 + fr, col0 = u.pn * 256 + wc * 32 + 8 * fq;
#pragma unroll
        EPI_LOOP_ROWS { const size_t row = (size_t)(row0 + ai * 128 + m * 16);
#pragma unroll
            EPI_LOOP_COLS { const int col = col0 + bj * 128 + n * 4; const f32x4 v = acc[ai][bj][m][n];
                const u32x2 gq = *(const u32x2*)(G + row * 3072 + GI * 1024 + col);
                f32x4 gv = (f32x4){__uint_as_float(gq[0] << 16), __uint_as_float(gq[0] & 0xffff0000u), __uint_as_float(gq[1] << 16), __uint_as_float(gq[1] & 0xffff0000u)};
                f32x4 r = v * gv;
                if (GI > 0) { const u32x2 mq = *(const u32x2*)(MB + row * 1024 + col);
                    r += (f32x4){__uint_as_float(mq[0] << 16), __uint_as_float(mq[0] & 0xffff0000u), __uint_as_float(mq[1] << 16), __uint_as_float(mq[1] & 0xffff0000u)}; }
                *(u32x2*)(MB + row * 1024 + col) = (u32x2){pk2(r[0], r[1]), pk2(r[2], r[3])}; } }
    }
};
struct EpiResid {
    float* H; const float* gate_lat; const float* gate_ctx;
    __device__ __forceinline__ void operator()(const f32x4 (&acc)[2][2][4][2], const Unit& u, int wr, int wc, int fr, int fq) const {
        const int row0 = u.pm * 256 + wr * 64 + fr, col0 = u.pn * 256 + wc * 32 + 8 * fq;
        const float* gp = (u.pm == 0) ? gate_ctx : gate_lat;
        f32x4 gv[2][2];
#pragma unroll
        EPI_LOOP_COLS gv[bj][n] = *(const f32x4*)(gp + col0 + bj * 128 + n * 4);
#pragma unroll
        EPI_LOOP_ROWS { float* rowp = H + (size_t)(row0 + ai * 128 + m * 16) * 1024 + col0;
#pragma unroll
            EPI_LOOP_COLS { f32x4* q = (f32x4*)(rowp + bj * 128 + n * 4); *q = *q + acc[ai][bj][m][n] * gv[bj][n]; } }
    }
};
struct EpiLora {
    bf16_t* B; bf16_t* RWG; const float* w0; const float* a0;
    __device__ __forceinline__ void operator()(const f32x4 (&acc)[2][2][4][2], const Unit& u, int wr, int wc, int fr, int fq) const {
        const int row0 = u.pm * 256 + wr * 64 + fr, blk = u.pn >> 1, cbase = (u.pn & 1) * 256 + wc * 32 + 8 * fq;
        f32x4 bv[2][2];
#pragma unroll
        EPI_LOOP_COLS { const int cc = cbase + bj * 128 + n * 4;
            bv[bj][n] = blk < 2 ? *(const f32x4*)(w0 + blk * 512 + cc) : (blk < 4 ? *(const f32x4*)(a0 + (blk - 2) * 512 + cc) : (f32x4){0.f, 0.f, 0.f, 0.f}); }
        bf16_t* dst; int ld;
        if (blk < 2) { dst = B + 3072 + blk * 512; ld = 4096; } else if (blk < 4) { dst = B + 2048 + (blk - 2) * 512; ld = 4096; } else { dst = RWG; ld = 512; }
#pragma unroll
        EPI_LOOP_ROWS { bf16_t* rowp = dst + (size_t)(row0 + ai * 128 + m * 16) * ld + cbase;
#pragma unroll
            EPI_LOOP_COLS { f32x4 v = acc[ai][bj][m][n] + bv[bj][n];
                if (blk < 2) {
#pragma unroll
                    for (int j = 0; j < 4; ++j) v[j] = 1.f - __expf(-0.60653066f * sigmoid_(v[j]));
                } else if (blk < 4) {
#pragma unroll
                    for (int j = 0; j < 4; ++j) v[j] = sigmoid_(v[j]);
                }
                *(u32x2*)(rowp + bj * 128 + n * 4) = (u32x2){pk2(v[0], v[1]), pk2(v[2], v[3])}; } }
    }
};
struct EpiResidAtomic {
    float* H; const float* gate_ctx;
    __device__ __forceinline__ void operator()(const f32x4 (&acc)[2][2][4][2], const Unit& u, int wr, int wc, int fr, int fq) const {
        const int row0 = u.pm * 256 + wr * 64 + fr, col0 = u.pn * 256 + wc * 32 + 8 * fq;
        const float* gp = gate_ctx + col0;
#pragma unroll
        EPI_LOOP_ROWS { float* rowp = H + (size_t)(row0 + ai * 128 + m * 16) * 1024 + col0;
#pragma unroll
            EPI_LOOP_COLS { const f32x4 v = acc[ai][bj][m][n] * *(const f32x4*)(gp + bj * 128 + n * 4); float* q = rowp + bj * 128 + n * 4;
                unsafeAtomicAdd(q, v[0]); unsafeAtomicAdd(q + 1, v[1]); unsafeAtomicAdd(q + 2, v[2]); unsafeAtomicAdd(q + 3, v[3]); }
            asm volatile("" ::: "memory"); }
    }
};
struct EpiMlp1 {
    bf16_t* U;
    __device__ __forceinline__ void operator()(const f32x4 (&acc)[2][2][4][2], const Unit& u, int wr, int wc, int fr, int fq) const {
        const int row0 = u.pm * 256 + wr * 64 + fr, col0 = u.pn * 256 + wc * 32 + 8 * fq;
#pragma unroll
        EPI_LOOP_ROWS { bf16_t* rowp = U + (size_t)(row0 + ai * 128 + m * 16) * 4096 + col0;
#pragma unroll
            EPI_LOOP_COLS { f32x4 v = acc[ai][bj][m][n];
#pragma unroll
                for (int j = 0; j < 4; ++j) { const float t = fmaxf(v[j], 0.f); v[j] = t * t; }
                *(u32x2*)(rowp + bj * 128 + n * 4) = (u32x2){pk2(v[0], v[1]), pk2(v[2], v[3])}; } }
    }
};

__device__ __forceinline__ void convert_T(const float* src, int ld, int K, int n0, int ncols, bf16_t* dst, LAS float* tile, int wg, int nwg) {
    const int ntn = (ncols + 63) >> 6, ntk = K >> 6, tid = otid();
    for (int t = wg; t < ntn * ntk; t += nwg) {
        const int tn = t / ntk, tk = t - tn * ntk, k0 = tk * 64, nb = tn * 64;
#pragma unroll
        for (int i = 0; i < 2; ++i) { const int idx = tid + i * 512, kk = idx >> 4, n4 = (idx & 15) * 4;
            f32x4 v = (f32x4){0.f, 0.f, 0.f, 0.f};
            if (nb + n4 < ncols) v = *(const f32x4*)(src + (size_t)(k0 + kk) * ld + n0 + nb + n4);
            tile[kk * 65 + n4 + 0] = v[0]; tile[kk * 65 + n4 + 1] = v[1]; tile[kk * 65 + n4 + 2] = v[2]; tile[kk * 65 + n4 + 3] = v[3]; }
        __syncthreads();
        { const int nn = tid >> 3, k8 = (tid & 7) * 8;
          if (nb + nn < ncols) { const LAS float* s = tile + k8 * 65 + nn;
              u32x4 o; o[0] = pk2(s[0], s[65]); o[1] = pk2(s[130], s[195]); o[2] = pk2(s[260], s[325]); o[3] = pk2(s[390], s[455]);
              *(u32x4*)(dst + (size_t)(nb + nn) * K + k0 + k8) = o; } }
        __syncthreads();
    }
}

__device__ __forceinline__ void phase_mod(const P& p, LAS unsigned char* lds) {
    const float* c = p.in[I_C]; const float* cc = p.in[I_CCTX]; const float* wm = p.in[I_WMOD]; const float* bm = p.in[I_BMOD];
    float* MOD = (float*)(p.ws + OFF_MOD);
    LAS float* red = (LAS float*)lds;
    const int tid = otid();
    for (int blk = blockIdx.x; blk < 256; blk += gridDim.x) {
        const int l = blk >> 6, col0 = (blk & 63) * 96;
        if (tid < 384) {
            const int cgp = tid % 24, ks = tid / 24;
            f32x4 a0 = (f32x4){0.f, 0.f, 0.f, 0.f}, a1 = a0;
            const float* w = wm + (size_t)l * 1024 * 6144 + col0 + cgp * 4;
#pragma unroll 8
            for (int k = ks * 64; k < ks * 64 + 64; ++k) {
                const f32x4 wv = *(const f32x4*)(w + (size_t)k * 6144);
                const float s0 = silu_(c[k]), s1 = silu_(cc[k]);
                a0 += wv * s0; a1 += wv * s1;
            }
            LAS f32x4* r4 = (LAS f32x4*)red;
            r4[(ks * 24 + cgp) * 2 + 0] = a0; r4[(ks * 24 + cgp) * 2 + 1] = a1;
        }
        __syncthreads();
        if (tid < 192) {
            const int col = tid % 96, s = tid / 96;
            float sum = 0.f;
#pragma unroll
            for (int k2 = 0; k2 < 16; ++k2) sum += red[((k2 * 24 + (col >> 2)) * 2 + s) * 4 + (col & 3)];
            MOD[((size_t)l * 2 + s) * 6144 + col0 + col] = sum + bm[l * 6144 + col0 + col];
        }
        __syncthreads();
    }
}

template <bool FROM_INPUT>
__device__ __forceinline__ void phase_norm(const P& p, int l, const float* gamma, int shift_idx, int scale_idx) {
    float* H = (float*)(p.ws + OFF_H); bf16_t* HN = (bf16_t*)(p.ws + OFF_HN);
    const float* MOD = (const float*)(p.ws + OFF_MOD) + (size_t)l * 2 * 6144;
    const int tid_ = otid(); const int wave = tid_ >> 6, lane = tid_ & 63;
    for (int row = blockIdx.x * 8 + wave; row < L; row += gridDim.x * 8) {
        const float* src = FROM_INPUT ? (row < NCTX ? p.in[I_CTX] + (size_t)row * 1024 : p.in[I_X] + (size_t)(row - NCTX) * 1024) : H + (size_t)row * 1024;
        f32x4 v[4]; float ss = 0.f;
#pragma unroll
        for (int j = 0; j < 4; ++j) { v[j] = *(const f32x4*)(src + j * 256 + lane * 4); ss += (v[j][0] * v[j][0] + v[j][1] * v[j][1]) + (v[j][2] * v[j][2] + v[j][3] * v[j][3]); }
        ss = wave_sum(ss);
        const float rstd = rsqrtf(ss * (1.f / 1024.f) + 1e-6f);
        const float* m = MOD + (row < NCTX ? 6144 : 0);
#pragma unroll
        for (int j = 0; j < 4; ++j) { const int col = j * 256 + lane * 4;
            const f32x4 g = *(const f32x4*)(gamma + col), sh = *(const f32x4*)(m + shift_idx * 1024 + col), sc = *(const f32x4*)(m + scale_idx * 1024 + col);
            const f32x4 o = v[j] * rstd * g * (sc + 1.f) + sh;
            *(u32x2*)(HN + (size_t)row * 1024 + col) = (u32x2){pk2(o[0], o[1]), pk2(o[2], o[3])};
            if (FROM_INPUT) *(f32x4*)(H + (size_t)row * 1024 + col) = v[j]; }
    }
}

constexpr int TT = 13;
__device__ __forceinline__ void phase_prep(const P& p, int l, LAS unsigned char* lds) {
    const bf16_t* R = (const bf16_t*)(p.ws + OFF_R); const bf16_t* PG = (const bf16_t*)(p.ws + OFF_PG);
    bf16_t* B = (bf16_t*)(p.ws + OFF_B); bf16_t* XL = (bf16_t*)(p.ws + OFF_XL);
    bf16_t* GLAD = (bf16_t*)(p.ws + OFF_GLAD); bf16_t* GDNC = (bf16_t*)(p.ws + OFF_GDNC); float* GDNGB = (float*)(p.ws + OFF_GDNGB);
    const float* mu = p.in[I_RWMU] + (size_t)l * 2 * 1920;
    const float* kkw = p.in[I_RWKK] + l * 512;
    const float* ga2 = p.in[I_GLAA2] + (size_t)l * 2 * 16 * 256; const float* gab = p.in[I_GLAAB] + l * 512;
    const float* cw = p.in[I_GDNCONV] + (size_t)l * 5 * 1536; const float* alog = p.in[I_GDNALOG] + l * 8; const float* dtb = p.in[I_GDNDT] + l * 8;
    LAS float* gal = (LAS float*)lds;
    LAS float* red = gal + TT * 32;
    const int tid = otid(), wave = tid >> 6;
    const int c = tid;
    const int gz = tid >> 8, gk = tid & 255;
    for (int tile = blockIdx.x; tile < L / TT; tile += gridDim.x) {
        const int t0 = tile * TT;
        if (tid < TT * 32) { const int tt = tid >> 5, e = tid & 31; gal[tt * 32 + e] = bf2f(PG[(size_t)(t0 + tt) * PG_LD + GLA_AL + e]); }
        {
            float xr[TT + 2], xk[TT + 2], xv[TT + 2], xe[TT + 2];
#pragma unroll
            for (int i = 0; i < TT + 2; ++i) { const int rr = t0 - 1 + i;
                if (rr >= 0 && rr < L) { const bf16_t* rp = R + (size_t)rr * R_LD + c; xr[i] = bf2f(rp[0]); xk[i] = bf2f(rp[512]); xv[i] = bf2f(rp[1024]); xe[i] = (c < 384) ? bf2f(rp[1536]) : 0.f; }
                else { xr[i] = 0.f; xk[i] = 0.f; xv[i] = 0.f; xe[i] = 0.f; } }
            const float mr0 = mu[c], mr1 = mu[1920 + c], mk0 = mu[512 + c], mk1 = mu[1920 + 512 + c], mv0 = mu[1024 + c], mv1 = mu[1920 + 1024 + c];
            const float me0 = (c < 384) ? mu[1536 + c] : 0.f, me1 = (c < 384) ? mu[1920 + 1536 + c] : 0.f;
            const float kkc = kkw[c];
#pragma unroll
            for (int tt = 0; tt < TT; ++tt) {
                const int t = t0 + tt;
                const float hp = (t != 0 && t != NCTX) ? 1.f : 0.f, hn = (t != NCTX - 1 && t != L - 1) ? 1.f : 0.f;
                const float r = mr0 * hp * xr[tt] + (1.f - mr0 - mr1) * xr[tt + 1] + mr1 * hn * xr[tt + 2];
                const float k = mk0 * hp * xk[tt] + (1.f - mk0 - mk1) * xk[tt + 1] + mk1 * hn * xk[tt + 2];
                const float v = mv0 * hp * xv[tt] + (1.f - mv0 - mv1) * xv[tt + 1] + mv1 * hn * xv[tt + 2];
                float e = me0 * hp * xe[tt] + (1.f - me0 - me1) * xe[tt + 1] + me1 * hn * xe[tt + 2];
                if (c < 128) e = 2.f * sigmoid_(2.f * e) - 1.f; else if (c >= 256 && c < 384) e = sigmoid_(e); else if (c >= 384) e = 0.f;
                const float kr = k * kkc;
                const float ssq = wave_sum(kr * kr);
                bf16_t* bp = B + (size_t)t * 4096 + c;
                bp[0] = f2bf(r); bp[512] = f2bf(k); bp[1024] = f2bf(v); bp[1536] = f2bf(kr * rsqrtf(ssq + 1e-12f));
                XL[(size_t)t * 512 + c] = f2bf(e);
            }
        }
        __syncthreads();
        {
        float ga2v[16];
#pragma unroll
        for (int e = 0; e < 16; ++e) ga2v[e] = ga2[(gz * 16 + e) * 256 + gk];
        const float gabv = gab[gz * 256 + gk];
#pragma unroll
        for (int tt = 0; tt < TT; ++tt) {
            float zv = gabv;
#pragma unroll
            for (int e = 0; e < 16; ++e) zv += gal[tt * 32 + gz * 16 + e] * ga2v[e];
            const float la = __logf(sigmoid_(zv)) * (1.f / 16.f);
            GLAD[(size_t)(t0 + tt) * 512 + tid] = f2bf(1.f - __expf(la));
        }
        }
        {
            float cwv[5], xv[TT + 4];
#pragma unroll
            for (int i = 0; i < 5; ++i) cwv[i] = cw[i * 1536 + 1024 + c];
#pragma unroll
            for (int i = 0; i < TT + 4; ++i) { const int rr = t0 - 2 + i; xv[i] = (rr >= 0 && rr < L) ? bf2f(PG[(size_t)rr * PG_LD + GDN_QKV + 1024 + c]) : 0.f; }
#pragma unroll
            for (int tt = 0; tt < TT; ++tt) { const int t = t0 + tt; float sv = 0.f;
#pragma unroll
                for (int i = 0; i < 5; ++i) { const int rr = t + i - 2; const bool ok_ = (rr >= 0) && (rr < L) && ((rr < NCTX) == (t < NCTX)); if (ok_) sv += xv[tt + i] * cwv[i]; }
                GDNC[(size_t)t * 1536 + 1024 + c] = f2bf(silu_(sv)); }
        }
        float oq[TT], ok[TT];
        {
            float cwq[5], cwk[5], xq[TT + 4], xk[TT + 4];
#pragma unroll
            for (int i = 0; i < 5; ++i) { cwq[i] = cw[i * 1536 + c]; cwk[i] = cw[i * 1536 + 512 + c]; }
#pragma unroll
            for (int i = 0; i < TT + 4; ++i) { const int rr = t0 - 2 + i;
                if (rr >= 0 && rr < L) { const bf16_t* rp = PG + (size_t)rr * PG_LD + GDN_QKV + c; xq[i] = bf2f(rp[0]); xk[i] = bf2f(rp[512]); } else { xq[i] = 0.f; xk[i] = 0.f; } }
#pragma unroll
            for (int tt = 0; tt < TT; ++tt) {
                const int t = t0 + tt; float sq = 0.f, sk = 0.f;
#pragma unroll
                for (int i = 0; i < 5; ++i) { const int rr = t + i - 2; const bool ok_ = (rr >= 0) && (rr < L) && ((rr < NCTX) == (t < NCTX));
                    if (ok_) { sq += xq[tt + i] * cwq[i]; sk += xk[tt + i] * cwk[i]; } }
                oq[tt] = silu_(sq); ok[tt] = silu_(sk);
                const float pq = wave_sum(oq[tt] * oq[tt]), pk = wave_sum(ok[tt] * ok[tt]);
                if ((tid & 63) == 0) { red[(tt * 8 + wave) * 2 + 0] = pq; red[(tt * 8 + wave) * 2 + 1] = pk; }
            }
        }
        __syncthreads();
#pragma unroll
        for (int tt = 0; tt < TT; ++tt) {
            const int w0i = (wave >> 1) * 2;
            const float ssq = red[(tt * 8 + w0i) * 2 + 0] + red[(tt * 8 + w0i + 1) * 2 + 0], ssk = red[(tt * 8 + w0i) * 2 + 1] + red[(tt * 8 + w0i + 1) * 2 + 1];
            bf16_t* gp = GDNC + (size_t)(t0 + tt) * 1536 + c;
            gp[0] = f2bf(oq[tt] * rsqrtf(ssq + 1e-12f) * 0.08838834764831845f); gp[512] = f2bf(ok[tt] * rsqrtf(ssk + 1e-12f));
        }
        if (tid < TT * 16) { const int tt = tid >> 4, j = tid & 15, t = t0 + tt;
            float o;
            if (j < 8) { const float a = bf2f(PG[(size_t)t * PG_LD + GDN_A + j]); o = __expf(-__expf(alog[j]) * softplus_(a + dtb[j])); }
            else o = sigmoid_(bf2f(PG[(size_t)t * PG_LD + GDN_B + (j - 8)]));
            GDNGB[t * 16 + j] = o; }
        __syncthreads();
    }
}
__device__ __forceinline__ void build_wl(const P& p, int l, int wg, int nwg) {
    const float* w2 = p.in[I_RWW2] + (size_t)l * 2 * 64 * 512; const float* a2 = p.in[I_RWA2] + (size_t)l * 2 * 64 * 512; const float* g2 = p.in[I_RWG2] + (size_t)l * 128 * 512;
    bf16_t* WL = (bf16_t*)(p.ws + OFF_WL);
    const int tid = otid();
    for (int it = wg * 512 + tid; it < 2560 * 64; it += nwg * 512) {
        const int kc = it / 2560, n = it - kc * 2560, k0 = kc * 8, blk = n >> 9, cc = n & 511;
        const float* src = nullptr; int kb = 0, kn = 0;
        if (blk == 0) { src = w2; kb = 0; kn = 64; } else if (blk == 1) { src = w2 + 64 * 512; kb = 64; kn = 64; }
        else if (blk == 2) { src = a2; kb = 128; kn = 64; } else if (blk == 3) { src = a2 + 64 * 512; kb = 192; kn = 64; }
        else { src = g2; kb = 256; kn = 128; }
        float v[8];
#pragma unroll
        for (int j = 0; j < 8; ++j) { const int k = k0 + j - kb; v[j] = (k >= 0 && k < kn) ? src[(size_t)k * 512 + cc] : 0.f; }
        u32x4 o; o[0] = pk2(v[0], v[1]); o[1] = pk2(v[2], v[3]); o[2] = pk2(v[4], v[5]); o[3] = pk2(v[6], v[7]);
        *(u32x4*)(WL + (size_t)n * 512 + k0) = o;
    }
}

constexpr int TB = 32, NBLK = L / TB;
__device__ __forceinline__ int tok_seq(int z, int j) { return z == 0 ? j : (j < NCTX ? NCTX - 1 - j : L - 1 - (j - NCTX)); }
__device__ __forceinline__ int tok_gla(int z, int j) {
    if (j < NCTX) return z == 0 ? j : NCTX - 1 - j;
    const int jj = j - NCTX, pp = z == 0 ? jj : NLAT - 1 - jj;
    return NCTX + (pp & 255) * 64 + (pp >> 8);
}

template <int NCW> struct ScanRole {
    bool cons, prod; int ct;
    __device__ __forceinline__ ScanRole(int tid) {
        const int w = tid >> 6, lane = tid & 63;
        if (NCW == 4) { cons = w < 4; prod = !cons; ct = tid & 255; }
        else { cons = w < 2; prod = (w & 2) != 0; ct = cons ? tid : ((((w >> 2) << 1) | (w & 1)) * 64 + lane); }
    }
};
__device__ __forceinline__ float rowpair_sum(float x) {
    const unsigned u = __float_as_uint(x); auto r = __builtin_amdgcn_permlane16_swap(u, u, false, false);
    return __uint_as_float(r[0]) + __uint_as_float(r[1]);
}
#define SCAN_BARRIER() asm volatile("s_waitcnt lgkmcnt(0)\n\ts_barrier" ::: "memory")
__device__ __forceinline__ float bfraw2f(unsigned short b) { return __uint_as_float(((unsigned)b) << 16); }
__device__ __forceinline__ f32x4 bf4(u32x2 r) { return (f32x4){__uint_as_float(r[0] << 16), __uint_as_float(r[0] & 0xffff0000u), __uint_as_float(r[1] << 16), __uint_as_float(r[1] & 0xffff0000u)}; }

__device__ __forceinline__ void scan_rwkv(const P& p, int l, int unit, LAS unsigned char* lds) {
    const int z = unit >> 5, h = (unit >> 2) & 7, rq = unit & 3;
    const bf16_t* B = (const bf16_t*)(p.ws + OFF_B); bf16_t* Y = (bf16_t*)(p.ws + OFF_PG) + YRW_COL + z * 512 + h * 64 + rq * 16;
    const float* kaw = p.in[I_RWKA] + l * 512 + h * 64;
    LAS float* vec = (LAS float*)lds;
    LAS float* vv = vec + 2 * TB * 320;
    LAS float* yo = vv + 2 * TB * 16;
    const int tid = otid(); const ScanRole<4> role(tid); const int ct = role.ct; const bool prod = role.prod, cons = role.cons;
    u32x2 pr[2], pk[2], pkk[2], pa[2], pw[2]; unsigned short pv[2];
    const f32x4 kac4 = *(const f32x4*)(kaw + (ct & 15) * 4);
    auto p_load = [&](int blk) {
#pragma unroll
        for (int i = 0; i < 2; ++i) { const int idx = ct + i * 256, s = idx >> 4, n4 = idx & 15; const int t = tok_seq(z, blk * TB + s);
            const bf16_t* bp = B + (size_t)t * 4096 + h * 64 + n4 * 4;
            pr[i] = *(const u32x2*)(bp); pk[i] = *(const u32x2*)(bp + 512); pkk[i] = *(const u32x2*)(bp + 1536); pa[i] = *(const u32x2*)(bp + 2048 + z * 512); pw[i] = *(const u32x2*)(bp + 3072 + z * 512); }
#pragma unroll
        for (int i = 0; i < 2; ++i) { const int idx = ct + i * 256, s = idx >> 4, r = idx & 15; const int t = tok_seq(z, blk * TB + s); pv[i] = B[(size_t)t * 4096 + 1024 + h * 64 + rq * 16 + r]; }
    };
    auto p_write = [&](int buf) {
#pragma unroll
        for (int i = 0; i < 2; ++i) { const int idx = ct + i * 256, s = idx >> 4, n4 = idx & 15;
            LAS float* d = vec + ((buf * TB + s) * 16 + n4) * 20;
            const f32x4 kk = bf4(pkk[i]), a = bf4(pa[i]);
            *(LAS f32x4*)(d) = kk; *(LAS f32x4*)(d + 4) = 1.f - bf4(pw[i]); *(LAS f32x4*)(d + 8) = kk * a;
            *(LAS f32x4*)(d + 12) = bf4(pk[i]) * ((a - 1.f) * kac4 + 1.f); *(LAS f32x4*)(d + 16) = bf4(pr[i]); }
#pragma unroll
        for (int i = 0; i < 2; ++i) vv[buf * TB * 16 + ct + i * 256] = bfraw2f(pv[i]);
    };
    auto p_yout = [&](int blk) {
        const int buf = blk & 1;
#pragma unroll
        for (int i = 0; i < 2; ++i) { const int idx = ct + i * 256, s = idx >> 4, r = idx & 15; const int t = tok_seq(z, blk * TB + s);
            const f32x4 y0 = *(const LAS f32x4*)(yo + (buf * TB * 16 + idx) * 8), y1 = *(const LAS f32x4*)(yo + (buf * TB * 16 + idx) * 8 + 4);
            Y[(size_t)t * PG_LD + r] = f2bf(((y0[0] + y0[1]) + (y0[2] + y0[3])) + ((y1[0] + y1[1]) + (y1[2] + y1[3]))); }
    };
    const int irow = (ct >> 4) & 15, ks = ct & 15;
    const LAS float* vbase = vec; const LAS float* vvb = vv; LAS float* yob = yo;
    f32x2 S0 = (f32x2){0.f, 0.f}, S1 = S0;
    struct Vx { f32x4 kk, w, b, k, r; float v; };
    auto c_ld = [&](Vx& x, int buf, int s) {
        const LAS float* d = vbase + s * 320;
        x.kk = *(const LAS f32x4*)(d); x.w = *(const LAS f32x4*)(d + 4); x.b = *(const LAS f32x4*)(d + 8); x.k = *(const LAS f32x4*)(d + 12);
        x.r = *(const LAS f32x4*)(d + 16); x.v = vvb[s * 16];
    };
    float sa = 0.f;
    auto c_step = [&](const Vx& x, const f32x4& kkn, int buf, int s) {
        const f32x2 vv2 = (f32x2){x.v, x.v};
        const f32x2 pre0 = S0 * (f32x2){x.w[0], x.w[1]} + vv2 * (f32x2){x.k[0], x.k[1]}, pre1 = S1 * (f32x2){x.w[2], x.w[3]} + vv2 * (f32x2){x.k[2], x.k[3]};
        const f32x2 nsa = (f32x2){-sa, -sa};
        S0 = nsa * (f32x2){x.b[0], x.b[1]} + pre0;
        S1 = nsa * (f32x2){x.b[2], x.b[3]} + pre1;
        const f32x2 y2 = S0 * (f32x2){x.r[0], x.r[1]} + S1 * (f32x2){x.r[2], x.r[3]};
        const f32x2 s2 = S0 * (f32x2){kkn[0], kkn[1]} + S1 * (f32x2){kkn[2], kkn[3]};
        float yp = y2[0] + y2[1], sp = s2[0] + s2[1];
        yp += dpp_<0xB1>(yp); sp += dpp_<0xB1>(sp); sp += dpp_<0x4E>(sp);
        sp += dpp_<0x141>(sp); sp += dpp_<0x140>(sp);
        sa = sp;
        yob[s * 128] = yp;
    };
    if (cons) __builtin_amdgcn_s_setprio(3);
    if (prod) { p_load(0); p_write(0); p_load(1); }
    SCAN_BARRIER();
    for (int b = 0; b < NBLK; ++b) {
        if (prod) {
            if (b + 1 < NBLK) p_write((b + 1) & 1);
            if (b + 2 < NBLK) p_load(b + 2);
            if (b > 0) p_yout(b - 1);
        } else if (cons) {
            const int buf = b & 1;
            vbase = vec + (buf * TB * 16 + ks) * 20; vvb = vv + buf * TB * 16 + irow; yob = yo + (buf * TB * 16 + irow) * 8 + (ks >> 1);
            Vx xa, xb;
            c_ld(xa, buf, 0);
            { const f32x2 s2 = S0 * (f32x2){xa.kk[0], xa.kk[1]} + S1 * (f32x2){xa.kk[2], xa.kk[3]}; sa = reduce16(s2[0] + s2[1]); }
#pragma unroll
            for (int s = 0; s < TB; s += 2) {
                c_ld(xb, buf, s + 1); c_step(xa, xb.kk, buf, s);
                c_ld(xa, buf, s + 2);
                c_step(xb, xa.kk, buf, s + 1);
            }
        }
        SCAN_BARRIER();
    }
    __builtin_amdgcn_s_setprio(0);
    if (prod) p_yout(NBLK - 1);
    SCAN_BARRIER();
}

__device__ __forceinline__ void scan_gla(const P& p, int l, int unit, LAS unsigned char* lds) {
    const int z = unit >> 4, h = (unit >> 2) & 3, cb = unit & 3;
    const bf16_t* PG = (const bf16_t*)(p.ws + OFF_PG); const bf16_t* GLAD = (const bf16_t*)(p.ws + OFF_GLAD);
    bf16_t* O = (bf16_t*)(p.ws + OFF_R) + z * 512 + h * 128 + cb * 32;
    LAS float* vec = (LAS float*)lds;
    LAS float* vv = vec + 2 * TB * 192;
    LAS float* yo = vv + 2 * TB * 32;
    const int tid = otid(); const ScanRole<4> role(tid); const int ct = role.ct; const bool prod = role.prod, cons = role.cons;
    unsigned short pq[8], pk[8], pa[8], pv[4];
    auto p_load = [&](int blk) {
#pragma unroll
        for (int i = 0; i < 8; ++i) { const int idx = ct + i * 256, s = idx >> 6, n = idx & 63; const int t = tok_gla(z, blk * TB + s);
            const bf16_t* bp = PG + (size_t)t * PG_LD + h * 64 + n;
            pq[i] = bp[GLA_Q]; pk[i] = bp[GLA_K]; pa[i] = GLAD[(size_t)t * 512 + z * 256 + h * 64 + n]; }
#pragma unroll
        for (int i = 0; i < 4; ++i) { const int idx = ct + i * 256, s = idx >> 5, r = idx & 31; const int t = tok_gla(z, blk * TB + s);
            pv[i] = PG[(size_t)t * PG_LD + GLA_V + h * 128 + cb * 32 + r]; }
    };
    auto p_write = [&](int buf) {
#pragma unroll
        for (int i = 0; i < 8; ++i) { const int idx = ct + i * 256, s = idx >> 6, n = idx & 63;
            LAS float* d = vec + ((buf * TB + s) * 8 + (n >> 3)) * 24 + (n & 7);
            d[0] = bfraw2f(pq[i]) * 0.125f; d[8] = bfraw2f(pk[i]); d[16] = 1.f - bfraw2f(pa[i]); }
#pragma unroll
        for (int i = 0; i < 4; ++i) vv[buf * TB * 32 + ct + i * 256] = bfraw2f(pv[i]);
    };
    auto p_yout = [&](int blk) {
        const int buf = blk & 1;
#pragma unroll
        for (int i = 0; i < 4; ++i) { const int idx = ct + i * 256, s = idx >> 5, r = idx & 31; const int t = tok_gla(z, blk * TB + s);
            const f32x4 y0 = *(const LAS f32x4*)(yo + (buf * TB * 32 + idx) * 4);
            O[(size_t)t * R_LD + r] = f2bf((y0[0] + y0[1]) + (y0[2] + y0[3])); }
    };
    const int icol = (ct >> 3) & 31, ks = ct & 7;
    const LAS float* vbase = vec; const LAS float* vvb = vv; LAS float* yob = yo;
    f32x2 S[4];
#pragma unroll
    for (int j = 0; j < 4; ++j) S[j] = (f32x2){0.f, 0.f};
    struct Vx { f32x4 q0, q1, k0, k1, a0, a1; float v; };
    auto c_ld = [&](Vx& x, int buf, int s) {
        const LAS float* d = vbase + s * 192;
        x.q0 = *(const LAS f32x4*)(d); x.q1 = *(const LAS f32x4*)(d + 4); x.k0 = *(const LAS f32x4*)(d + 8); x.k1 = *(const LAS f32x4*)(d + 12);
        x.a0 = *(const LAS f32x4*)(d + 16); x.a1 = *(const LAS f32x4*)(d + 20); x.v = vvb[s * 32];
    };
    auto c_upd = [&](const Vx& x) -> float {
        const f32x2 vv2 = (f32x2){x.v, x.v};
        S[0] = S[0] * (f32x2){x.a0[0], x.a0[1]} + vv2 * (f32x2){x.k0[0], x.k0[1]};
        S[1] = S[1] * (f32x2){x.a0[2], x.a0[3]} + vv2 * (f32x2){x.k0[2], x.k0[3]};
        S[2] = S[2] * (f32x2){x.a1[0], x.a1[1]} + vv2 * (f32x2){x.k1[0], x.k1[1]};
        S[3] = S[3] * (f32x2){x.a1[2], x.a1[3]} + vv2 * (f32x2){x.k1[2], x.k1[3]};
        const f32x2 y2 = (S[0] * (f32x2){x.q0[0], x.q0[1]} + S[1] * (f32x2){x.q0[2], x.q0[3]}) + (S[2] * (f32x2){x.q1[0], x.q1[1]} + S[3] * (f32x2){x.q1[2], x.q1[3]});
        return y2[0] + y2[1];
    };
    if (cons) __builtin_amdgcn_s_setprio(3);
    if (prod) { p_load(0); p_write(0); p_load(1); }
    SCAN_BARRIER();
    for (int b = 0; b < NBLK; ++b) {
        if (prod) {
            if (b + 1 < NBLK) p_write((b + 1) & 1);
            if (b + 2 < NBLK) p_load(b + 2);
            if (b > 0) p_yout(b - 1);
        } else if (cons) {
            const int buf = b & 1;
            vbase = vec + (buf * TB * 8 + ks) * 24; vvb = vv + buf * TB * 32 + icol; yob = yo + (buf * TB * 32 + icol) * 4 + (ks >> 1);
            Vx xa, xb;
            c_ld(xa, buf, 0);
#pragma unroll
            for (int s = 0; s < TB; s += 2) {
                c_ld(xb, buf, s + 1);
                float ya = c_upd(xa);
                c_ld(xa, buf, s + 2);
                float yb = c_upd(xb);
                ya += dpp_<0xB1>(ya); yb += dpp_<0xB1>(yb);
                yob[s * 128] = ya; yob[(s + 1) * 128] = yb;
            }
        }
        SCAN_BARRIER();
    }
    __builtin_amdgcn_s_setprio(0);
    if (prod) p_yout(NBLK - 1);
    SCAN_BARRIER();
}

__device__ __forceinline__ void scan_gdn(const P& p, int l, int unit, LAS unsigned char* lds) {
    const int z = unit >> 6, h = (unit >> 4) & 3, cb = unit & 15;
    const bf16_t* GDNC = (const bf16_t*)(p.ws + OFF_GDNC); const float* GDNGB = (const float*)(p.ws + OFF_GDNGB);
    bf16_t* O = (bf16_t*)(p.ws + OFF_R) + 1024 + z * 512 + h * 128 + cb * 8;
    LAS float* vec = (LAS float*)lds;
    LAS float* vv = vec + 2 * TB * 384;
    LAS float* sc = vv + 2 * TB * 8;
    LAS float* yo = sc + 2 * TB * 2;
    const int tid = otid(); const ScanRole<4> role(tid); const int ct = role.ct; const bool prod = role.prod, cons = role.cons;
    u32x2 pq[4], pk[4]; unsigned short pv; float psc = 0.f;
    auto p_load = [&](int blk) {
#pragma unroll
        for (int i = 0; i < 4; ++i) { const int idx = ct + i * 256, s = idx >> 5, n4 = idx & 31; const int t = tok_seq(z, blk * TB + s);
            const bf16_t* bp = GDNC + (size_t)t * 1536 + h * 128 + n4 * 4;
            pq[i] = *(const u32x2*)(bp); pk[i] = *(const u32x2*)(bp + 512); }
        { const int s = ct >> 3, r = ct & 7; const int t = tok_seq(z, blk * TB + s); pv = GDNC[(size_t)t * 1536 + 1024 + h * 128 + cb * 8 + r]; }
        if (ct < 64) { const int s = ct >> 1, w = ct & 1; const int t = tok_seq(z, blk * TB + s); psc = GDNGB[t * 16 + w * 8 + z * 4 + h]; }
    };
    auto p_write = [&](int buf) {
#pragma unroll
        for (int i = 0; i < 4; ++i) { const int idx = ct + i * 256, s = idx >> 5, n4 = idx & 31;
            LAS float* d = vec + ((buf * TB + s) * 32 + n4) * 12;
            *(LAS f32x4*)(d) = bf4(pq[i]); *(LAS f32x4*)(d + 4) = bf4(pk[i]); }
        vv[buf * TB * 8 + ct] = bfraw2f(pv);
        if (ct < 64) sc[buf * TB * 2 + ct] = psc;
    };
    auto p_yout = [&](int blk) {
        const int buf = blk & 1; const int s = ct >> 3, r = ct & 7; const int t = tok_seq(z, blk * TB + s);
        const f32x4 y0 = *(const LAS f32x4*)(yo + (buf * TB * 8 + ct) * 8), y1 = *(const LAS f32x4*)(yo + (buf * TB * 8 + ct) * 8 + 4);
        O[(size_t)t * R_LD + r] = f2bf(((y0[0] + y0[1]) + (y0[2] + y0[3])) + ((y1[0] + y1[1]) + (y1[2] + y1[3])));
    };
    const int icol = (ct >> 5) & 7, ks = ct & 31;
    const LAS float* vbase = vec; const LAS float* vvb = vv; const LAS float* scb = sc; LAS float* yob = yo;
    f32x2 S0 = (f32x2){0.f, 0.f}, S1 = S0;
    struct Vx { f32x4 q, k; float v; f32x2 gb; };
    auto c_ld = [&](Vx& x, int buf, int s) {
        const LAS float* d = vbase + s * 384;
        x.q = *(const LAS f32x4*)(d); x.k = *(const LAS f32x4*)(d + 4);
        x.v = vvb[s * 8]; x.gb = *(const LAS f32x2*)(scb + s * 2);
    };
    float dd = 0.f;
    auto c_step = [&](const Vx& x, const f32x4& kn, int buf, int s) {
        const float eg = x.gb[0];
        const f32x2 eg2 = (f32x2){eg, eg};
        const f32x2 pre0 = S0 * eg2, pre1 = S1 * eg2;
        const float cc = x.gb[1] * (x.v - eg * dd);
        const f32x2 cc2 = (f32x2){cc, cc};
        S0 = cc2 * (f32x2){x.k[0], x.k[1]} + pre0;
        S1 = cc2 * (f32x2){x.k[2], x.k[3]} + pre1;
        const f32x2 y2 = S0 * (f32x2){x.q[0], x.q[1]} + S1 * (f32x2){x.q[2], x.q[3]};
        const f32x2 d2 = S0 * (f32x2){kn[0], kn[1]} + S1 * (f32x2){kn[2], kn[3]};
        float yp = y2[0] + y2[1], dp = d2[0] + d2[1];
        yp += dpp_<0xB1>(yp); dp += dpp_<0xB1>(dp); yp += dpp_<0x4E>(yp); dp += dpp_<0x4E>(dp);
        dp += dpp_<0x141>(dp); dp += dpp_<0x140>(dp);
        dp = rowpair_sum(dp);
        dd = dp;
        yob[s * 64] = yp;
    };
    if (cons) __builtin_amdgcn_s_setprio(3);
    if (prod) { p_load(0); p_write(0); p_load(1); }
    SCAN_BARRIER();
    for (int b = 0; b < NBLK; ++b) {
        if (prod) {
            if (b + 1 < NBLK) p_write((b + 1) & 1);
            if (b + 2 < NBLK) p_load(b + 2);
            if (b > 0) p_yout(b - 1);
        } else if (cons) {
            const int buf = b & 1;
            vbase = vec + (buf * TB * 32 + ks) * 12; vvb = vv + buf * TB * 8 + icol; scb = sc + buf * TB * 2; yob = yo + (buf * TB * 8 + icol) * 8 + (ks >> 2);
            Vx xa, xb;
            c_ld(xa, buf, 0);
            { const f32x2 d2 = S0 * (f32x2){xa.k[0], xa.k[1]} + S1 * (f32x2){xa.k[2], xa.k[3]}; dd = rowpair_sum(reduce16(d2[0] + d2[1])); }
#pragma unroll
            for (int s = 0; s < TB; s += 2) {
                c_ld(xb, buf, s + 1); c_step(xa, xb.k, buf, s);
                c_ld(xa, buf, s + 2);
                c_step(xb, xa.k, buf, s + 1);
            }
        }
        SCAN_BARRIER();
    }
    __builtin_amdgcn_s_setprio(0);
    if (prod) p_yout(NBLK - 1);
    SCAN_BARRIER();
}

__device__ __forceinline__ void unpack8(const u32x4 r, float (&f)[8]) {
#pragma unroll
    for (int j = 0; j < 4; ++j) { f[2 * j] = __uint_as_float(r[j] << 16); f[2 * j + 1] = __uint_as_float(r[j] & 0xffff0000u); }
}
__device__ __forceinline__ u32x4 pack8(const float (&f)[8]) { u32x4 o; o[0] = pk2(f[0], f[1]); o[1] = pk2(f[2], f[3]); o[2] = pk2(f[4], f[5]); o[3] = pk2(f[6], f[7]); return o; }
__device__ __forceinline__ void phase_post(const P& p, int l, LAS unsigned char* lds) {
    const bf16_t* PG = (const bf16_t*)(p.ws + OFF_PG); const bf16_t* Rb = (const bf16_t*)(p.ws + OFF_R); const bf16_t* B = (const bf16_t*)(p.ws + OFF_B);
    const bf16_t* RWG = (const bf16_t*)(p.ws + OFF_RWG);
    bf16_t* YC = (bf16_t*)(p.ws + OFF_GDNC);
    const int tid = otid(), wave = tid >> 6, lane = tid & 63, c0 = lane * 8;
    float lnw[8], lnb[8], kac[8], rkc[8], gng[8], dng[8];
#pragma unroll
    for (int j = 0; j < 8; ++j) { lnw[j] = p.in[I_RWLNW][l * 512 + c0 + j]; lnb[j] = p.in[I_RWLNB][l * 512 + c0 + j]; kac[j] = p.in[I_RWKA][l * 512 + c0 + j]; rkc[j] = p.in[I_RWRK][l * 512 + c0 + j];
        gng[j] = p.in[I_GLANG][l * 128 + ((c0 + j) & 127)]; dng[j] = p.in[I_GDNNG][l * 128 + ((c0 + j) & 127)]; }
#pragma unroll 1
    for (int t = blockIdx.x * 8 + wave; t < L; t += gridDim.x * 8) {
        const bf16_t* pgr = PG + (size_t)t * PG_LD; const bf16_t* br = B + (size_t)t * 4096 + c0; const bf16_t* rr = Rb + (size_t)t * R_LD + c0;
        const u32x4 qy0 = *(const u32x4*)(pgr + YRW_COL + c0), qy1 = *(const u32x4*)(pgr + YRW_COL + 512 + c0);
        const u32x4 qr = *(const u32x4*)(br), qk = *(const u32x4*)(br + 512), qv = *(const u32x4*)(br + 1024), qa0 = *(const u32x4*)(br + 2048), qa1 = *(const u32x4*)(br + 2560);
        const u32x4 qg = *(const u32x4*)(RWG + (size_t)t * 512 + c0);
        const u32x4 qo0 = *(const u32x4*)(rr), qo1 = *(const u32x4*)(rr + 512), qd0 = *(const u32x4*)(rr + 1024), qd1 = *(const u32x4*)(rr + 1536);
        const u32x4 qog = *(const u32x4*)(pgr + GLA_OG + c0), qzg = *(const u32x4*)(pgr + GDN_ZG + c0);
        float a[8], b[8], o[8];
        unpack8(qy0, a); unpack8(qy1, b);
        float s = 0.f;
#pragma unroll
        for (int j = 0; j < 8; ++j) { a[j] += b[j]; s += a[j]; }
        const float mean = reduce8(s) * (1.f / 64.f);
        float s2 = 0.f;
#pragma unroll
        for (int j = 0; j < 8; ++j) { a[j] -= mean; s2 += a[j] * a[j]; }
        const float rstd = rsqrtf(reduce8(s2) * (1.f / 64.f) + 64e-5f);
        {
            float r[8], k[8], z0[8], z1[8];
            unpack8(qr, r); unpack8(qk, k); unpack8(qa0, z0); unpack8(qa1, z1);
            float sb = 0.f;
#pragma unroll
            for (int j = 0; j < 8; ++j) sb += r[j] * rkc[j] * (k[j] * (1.f + (z0[j] - 1.f) * kac[j]) + k[j] * (1.f + (z1[j] - 1.f) * kac[j]));
            const float bon = reduce8(sb);
            unpack8(qv, r); unpack8(qg, k);
#pragma unroll
            for (int j = 0; j < 8; ++j) o[j] = (a[j] * rstd * lnw[j] + lnb[j] + bon * r[j]) * k[j];
            *(u32x4*)(YC + (size_t)t * 512 + c0) = pack8(o);
        }
        unpack8(qo0, a); unpack8(qo1, b);
        s = 0.f;
#pragma unroll
        for (int j = 0; j < 8; ++j) { a[j] += b[j]; s += a[j] * a[j]; }
        float rs = rsqrtf(reduce16(s) * (1.f / 128.f) + 1e-6f);
        unpack8(qog, b);
#pragma unroll
        for (int j = 0; j < 8; ++j) o[j] = a[j] * rs * gng[j] * silu_(b[j]);
        *(u32x4*)(YC + (size_t)L * 512 + (size_t)t * 512 + c0) = pack8(o);
        unpack8(qd0, a); unpack8(qd1, b);
        s = 0.f;
#pragma unroll
        for (int j = 0; j < 8; ++j) { a[j] += b[j]; s += a[j] * a[j]; }
        rs = rsqrtf(reduce16(s) * (1.f / 128.f) + 1e-6f);
        unpack8(qzg, b);
#pragma unroll
        for (int j = 0; j < 8; ++j) o[j] = a[j] * rs * dng[j] * silu_(b[j]);
        *(u32x4*)(YC + (size_t)2 * L * 512 + (size_t)t * 512 + c0) = pack8(o);
    }
}

__device__ __forceinline__ void phase_final(const P& p) {
    const float* H = (const float*)(p.ws + OFF_H); const float* gamma = p.in[I_FINALG];
    const int tid_ = otid(); const int wave = tid_ >> 6, lane = tid_ & 63;
    for (int row = blockIdx.x * 8 + wave; row < NLAT; row += gridDim.x * 8) {
        const float* src = H + (size_t)(row + NCTX) * 1024;
        f32x4 v[4]; float ss = 0.f;
#pragma unroll
        for (int j = 0; j < 4; ++j) { v[j] = *(const f32x4*)(src + j * 256 + lane * 4); ss += (v[j][0] * v[j][0] + v[j][1] * v[j][1]) + (v[j][2] * v[j][2] + v[j][3] * v[j][3]); }
        ss = wave_sum(ss);
        const float rstd = rsqrtf(ss * (1.f / 1024.f) + 1e-6f);
#pragma unroll
        for (int j = 0; j < 4; ++j) { const int col = j * 256 + lane * 4; const f32x4 g = *(const f32x4*)(gamma + col);
            *(f32x4*)(p.out + (size_t)row * 1024 + col) = v[j] * rstd * g; }
    }
}


#define XB_TMO      128
#define XB_XCNT(j)  (256  + 64 * (j))
#define XB_XSUB(j)  (1280 + 64 * (j))
#define XB_XGEN(j)  (2304 + 64 * (j))
#define XB_TOP      3328
#define XB_TOPGEN   3392
#define XCD_BAR_WORDS 3456
#define XB_SPIN_CAP (1u << 18)
__device__ __forceinline__ unsigned xb_ld(unsigned* p)              { return __hip_atomic_load(p, __ATOMIC_RELAXED, __HIP_MEMORY_SCOPE_AGENT); }
__device__ __forceinline__ unsigned xb_add(unsigned* p, unsigned v) { return __hip_atomic_fetch_add(p, v, __ATOMIC_RELAXED, __HIP_MEMORY_SCOPE_AGENT); }
__device__ __forceinline__ unsigned xb_xcc_id() { return (unsigned)__builtin_amdgcn_s_getreg((3 << 11) | 20) & 0xFu; }
#define XB_SPIN(cond, bar) do { unsigned _sp = 0; while (cond) { __builtin_amdgcn_s_sleep(1); \
    if ((++_sp & 255u) == 0u) { if (xb_ld(&(bar)[XB_TMO])) break; if (_sp > XB_SPIN_CAP) { atomicAdd(&(bar)[XB_TMO], 1u); break; } } } } while (0)
struct XcdBarrier { unsigned* bar; unsigned x; volatile LAS unsigned* st; };
__device__ __forceinline__ XcdBarrier xcd_barrier_post(unsigned* bar, volatile LAS unsigned* st) {
    XcdBarrier b; b.bar = bar; b.x = xb_xcc_id(); b.st = st;
    if (threadIdx.x == 0) (void)xb_add(&bar[XB_XCNT(b.x)], 1u);
    return b;
}
__device__ __forceinline__ void xcd_barrier_complete(unsigned* bar, unsigned x, unsigned& nloc, unsigned& nx) {
    const unsigned G = gridDim.x * gridDim.y * gridDim.z;
    unsigned sum, cnt, mine, sp = 0u;
    for (;;) {
        sum = 0u; cnt = 0u; mine = 0u;
#pragma unroll
        for (unsigned j = 0; j < 16; ++j) { const unsigned c = xb_ld(&bar[XB_XCNT(j)]); sum += c; cnt += (c > 0u) ? 1u : 0u; mine = (j == x) ? c : mine; }
        if (sum == G) break;
        __builtin_amdgcn_s_sleep(1);
        if ((++sp & 255u) == 0u) { if (xb_ld(&bar[XB_TMO])) break; if (sp > XB_SPIN_CAP) { atomicAdd(&bar[XB_TMO], 1u); break; } }
    }
    nloc = mine > 0u ? mine : 1u; nx = cnt > 0u ? cnt : 1u;
}
__device__ __forceinline__ void xcd_barrier(const XcdBarrier& b) {
    asm volatile("s_waitcnt vmcnt(0)" ::: "memory");
    __syncthreads();
    if (threadIdx.x == 0) {
        unsigned* bar = b.bar;
        __builtin_amdgcn_s_waitcnt(0);
        unsigned nloc = b.st[0], nx = b.st[1];
        if (nloc == 0u) { xcd_barrier_complete(bar, b.x, nloc, nx); b.st[0] = nloc; b.st[1] = nx; }
        const unsigned old = xb_add(&bar[XB_XSUB(b.x)], 1u);
        const unsigned gen = old / nloc;
        if (old + 1u == (gen + 1u) * nloc) {
            __builtin_amdgcn_fence(__ATOMIC_RELEASE, "agent");
            asm volatile("s_waitcnt vmcnt(0)" ::: "memory");
            const unsigned og = xb_add(&bar[XB_TOP], 1u);
            const unsigned tg = og / nx;
            if (og + 1u == (tg + 1u) * nx) xb_add(&bar[XB_TOPGEN], 1u);
            else XB_SPIN(xb_ld(&bar[XB_TOPGEN]) == tg, bar);
            __builtin_amdgcn_fence(__ATOMIC_ACQUIRE, "agent");
            xb_add(&bar[XB_XGEN(b.x)], 1u);
            asm volatile("s_waitcnt vmcnt(0)" ::: "memory");
        } else {
            XB_SPIN(xb_ld(&bar[XB_XGEN(b.x)]) == gen, bar);
            __builtin_amdgcn_fence(__ATOMIC_ACQUIRE, "agent");
            asm volatile("s_waitcnt vmcnt(0)" ::: "memory");
        }
    }
    __syncthreads();
}

__global__ void __launch_bounds__(512, 2) fwd_megakernel(P p) {
    extern __shared__ __attribute__((aligned(16))) unsigned char shm_raw[];
    LAS unsigned char* lds = (LAS unsigned char*)shm_raw;
    cg::grid_group grid = cg::this_grid();
    const int G = gridDim.x, wg = blockIdx.x;
    unsigned char* ws = p.ws;
    float* H = (float*)(ws + OFF_H); bf16_t* HN = (bf16_t*)(ws + OFF_HN); bf16_t* WIN = (bf16_t*)(ws + OFF_WIN);
    const float* MODall = (const float*)(ws + OFF_MOD);

    volatile LAS unsigned* xbst = (volatile LAS unsigned*)(lds + 131072);
    if (threadIdx.x == 0) { xbst[0] = 0u; xbst[1] = 0u; xbst[2] = 0u; xbst[3] = 0u; }
    __syncthreads();
    const XcdBarrier xb = xcd_barrier_post((unsigned*)(ws + OFF_BAR), xbst);
    phase_mod(p, lds);
    grid.sync();
    for (int l = 0; l < DEPTH; ++l) {
        const float* MOD = MODall + (size_t)l * 2 * 6144;
        const bool lastl = (l == DEPTH - 1);
        const int Mg = lastl ? NLAT : L, pm0 = lastl ? 1 : 0;
        if (l == 0) phase_norm<true>(p, l, p.in[I_N1G] + l * 1024, 0, 1); else phase_norm<false>(p, l, p.in[I_N1G] + l * 1024, 0, 1);
        {
            const float* win = p.in[I_WIN] + (size_t)l * 1024 * IN_COLS;
            convert_T(win, IN_COLS, 1024, 0, 1920, WIN, (LAS float*)lds, wg, G);
            convert_T(win, IN_COLS, 1024, 1920, 3632, WIN + (size_t)2048 * 1024, (LAS float*)lds, (wg + 64) % G, G);
            convert_T(win, IN_COLS, 1024, 5552, 3072, WIN + (size_t)NMAIN * 1024, (LAS float*)lds, (wg + 128) % G, G);
            build_wl(p, l, wg, G);
        }
        xcd_barrier(xb);
        {
            pg8::Gemm g{HN, WIN, L, NMAIN, 1024, 16}; pg8::StaticOrder S; S.init(L, NMAIN, G, wg);
            EpiInMain E{(bf16_t*)(ws + OFF_R), (bf16_t*)(ws + OFF_PG)};
            pg8::gemm_phase(lds, g, S, E);
        }
        xcd_barrier(xb);
#ifndef NO_PREP
        phase_prep(p, l, lds);
        xcd_barrier(xb);
        {
            pg8::Gemm g{(const bf16_t*)(ws + OFF_XL), (const bf16_t*)(ws + OFF_WL), L, 2560, 512, 8}; pg8::StaticOrder S; S.init(L, 2560, G, wg);
            EpiLora E{(bf16_t*)(ws + OFF_B), (bf16_t*)(ws + OFF_RWG), p.in[I_RWW0] + (size_t)l * 1024, p.in[I_RWA0] + (size_t)l * 1024};
            pg8::gemm_phase(lds, g, S, E);
        }
#endif
        xcd_barrier(xb);
#ifndef NO_SCAN
        if (wg < 64) scan_rwkv(p, l, wg, lds);
        else if (wg < 96) scan_gla(p, l, wg - 64, lds);
        else if (wg < 224) scan_gdn(p, l, wg - 96, lds);
#endif
        xcd_barrier(xb);
#ifndef NO_POST
        phase_post(p, l, lds);
#endif
        xcd_barrier(xb);
        {
            convert_T(p.in[I_WBR] + (size_t)l * 3 * 512 * 1024, 1024, 512, 0, 1024, (bf16_t*)(ws + OFF_WBR), (LAS float*)lds, wg, G);
            convert_T(p.in[I_WBR] + (size_t)l * 3 * 512 * 1024 + (size_t)512 * 1024, 1024, 512, 0, 1024, (bf16_t*)(ws + OFF_WBR) + (size_t)1024 * 512, (LAS float*)lds, (wg + 128) % G, G);
            convert_T(p.in[I_WBR] + (size_t)l * 3 * 512 * 1024 + (size_t)2 * 512 * 1024, 1024, 512, 0, 1024, (bf16_t*)(ws + OFF_WBR) + (size_t)2 * 1024 * 512, (LAS float*)lds, wg, G);
            convert_T(p.in[I_WOUT] + (size_t)l * 1024 * 1024, 1024, 1024, 0, 1024, (bf16_t*)(ws + OFF_WOUT), (LAS float*)lds, wg, G);
            convert_T(p.in[I_W1] + (size_t)l * 1024 * 4096, 4096, 1024, 0, 4096, (bf16_t*)(ws + OFF_W1), (LAS float*)lds, wg, G);
            convert_T(p.in[I_W2] + (size_t)l * 4096 * 1024, 1024, 4096, 0, 1024, (bf16_t*)(ws + OFF_W2), (LAS float*)lds, wg, G);
            pg8::Gemm g{HN, WIN + (size_t)NMAIN * 1024, L, 3072, 1024, 16}; pg8::StaticOrder S; S.init(Mg, 3072, G, wg, pm0);
            EpiGates E{(bf16_t*)(ws + OFF_B)};
            pg8::gemm_phase(lds, g, S, E);
        }
        xcd_barrier(xb);
        {
            const bf16_t* YC = (const bf16_t*)(ws + OFF_GDNC); const bf16_t* WBR = (const bf16_t*)(ws + OFF_WBR);
            pg8::StaticOrder S; S.init(Mg, 1024, G, wg, pm0);
            { pg8::Gemm g{YC, WBR, L, 1024, 512, 8}; EpiBranch<0> E{(const bf16_t*)(ws + OFF_B), (float*)(ws + OFF_PG), HN}; pg8::gemm_phase(lds, g, S, E); }
            { pg8::Gemm g{YC + (size_t)L * 512, WBR + (size_t)1024 * 512, L, 1024, 512, 8}; EpiBranch<1> E{(const bf16_t*)(ws + OFF_B), (float*)(ws + OFF_PG), HN}; pg8::gemm_phase(lds, g, S, E); }
            { pg8::Gemm g{YC + (size_t)2 * L * 512, WBR + (size_t)2 * 1024 * 512, L, 1024, 512, 8}; EpiBranch<2> E{(const bf16_t*)(ws + OFF_B), (float*)(ws + OFF_PG), HN}; pg8::gemm_phase(lds, g, S, E); }
        }
        xcd_barrier(xb);
        {
            pg8::Gemm g{HN, (const bf16_t*)(ws + OFF_WOUT), L, 1024, 1024, 16}; pg8::StaticOrder S; S.init(Mg, 1024, G, wg, pm0);
            EpiResid E{H, MOD + 2 * 1024, MOD + 6144 + 2 * 1024};
            pg8::gemm_phase(lds, g, S, E);
        }
        xcd_barrier(xb);
        phase_norm<false>(p, l, p.in[I_N2G] + l * 1024, 3, 4);
        xcd_barrier(xb);
        {
            pg8::Gemm g{HN, (const bf16_t*)(ws + OFF_W1), L, 4096, 1024, 16}; pg8::StaticOrder S; S.init(Mg, 4096, G, wg, pm0);
            EpiMlp1 E{(bf16_t*)(ws + OFF_B)};
            pg8::gemm_phase(lds, g, S, E);
        }
        xcd_barrier(xb);
        {
            pg8::Gemm g{(const bf16_t*)(ws + OFF_B), (const bf16_t*)(ws + OFF_W2), L, 1024, 4096, 64}; pg8::StaticOrder S; S.init(Mg, 1024, G, wg, pm0);
            EpiResid E{H, MOD + 5 * 1024, MOD + 6144 + 5 * 1024};
            pg8::gemm_phase(lds, g, S, E);
        }
        xcd_barrier(xb);
    }
    phase_final(p);
}

extern "C" void kernel_launch(void* const* d_in, const int* in_sizes, int n_in, void* d_out, int out_size, void* d_ws, size_t ws_size, hipStream_t stream) {
    static int grid_blocks = 0;
    if (n_in != 32 || ws_size < WS_END || out_size != NLAT * DM) {
        fprintf(stderr, "kernel_launch: unexpected shapes / workspace (n_in %d, ws %zu need %zu, out %d)\n", n_in, ws_size, (size_t)WS_END, out_size);
        hipMemsetAsync(d_out, 0xFF, (size_t)out_size * 4, stream);
        return;
    }
    if (!grid_blocks) {
        int dev = 0, cus = 0, per_cu = 0;
        hipGetDevice(&dev);
        hipDeviceGetAttribute(&cus, hipDeviceAttributeMultiprocessorCount, dev);
        hipFuncSetAttribute((const void*)fwd_megakernel, hipFuncAttributeMaxDynamicSharedMemorySize, LDS_BYTES);
        hipOccupancyMaxActiveBlocksPerMultiprocessor(&per_cu, (const void*)fwd_megakernel, 512, LDS_BYTES);
        if (per_cu < 1) per_cu = 1;
        grid_blocks = cus * 1;
        (void)hipGetLastError();
    }
    P p{};
    for (int i = 0; i < 32; ++i) p.in[i] = (const float*)d_in[i];
    p.out = (float*)d_out; p.ws = (unsigned char*)d_ws;
    (void)hipMemsetAsync((unsigned char*)d_ws + OFF_BAR, 0, 16384, stream);
    void* args[] = {&p};
    hipError_t e = hipLaunchCooperativeKernel((const void*)fwd_megakernel, dim3(grid_blocks), dim3(512), args, LDS_BYTES, stream);
    if (e != hipSuccess) fprintf(stderr, "cooperative launch failed: %s (grid %d)\n", hipGetErrorString(e), grid_blocks);
}
```

```cpp
#include <hip/hip_runtime.h>
#include <hip/hip_cooperative_groups.h>
#include <cstdio>
#include <cstdint>
namespace cg = cooperative_groups;

#define LAS __attribute__((address_space(3)))
typedef unsigned short bf16_t;
typedef short bf16x8 __attribute__((ext_vector_type(8)));
typedef float f32x4 __attribute__((ext_vector_type(4)));
typedef float f32x2 __attribute__((ext_vector_type(2)));
typedef unsigned u32x4 __attribute__((ext_vector_type(4)));
typedef unsigned u32x2 __attribute__((ext_vector_type(2)));

constexpr int L = 16640, NCTX = 256, NLAT = 16384, DM = 1024, BW = 512, DEPTH = 4;
constexpr int IN_COLS = 8624;
constexpr int NMAIN = 5888;
constexpr int NWIN = 8960;
constexpr int R_LD = 2048, PG_LD = 3840;
constexpr int GLA_Q = 0, GLA_K = 256, GLA_V = 512, GLA_OG = 1024, GLA_AL = 1536;
constexpr int GDN_QKV = 1568, GDN_ZG = 3104, GDN_A = 3616, GDN_B = 3624;
constexpr int YRW_COL = 1568;

constexpr size_t al256(size_t x) { return (x + 255) & ~(size_t)255; }
constexpr size_t OFF_MOD = 0;
constexpr size_t OFF_H = al256(OFF_MOD + (size_t)4 * 2 * 6144 * 4);
constexpr size_t OFF_HN = OFF_H + (size_t)L * 1024 * 4;
constexpr size_t OFF_WIN = OFF_HN + (size_t)L * 1024 * 2;
constexpr size_t OFF_R = OFF_WIN + (size_t)NWIN * 1024 * 2;
constexpr size_t OFF_PG = OFF_R + (size_t)L * R_LD * 2;
constexpr size_t OFF_B = OFF_PG + (size_t)L * PG_LD * 2;
constexpr size_t OFF_RWG = OFF_B + (size_t)L * 4096 * 2;
constexpr size_t OFF_BONUS = OFF_RWG + (size_t)L * 512 * 2;
constexpr size_t OFF_GLAD = OFF_BONUS + (size_t)L * 8 * 4;
constexpr size_t OFF_GDNC = OFF_GLAD + (size_t)L * 512 * 2;
constexpr size_t OFF_GDNGB = OFF_GDNC + (size_t)L * 1536 * 2;
constexpr size_t OFF_XL = OFF_GDNGB + (size_t)L * 16 * 4;
constexpr size_t OFF_WL = OFF_XL + (size_t)L * 512 * 2;
constexpr size_t OFF_BAR = OFF_WL + (size_t)2560 * 512 * 2;
constexpr size_t WS_END = OFF_BAR + 16384;
constexpr size_t OFF_WBR = OFF_R;
constexpr size_t OFF_WOUT = OFF_WBR + (size_t)3 * 1024 * 512 * 2;
constexpr size_t OFF_W1 = OFF_WOUT + (size_t)1024 * 1024 * 2;
constexpr size_t OFF_W2 = OFF_W1 + (size_t)4096 * 1024 * 2;

constexpr int LDS_BYTES = 131072 + 16;

struct P { const float* in[32]; float* out; unsigned char* ws; };
enum { I_X = 0, I_C, I_CTX, I_CCTX, I_WMOD, I_BMOD, I_N1G, I_WIN, I_RWMU, I_RWW0, I_RWW2, I_RWA0, I_RWA2, I_RWG2, I_RWKK, I_RWKA, I_RWRK,
       I_RWLNW, I_RWLNB, I_GLAA2, I_GLAAB, I_GLANG, I_GDNCONV, I_GDNALOG, I_GDNDT, I_GDNNG, I_WBR, I_WOUT, I_N2G, I_W1, I_W2, I_FINALG };

__device__ __forceinline__ float bf2f(bf16_t b) { return __uint_as_float(((unsigned)b) << 16); }
__device__ __forceinline__ unsigned pk2(float lo, float hi) { unsigned r; asm("v_cvt_pk_bf16_f32 %0, %1, %2" : "=v"(r) : "v"(lo), "v"(hi)); return r; }
__device__ __forceinline__ bf16_t f2bf(float f) { return (bf16_t)(pk2(f, 0.f) & 0xffffu); }
__device__ __forceinline__ float sigmoid_(float x) { return 1.f / (1.f + __expf(-x)); }
__device__ __forceinline__ float silu_(float x) { return x / (1.f + __expf(-x)); }
__device__ __forceinline__ float softplus_(float x) { return fmaxf(x, 0.f) + log1pf(__expf(-fabsf(x))); }
template <int CTRL> __device__ __forceinline__ float dpp_(float x) { return __int_as_float(__builtin_amdgcn_update_dpp(0, __float_as_int(x), CTRL, 0xF, 0xF, true)); }
__device__ __forceinline__ float reduce8(float x) { x += dpp_<0xB1>(x); x += dpp_<0x4E>(x); x += dpp_<0x141>(x); return x; }
__device__ __forceinline__ float reduce16(float x) { x = reduce8(x); x += dpp_<0x140>(x); return x; }
__device__ __forceinline__ float wave_sum(float v) {
    v = reduce16(v);
    const float r0 = __int_as_float(__builtin_amdgcn_readlane(__float_as_int(v), 0)), r1 = __int_as_float(__builtin_amdgcn_readlane(__float_as_int(v), 16));
    const float r2 = __int_as_float(__builtin_amdgcn_readlane(__float_as_int(v), 32)), r3 = __int_as_float(__builtin_amdgcn_readlane(__float_as_int(v), 48));
    return (r0 + r1) + (r2 + r3);
}

__device__ __forceinline__ int otid() { int t = threadIdx.x; asm volatile("" : "+v"(t)); return t; }
__device__ __forceinline__ int osgpr(int x) { asm volatile("" : "+s"(x)); return x; }
namespace pg8 {
constexpr int BM = 256, BK = 64, HALF = 128, HTB = HALF * BK * 2, STAGE_BYTES = 8 * HTB, NXCD = 8, WGM = 8;
__host__ __device__ __forceinline__ int lds_byte(int r, int c) { const int st = (r >> 4) * 2 + (c >> 5), rr = r & 15, cc = c & 31, ob = rr * 64 + cc * 2; return st * 1024 + (ob ^ (((ob >> 9) & 1) << 5)); }
__host__ __device__ __forceinline__ int perm32(int rho) { const int n = rho >> 4, i = rho & 15; return 8 * (i >> 2) + 4 * n + (i & 3); }
__host__ __device__ __forceinline__ void stage_rc(int b, int& R, int& C) { const int st = b / 1024, sb = b % 1024, swz = sb ^ (((sb >> 9) & 1) << 5); R = (st >> 1) * 16 + swz / 64; C = (st & 1) * 32 + (swz % 64) / 2; }
struct Unit { int pm, pn, k0; };
struct Gemm { const bf16_t* A; const bf16_t* Bt; int M, N, K, nt; };
struct StaticOrder {
    int nM, nN, nwg, G, c, pm0;
    __host__ __device__ void init(int M, int N, int G_, int c_, int pm0_ = 0) { nM = M / BM; nN = N / BM; nwg = nM * nN; G = G_; c = c_; pm0 = pm0_; }
    __host__ __device__ bool next(int i, Unit& u) const {
        const long Lx = (long)i * G + c; if (Lx >= nwg) return false;
        int wgid = (int)Lx; { const int q = nwg / NXCD, r = nwg % NXCD, xcd = wgid % NXCD, off = wgid / NXCD; wgid = (xcd < r ? xcd * (q + 1) : r * (q + 1) + (xcd - r) * q) + off; }
        const int nig = WGM * nN, gid = wgid / nig, fm = gid * WGM, gsz = (nM - fm) < WGM ? (nM - fm) : WGM;
        u.pm = pm0 + fm + ((wgid % nig) % gsz); u.pn = (wgid % nig) / gsz; u.k0 = 0; return true;
    }
};
struct SplitOrder {
    int nN, nunits, G, c, nt;
    __host__ __device__ void init(int N, int K, int nt_, int G_, int c_) { nN = N / BM; nt = nt_; nunits = nN * (K / BK / nt_); G = G_; c = c_; }
    __host__ __device__ bool next(int i, Unit& u) const {
        const int idx = i * G + c; if (idx >= nunits) return false;
        u.pm = 0; u.pn = idx % nN; u.k0 = (idx / nN) * nt; return true;
    }
};
template <class Epi, class Ord>
__device__ __forceinline__ void gemm_phase(LAS unsigned char* lds, const Gemm g, const Ord& S, const Epi& E) {
#ifdef NO_GEMM
    return;
#endif
    const int tid = otid(), wid = __builtin_amdgcn_readfirstlane(tid >> 6), lane = tid & 63, wr = wid >> 2, wc = wid & 3, fr = lane & 15, fq = lane >> 4;
    const int K = g.K, nt = g.nt;
    unsigned voffA[2], voffB[2];
#pragma unroll
    for (int i = 0; i < 2; ++i) { int R, C; stage_rc(tid * 16 + i * 8192, R, C); const int Rb = (R & ~31) + perm32(R & 31);
        voffA[i] = (unsigned)(R * K + C) * 2u; voffB[i] = (unsigned)(Rb * K + C) * 2u; }
    const size_t kstep = (size_t)(BK * 2);
    const size_t hstep = (size_t)HALF * K * 2;
    const size_t tstep = 2 * hstep;
    const unsigned ldsw = (unsigned)wid * 1024u;
    const int aoff = lds_byte(wr * 64 + fr, fq * 8), boff = lds_byte(wc * 32 + fr, fq * 8);
#define PG8_SA(b, h) (((b) * 2 + (h)) * HTB)
#define PG8_SB(b, h) ((4 + (b) * 2 + (h)) * HTB)
#define PG8_STAGE(bufoff, gbase, voff) do { _Pragma("unroll") for (int _i = 0; _i < 2; ++_i) \
        __builtin_amdgcn_global_load_lds((const unsigned*)((const char*)(gbase) + (voff)[_i]), (LAS unsigned*)(lds + (bufoff) + ldsw + _i * 8192), 16, 0, 0); } while (0)
#define PG8_LDA(dst, b, h) do { _Pragma("unroll") for (int m = 0; m < 4; ++m) _Pragma("unroll") for (int k = 0; k < 2; ++k) dst[m][k] = *(const LAS bf16x8*)(lds + PG8_SA(b, h) + aoff + m * 2048 + k * 1024); } while (0)
#define PG8_LDB(dst, b, h) do { _Pragma("unroll") for (int n = 0; n < 2; ++n) _Pragma("unroll") for (int k = 0; k < 2; ++k) dst[n][k] = *(const LAS bf16x8*)(lds + PG8_SB(b, h) + boff + n * 2048 + k * 1024); } while (0)
#define PG8_MMA(ai, bj, At, Bt) do { __builtin_amdgcn_s_setprio(1); _Pragma("unroll") for (int m = 0; m < 4; ++m) _Pragma("unroll") for (int n = 0; n < 2; ++n) _Pragma("unroll") for (int k = 0; k < 2; ++k) \
        acc[ai][bj][m][n] = __builtin_amdgcn_mfma_f32_16x16x32_bf16(Bt[n][k], At[m][k], acc[ai][bj][m][n], 0, 0, 0); __builtin_amdgcn_s_setprio(0); } while (0)
#define PG8_WAIT_V(n) asm volatile("s_waitcnt vmcnt(" #n ")" ::: "memory")
#define PG8_WAIT_L(n) asm volatile("s_waitcnt lgkmcnt(" #n ")" ::: "memory")
#define PG8_BAR __builtin_amdgcn_s_barrier()
#define PG8_SCHED __builtin_amdgcn_sched_barrier(0)
    Unit cur, nxt; int ui = 0;
    if (!S.next(0, cur)) return;
    f32x4 acc[2][2][4][2];
#pragma unroll
    for (int a = 0; a < 2; ++a)
#pragma unroll
        for (int b = 0; b < 2; ++b)
#pragma unroll
            for (int m = 0; m < 4; ++m)
#pragma unroll
                for (int n = 0; n < 2; ++n) acc[a][b][m][n] = (f32x4){0.f, 0.f, 0.f, 0.f};
    bf16x8 At[4][2], B0[2][2], B1[2][2];
    const size_t kstep0 = (size_t)(BK * 2);
    const char* cA = (const char*)g.A + (size_t)cur.pm * tstep + (size_t)cur.k0 * kstep0; const char* cB = (const char*)g.Bt + (size_t)cur.pn * tstep + (size_t)cur.k0 * kstep0;
    PG8_STAGE(PG8_SB(0, 0), cB, voffB); PG8_STAGE(PG8_SA(0, 0), cA, voffA); PG8_STAGE(PG8_SB(0, 1), cB + hstep, voffB); PG8_STAGE(PG8_SA(0, 1), cA + hstep, voffA);
    if (wr == 1) PG8_BAR;
    PG8_WAIT_V(4); PG8_BAR;
    PG8_STAGE(PG8_SB(1, 0), cB + kstep, voffB); PG8_STAGE(PG8_SA(1, 0), cA + kstep, voffA); PG8_STAGE(PG8_SB(1, 1), cB + hstep + kstep, voffB);
    PG8_WAIT_V(6); PG8_BAR;
    for (;;) {
        const bool has_next = S.next(ui + 1, nxt);
        const char* nA = has_next ? (const char*)g.A + (size_t)nxt.pm * tstep + (size_t)nxt.k0 * kstep0 : cA; const char* nB = has_next ? (const char*)g.Bt + (size_t)nxt.pn * tstep + (size_t)nxt.k0 * kstep0 : cB;
        for (int t = 0; t < nt; t += 2) {
            const bool last = (t == nt - 2);
            const char* a1 = cA + (size_t)(t + 1) * kstep;
            const char* a2 = last ? nA : cA + (size_t)(t + 2) * kstep; const char* b2 = last ? nB : cB + (size_t)(t + 2) * kstep;
            const char* a3 = a2 + kstep; const char* b3 = b2 + kstep;
            PG8_LDB(B0, 0, 0); PG8_SCHED; PG8_LDA(At, 0, 0); PG8_STAGE(PG8_SA(1, 1), a1 + hstep, voffA);
            PG8_WAIT_L(8); PG8_BAR; PG8_WAIT_L(0); PG8_MMA(0, 0, At, B0); PG8_BAR; PG8_SCHED;
            PG8_LDB(B1, 0, 1); PG8_STAGE(PG8_SB(0, 0), b2, voffB);
            PG8_BAR; PG8_WAIT_L(0); PG8_MMA(0, 1, At, B1); PG8_BAR;
            PG8_LDA(At, 0, 1); PG8_STAGE(PG8_SA(0, 0), a2, voffA);
            PG8_BAR; PG8_WAIT_L(0); PG8_MMA(1, 0, At, B0); PG8_BAR; PG8_SCHED;
            PG8_STAGE(PG8_SB(0, 1), b2 + hstep, voffB);
            PG8_WAIT_V(6); PG8_BAR; PG8_MMA(1, 1, At, B1); PG8_BAR;
            PG8_LDB(B0, 1, 0); PG8_SCHED; PG8_LDA(At, 1, 0); PG8_STAGE(PG8_SA(0, 1), a2 + hstep, voffA);
            PG8_WAIT_L(8); PG8_BAR; PG8_WAIT_L(0); PG8_MMA(0, 0, At, B0); PG8_BAR; PG8_SCHED;
            PG8_LDB(B1, 1, 1); PG8_STAGE(PG8_SB(1, 0), b3, voffB);
            PG8_BAR; PG8_WAIT_L(0); PG8_MMA(0, 1, At, B1); PG8_BAR;
            PG8_LDA(At, 1, 1); PG8_STAGE(PG8_SA(1, 0), a3, voffA);
            PG8_BAR; PG8_WAIT_L(0); PG8_MMA(1, 0, At, B0); PG8_BAR; PG8_SCHED;
            PG8_STAGE(PG8_SB(1, 1), b3 + hstep, voffB);
            PG8_WAIT_V(6); PG8_BAR; PG8_MMA(1, 1, At, B1); PG8_BAR;
        }
        E(acc, cur, wr, wc, fr, fq);
        if (!has_next) break;
#pragma unroll
        for (int a = 0; a < 2; ++a)
#pragma unroll
            for (int b = 0; b < 2; ++b)
#pragma unroll
                for (int m = 0; m < 4; ++m)
#pragma unroll
                    for (int n = 0; n < 2; ++n) acc[a][b][m][n] = (f32x4){0.f, 0.f, 0.f, 0.f};
        cur = nxt; cA = nA; cB = nB; ++ui;
    }
    PG8_WAIT_V(0);
    if (wr == 0) PG8_BAR;
    PG8_BAR;
#undef PG8_SA
#undef PG8_SB
#undef PG8_STAGE
#undef PG8_LDA
#undef PG8_LDB
#undef PG8_MMA
#undef PG8_WAIT_V
#undef PG8_WAIT_L
#undef PG8_BAR
#undef PG8_SCHED
}
}
using pg8::Unit;

#define EPI_LOOP_ROWS for (int ai = 0; ai < 2; ++ai) for (int m = 0; m < 4; ++m)
#define EPI_LOOP_COLS for (int bj = 0; bj < 2; ++bj) for (int n = 0; n < 2; ++n)
struct EpiInMain {
    bf16_t* R; bf16_t* PG;
    __device__ __forceinline__ void operator()(const f32x4 (&acc)[2][2][4][2], const Unit& u, int wr, int wc, int fr, int fq) const {
        bf16_t* dst; int ld, c0;
        if (u.pn < 8) { dst = R; ld = R_LD; c0 = u.pn * 256; } else { dst = PG; ld = PG_LD; c0 = (u.pn - 8) * 256; }
        const int row0 = u.pm * 256 + wr * 64 + fr, col0 = c0 + wc * 32 + 8 * fq;
#pragma unroll
        EPI_LOOP_ROWS { bf16_t* rowp = dst + (size_t)(row0 + ai * 128 + m * 16) * ld + col0;
#pragma unroll
            EPI_LOOP_COLS { const f32x4 v = acc[ai][bj][m][n]; *(u32x2*)(rowp + bj * 128 + n * 4) = (u32x2){pk2(v[0], v[1]), pk2(v[2], v[3])}; } }
    }
};
struct EpiGates {
    bf16_t* G;
    __device__ __forceinline__ void operator()(const f32x4 (&acc)[2][2][4][2], const Unit& u, int wr, int wc, int fr, int fq) const {
        const int row0 = u.pm * 256 + wr * 64 + fr, col0 = u.pn * 256 + wc * 32 + 8 * fq;
#pragma unroll
        EPI_LOOP_ROWS { bf16_t* rowp = G + (size_t)(row0 + ai * 128 + m * 16) * 3072 + col0;
#pragma unroll
            EPI_LOOP_COLS { const f32x4 v = acc[ai][bj][m][n];
                *(u32x2*)(rowp + bj * 128 + n * 4) = (u32x2){pk2(sigmoid_(v[0]), sigmoid_(v[1])), pk2(sigmoid_(v[2]), sigmoid_(v[3]))}; } }
    }
};
template <int GI> struct EpiBranch {
    const bf16_t* G; float* MG; bf16_t* MB;
    __device__ __forceinline__ void operator()(const f32x4 (&acc)[2][2][4][2], const Unit& u, int wr, int wc, int fr, int fq) const {
        const int row0 = u.pm * 256 + wr * 64 + fr, col0 = u.pn * 256 + wc * 32 + 8 * fq;
#pragma unroll
        EPI_LOOP_ROWS { const size_t row = (size_t)(row0 + ai * 128 + m * 16);
#pragma unroll
            EPI_LOOP_COLS { const int col = col0 + bj * 128 + n * 4; const f32x4 v = acc[ai][bj][m][n];
                const u32x2 gq = *(const u32x2*)(G + row * 3072 + GI * 1024 + col);
                f32x4 gv = (f32x4){__uint_as_float(gq[0] << 16), __uint_as_float(gq[0] & 0xffff0000u), __uint_as_float(gq[1] << 16), __uint_as_float(gq[1] & 0xffff0000u)};
                f32x4 r = v * gv;
                if (GI > 0) { const u32x2 mq = *(const u32x2*)(MB + row * 1024 + col);
                    r += (f32x4){__uint_as_float(mq[0] << 16), __uint_as_float(mq[0] & 0xffff0000u), __uint_as_float(mq[1] << 16), __uint_as_float(mq[1] & 0xffff0000u)}; }
                *(u32x2*)(MB + row * 1024 + col) = (u32x2){pk2(r[0], r[1]), pk2(r[2], r[3])}; } }
    }
};
struct EpiResid {
    float* H; const float* gate_lat; const float* gate_ctx;
    __device__ __forceinline__ void operator()(const f32x4 (&acc)[2][2][4][2], const Unit& u, int wr, int wc, int fr, int fq) const {
        const int row0 = u.pm * 256 + wr * 64 + fr, col0 = u.pn * 256 + wc * 32 + 8 * fq;
        const float* gp = (u.pm == 0) ? gate_ctx : gate_lat;
        f32x4 gv[2][2];
#pragma unroll
        EPI_LOOP_COLS gv[bj][n] = *(const f32x4*)(gp + col0 + bj * 128 + n * 4);
#pragma unroll
        EPI_LOOP_ROWS { float* rowp = H + (size_t)(row0 + ai * 128 + m * 16) * 1024 + col0;
#pragma unroll
            EPI_LOOP_COLS { f32x4* q = (f32x4*)(rowp + bj * 128 + n * 4); *q = *q + acc[ai][bj][m][n] * gv[bj][n]; } }
    }
};
struct EpiLora {
    bf16_t* B; bf16_t* RWG; const float* w0; const float* a0;
    __device__ __forceinline__ void operator()(const f32x4 (&acc)[2][2][4][2], const Unit& u, int wr, int wc, int fr, int fq) const {
        const int row0 = u.pm * 256 + wr * 64 + fr, blk = u.pn >> 1, cbase = (u.pn & 1) * 256 + wc * 32 + 8 * fq;
        f32x4 bv[2][2];
#pragma unroll
        EPI_LOOP_COLS { const int cc = cbase + bj * 128 + n * 4;
            bv[bj][n] = blk < 2 ? *(const f32x4*)(w0 + blk * 512 + cc) : (blk < 4 ? *(const f32x4*)(a0 + (blk - 2) * 512 + cc) : (f32x4){0.f, 0.f, 0.f, 0.f}); }
        bf16_t* dst; int ld;
        if (blk < 2) { dst = B + 3072 + blk * 512; ld = 4096; } else if (blk < 4) { dst = B + 2048 + (blk - 2) * 512; ld = 4096; } else { dst = RWG; ld = 512; }
#pragma unroll
        EPI_LOOP_ROWS { bf16_t* rowp = dst + (size_t)(row0 + ai * 128 + m * 16) * ld + cbase;
#pragma unroll
            EPI_LOOP_COLS { f32x4 v = acc[ai][bj][m][n] + bv[bj][n];
                if (blk < 2) {
#pragma unroll
                    for (int j = 0; j < 4; ++j) v[j] = 1.f - __expf(-0.60653066f * sigmoid_(v[j]));
                } else if (blk < 4) {
#pragma unroll
                    for (int j = 0; j < 4; ++j) v[j] = sigmoid_(v[j]);
                }
                *(u32x2*)(rowp + bj * 128 + n * 4) = (u32x2){pk2(v[0], v[1]), pk2(v[2], v[3])}; } }
    }
};
struct EpiResidAtomic {
    float* H; const float* gate_ctx;
    __device__ __forceinline__ void operator()(const f32x4 (&acc)[2][2][4][2], const Unit& u, int wr, int wc, int fr, int fq) const {
        const int row0 = u.pm * 256 + wr * 64 + fr, col0 = u.pn * 256 + wc * 32 + 8 * fq;
        const float* gp = gate_ctx + col0;
#pragma unroll
        EPI_LOOP_ROWS { float* rowp = H + (size_t)(row0 + ai * 128 + m * 16) * 1024 + col0;
#pragma unroll
            EPI_LOOP_COLS { const f32x4 v = acc[ai][bj][m][n] * *(const f32x4*)(gp + bj * 128 + n * 4); float* q = rowp + bj * 128 + n * 4;
                unsafeAtomicAdd(q, v[0]); unsafeAtomicAdd(q + 1, v[1]); unsafeAtomicAdd(q + 2, v[2]); unsafeAtomicAdd(q + 3, v[3]); }
            asm volatile("" ::: "memory"); }
    }
};
struct EpiMlp1 {
    bf16_t* U;
    __device__ __forceinline__ void operator()(const f32x4 (&acc)[2][2][4][2], const Unit& u, int wr, int wc, int fr, int fq) const {
        const int row0 = u.pm * 256 + wr * 64 + fr, col0 = u.pn * 256 + wc * 32 + 8 * fq;
#pragma unroll
        EPI_LOOP_ROWS { bf16_t* rowp = U + (size_t)(row0 + ai * 128 + m * 16) * 4096 + col0;
#pragma unroll
            EPI_LOOP_COLS { f32x4 v = acc[ai][bj][m][n];
#pragma unroll
                for (int j = 0; j < 4; ++j) { const float t = fmaxf(v[j], 0.f); v[j] = t * t; }
                *(u32x2*)(rowp + bj * 128 + n * 4) = (u32x2){pk2(v[0], v[1]), pk2(v[2], v[3])}; } }
    }
};

__device__ __forceinline__ void convert_T(const float* src, int ld, int K, int n0, int ncols, bf16_t* dst, LAS float* tile, int wg, int nwg) {
    const int ntn = (ncols + 63) >> 6, ntk = K >> 6, tid = otid();
    for (int t = wg; t < ntn * ntk; t += nwg) {
        const int tn = t / ntk, tk = t - tn * ntk, k0 = tk * 64, nb = tn * 64;
#pragma unroll
        for (int i = 0; i < 2; ++i) { const int idx = tid + i * 512, kk = idx >> 4, n4 = (idx & 15) * 4;
            f32x4 v = (f32x4){0.f, 0.f, 0.f, 0.f};
            if (nb + n4 < ncols) v = *(const f32x4*)(src + (size_t)(k0 + kk) * ld + n0 + nb + n4);
            tile[kk * 65 + n4 + 0] = v[0]; tile[kk * 65 + n4 + 1] = v[1]; tile[kk * 65 + n4 + 2] = v[2]; tile[kk * 65 + n4 + 3] = v[3]; }
        __syncthreads();
        { const int nn = tid >> 3, k8 = (tid & 7) * 8;
          if (nb + nn < ncols) { const LAS float* s = tile + k8 * 65 + nn;
              u32x4 o; o[0] = pk2(s[0], s[65]); o[1] = pk2(s[130], s[195]); o[2] = pk2(s[260], s[325]); o[3] = pk2(s[390], s[455]);
              *(u32x4*)(dst + (size_t)(nb + nn) * K + k0 + k8) = o; } }
        __syncthreads();
    }
}

__device__ __forceinline__ void phase_mod(const P& p, LAS unsigned char* lds) {
    const float* c = p.in[I_C]; const float* cc = p.in[I_CCTX]; const float* wm = p.in[I_WMOD]; const float* bm = p.in[I_BMOD];
    float* MOD = (float*)(p.ws + OFF_MOD);
    LAS float* red = (LAS float*)lds;
    const int tid = otid();
    for (int blk = blockIdx.x; blk < 256; blk += gridDim.x) {
        const int l = blk >> 6, col0 = (blk & 63) * 96;
        if (tid < 384) {
            const int cgp = tid % 24, ks = tid / 24;
            f32x4 a0 = (f32x4){0.f, 0.f, 0.f, 0.f}, a1 = a0;
            const float* w = wm + (size_t)l * 1024 * 6144 + col0 + cgp * 4;
#pragma unroll 8
            for (int k = ks * 64; k < ks * 64 + 64; ++k) {
                const f32x4 wv = *(const f32x4*)(w + (size_t)k * 6144);
                const float s0 = silu_(c[k]), s1 = silu_(cc[k]);
                a0 += wv * s0; a1 += wv * s1;
            }
            LAS f32x4* r4 = (LAS f32x4*)red;
            r4[(ks * 24 + cgp) * 2 + 0] = a0; r4[(ks * 24 + cgp) * 2 + 1] = a1;
        }
        __syncthreads();
        if (tid < 192) {
            const int col = tid % 96, s = tid / 96;
            float sum = 0.f;
#pragma unroll
            for (int k2 = 0; k2 < 16; ++k2) sum += red[((k2 * 24 + (col >> 2)) * 2 + s) * 4 + (col & 3)];
            MOD[((size_t)l * 2 + s) * 6144 + col0 + col] = sum + bm[l * 6144 + col0 + col];
        }
        __syncthreads();
    }
}

template <bool FROM_INPUT>
__device__ __forceinline__ void phase_norm(const P& p, int l, const float* gamma, int shift_idx, int scale_idx) {
    float* H = (float*)(p.ws + OFF_H); bf16_t* HN = (bf16_t*)(p.ws + OFF_HN);
    const float* MOD = (const float*)(p.ws + OFF_MOD) + (size_t)l * 2 * 6144;
    const int tid_ = otid(); const int wave = tid_ >> 6, lane = tid_ & 63;
    for (int row = blockIdx.x * 8 + wave; row < L; row += gridDim.x * 8) {
        const float* src = FROM_INPUT ? (row < NCTX ? p.in[I_CTX] + (size_t)row * 1024 : p.in[I_X] + (size_t)(row - NCTX) * 1024) : H + (size_t)row * 1024;
        f32x4 v[4]; float ss = 0.f;
#pragma unroll
        for (int j = 0; j < 4; ++j) { v[j] = *(const f32x4*)(src + j * 256 + lane * 4); ss += (v[j][0] * v[j][0] + v[j][1] * v[j][1]) + (v[j][2] * v[j][2] + v[j][3] * v[j][3]); }
        ss = wave_sum(ss);
        const float rstd = rsqrtf(ss * (1.f / 1024.f) + 1e-6f);
        const float* m = MOD + (row < NCTX ? 6144 : 0);
#pragma unroll
        for (int j = 0; j < 4; ++j) { const int col = j * 256 + lane * 4;
            const f32x4 g = *(const f32x4*)(gamma + col), sh = *(const f32x4*)(m + shift_idx * 1024 + col), sc = *(const f32x4*)(m + scale_idx * 1024 + col);
            const f32x4 o = v[j] * rstd * g * (sc + 1.f) + sh;
            *(u32x2*)(HN + (size_t)row * 1024 + col) = (u32x2){pk2(o[0], o[1]), pk2(o[2], o[3])};
            if (FROM_INPUT) *(f32x4*)(H + (size_t)row * 1024 + col) = v[j]; }
    }
}

constexpr int TT = 13;
__device__ __forceinline__ void phase_prep(const P& p, int l, LAS unsigned char* lds) {
    const bf16_t* R = (const bf16_t*)(p.ws + OFF_R); const bf16_t* PG = (const bf16_t*)(p.ws + OFF_PG);
    bf16_t* B = (bf16_t*)(p.ws + OFF_B); bf16_t* XL = (bf16_t*)(p.ws + OFF_XL);
    bf16_t* GLAD = (bf16_t*)(p.ws + OFF_GLAD); bf16_t* GDNC = (bf16_t*)(p.ws + OFF_GDNC); float* GDNGB = (float*)(p.ws + OFF_GDNGB);
    const float* mu = p.in[I_RWMU] + (size_t)l * 2 * 1920;
    const float* kkw = p.in[I_RWKK] + l * 512;
    const float* ga2 = p.in[I_GLAA2] + (size_t)l * 2 * 16 * 256; const float* gab = p.in[I_GLAAB] + l * 512;
    const float* cw = p.in[I_GDNCONV] + (size_t)l * 5 * 1536; const float* alog = p.in[I_GDNALOG] + l * 8; const float* dtb = p.in[I_GDNDT] + l * 8;
    LAS float* gal = (LAS float*)lds;
    LAS float* red = gal + TT * 32;
    const int tid = otid(), wave = tid >> 6;
    const int c = tid;
    const int gz = tid >> 8, gk = tid & 255;
    for (int tile = blockIdx.x; tile < L / TT; tile += gridDim.x) {
        const int t0 = tile * TT;
        if (tid < TT * 32) { const int tt = tid >> 5, e = tid & 31; gal[tt * 32 + e] = bf2f(PG[(size_t)(t0 + tt) * PG_LD + GLA_AL + e]); }
        {
            float xr[TT + 2], xk[TT + 2], xv[TT + 2], xe[TT + 2];
#pragma unroll
            for (int i = 0; i < TT + 2; ++i) { const int rr = t0 - 1 + i;
                if (rr >= 0 && rr < L) { const bf16_t* rp = R + (size_t)rr * R_LD + c; xr[i] = bf2f(rp[0]); xk[i] = bf2f(rp[512]); xv[i] = bf2f(rp[1024]); xe[i] = (c < 384) ? bf2f(rp[1536]) : 0.f; }
                else { xr[i] = 0.f; xk[i] = 0.f; xv[i] = 0.f; xe[i] = 0.f; } }
            const float mr0 = mu[c], mr1 = mu[1920 + c], mk0 = mu[512 + c], mk1 = mu[1920 + 512 + c], mv0 = mu[1024 + c], mv1 = mu[1920 + 1024 + c];
            const float me0 = (c < 384) ? mu[1536 + c] : 0.f, me1 = (c < 384) ? mu[1920 + 1536 + c] : 0.f;
            const float kkc = kkw[c];
#pragma unroll
            for (int tt = 0; tt < TT; ++tt) {
                const int t = t0 + tt;
                const float hp = (t != 0 && t != NCTX) ? 1.f : 0.f, hn = (t != NCTX - 1 && t != L - 1) ? 1.f : 0.f;
                const float r = mr0 * hp * xr[tt] + (1.f - mr0 - mr1) * xr[tt + 1] + mr1 * hn * xr[tt + 2];
                const float k = mk0 * hp * xk[tt] + (1.f - mk0 - mk1) * xk[tt + 1] + mk1 * hn * xk[tt + 2];
                const float v = mv0 * hp * xv[tt] + (1.f - mv0 - mv1) * xv[tt + 1] + mv1 * hn * xv[tt + 2];
                float e = me0 * hp * xe[tt] + (1.f - me0 - me1) * xe[tt + 1] + me1 * hn * xe[tt + 2];
                if (c < 128) e = 2.f * sigmoid_(2.f * e) - 1.f; else if (c >= 256 && c < 384) e = sigmoid_(e); else if (c >= 384) e = 0.f;
                const float kr = k * kkc;
                const float ssq = wave_sum(kr * kr);
                bf16_t* bp = B + (size_t)t * 4096 + c;
                bp[0] = f2bf(r); bp[512] = f2bf(k); bp[1024] = f2bf(v); bp[1536] = f2bf(kr * rsqrtf(ssq + 1e-12f));
                if (c < 384) XL[(size_t)t * 384 + c] = f2bf(e);
            }
        }
        __syncthreads();
        {
        float ga2v[16];
#pragma unroll
        for (int e = 0; e < 16; ++e) ga2v[e] = ga2[(gz * 16 + e) * 256 + gk];
        const float gabv = gab[gz * 256 + gk];
#pragma unroll
        for (int tt = 0; tt < TT; ++tt) {
            float zv = gabv;
#pragma unroll
            for (int e = 0; e < 16; ++e) zv += gal[tt * 32 + gz * 16 + e] * ga2v[e];
            const float la = __logf(sigmoid_(zv)) * (1.f / 16.f);
            GLAD[(size_t)(t0 + tt) * 512 + tid] = f2bf(1.f - __expf(la));
        }
        }
        {
            float cwv[5], xv[TT + 4];
#pragma unroll
            for (int i = 0; i < 5; ++i) cwv[i] = cw[i * 1536 + 1024 + c];
#pragma unroll
            for (int i = 0; i < TT + 4; ++i) { const int rr = t0 - 2 + i; xv[i] = (rr >= 0 && rr < L) ? bf2f(PG[(size_t)rr * PG_LD + GDN_QKV + 1024 + c]) : 0.f; }
#pragma unroll
            for (int tt = 0; tt < TT; ++tt) { const int t = t0 + tt; float sv = 0.f;
#pragma unroll
                for (int i = 0; i < 5; ++i) { const int rr = t + i - 2; const bool ok_ = (rr >= 0) && (rr < L) && ((rr < NCTX) == (t < NCTX)); if (ok_) sv += xv[tt + i] * cwv[i]; }
                GDNC[(size_t)t * 1536 + 1024 + c] = f2bf(silu_(sv)); }
        }
        float oq[TT], ok[TT];
        {
            float cwq[5], cwk[5], xq[TT + 4], xk[TT + 4];
#pragma unroll
            for (int i = 0; i < 5; ++i) { cwq[i] = cw[i * 1536 + c]; cwk[i] = cw[i * 1536 + 512 + c]; }
#pragma unroll
            for (int i = 0; i < TT + 4; ++i) { const int rr = t0 - 2 + i;
                if (rr >= 0 && rr < L) { const bf16_t* rp = PG + (size_t)rr * PG_LD + GDN_QKV + c; xq[i] = bf2f(rp[0]); xk[i] = bf2f(rp[512]); } else { xq[i] = 0.f; xk[i] = 0.f; } }
#pragma unroll
            for (int tt = 0; tt < TT; ++tt) {
                const int t = t0 + tt; float sq = 0.f, sk = 0.f;
#pragma unroll
                for (int i = 0; i < 5; ++i) { const int rr = t + i - 2; const bool ok_ = (rr >= 0) && (rr < L) && ((rr < NCTX) == (t < NCTX));
                    if (ok_) { sq += xq[tt + i] * cwq[i]; sk += xk[tt + i] * cwk[i]; } }
                oq[tt] = silu_(sq); ok[tt] = silu_(sk);
                const float pq = wave_sum(oq[tt] * oq[tt]), pk = wave_sum(ok[tt] * ok[tt]);
                if ((tid & 63) == 0) { red[(tt * 8 + wave) * 2 + 0] = pq; red[(tt * 8 + wave) * 2 + 1] = pk; }
            }
        }
        __syncthreads();
#pragma unroll
        for (int tt = 0; tt < TT; ++tt) {
            const int w0i = (wave >> 1) * 2;
            const float ssq = red[(tt * 8 + w0i) * 2 + 0] + red[(tt * 8 + w0i + 1) * 2 + 0], ssk = red[(tt * 8 + w0i) * 2 + 1] + red[(tt * 8 + w0i + 1) * 2 + 1];
            bf16_t* gp = GDNC + (size_t)(t0 + tt) * 1536 + c;
            gp[0] = f2bf(oq[tt] * rsqrtf(ssq + 1e-12f) * 0.08838834764831845f); gp[512] = f2bf(ok[tt] * rsqrtf(ssk + 1e-12f));
        }
        if (tid < TT * 16) { const int tt = tid >> 4, j = tid & 15, t = t0 + tt;
            float o;
            if (j < 8) { const float a = bf2f(PG[(size_t)t * PG_LD + GDN_A + j]); o = __expf(-__expf(alog[j]) * softplus_(a + dtb[j])); }
            else o = sigmoid_(bf2f(PG[(size_t)t * PG_LD + GDN_B + (j - 8)]));
            GDNGB[t * 16 + j] = o; }
        __syncthreads();
    }
}
__device__ __forceinline__ void build_wl(const P& p, int l, int wg, int nwg) {
    const float* w2 = p.in[I_RWW2] + (size_t)l * 2 * 64 * 512; const float* a2 = p.in[I_RWA2] + (size_t)l * 2 * 64 * 512; const float* g2 = p.in[I_RWG2] + (size_t)l * 128 * 512;
    bf16_t* WL = (bf16_t*)(p.ws + OFF_WL);
    const int tid = otid();
    for (int it = wg * 512 + tid; it < 2560 * 48; it += nwg * 512) {
        const int kc = it / 2560, n = it - kc * 2560, k0 = kc * 8, blk = n >> 9, cc = n & 511;
        const float* src = nullptr; int kb = 0, kn = 0;
        if (blk == 0) { src = w2; kb = 0; kn = 64; } else if (blk == 1) { src = w2 + 64 * 512; kb = 64; kn = 64; }
        else if (blk == 2) { src = a2; kb = 128; kn = 64; } else if (blk == 3) { src = a2 + 64 * 512; kb = 192; kn = 64; }
        else { src = g2; kb = 256; kn = 128; }
        float v[8];
#pragma unroll
        for (int j = 0; j < 8; ++j) { const int k = k0 + j - kb; v[j] = (k >= 0 && k < kn) ? src[(size_t)k * 512 + cc] : 0.f; }
        u32x4 o; o[0] = pk2(v[0], v[1]); o[1] = pk2(v[2], v[3]); o[2] = pk2(v[4], v[5]); o[3] = pk2(v[6], v[7]);
        *(u32x4*)(WL + (size_t)n * 384 + k0) = o;
    }
}

constexpr int TB = 32, NBLK = L / TB;
__device__ __forceinline__ int tok_seq(int z, int j) { return z == 0 ? j : (j < NCTX ? NCTX - 1 - j : L - 1 - (j - NCTX)); }
__device__ __forceinline__ int tok_gla(int z, int j) {
    if (j < NCTX) return z == 0 ? j : NCTX - 1 - j;
    const int jj = j - NCTX, pp = z == 0 ? jj : NLAT - 1 - jj;
    return NCTX + (pp & 255) * 64 + (pp >> 8);
}

template <int NCW> struct ScanRole {
    bool cons, prod; int ct;
    __device__ __forceinline__ ScanRole(int tid) {
        const int w = tid >> 6, lane = tid & 63;
        if (NCW == 4) { cons = w < 4; prod = !cons; ct = tid & 255; }
        else { cons = w < 2; prod = (w & 2) != 0; ct = cons ? tid : ((((w >> 2) << 1) | (w & 1)) * 64 + lane); }
    }
};
__device__ __forceinline__ float rowpair_sum(float x) {
    const unsigned u = __float_as_uint(x); auto r = __builtin_amdgcn_permlane16_swap(u, u, false, false);
    return __uint_as_float(r[0]) + __uint_as_float(r[1]);
}
#define SCAN_BARRIER() asm volatile("s_waitcnt lgkmcnt(0)\n\ts_barrier" ::: "memory")
__device__ __forceinline__ float bfraw2f(unsigned short b) { return __uint_as_float(((unsigned)b) << 16); }
__device__ __forceinline__ f32x4 bf4(u32x2 r) { return (f32x4){__uint_as_float(r[0] << 16), __uint_as_float(r[0] & 0xffff0000u), __uint_as_float(r[1] << 16), __uint_as_float(r[1] & 0xffff0000u)}; }

__device__ __forceinline__ void scan_rwkv(const P& p, int l, int unit, LAS unsigned char* lds) {
    const int z = unit >> 5, h = (unit >> 2) & 7, rq = unit & 3;
    const bf16_t* B = (const bf16_t*)(p.ws + OFF_B); bf16_t* Y = (bf16_t*)(p.ws + OFF_PG) + YRW_COL + z * 512 + h * 64 + rq * 16;
    const float* kaw = p.in[I_RWKA] + l * 512 + h * 64;
    LAS float* vec = (LAS float*)lds;
    LAS float* vv = vec + 2 * TB * 320;
    LAS float* yo = vv + 2 * TB * 16;
    const int tid = otid(); const ScanRole<4> role(tid); const int ct = role.ct; const bool prod = role.prod, cons = role.cons;
    u32x2 pr[2], pk[2], pkk[2], pa[2], pw[2]; unsigned short pv[2];
    const f32x4 kac4 = *(const f32x4*)(kaw + (ct & 15) * 4);
    auto p_load = [&](int blk) {
#pragma unroll
        for (int i = 0; i < 2; ++i) { const int idx = ct + i * 256, s = idx >> 4, n4 = idx & 15; const int t = tok_seq(z, blk * TB + s);
            const bf16_t* bp = B + (size_t)t * 4096 + h * 64 + n4 * 4;
            pr[i] = *(const u32x2*)(bp); pk[i] = *(const u32x2*)(bp + 512); pkk[i] = *(const u32x2*)(bp + 1536); pa[i] = *(const u32x2*)(bp + 2048 + z * 512); pw[i] = *(const u32x2*)(bp + 3072 + z * 512); }
#pragma unroll
        for (int i = 0; i < 2; ++i) { const int idx = ct + i * 256, s = idx >> 4, r = idx & 15; const int t = tok_seq(z, blk * TB + s); pv[i] = B[(size_t)t * 4096 + 1024 + h * 64 + rq * 16 + r]; }
    };
    auto p_write = [&](int buf) {
#pragma unroll
        for (int i = 0; i < 2; ++i) { const int idx = ct + i * 256, s = idx >> 4, n4 = idx & 15;
            LAS float* d = vec + ((buf * TB + s) * 16 + n4) * 20;
            const f32x4 kk = bf4(pkk[i]), a = bf4(pa[i]);
            *(LAS f32x4*)(d) = kk; *(LAS f32x4*)(d + 4) = 1.f - bf4(pw[i]); *(LAS f32x4*)(d + 8) = kk * a;
            *(LAS f32x4*)(d + 12) = bf4(pk[i]) * ((a - 1.f) * kac4 + 1.f); *(LAS f32x4*)(d + 16) = bf4(pr[i]); }
#pragma unroll
        for (int i = 0; i < 2; ++i) vv[buf * TB * 16 + ct + i * 256] = bfraw2f(pv[i]);
    };
    auto p_yout = [&](int blk) {
        const int buf = blk & 1;
#pragma unroll
        for (int i = 0; i < 2; ++i) { const int idx = ct + i * 256, s = idx >> 4, r = idx & 15; const int t = tok_seq(z, blk * TB + s);
            const f32x4 y0 = *(const LAS f32x4*)(yo + (buf * TB * 16 + idx) * 8), y1 = *(const LAS f32x4*)(yo + (buf * TB * 16 + idx) * 8 + 4);
            Y[(size_t)t * PG_LD + r] = f2bf(((y0[0] + y0[1]) + (y0[2] + y0[3])) + ((y1[0] + y1[1]) + (y1[2] + y1[3]))); }
    };
    const int irow = (ct >> 4) & 15, ks = ct & 15;
    const LAS float* vbase = vec; const LAS float* vvb = vv; LAS float* yob = yo;
    f32x2 S0 = (f32x2){0.f, 0.f}, S1 = S0;
    struct Vx { f32x4 kk, w, b, k, r; float v; };
    auto c_ld = [&](Vx& x, int buf, int s) {
        const LAS float* d = vbase + s * 320;
        x.kk = *(const LAS f32x4*)(d); x.w = *(const LAS f32x4*)(d + 4); x.b = *(const LAS f32x4*)(d + 8); x.k = *(const LAS f32x4*)(d + 12);
        x.r = *(const LAS f32x4*)(d + 16); x.v = vvb[s * 16];
    };
    float sa = 0.f;
    auto c_step = [&](const Vx& x, const f32x4& kkn, int buf, int s) {
        const f32x2 vv2 = (f32x2){x.v, x.v};
        const f32x2 pre0 = S0 * (f32x2){x.w[0], x.w[1]} + vv2 * (f32x2){x.k[0], x.k[1]}, pre1 = S1 * (f32x2){x.w[2], x.w[3]} + vv2 * (f32x2){x.k[2], x.k[3]};
        const f32x2 nsa = (f32x2){-sa, -sa};
        S0 = nsa * (f32x2){x.b[0], x.b[1]} + pre0;
        S1 = nsa * (f32x2){x.b[2], x.b[3]} + pre1;
        const f32x2 y2 = S0 * (f32x2){x.r[0], x.r[1]} + S1 * (f32x2){x.r[2], x.r[3]};
        const f32x2 s2 = S0 * (f32x2){kkn[0], kkn[1]} + S1 * (f32x2){kkn[2], kkn[3]};
        float yp = y2[0] + y2[1], sp = s2[0] + s2[1];
        yp += dpp_<0xB1>(yp); sp += dpp_<0xB1>(sp); sp += dpp_<0x4E>(sp);
        sp += dpp_<0x141>(sp); sp += dpp_<0x140>(sp);
        sa = sp;
        yob[s * 128] = yp;
    };
    if (cons) __builtin_amdgcn_s_setprio(3);
    if (prod) { p_load(0); p_write(0); p_load(1); }
    SCAN_BARRIER();
    for (int b = 0; b < NBLK; ++b) {
        if (prod) {
            if (b + 1 < NBLK) p_write((b + 1) & 1);
            if (b + 2 < NBLK) p_load(b + 2);
            if (b > 0) p_yout(b - 1);
        } else if (cons) {
            const int buf = b & 1;
            vbase = vec + (buf * TB * 16 + ks) * 20; vvb = vv + buf * TB * 16 + irow; yob = yo + (buf * TB * 16 + irow) * 8 + (ks >> 1);
            Vx xa, xb;
            c_ld(xa, buf, 0);
            { const f32x2 s2 = S0 * (f32x2){xa.kk[0], xa.kk[1]} + S1 * (f32x2){xa.kk[2], xa.kk[3]}; sa = reduce16(s2[0] + s2[1]); }
#pragma unroll
            for (int s = 0; s < TB; s += 2) {
                c_ld(xb, buf, s + 1); c_step(xa, xb.kk, buf, s);
                c_ld(xa, buf, s + 2);
                c_step(xb, xa.kk, buf, s + 1);
            }
        }
        SCAN_BARRIER();
    }
    __builtin_amdgcn_s_setprio(0);
    if (prod) p_yout(NBLK - 1);
    SCAN_BARRIER();
}

__device__ __forceinline__ void scan_gla(const P& p, int l, int unit, LAS unsigned char* lds) {
    const int z = unit >> 4, h = (unit >> 2) & 3, cb = unit & 3;
    const bf16_t* PG = (const bf16_t*)(p.ws + OFF_PG); const bf16_t* GLAD = (const bf16_t*)(p.ws + OFF_GLAD);
    bf16_t* O = (bf16_t*)(p.ws + OFF_R) + z * 512 + h * 128 + cb * 32;
    LAS float* vec = (LAS float*)lds;
    LAS float* vv = vec + 2 * TB * 192;
    LAS float* yo = vv + 2 * TB * 32;
    const int tid = otid(); const ScanRole<4> role(tid); const int ct = role.ct; const bool prod = role.prod, cons = role.cons;
    unsigned short pq[8], pk[8], pa[8], pv[4];
    auto p_load = [&](int blk) {
#pragma unroll
        for (int i = 0; i < 8; ++i) { const int idx = ct + i * 256, s = idx >> 6, n = idx & 63; const int t = tok_gla(z, blk * TB + s);
            const bf16_t* bp = PG + (size_t)t * PG_LD + h * 64 + n;
            pq[i] = bp[GLA_Q]; pk[i] = bp[GLA_K]; pa[i] = GLAD[(size_t)t * 512 + z * 256 + h * 64 + n]; }
#pragma unroll
        for (int i = 0; i < 4; ++i) { const int idx = ct + i * 256, s = idx >> 5, r = idx & 31; const int t = tok_gla(z, blk * TB + s);
            pv[i] = PG[(size_t)t * PG_LD + GLA_V + h * 128 + cb * 32 + r]; }
    };
    auto p_write = [&](int buf) {
#pragma unroll
        for (int i = 0; i < 8; ++i) { const int idx = ct + i * 256, s = idx >> 6, n = idx & 63;
            LAS float* d = vec + ((buf * TB + s) * 8 + (n >> 3)) * 24 + (n & 7);
            d[0] = bfraw2f(pq[i]) * 0.125f; d[8] = bfraw2f(pk[i]); d[16] = 1.f - bfraw2f(pa[i]); }
#pragma unroll
        for (int i = 0; i < 4; ++i) vv[buf * TB * 32 + ct + i * 256] = bfraw2f(pv[i]);
    };
    auto p_yout = [&](int blk) {
        const int buf = blk & 1;
#pragma unroll
        for (int i = 0; i < 4; ++i) { const int idx = ct + i * 256, s = idx >> 5, r = idx & 31; const int t = tok_gla(z, blk * TB + s);
            const f32x4 y0 = *(const LAS f32x4*)(yo + (buf * TB * 32 + idx) * 4);
            O[(size_t)t * R_LD + r] = f2bf((y0[0] + y0[1]) + (y0[2] + y0[3])); }
    };
    const int icol = (ct >> 3) & 31, ks = ct & 7;
    const LAS float* vbase = vec; const LAS float* vvb = vv; LAS float* yob = yo;
    f32x2 S[4];
#pragma unroll
    for (int j = 0; j < 4; ++j) S[j] = (f32x2){0.f, 0.f};
    struct Vx { f32x4 q0, q1, k0, k1, a0, a1; float v; };
    auto c_ld = [&](Vx& x, int buf, int s) {
        const LAS float* d = vbase + s * 192;
        x.q0 = *(const LAS f32x4*)(d); x.q1 = *(const LAS f32x4*)(d + 4); x.k0 = *(const LAS f32x4*)(d + 8); x.k1 = *(const LAS f32x4*)(d + 12);
        x.a0 = *(const LAS f32x4*)(d + 16); x.a1 = *(const LAS f32x4*)(d + 20); x.v = vvb[s * 32];
    };
    auto c_upd = [&](const Vx& x) -> float {
        const f32x2 vv2 = (f32x2){x.v, x.v};
        S[0] = S[0] * (f32x2){x.a0[0], x.a0[1]} + vv2 * (f32x2){x.k0[0], x.k0[1]};
        S[1] = S[1] * (f32x2){x.a0[2], x.a0[3]} + vv2 * (f32x2){x.k0[2], x.k0[3]};
        S[2] = S[2] * (f32x2){x.a1[0], x.a1[1]} + vv2 * (f32x2){x.k1[0], x.k1[1]};
        S[3] = S[3] * (f32x2){x.a1[2], x.a1[3]} + vv2 * (f32x2){x.k1[2], x.k1[3]};
        const f32x2 y2 = (S[0] * (f32x2){x.q0[0], x.q0[1]} + S[1] * (f32x2){x.q0[2], x.q0[3]}) + (S[2] * (f32x2){x.q1[0], x.q1[1]} + S[3] * (f32x2){x.q1[2], x.q1[3]});
        return y2[0] + y2[1];
    };
    if (cons) __builtin_amdgcn_s_setprio(3);
    if (prod) { p_load(0); p_write(0); p_load(1); }
    SCAN_BARRIER();
    for (int b = 0; b < NBLK; ++b) {
        if (prod) {
            if (b + 1 < NBLK) p_write((b + 1) & 1);
            if (b + 2 < NBLK) p_load(b + 2);
            if (b > 0) p_yout(b - 1);
        } else if (cons) {
            const int buf = b & 1;
            vbase = vec + (buf * TB * 8 + ks) * 24; vvb = vv + buf * TB * 32 + icol; yob = yo + (buf * TB * 32 + icol) * 4 + (ks >> 1);
            Vx xa, xb;
            c_ld(xa, buf, 0);
#pragma unroll
            for (int s = 0; s < TB; s += 2) {
                c_ld(xb, buf, s + 1);
                float ya = c_upd(xa);
                c_ld(xa, buf, s + 2);
                float yb = c_upd(xb);
                ya += dpp_<0xB1>(ya); yb += dpp_<0xB1>(yb);
                yob[s * 128] = ya; yob[(s + 1) * 128] = yb;
            }
        }
        SCAN_BARRIER();
    }
    __builtin_amdgcn_s_setprio(0);
    if (prod) p_yout(NBLK - 1);
    SCAN_BARRIER();
}

__device__ __forceinline__ void scan_gdn(const P& p, int l, int unit, LAS unsigned char* lds) {
    const int z = unit >> 6, h = (unit >> 4) & 3, cb = unit & 15;
    const bf16_t* GDNC = (const bf16_t*)(p.ws + OFF_GDNC); const float* GDNGB = (const float*)(p.ws + OFF_GDNGB);
    bf16_t* O = (bf16_t*)(p.ws + OFF_R) + 1024 + z * 512 + h * 128 + cb * 8;
    LAS float* vec = (LAS float*)lds;
    LAS float* vv = vec + 2 * TB * 384;
    LAS float* sc = vv + 2 * TB * 8;
    LAS float* yo = sc + 2 * TB * 2;
    const int tid = otid(); const ScanRole<4> role(tid); const int ct = role.ct; const bool prod = role.prod, cons = role.cons;
    u32x2 pq[4], pk[4]; unsigned short pv; float psc = 0.f;
    auto p_load = [&](int blk) {
#pragma unroll
        for (int i = 0; i < 4; ++i) { const int idx = ct + i * 256, s = idx >> 5, n4 = idx & 31; const int t = tok_seq(z, blk * TB + s);
            const bf16_t* bp = GDNC + (size_t)t * 1536 + h * 128 + n4 * 4;
            pq[i] = *(const u32x2*)(bp); pk[i] = *(const u32x2*)(bp + 512); }
        { const int s = ct >> 3, r = ct & 7; const int t = tok_seq(z, blk * TB + s); pv = GDNC[(size_t)t * 1536 + 1024 + h * 128 + cb * 8 + r]; }
        if (ct < 64) { const int s = ct >> 1, w = ct & 1; const int t = tok_seq(z, blk * TB + s); psc = GDNGB[t * 16 + w * 8 + z * 4 + h]; }
    };
    auto p_write = [&](int buf) {
#pragma unroll
        for (int i = 0; i < 4; ++i) { const int idx = ct + i * 256, s = idx >> 5, n4 = idx & 31;
            LAS float* d = vec + ((buf * TB + s) * 32 + n4) * 12;
            *(LAS f32x4*)(d) = bf4(pq[i]); *(LAS f32x4*)(d + 4) = bf4(pk[i]); }
        vv[buf * TB * 8 + ct] = bfraw2f(pv);
        if (ct < 64) sc[buf * TB * 2 + ct] = psc;
    };
    auto p_yout = [&](int blk) {
        const int buf = blk & 1; const int s = ct >> 3, r = ct & 7; const int t = tok_seq(z, blk * TB + s);
        const f32x4 y0 = *(const LAS f32x4*)(yo + (buf * TB * 8 + ct) * 8), y1 = *(const LAS f32x4*)(yo + (buf * TB * 8 + ct) * 8 + 4);
        O[(size_t)t * R_LD + r] = f2bf(((y0[0] + y0[1]) + (y0[2] + y0[3])) + ((y1[0] + y1[1]) + (y1[2] + y1[3])));
    };
    const int icol = (ct >> 5) & 7, ks = ct & 31;
    const LAS float* vbase = vec; const LAS float* vvb = vv; const LAS float* scb = sc; LAS float* yob = yo;
    f32x2 S0 = (f32x2){0.f, 0.f}, S1 = S0;
    struct Vx { f32x4 q, k; float v; f32x2 gb; };
    auto c_ld = [&](Vx& x, int buf, int s) {
        const LAS float* d = vbase + s * 384;
        x.q = *(const LAS f32x4*)(d); x.k = *(const LAS f32x4*)(d + 4);
        x.v = vvb[s * 8]; x.gb = *(const LAS f32x2*)(scb + s * 2);
    };
    float dd = 0.f;
    auto c_step = [&](const Vx& x, const f32x4& kn, int buf, int s) {
        const float eg = x.gb[0];
        const f32x2 eg2 = (f32x2){eg, eg};
        const f32x2 pre0 = S0 * eg2, pre1 = S1 * eg2;
        const float cc = x.gb[1] * (x.v - eg * dd);
        const f32x2 cc2 = (f32x2){cc, cc};
        S0 = cc2 * (f32x2){x.k[0], x.k[1]} + pre0;
        S1 = cc2 * (f32x2){x.k[2], x.k[3]} + pre1;
        const f32x2 y2 = S0 * (f32x2){x.q[0], x.q[1]} + S1 * (f32x2){x.q[2], x.q[3]};
        const f32x2 d2 = S0 * (f32x2){kn[0], kn[1]} + S1 * (f32x2){kn[2], kn[3]};
        float yp = y2[0] + y2[1], dp = d2[0] + d2[1];
        yp += dpp_<0xB1>(yp); dp += dpp_<0xB1>(dp); yp += dpp_<0x4E>(yp); dp += dpp_<0x4E>(dp);
        dp += dpp_<0x141>(dp); dp += dpp_<0x140>(dp);
        dp = rowpair_sum(dp);
        dd = dp;
        yob[s * 64] = yp;
    };
    if (cons) __builtin_amdgcn_s_setprio(3);
    if (prod) { p_load(0); p_write(0); p_load(1); }
    SCAN_BARRIER();
    for (int b = 0; b < NBLK; ++b) {
        if (prod) {
            if (b + 1 < NBLK) p_write((b + 1) & 1);
            if (b + 2 < NBLK) p_load(b + 2);
            if (b > 0) p_yout(b - 1);
        } else if (cons) {
            const int buf = b & 1;
            vbase = vec + (buf * TB * 32 + ks) * 12; vvb = vv + buf * TB * 8 + icol; scb = sc + buf * TB * 2; yob = yo + (buf * TB * 8 + icol) * 8 + (ks >> 2);
            Vx xa, xb;
            c_ld(xa, buf, 0);
            { const f32x2 d2 = S0 * (f32x2){xa.k[0], xa.k[1]} + S1 * (f32x2){xa.k[2], xa.k[3]}; dd = rowpair_sum(reduce16(d2[0] + d2[1])); }
#pragma unroll
            for (int s = 0; s < TB; s += 2) {
                c_ld(xb, buf, s + 1); c_step(xa, xb.k, buf, s);
                c_ld(xa, buf, s + 2);
                c_step(xb, xa.k, buf, s + 1);
            }
        }
        SCAN_BARRIER();
    }
    __builtin_amdgcn_s_setprio(0);
    if (prod) p_yout(NBLK - 1);
    SCAN_BARRIER();
}

__device__ __forceinline__ void unpack8(const u32x4 r, float (&f)[8]) {
#pragma unroll
    for (int j = 0; j < 4; ++j) { f[2 * j] = __uint_as_float(r[j] << 16); f[2 * j + 1] = __uint_as_float(r[j] & 0xffff0000u); }
}
__device__ __forceinline__ u32x4 pack8(const float (&f)[8]) { u32x4 o; o[0] = pk2(f[0], f[1]); o[1] = pk2(f[2], f[3]); o[2] = pk2(f[4], f[5]); o[3] = pk2(f[6], f[7]); return o; }
__device__ __forceinline__ void phase_post(const P& p, int l, LAS unsigned char* lds) {
    const bf16_t* PG = (const bf16_t*)(p.ws + OFF_PG); const bf16_t* Rb = (const bf16_t*)(p.ws + OFF_R); const bf16_t* B = (const bf16_t*)(p.ws + OFF_B);
    const bf16_t* RWG = (const bf16_t*)(p.ws + OFF_RWG);
    bf16_t* YC = (bf16_t*)(p.ws + OFF_GDNC);
    const int tid = otid(), wave = tid >> 6, lane = tid & 63, c0 = lane * 8;
    float lnw[8], lnb[8], kac[8], rkc[8], gng[8], dng[8];
#pragma unroll
    for (int j = 0; j < 8; ++j) { lnw[j] = p.in[I_RWLNW][l * 512 + c0 + j]; lnb[j] = p.in[I_RWLNB][l * 512 + c0 + j]; kac[j] = p.in[I_RWKA][l * 512 + c0 + j]; rkc[j] = p.in[I_RWRK][l * 512 + c0 + j];
        gng[j] = p.in[I_GLANG][l * 128 + ((c0 + j) & 127)]; dng[j] = p.in[I_GDNNG][l * 128 + ((c0 + j) & 127)]; }
#pragma unroll 1
    for (int t = blockIdx.x * 8 + wave; t < L; t += gridDim.x * 8) {
        const bf16_t* pgr = PG + (size_t)t * PG_LD; const bf16_t* br = B + (size_t)t * 4096 + c0; const bf16_t* rr = Rb + (size_t)t * R_LD + c0;
        const u32x4 qy0 = *(const u32x4*)(pgr + YRW_COL + c0), qy1 = *(const u32x4*)(pgr + YRW_COL + 512 + c0);
        const u32x4 qr = *(const u32x4*)(br), qk = *(const u32x4*)(br + 512), qv = *(const u32x4*)(br + 1024), qa0 = *(const u32x4*)(br + 2048), qa1 = *(const u32x4*)(br + 2560);
        const u32x4 qg = *(const u32x4*)(RWG + (size_t)t * 512 + c0);
        const u32x4 qo0 = *(const u32x4*)(rr), qo1 = *(const u32x4*)(rr + 512), qd0 = *(const u32x4*)(rr + 1024), qd1 = *(const u32x4*)(rr + 1536);
        const u32x4 qog = *(const u32x4*)(pgr + GLA_OG + c0), qzg = *(const u32x4*)(pgr + GDN_ZG + c0);
        float a[8], b[8], o[8];
        unpack8(qy0, a); unpack8(qy1, b);
        float s = 0.f;
#pragma unroll
        for (int j = 0; j < 8; ++j) { a[j] += b[j]; s += a[j]; }
        const float mean = reduce8(s) * (1.f / 64.f);
        float s2 = 0.f;
#pragma unroll
        for (int j = 0; j < 8; ++j) { a[j] -= mean; s2 += a[j] * a[j]; }
        const float rstd = rsqrtf(reduce8(s2) * (1.f / 64.f) + 64e-5f);
        {
            float r[8], k[8], z0[8], z1[8];
            unpack8(qr, r); unpack8(qk, k); unpack8(qa0, z0); unpack8(qa1, z1);
            float sb = 0.f;
#pragma unroll
            for (int j = 0; j < 8; ++j) sb += r[j] * rkc[j] * (k[j] * (1.f + (z0[j] - 1.f) * kac[j]) + k[j] * (1.f + (z1[j] - 1.f) * kac[j]));
            const float bon = reduce8(sb);
            unpack8(qv, r); unpack8(qg, k);
#pragma unroll
            for (int j = 0; j < 8; ++j) o[j] = (a[j] * rstd * lnw[j] + lnb[j] + bon * r[j]) * k[j];
            *(u32x4*)(YC + (size_t)t * 512 + c0) = pack8(o);
        }
        unpack8(qo0, a); unpack8(qo1, b);
        s = 0.f;
#pragma unroll
        for (int j = 0; j < 8; ++j) { a[j] += b[j]; s += a[j] * a[j]; }
        float rs = rsqrtf(reduce16(s) * (1.f / 128.f) + 1e-6f);
        unpack8(qog, b);
#pragma unroll
        for (int j = 0; j < 8; ++j) o[j] = a[j] * rs * gng[j] * silu_(b[j]);
        *(u32x4*)(YC + (size_t)L * 512 + (size_t)t * 512 + c0) = pack8(o);
        unpack8(qd0, a); unpack8(qd1, b);
        s = 0.f;
#pragma unroll
        for (int j = 0; j < 8; ++j) { a[j] += b[j]; s += a[j] * a[j]; }
        rs = rsqrtf(reduce16(s) * (1.f / 128.f) + 1e-6f);
        unpack8(qzg, b);
#pragma unroll
        for (int j = 0; j < 8; ++j) o[j] = a[j] * rs * dng[j] * silu_(b[j]);
        *(u32x4*)(YC + (size_t)2 * L * 512 + (size_t)t * 512 + c0) = pack8(o);
    }
}

__device__ __forceinline__ void phase_final(const P& p) {
    const float* H = (const float*)(p.ws + OFF_H); const float* gamma = p.in[I_FINALG];
    const int tid_ = otid(); const int wave = tid_ >> 6, lane = tid_ & 63;
    for (int row = blockIdx.x * 8 + wave; row < NLAT; row += gridDim.x * 8) {
        const float* src = H + (size_t)(row + NCTX) * 1024;
        f32x4 v[4]; float ss = 0.f;
#pragma unroll
        for (int j = 0; j < 4; ++j) { v[j] = *(const f32x4*)(src + j * 256 + lane * 4); ss += (v[j][0] * v[j][0] + v[j][1] * v[j][1]) + (v[j][2] * v[j][2] + v[j][3] * v[j][3]); }
        ss = wave_sum(ss);
        const float rstd = rsqrtf(ss * (1.f / 1024.f) + 1e-6f);
#pragma unroll
        for (int j = 0; j < 4; ++j) { const int col = j * 256 + lane * 4; const f32x4 g = *(const f32x4*)(gamma + col);
            *(f32x4*)(p.out + (size_t)row * 1024 + col) = v[j] * rstd * g; }
    }
}


#define XB_TMO      128
#define XB_XCNT(j)  (256  + 64 * (j))
#define XB_XSUB(j)  (1280 + 64 * (j))
#define XB_XGEN(j)  (2304 + 64 * (j))
#define XB_TOP      3328
#define XB_TOPGEN   3392
#define XCD_BAR_WORDS 3456
#define XB_SPIN_CAP (1u << 18)
__device__ __forceinline__ unsigned xb_ld(unsigned* p)              { return __hip_atomic_load(p, __ATOMIC_RELAXED, __HIP_MEMORY_SCOPE_AGENT); }
__device__ __forceinline__ unsigned xb_add(unsigned* p, unsigned v) { return __hip_atomic_fetch_add(p, v, __ATOMIC_RELAXED, __HIP_MEMORY_SCOPE_AGENT); }
__device__ __forceinline__ unsigned xb_xcc_id() { return (unsigned)__builtin_amdgcn_s_getreg((3 << 11) | 20) & 0xFu; }
#define XB_SPIN(cond, bar) do { unsigned _sp = 0; while (cond) { __builtin_amdgcn_s_sleep(1); \
    if ((++_sp & 255u) == 0u) { if (xb_ld(&(bar)[XB_TMO])) break; if (_sp > XB_SPIN_CAP) { atomicAdd(&(bar)[XB_TMO], 1u); break; } } } } while (0)
struct XcdBarrier { unsigned* bar; unsigned x; volatile LAS unsigned* st; };
__device__ __forceinline__ XcdBarrier xcd_barrier_post(unsigned* bar, volatile LAS unsigned* st) {
    XcdBarrier b; b.bar = bar; b.x = xb_xcc_id(); b.st = st;
    if (threadIdx.x == 0) (void)xb_add(&bar[XB_XCNT(b.x)], 1u);
    return b;
}
__device__ __forceinline__ void xcd_barrier_complete(unsigned* bar, unsigned x, unsigned& nloc, unsigned& nx) {
    const unsigned G = gridDim.x * gridDim.y * gridDim.z;
    unsigned sum, cnt, mine, sp = 0u;
    for (;;) {
        sum = 0u; cnt = 0u; mine = 0u;
#pragma unroll
        for (unsigned j = 0; j < 16; ++j) { const unsigned c = xb_ld(&bar[XB_XCNT(j)]); sum += c; cnt += (c > 0u) ? 1u : 0u; mine = (j == x) ? c : mine; }
        if (sum == G) break;
        __builtin_amdgcn_s_sleep(1);
        if ((++sp & 255u) == 0u) { if (xb_ld(&bar[XB_TMO])) break; if (sp > XB_SPIN_CAP) { atomicAdd(&bar[XB_TMO], 1u); break; } }
    }
    nloc = mine > 0u ? mine : 1u; nx = cnt > 0u ? cnt : 1u;
}
__device__ __forceinline__ void xcd_barrier(const XcdBarrier& b) {
    asm volatile("s_waitcnt vmcnt(0)" ::: "memory");
    __syncthreads();
    if (threadIdx.x == 0) {
        unsigned* bar = b.bar;
        __builtin_amdgcn_s_waitcnt(0);
        unsigned nloc = b.st[0], nx = b.st[1];
        if (nloc == 0u) { xcd_barrier_complete(bar, b.x, nloc, nx); b.st[0] = nloc; b.st[1] = nx; }
        const unsigned old = xb_add(&bar[XB_XSUB(b.x)], 1u);
        const unsigned gen = old / nloc;
        if (old + 1u == (gen + 1u) * nloc) {
            __builtin_amdgcn_fence(__ATOMIC_RELEASE, "agent");
            asm volatile("s_waitcnt vmcnt(0)" ::: "memory");
            const unsigned og = xb_add(&bar[XB_TOP], 1u);
            const unsigned tg = og / nx;
            if (og + 1u == (tg + 1u) * nx) xb_add(&bar[XB_TOPGEN], 1u);
            else XB_SPIN(xb_ld(&bar[XB_TOPGEN]) == tg, bar);
            __builtin_amdgcn_fence(__ATOMIC_ACQUIRE, "agent");
            xb_add(&bar[XB_XGEN(b.x)], 1u);
            asm volatile("s_waitcnt vmcnt(0)" ::: "memory");
        } else {
            XB_SPIN(xb_ld(&bar[XB_XGEN(b.x)]) == gen, bar);
            __builtin_amdgcn_fence(__ATOMIC_ACQUIRE, "agent");
            asm volatile("s_waitcnt vmcnt(0)" ::: "memory");
        }
    }
    __syncthreads();
}

__global__ void __launch_bounds__(512, 2) fwd_megakernel(P p) {
    extern __shared__ __attribute__((aligned(16))) unsigned char shm_raw[];
    LAS unsigned char* lds = (LAS unsigned char*)shm_raw;
    cg::grid_group grid = cg::this_grid();
    const int G = gridDim.x, wg = blockIdx.x;
    unsigned char* ws = p.ws;
    float* H = (float*)(ws + OFF_H); bf16_t* HN = (bf16_t*)(ws + OFF_HN); bf16_t* WIN = (bf16_t*)(ws + OFF_WIN);
    const float* MODall = (const float*)(ws + OFF_MOD);

    volatile LAS unsigned* xbst = (volatile LAS unsigned*)(lds + 131072);
    if (threadIdx.x == 0) { xbst[0] = 0u; xbst[1] = 0u; xbst[2] = 0u; xbst[3] = 0u; }
    __syncthreads();
    const XcdBarrier xb = xcd_barrier_post((unsigned*)(ws + OFF_BAR), xbst);
    phase_mod(p, lds);
    grid.sync();
    for (int l = 0; l < DEPTH; ++l) {
        const float* MOD = MODall + (size_t)l * 2 * 6144;
        const bool lastl = (l == DEPTH - 1);
        const int Mg = lastl ? NLAT : L, pm0 = lastl ? 1 : 0;
        if (l == 0) phase_norm<true>(p, l, p.in[I_N1G] + l * 1024, 0, 1); else phase_norm<false>(p, l, p.in[I_N1G] + l * 1024, 0, 1);
        {
            const float* win = p.in[I_WIN] + (size_t)l * 1024 * IN_COLS;
            convert_T(win, IN_COLS, 1024, 0, 1920, WIN, (LAS float*)lds, wg, G);
            convert_T(win, IN_COLS, 1024, 1920, 3632, WIN + (size_t)2048 * 1024, (LAS float*)lds, (wg + 64) % G, G);
            convert_T(win, IN_COLS, 1024, 5552, 3072, WIN + (size_t)NMAIN * 1024, (LAS float*)lds, (wg + 128) % G, G);
            build_wl(p, l, wg, G);
        }
        xcd_barrier(xb);
        {
            pg8::Gemm g{HN, WIN, L, NMAIN, 1024, 16}; pg8::StaticOrder S; S.init(L, NMAIN, G, wg);
            EpiInMain E{(bf16_t*)(ws + OFF_R), (bf16_t*)(ws + OFF_PG)};
            pg8::gemm_phase(lds, g, S, E);
        }
        xcd_barrier(xb);
#ifndef NO_PREP
        phase_prep(p, l, lds);
        xcd_barrier(xb);
        {
            pg8::Gemm g{(const bf16_t*)(ws + OFF_XL), (const bf16_t*)(ws + OFF_WL), L, 2560, 384, osgpr(6)}; pg8::StaticOrder S; S.init(L, 2560, G, wg);
            EpiLora E{(bf16_t*)(ws + OFF_B), (bf16_t*)(ws + OFF_RWG), p.in[I_RWW0] + (size_t)l * 1024, p.in[I_RWA0] + (size_t)l * 1024};
            pg8::gemm_phase(lds, g, S, E);
        }
#endif
        xcd_barrier(xb);
#ifndef NO_SCAN
        if (wg < 64) scan_rwkv(p, l, wg, lds);
        else if (wg < 96) scan_gla(p, l, wg - 64, lds);
        else if (wg < 224) scan_gdn(p, l, wg - 96, lds);
#endif
        xcd_barrier(xb);
#ifndef NO_POST
        phase_post(p, l, lds);
#endif
        xcd_barrier(xb);
        {
            convert_T(p.in[I_WBR] + (size_t)l * 3 * 512 * 1024, 1024, 512, 0, 1024, (bf16_t*)(ws + OFF_WBR), (LAS float*)lds, wg, G);
            convert_T(p.in[I_WBR] + (size_t)l * 3 * 512 * 1024 + (size_t)512 * 1024, 1024, 512, 0, 1024, (bf16_t*)(ws + OFF_WBR) + (size_t)1024 * 512, (LAS float*)lds, (wg + 128) % G, G);
            convert_T(p.in[I_WBR] + (size_t)l * 3 * 512 * 1024 + (size_t)2 * 512 * 1024, 1024, 512, 0, 1024, (bf16_t*)(ws + OFF_WBR) + (size_t)2 * 1024 * 512, (LAS float*)lds, wg, G);
            convert_T(p.in[I_WOUT] + (size_t)l * 1024 * 1024, 1024, 1024, 0, 1024, (bf16_t*)(ws + OFF_WOUT), (LAS float*)lds, wg, G);
            convert_T(p.in[I_W1] + (size_t)l * 1024 * 4096, 4096, 1024, 0, 4096, (bf16_t*)(ws + OFF_W1), (LAS float*)lds, wg, G);
            convert_T(p.in[I_W2] + (size_t)l * 4096 * 1024, 1024, 4096, 0, 1024, (bf16_t*)(ws + OFF_W2), (LAS float*)lds, wg, G);
            pg8::Gemm g{HN, WIN + (size_t)NMAIN * 1024, L, 3072, 1024, 16}; pg8::StaticOrder S; S.init(Mg, 3072, G, wg, pm0);
            EpiGates E{(bf16_t*)(ws + OFF_B)};
            pg8::gemm_phase(lds, g, S, E);
        }
        xcd_barrier(xb);
        {
            const bf16_t* YC = (const bf16_t*)(ws + OFF_GDNC); const bf16_t* WBR = (const bf16_t*)(ws + OFF_WBR);
            pg8::StaticOrder S; S.init(Mg, 1024, G, wg, pm0);
            { pg8::Gemm g{YC, WBR, L, 1024, 512, 8}; EpiBranch<0> E{(const bf16_t*)(ws + OFF_B), (float*)(ws + OFF_PG), HN}; pg8::gemm_phase(lds, g, S, E); }
            { pg8::Gemm g{YC + (size_t)L * 512, WBR + (size_t)1024 * 512, L, 1024, 512, 8}; EpiBranch<1> E{(const bf16_t*)(ws + OFF_B), (float*)(ws + OFF_PG), HN}; pg8::gemm_phase(lds, g, S, E); }
            { pg8::Gemm g{YC + (size_t)2 * L * 512, WBR + (size_t)2 * 1024 * 512, L, 1024, 512, 8}; EpiBranch<2> E{(const bf16_t*)(ws + OFF_B), (float*)(ws + OFF_PG), HN}; pg8::gemm_phase(lds, g, S, E); }
        }
        xcd_barrier(xb);
        {
            pg8::Gemm g{HN, (const bf16_t*)(ws + OFF_WOUT), L, 1024, 1024, 16}; pg8::StaticOrder S; S.init(Mg, 1024, G, wg, pm0);
            EpiResid E{H, MOD + 2 * 1024, MOD + 6144 + 2 * 1024};
            pg8::gemm_phase(lds, g, S, E);
        }
        xcd_barrier(xb);
        phase_norm<false>(p, l, p.in[I_N2G] + l * 1024, 3, 4);
        xcd_barrier(xb);
        {
            pg8::Gemm g{HN, (const bf16_t*)(ws + OFF_W1), L, 4096, 1024, 16}; pg8::StaticOrder S; S.init(Mg, 4096, G, wg, pm0);
            EpiMlp1 E{(bf16_t*)(ws + OFF_B)};
            pg8::gemm_phase(lds, g, S, E);
        }
        xcd_barrier(xb);
        {
            pg8::Gemm g{(const bf16_t*)(ws + OFF_B), (const bf16_t*)(ws + OFF_W2), L, 1024, 4096, 64}; pg8::StaticOrder S; S.init(Mg, 1024, G, wg, pm0);
            EpiResid E{H, MOD + 5 * 1024, MOD + 6144 + 5 * 1024};
            pg8::gemm_phase(lds, g, S, E);
        }
        xcd_barrier(xb);
    }
    phase_final(p);
}

extern "C" void kernel_launch(void* const* d_in, const int* in_sizes, int n_in, void* d_out, int out_size, void* d_ws, size_t ws_size, hipStream_t stream) {
    static int grid_blocks = 0;
    if (n_in != 32 || ws_size < WS_END || out_size != NLAT * DM) {
        fprintf(stderr, "kernel_launch: unexpected shapes / workspace (n_in %d, ws %zu need %zu, out %d)\n", n_in, ws_size, (size_t)WS_END, out_size);
        hipMemsetAsync(d_out, 0xFF, (size_t)out_size * 4, stream);
        return;
    }
    if (!grid_blocks) {
        int dev = 0, cus = 0, per_cu = 0;
        hipGetDevice(&dev);
        hipDeviceGetAttribute(&cus, hipDeviceAttributeMultiprocessorCount, dev);
        hipFuncSetAttribute((const void*)fwd_megakernel, hipFuncAttributeMaxDynamicSharedMemorySize, LDS_BYTES);
        hipOccupancyMaxActiveBlocksPerMultiprocessor(&per_cu, (const void*)fwd_megakernel, 512, LDS_BYTES);
        if (per_cu < 1) per_cu = 1;
        grid_blocks = cus * 1;
        (void)hipGetLastError();
    }
    P p{};
    for (int i = 0; i < 32; ++i) p.in[i] = (const float*)d_in[i];
    p.out = (float*)d_out; p.ws = (unsigned char*)d_ws;
    (void)hipMemsetAsync((unsigned char*)d_ws + OFF_BAR, 0, 16384, stream);
    void* args[] = {&p};
    hipError_t e = hipLaunchCooperativeKernel((const void*)fwd_megakernel, dim3(grid_blocks), dim3(512), args, LDS_BYTES, stream);
    if (e != hipSuccess) fprintf(stderr, "cooperative launch failed: %s (grid %d)\n", hipGetErrorString(e), grid_blocks);
}
```

```cpp
#include <hip/hip_runtime.h>
#include <hip/hip_cooperative_groups.h>
#include <cstdio>
#include <cstdint>
namespace cg = cooperative_groups;

#define LAS __attribute__((address_space(3)))
typedef unsigned short bf16_t;
typedef short bf16x8 __attribute__((ext_vector_type(8)));
typedef float f32x4 __attribute__((ext_vector_type(4)));
typedef float f32x2 __attribute__((ext_vector_type(2)));
typedef unsigned u32x4 __attribute__((ext_vector_type(4)));
typedef unsigned u32x2 __attribute__((ext_vector_type(2)));

constexpr int L = 16640, NCTX = 256, NLAT = 16384, DM = 1024, BW = 512, DEPTH = 4;
constexpr int IN_COLS = 8624;
constexpr int NMAIN = 5888;
constexpr int NWIN = 8960;
constexpr int R_LD = 2048, PG_LD = 3840;
constexpr int GLA_Q = 0, GLA_K = 256, GLA_V = 512, GLA_OG = 1024, GLA_AL = 1536;
constexpr int GDN_QKV = 1568, GDN_ZG = 3104, GDN_A = 3616, GDN_B = 3624;
constexpr int YRW_COL = 1568;

constexpr size_t al256(size_t x) { return (x + 255) & ~(size_t)255; }
constexpr size_t OFF_MOD = 0;
constexpr size_t OFF_H = al256(OFF_MOD + (size_t)4 * 2 * 6144 * 4);
constexpr size_t OFF_HN = OFF_H + (size_t)L * 1024 * 4;
constexpr size_t OFF_WIN = OFF_HN + (size_t)L * 1024 * 2;
constexpr size_t OFF_R = OFF_WIN + (size_t)NWIN * 1024 * 2;
constexpr size_t OFF_PG = OFF_R + (size_t)L * R_LD * 2;
constexpr size_t OFF_B = OFF_PG + (size_t)L * PG_LD * 2;
constexpr size_t OFF_RWG = OFF_B + (size_t)L * 4096 * 2;
constexpr size_t OFF_BONUS = OFF_RWG + (size_t)L * 512 * 2;
constexpr size_t OFF_GLAD = OFF_BONUS + (size_t)L * 8 * 4;
constexpr size_t OFF_GDNC = OFF_GLAD + (size_t)L * 512 * 2;
constexpr size_t OFF_GDNGB = OFF_GDNC + (size_t)L * 1536 * 2;
constexpr size_t OFF_XL = OFF_GDNGB + (size_t)L * 16 * 4;
constexpr size_t OFF_WL = OFF_XL + (size_t)L * 512 * 2;
constexpr size_t OFF_BAR = OFF_WL + (size_t)2560 * 512 * 2;
constexpr size_t WS_END = OFF_BAR + 16384;
constexpr size_t OFF_WBR = OFF_R;
constexpr size_t OFF_WOUT = OFF_WBR + (size_t)3 * 1024 * 512 * 2;
constexpr size_t OFF_W1 = OFF_WOUT + (size_t)1024 * 1024 * 2;
constexpr size_t OFF_W2 = OFF_W1 + (size_t)4096 * 1024 * 2;

constexpr int LDS_BYTES = 131072 + 16;

struct P { const float* in[32]; float* out; unsigned char* ws; };
enum { I_X = 0, I_C, I_CTX, I_CCTX, I_WMOD, I_BMOD, I_N1G, I_WIN, I_RWMU, I_RWW0, I_RWW2, I_RWA0, I_RWA2, I_RWG2, I_RWKK, I_RWKA, I_RWRK,
       I_RWLNW, I_RWLNB, I_GLAA2, I_GLAAB, I_GLANG, I_GDNCONV, I_GDNALOG, I_GDNDT, I_GDNNG, I_WBR, I_WOUT, I_N2G, I_W1, I_W2, I_FINALG };

__device__ __forceinline__ float bf2f(bf16_t b) { return __uint_as_float(((unsigned)b) << 16); }
__device__ __forceinline__ unsigned pk2(float lo, float hi) { unsigned r; asm("v_cvt_pk_bf16_f32 %0, %1, %2" : "=v"(r) : "v"(lo), "v"(hi)); return r; }
__device__ __forceinline__ bf16_t f2bf(float f) { return (bf16_t)(pk2(f, 0.f) & 0xffffu); }
__device__ __forceinline__ float sigmoid_(float x) { return 1.f / (1.f + __expf(-x)); }
__device__ __forceinline__ float silu_(float x) { return x / (1.f + __expf(-x)); }
__device__ __forceinline__ float softplus_(float x) { return fmaxf(x, 0.f) + log1pf(__expf(-fabsf(x))); }
template <int CTRL> __device__ __forceinline__ float dpp_(float x) { return __int_as_float(__builtin_amdgcn_update_dpp(0, __float_as_int(x), CTRL, 0xF, 0xF, true)); }
__device__ __forceinline__ float reduce8(float x) { x += dpp_<0xB1>(x); x += dpp_<0x4E>(x); x += dpp_<0x141>(x); return x; }
__device__ __forceinline__ float reduce16(float x) { x = reduce8(x); x += dpp_<0x140>(x); return x; }
__device__ __forceinline__ float wave_sum(float v) {
    v = reduce16(v);
    const float r0 = __int_as_float(__builtin_amdgcn_readlane(__float_as_int(v), 0)), r1 = __int_as_float(__builtin_amdgcn_readlane(__float_as_int(v), 16));
    const float r2 = __int_as_float(__builtin_amdgcn_readlane(__float_as_int(v), 32)), r3 = __int_as_float(__builtin_amdgcn_readlane(__float_as_int(v), 48));
    return (r0 + r1) + (r2 + r3);
}

__device__ __forceinline__ int otid() { int t = threadIdx.x; asm volatile("" : "+v"(t)); return t; }
__device__ __forceinline__ int osgpr(int x) { asm volatile("" : "+s"(x)); return x; }
namespace pg8 {
constexpr int BM = 256, BK = 64, HALF = 128, HTB = HALF * BK * 2, STAGE_BYTES = 8 * HTB, NXCD = 8, WGM = 8;
__host__ __device__ __forceinline__ int lds_byte(int r, int c) { const int st = (r >> 4) * 2 + (c >> 5), rr = r & 15, cc = c & 31, ob = rr * 64 + cc * 2; return st * 1024 + (ob ^ (((ob >> 9) & 1) << 5)); }
__host__ __device__ __forceinline__ int perm32(int rho) { const int n = rho >> 4, i = rho & 15; return 8 * (i >> 2) + 4 * n + (i & 3); }
__host__ __device__ __forceinline__ void stage_rc(int b, int& R, int& C) { const int st = b / 1024, sb = b % 1024, swz = sb ^ (((sb >> 9) & 1) << 5); R = (st >> 1) * 16 + swz / 64; C = (st & 1) * 32 + (swz % 64) / 2; }
struct Unit { int pm, pn, k0; };
struct Gemm { const bf16_t* A; const bf16_t* Bt; int M, N, K, nt; };
struct StaticOrder {
    int nM, nN, nwg, G, c, pm0;
    __host__ __device__ void init(int M, int N, int G_, int c_, int pm0_ = 0) { nM = M / BM; nN = N / BM; nwg = nM * nN; G = G_; c = c_; pm0 = pm0_; }
    __host__ __device__ bool next(int i, Unit& u) const {
        const long Lx = (long)i * G + c; if (Lx >= nwg) return false;
        int wgid = (int)Lx; { const int q = nwg / NXCD, r = nwg % NXCD, xcd = wgid % NXCD, off = wgid / NXCD; wgid = (xcd < r ? xcd * (q + 1) : r * (q + 1) + (xcd - r) * q) + off; }
        const int nig = WGM * nN, gid = wgid / nig, fm = gid * WGM, gsz = (nM - fm) < WGM ? (nM - fm) : WGM;
        u.pm = pm0 + fm + ((wgid % nig) % gsz); u.pn = (wgid % nig) / gsz; u.k0 = 0; return true;
    }
};
struct SplitOrder {
    int nN, nunits, G, c, nt;
    __host__ __device__ void init(int N, int K, int nt_, int G_, int c_) { nN = N / BM; nt = nt_; nunits = nN * (K / BK / nt_); G = G_; c = c_; }
    __host__ __device__ bool next(int i, Unit& u) const {
        const int idx = i * G + c; if (idx >= nunits) return false;
        u.pm = 0; u.pn = idx % nN; u.k0 = (idx / nN) * nt; return true;
    }
};
template <class Epi, class Ord>
__device__ __forceinline__ void gemm_phase(LAS unsigned char* lds, const Gemm g, const Ord& S, const Epi& E) {
#ifdef NO_GEMM
    return;
#endif
    const int tid = otid(), wid = __builtin_amdgcn_readfirstlane(tid >> 6), lane = tid & 63, wr = wid >> 2, wc = wid & 3, fr = lane & 15, fq = lane >> 4;
    const int K = g.K, nt = g.nt;
    unsigned voffA[2], voffB[2];
#pragma unroll
    for (int i = 0; i < 2; ++i) { int R, C; stage_rc(tid * 16 + i * 8192, R, C); const int Rb = (R & ~31) + perm32(R & 31);
        voffA[i] = (unsigned)(R * K + C) * 2u; voffB[i] = (unsigned)(Rb * K + C) * 2u; }
    const size_t kstep = (size_t)(BK * 2);
    const size_t hstep = (size_t)HALF * K * 2;
    const size_t tstep = 2 * hstep;
    const unsigned ldsw = (unsigned)wid * 1024u;
    const int aoff = lds_byte(wr * 64 + fr, fq * 8), boff = lds_byte(wc * 32 + fr, fq * 8);
#define PG8_SA(b, h) (((b) * 2 + (h)) * HTB)
#define PG8_SB(b, h) ((4 + (b) * 2 + (h)) * HTB)
#define PG8_STAGE(bufoff, gbase, voff) do { _Pragma("unroll") for (int _i = 0; _i < 2; ++_i) \
        __builtin_amdgcn_global_load_lds((const unsigned*)((const char*)(gbase) + (voff)[_i]), (LAS unsigned*)(lds + (bufoff) + ldsw + _i * 8192), 16, 0, 0); } while (0)
#define PG8_LDA(dst, b, h) do { _Pragma("unroll") for (int m = 0; m < 4; ++m) _Pragma("unroll") for (int k = 0; k < 2; ++k) dst[m][k] = *(const LAS bf16x8*)(lds + PG8_SA(b, h) + aoff + m * 2048 + k * 1024); } while (0)
#define PG8_LDB(dst, b, h) do { _Pragma("unroll") for (int n = 0; n < 2; ++n) _Pragma("unroll") for (int k = 0; k < 2; ++k) dst[n][k] = *(const LAS bf16x8*)(lds + PG8_SB(b, h) + boff + n * 2048 + k * 1024); } while (0)
#define PG8_MMA(ai, bj, At, Bt) do { __builtin_amdgcn_s_setprio(1); _Pragma("unroll") for (int m = 0; m < 4; ++m) _Pragma("unroll") for (int n = 0; n < 2; ++n) _Pragma("unroll") for (int k = 0; k < 2; ++k) \
        acc[ai][bj][m][n] = __builtin_amdgcn_mfma_f32_16x16x32_bf16(Bt[n][k], At[m][k], acc[ai][bj][m][n], 0, 0, 0); __builtin_amdgcn_s_setprio(0); } while (0)
#define PG8_WAIT_V(n) asm volatile("s_waitcnt vmcnt(" #n ")" ::: "memory")
#define PG8_WAIT_L(n) asm volatile("s_waitcnt lgkmcnt(" #n ")" ::: "memory")
#define PG8_BAR __builtin_amdgcn_s_barrier()
#define PG8_SCHED __builtin_amdgcn_sched_barrier(0)
    Unit cur, nxt; int ui = 0;
    if (!S.next(0, cur)) return;
    f32x4 acc[2][2][4][2];
#pragma unroll
    for (int a = 0; a < 2; ++a)
#pragma unroll
        for (int b = 0; b < 2; ++b)
#pragma unroll
            for (int m = 0; m < 4; ++m)
#pragma unroll
                for (int n = 0; n < 2; ++n) acc[a][b][m][n] = (f32x4){0.f, 0.f, 0.f, 0.f};
    bf16x8 At[4][2], B0[2][2], B1[2][2];
    const size_t kstep0 = (size_t)(BK * 2);
    const char* cA = (const char*)g.A + (size_t)cur.pm * tstep + (size_t)cur.k0 * kstep0; const char* cB = (const char*)g.Bt + (size_t)cur.pn * tstep + (size_t)cur.k0 * kstep0;
    PG8_STAGE(PG8_SB(0, 0), cB, voffB); PG8_STAGE(PG8_SA(0, 0), cA, voffA); PG8_STAGE(PG8_SB(0, 1), cB + hstep, voffB); PG8_STAGE(PG8_SA(0, 1), cA + hstep, voffA);
    if (wr == 1) PG8_BAR;
    PG8_WAIT_V(4); PG8_BAR;
    PG8_STAGE(PG8_SB(1, 0), cB + kstep, voffB); PG8_STAGE(PG8_SA(1, 0), cA + kstep, voffA); PG8_STAGE(PG8_SB(1, 1), cB + hstep + kstep, voffB);
    PG8_WAIT_V(6); PG8_BAR;
    for (;;) {
        const bool has_next = S.next(ui + 1, nxt);
        const char* nA = has_next ? (const char*)g.A + (size_t)nxt.pm * tstep + (size_t)nxt.k0 * kstep0 : cA; const char* nB = has_next ? (const char*)g.Bt + (size_t)nxt.pn * tstep + (size_t)nxt.k0 * kstep0 : cB;
        for (int t = 0; t < nt; t += 2) {
            const bool last = (t == nt - 2);
            const char* a1 = cA + (size_t)(t + 1) * kstep;
            const char* a2 = last ? nA : cA + (size_t)(t + 2) * kstep; const char* b2 = last ? nB : cB + (size_t)(t + 2) * kstep;
            const char* a3 = a2 + kstep; const char* b3 = b2 + kstep;
            PG8_LDB(B0, 0, 0); PG8_SCHED; PG8_LDA(At, 0, 0); PG8_STAGE(PG8_SA(1, 1), a1 + hstep, voffA);
            PG8_WAIT_L(8); PG8_BAR; PG8_WAIT_L(0); PG8_MMA(0, 0, At, B0); PG8_BAR; PG8_SCHED;
            PG8_LDB(B1, 0, 1); PG8_STAGE(PG8_SB(0, 0), b2, voffB);
            PG8_BAR; PG8_WAIT_L(0); PG8_MMA(0, 1, At, B1); PG8_BAR;
            PG8_LDA(At, 0, 1); PG8_STAGE(PG8_SA(0, 0), a2, voffA);
            PG8_BAR; PG8_WAIT_L(0); PG8_MMA(1, 0, At, B0); PG8_BAR; PG8_SCHED;
            PG8_STAGE(PG8_SB(0, 1), b2 + hstep, voffB);
            PG8_WAIT_V(6); PG8_BAR; PG8_MMA(1, 1, At, B1); PG8_BAR;
            PG8_LDB(B0, 1, 0); PG8_SCHED; PG8_LDA(At, 1, 0); PG8_STAGE(PG8_SA(0, 1), a2 + hstep, voffA);
            PG8_WAIT_L(8); PG8_BAR; PG8_WAIT_L(0); PG8_MMA(0, 0, At, B0); PG8_BAR; PG8_SCHED;
            PG8_LDB(B1, 1, 1); PG8_STAGE(PG8_SB(1, 0), b3, voffB);
            PG8_BAR; PG8_WAIT_L(0); PG8_MMA(0, 1, At, B1); PG8_BAR;
            PG8_LDA(At, 1, 1); PG8_STAGE(PG8_SA(1, 0), a3, voffA);
            PG8_BAR; PG8_WAIT_L(0); PG8_MMA(1, 0, At, B0); PG8_BAR; PG8_SCHED;
            PG8_STAGE(PG8_SB(1, 1), b3 + hstep, voffB);
            PG8_WAIT_V(6); PG8_BAR; PG8_MMA(1, 1, At, B1); PG8_BAR;
        }
        E(acc, cur, wr, wc, fr, fq);
        if (!has_next) break;
#pragma unroll
        for (int a = 0; a < 2; ++a)
#pragma unroll
            for (int b = 0; b < 2; ++b)
#pragma unroll
                for (int m = 0; m < 4; ++m)
#pragma unroll
                    for (int n = 0; n < 2; ++n) acc[a][b][m][n] = (f32x4){0.f, 0.f, 0.f, 0.f};
        cur = nxt; cA = nA; cB = nB; ++ui;
    }
    PG8_WAIT_V(0);
    if (wr == 0) PG8_BAR;
    PG8_BAR;
#undef PG8_SA
#undef PG8_SB
#undef PG8_STAGE
#undef PG8_LDA
#undef PG8_LDB
#undef PG8_MMA
#undef PG8_WAIT_V
#undef PG8_WAIT_L
#undef PG8_BAR
#undef PG8_SCHED
}
}
using pg8::Unit;

#define EPI_LOOP_ROWS for (int ai = 0; ai < 2; ++ai) for (int m = 0; m < 4; ++m)
#define EPI_LOOP_COLS for (int bj = 0; bj < 2; ++bj) for (int n = 0; n < 2; ++n)
struct EpiInMain {
    bf16_t* R; bf16_t* PG;
    __device__ __forceinline__ void operator()(const f32x4 (&acc)[2][2][4][2], const Unit& u, int wr, int wc, int fr, int fq) const {
        bf16_t* dst; int ld, c0;
        if (u.pn < 8) { dst = R; ld = R_LD; c0 = u.pn * 256; } else { dst = PG; ld = PG_LD; c0 = (u.pn - 8) * 256; }
        const int row0 = u.pm * 256 + wr * 64 + fr, col0 = c0 + wc * 32 + 8 * fq;
#pragma unroll
        EPI_LOOP_ROWS { bf16_t* rowp = dst + (size_t)(row0 + ai * 128 + m * 16) * ld + col0;
#pragma unroll
            EPI_LOOP_COLS { const f32x4 v = acc[ai][bj][m][n]; *(u32x2*)(rowp + bj * 128 + n * 4) = (u32x2){pk2(v[0], v[1]), pk2(v[2], v[3])}; } }
    }
};
struct EpiGates {
    bf16_t* G;
    __device__ __forceinline__ void operator()(const f32x4 (&acc)[2][2][4][2], const Unit& u, int wr, int wc, int fr, int fq) const {
        const int row0 = u.pm * 256 + wr * 64 + fr, col0 = u.pn * 256 + wc * 32 + 8 * fq;
#pragma unroll
        EPI_LOOP_ROWS { bf16_t* rowp = G + (size_t)(row0 + ai * 128 + m * 16) * 3072 + col0;
#pragma unroll
            EPI_LOOP_COLS { const f32x4 v = acc[ai][bj][m][n];
                *(u32x2*)(rowp + bj * 128 + n * 4) = (u32x2){pk2(sigmoid_(v[0]), sigmoid_(v[1])), pk2(sigmoid_(v[2]), sigmoid_(v[3]))}; } }
    }
};
template <int GI> struct EpiBranch {
    const bf16_t* G; float* MG; bf16_t* MB;
    __device__ __forceinline__ void operator()(const f32x4 (&acc)[2][2][4][2], const Unit& u, int wr, int wc, int fr, int fq) const {
        const int row0 = u.pm * 256 + wr * 64 + fr, col0 = u.pn * 256 + wc * 32 + 8 * fq;
#pragma unroll
        EPI_LOOP_ROWS { const size_t row = (size_t)(row0 + ai * 128 + m * 16);
#pragma unroll
            EPI_LOOP_COLS { const int col = col0 + bj * 128 + n * 4; const f32x4 v = acc[ai][bj][m][n];
                const u32x2 gq = *(const u32x2*)(G + row * 3072 + GI * 1024 + col);
                f32x4 gv = (f32x4){__uint_as_float(gq[0] << 16), __uint_as_float(gq[0] & 0xffff0000u), __uint_as_float(gq[1] << 16), __uint_as_float(gq[1] & 0xffff0000u)};
                f32x4 r = v * gv;
                if (GI > 0) { const u32x2 mq = *(const u32x2*)(MB + row * 1024 + col);
                    r += (f32x4){__uint_as_float(mq[0] << 16), __uint_as_float(mq[0] & 0xffff0000u), __uint_as_float(mq[1] << 16), __uint_as_float(mq[1] & 0xffff0000u)}; }
                *(u32x2*)(MB + row * 1024 + col) = (u32x2){pk2(r[0], r[1]), pk2(r[2], r[3])}; } }
    }
};
struct EpiResid {
    float* H; const float* gate_lat; const float* gate_ctx;
    __device__ __forceinline__ void operator()(const f32x4 (&acc)[2][2][4][2], const Unit& u, int wr, int wc, int fr, int fq) const {
        const int row0 = u.pm * 256 + wr * 64 + fr, col0 = u.pn * 256 + wc * 32 + 8 * fq;
        const float* gp = (u.pm == 0) ? gate_ctx : gate_lat;
        f32x4 gv[2][2];
#pragma unroll
        EPI_LOOP_COLS gv[bj][n] = *(const f32x4*)(gp + col0 + bj * 128 + n * 4);
#pragma unroll
        EPI_LOOP_ROWS { float* rowp = H + (size_t)(row0 + ai * 128 + m * 16) * 1024 + col0;
#pragma unroll
            EPI_LOOP_COLS { f32x4* q = (f32x4*)(rowp + bj * 128 + n * 4); *q = *q + acc[ai][bj][m][n] * gv[bj][n]; } }
    }
};
struct EpiLora {
    bf16_t* B; bf16_t* RWG; const float* w0; const float* a0;
    __device__ __forceinline__ void operator()(const f32x4 (&acc)[2][2][4][2], const Unit& u, int wr, int wc, int fr, int fq) const {
        const int row0 = u.pm * 256 + wr * 64 + fr, blk = u.pn >> 1, cbase = (u.pn & 1) * 256 + wc * 32 + 8 * fq;
        f32x4 bv[2][2];
#pragma unroll
        EPI_LOOP_COLS { const int cc = cbase + bj * 128 + n * 4;
            bv[bj][n] = blk < 2 ? *(const f32x4*)(w0 + blk * 512 + cc) : (blk < 4 ? *(const f32x4*)(a0 + (blk - 2) * 512 + cc) : (f32x4){0.f, 0.f, 0.f, 0.f}); }
        bf16_t* dst; int ld;
        if (blk < 2) { dst = B + 3072 + blk * 512; ld = 4096; } else if (blk < 4) { dst = B + 2048 + (blk - 2) * 512; ld = 4096; } else { dst = RWG; ld = 512; }
#pragma unroll
        EPI_LOOP_ROWS { bf16_t* rowp = dst + (size_t)(row0 + ai * 128 + m * 16) * ld + cbase;
#pragma unroll
            EPI_LOOP_COLS { f32x4 v = acc[ai][bj][m][n] + bv[bj][n];
                if (blk < 2) {
#pragma unroll
                    for (int j = 0; j < 4; ++j) v[j] = 1.f - __expf(-0.60653066f * sigmoid_(v[j]));
                } else if (blk < 4) {
#pragma unroll
                    for (int j = 0; j < 4; ++j) v[j] = sigmoid_(v[j]);
                }
                *(u32x2*)(rowp + bj * 128 + n * 4) = (u32x2){pk2(v[0], v[1]), pk2(v[2], v[3])}; } }
    }
};
struct EpiResidAtomic {
    float* H; const float* gate_ctx;
    __device__ __forceinline__ void operator()(const f32x4 (&acc)[2][2][4][2], const Unit& u, int wr, int wc, int fr, int fq) const {
        const int row0 = u.pm * 256 + wr * 64 + fr, col0 = u.pn * 256 + wc * 32 + 8 * fq;
        const float* gp = gate_ctx + col0;
#pragma unroll
        EPI_LOOP_ROWS { float* rowp = H + (size_t)(row0 + ai * 128 + m * 16) * 1024 + col0;
#pragma unroll
            EPI_LOOP_COLS { const f32x4 v = acc[ai][bj][m][n] * *(const f32x4*)(gp + bj * 128 + n * 4); float* q = rowp + bj * 128 + n * 4;
                unsafeAtomicAdd(q, v[0]); unsafeAtomicAdd(q + 1, v[1]); unsafeAtomicAdd(q + 2, v[2]); unsafeAtomicAdd(q + 3, v[3]); }
            asm volatile("" ::: "memory"); }
    }
};
struct EpiMlp1 {
    bf16_t* U;
    __device__ __forceinline__ void operator()(const f32x4 (&acc)[2][2][4][2], const Unit& u, int wr, int wc, int fr, int fq) const {
        const int row0 = u.pm * 256 + wr * 64 + fr, col0 = u.pn * 256 + wc * 32 + 8 * fq;
#pragma unroll
        EPI_LOOP_ROWS { bf16_t* rowp = U + (size_t)(row0 + ai * 128 + m * 16) * 4096 + col0;
#pragma unroll
            EPI_LOOP_COLS { f32x4 v = acc[ai][bj][m][n];
#pragma unroll
                for (int j = 0; j < 4; ++j) { const float t = fmaxf(v[j], 0.f); v[j] = t * t; }
                *(u32x2*)(rowp + bj * 128 + n * 4) = (u32x2){pk2(v[0], v[1]), pk2(v[2], v[3])}; } }
    }
};

__device__ __forceinline__ void convert_T(const float* src, int ld, int K, int n0, int ncols, bf16_t* dst, LAS float* tile, int wg, int nwg) {
    const int ntn = (ncols + 63) >> 6, ntk = K >> 6, tid = otid();
    for (int t = wg; t < ntn * ntk; t += nwg) {
        const int tn = t / ntk, tk = t - tn * ntk, k0 = tk * 64, nb = tn * 64;
#pragma unroll
        for (int i = 0; i < 2; ++i) { const int idx = tid + i * 512, kk = idx >> 4, n4 = (idx & 15) * 4;
            f32x4 v = (f32x4){0.f, 0.f, 0.f, 0.f};
            if (nb + n4 < ncols) v = *(const f32x4*)(src + (size_t)(k0 + kk) * ld + n0 + nb + n4);
            tile[kk * 65 + n4 + 0] = v[0]; tile[kk * 65 + n4 + 1] = v[1]; tile[kk * 65 + n4 + 2] = v[2]; tile[kk * 65 + n4 + 3] = v[3]; }
        __syncthreads();
        { const int nn = tid >> 3, k8 = (tid & 7) * 8;
          if (nb + nn < ncols) { const LAS float* s = tile + k8 * 65 + nn;
              u32x4 o; o[0] = pk2(s[0], s[65]); o[1] = pk2(s[130], s[195]); o[2] = pk2(s[260], s[325]); o[3] = pk2(s[390], s[455]);
              *(u32x4*)(dst + (size_t)(nb + nn) * K + k0 + k8) = o; } }
        __syncthreads();
    }
}

__device__ __forceinline__ void phase_mod(const P& p, LAS unsigned char* lds) {
    const float* c = p.in[I_C]; const float* cc = p.in[I_CCTX]; const float* wm = p.in[I_WMOD]; const float* bm = p.in[I_BMOD];
    float* MOD = (float*)(p.ws + OFF_MOD);
    LAS float* red = (LAS float*)lds;
    const int tid = otid();
    for (int blk = blockIdx.x; blk < 256; blk += gridDim.x) {
        const int l = blk >> 6, col0 = (blk & 63) * 96;
        if (tid < 384) {
            const int cgp = tid % 24, ks = tid / 24;
            f32x4 a0 = (f32x4){0.f, 0.f, 0.f, 0.f}, a1 = a0;
            const float* w = wm + (size_t)l * 1024 * 6144 + col0 + cgp * 4;
#pragma unroll 8
            for (int k = ks * 64; k < ks * 64 + 64; ++k) {
                const f32x4 wv = *(const f32x4*)(w + (size_t)k * 6144);
                const float s0 = silu_(c[k]), s1 = silu_(cc[k]);
                a0 += wv * s0; a1 += wv * s1;
            }
            LAS f32x4* r4 = (LAS f32x4*)red;
            r4[(ks * 24 + cgp) * 2 + 0] = a0; r4[(ks * 24 + cgp) * 2 + 1] = a1;
        }
        __syncthreads();
        if (tid < 192) {
            const int col = tid % 96, s = tid / 96;
            float sum = 0.f;
#pragma unroll
            for (int k2 = 0; k2 < 16; ++k2) sum += red[((k2 * 24 + (col >> 2)) * 2 + s) * 4 + (col & 3)];
            MOD[((size_t)l * 2 + s) * 6144 + col0 + col] = sum + bm[l * 6144 + col0 + col];
        }
        __syncthreads();
    }
}

template <bool FROM_INPUT>
__device__ __forceinline__ void phase_norm(const P& p, int l, const float* gamma, int shift_idx, int scale_idx) {
    float* H = (float*)(p.ws + OFF_H); bf16_t* HN = (bf16_t*)(p.ws + OFF_HN);
    const float* MOD = (const float*)(p.ws + OFF_MOD) + (size_t)l * 2 * 6144;
    const int tid_ = otid(); const int wave = tid_ >> 6, lane = tid_ & 63;
    for (int row = blockIdx.x * 8 + wave; row < L; row += gridDim.x * 8) {
        const float* src = FROM_INPUT ? (row < NCTX ? p.in[I_CTX] + (size_t)row * 1024 : p.in[I_X] + (size_t)(row - NCTX) * 1024) : H + (size_t)row * 1024;
        f32x4 v[4]; float ss = 0.f;
#pragma unroll
        for (int j = 0; j < 4; ++j) { v[j] = *(const f32x4*)(src + j * 256 + lane * 4); ss += (v[j][0] * v[j][0] + v[j][1] * v[j][1]) + (v[j][2] * v[j][2] + v[j][3] * v[j][3]); }
        ss = wave_sum(ss);
        const float rstd = rsqrtf(ss * (1.f / 1024.f) + 1e-6f);
        const float* m = MOD + (row < NCTX ? 6144 : 0);
#pragma unroll
        for (int j = 0; j < 4; ++j) { const int col = j * 256 + lane * 4;
            const f32x4 g = *(const f32x4*)(gamma + col), sh = *(const f32x4*)(m + shift_idx * 1024 + col), sc = *(const f32x4*)(m + scale_idx * 1024 + col);
            const f32x4 o = v[j] * rstd * g * (sc + 1.f) + sh;
            *(u32x2*)(HN + (size_t)row * 1024 + col) = (u32x2){pk2(o[0], o[1]), pk2(o[2], o[3])};
            if (FROM_INPUT) *(f32x4*)(H + (size_t)row * 1024 + col) = v[j]; }
    }
}

constexpr int TT = 13;
__device__ __forceinline__ void phase_prep(const P& p, int l, LAS unsigned char* lds) {
    const bf16_t* R = (const bf16_t*)(p.ws + OFF_R); const bf16_t* PG = (const bf16_t*)(p.ws + OFF_PG);
    bf16_t* B = (bf16_t*)(p.ws + OFF_B); bf16_t* XL = (bf16_t*)(p.ws + OFF_XL);
    bf16_t* GLAD = (bf16_t*)(p.ws + OFF_GLAD); bf16_t* GDNC = (bf16_t*)(p.ws + OFF_GDNC); float* GDNGB = (float*)(p.ws + OFF_GDNGB);
    const float* mu = p.in[I_RWMU] + (size_t)l * 2 * 1920;
    const float* kkw = p.in[I_RWKK] + l * 512;
    const float* ga2 = p.in[I_GLAA2] + (size_t)l * 2 * 16 * 256; const float* gab = p.in[I_GLAAB] + l * 512;
    const float* cw = p.in[I_GDNCONV] + (size_t)l * 5 * 1536; const float* alog = p.in[I_GDNALOG] + l * 8; const float* dtb = p.in[I_GDNDT] + l * 8;
    LAS float* gal = (LAS float*)lds;
    LAS float* red = gal + TT * 32;
    const int tid = otid(), wave = tid >> 6;
    const int c = tid;
    const int gz = tid >> 8, gk = tid & 255;
    for (int tile = blockIdx.x; tile < L / TT; tile += gridDim.x) {
        const int t0 = tile * TT;
        if (tid < TT * 32) { const int tt = tid >> 5, e = tid & 31; gal[tt * 32 + e] = bf2f(PG[(size_t)(t0 + tt) * PG_LD + GLA_AL + e]); }
        {
            float xr[TT + 2], xk[TT + 2], xv[TT + 2], xe[TT + 2];
#pragma unroll
            for (int i = 0; i < TT + 2; ++i) { const int rr = t0 - 1 + i;
                if (rr >= 0 && rr < L) { const bf16_t* rp = R + (size_t)rr * R_LD + c; xr[i] = bf2f(rp[0]); xk[i] = bf2f(rp[512]); xv[i] = bf2f(rp[1024]); xe[i] = (c < 384) ? bf2f(rp[1536]) : 0.f; }
                else { xr[i] = 0.f; xk[i] = 0.f; xv[i] = 0.f; xe[i] = 0.f; } }
            const float mr0 = mu[c], mr1 = mu[1920 + c], mk0 = mu[512 + c], mk1 = mu[1920 + 512 + c], mv0 = mu[1024 + c], mv1 = mu[1920 + 1024 + c];
            const float me0 = (c < 384) ? mu[1536 + c] : 0.f, me1 = (c < 384) ? mu[1920 + 1536 + c] : 0.f;
            const float kkc = kkw[c];
#pragma unroll
            for (int tt = 0; tt < TT; ++tt) {
                const int t = t0 + tt;
                const float hp = (t != 0 && t != NCTX) ? 1.f : 0.f, hn = (t != NCTX - 1 && t != L - 1) ? 1.f : 0.f;
                const float r = mr0 * hp * xr[tt] + (1.f - mr0 - mr1) * xr[tt + 1] + mr1 * hn * xr[tt + 2];
                const float k = mk0 * hp * xk[tt] + (1.f - mk0 - mk1) * xk[tt + 1] + mk1 * hn * xk[tt + 2];
                const float v = mv0 * hp * xv[tt] + (1.f - mv0 - mv1) * xv[tt + 1] + mv1 * hn * xv[tt + 2];
                float e = me0 * hp * xe[tt] + (1.f - me0 - me1) * xe[tt + 1] + me1 * hn * xe[tt + 2];
                if (c < 128) e = 2.f * sigmoid_(2.f * e) - 1.f; else if (c >= 256 && c < 384) e = sigmoid_(e); else if (c >= 384) e = 0.f;
                const float kr = k * kkc;
                const float ssq = wave_sum(kr * kr);
                bf16_t* bp = B + (size_t)t * 4096 + c;
                bp[0] = f2bf(r); bp[512] = f2bf(k); bp[1024] = f2bf(v); bp[1536] = f2bf(kr * rsqrtf(ssq + 1e-12f));
                if (c < 384) XL[(size_t)t * 384 + c] = f2bf(e);
            }
        }
        __syncthreads();
        {
        float ga2v[16];
#pragma unroll
        for (int e = 0; e < 16; ++e) ga2v[e] = ga2[(gz * 16 + e) * 256 + gk];
        const float gabv = gab[gz * 256 + gk];
#pragma unroll
        for (int tt = 0; tt < TT; ++tt) {
            float zv = gabv;
#pragma unroll
            for (int e = 0; e < 16; ++e) zv += gal[tt * 32 + gz * 16 + e] * ga2v[e];
            const float la = __logf(sigmoid_(zv)) * (1.f / 16.f);
            GLAD[(size_t)(t0 + tt) * 512 + tid] = f2bf(1.f - __expf(la));
        }
        }
        {
            float cwv[5], xv[TT + 4];
#pragma unroll
            for (int i = 0; i < 5; ++i) cwv[i] = cw[i * 1536 + 1024 + c];
#pragma unroll
            for (int i = 0; i < TT + 4; ++i) { const int rr = t0 - 2 + i; xv[i] = (rr >= 0 && rr < L) ? bf2f(PG[(size_t)rr * PG_LD + GDN_QKV + 1024 + c]) : 0.f; }
#pragma unroll
            for (int tt = 0; tt < TT; ++tt) { const int t = t0 + tt; float sv = 0.f;
#pragma unroll
                for (int i = 0; i < 5; ++i) { const int rr = t + i - 2; const bool ok_ = (rr >= 0) && (rr < L) && ((rr < NCTX) == (t < NCTX)); if (ok_) sv += xv[tt + i] * cwv[i]; }
                GDNC[(size_t)t * 1536 + 1024 + c] = f2bf(silu_(sv)); }
        }
        float oq[TT], ok[TT];
        {
            float cwq[5], cwk[5], xq[TT + 4], xk[TT + 4];
#pragma unroll
            for (int i = 0; i < 5; ++i) { cwq[i] = cw[i * 1536 + c]; cwk[i] = cw[i * 1536 + 512 + c]; }
#pragma unroll
            for (int i = 0; i < TT + 4; ++i) { const int rr = t0 - 2 + i;
                if (rr >= 0 && rr < L) { const bf16_t* rp = PG + (size_t)rr * PG_LD + GDN_QKV + c; xq[i] = bf2f(rp[0]); xk[i] = bf2f(rp[512]); } else { xq[i] = 0.f; xk[i] = 0.f; } }
#pragma unroll
            for (int tt = 0; tt < TT; ++tt) {
                const int t = t0 + tt; float sq = 0.f, sk = 0.f;
#pragma unroll
                for (int i = 0; i < 5; ++i) { const int rr = t + i - 2; const bool ok_ = (rr >= 0) && (rr < L) && ((rr < NCTX) == (t < NCTX));
                    if (ok_) { sq += xq[tt + i] * cwq[i]; sk += xk[tt + i] * cwk[i]; } }
                oq[tt] = silu_(sq); ok[tt] = silu_(sk);
                const float pq = wave_sum(oq[tt] * oq[tt]), pk = wave_sum(ok[tt] * ok[tt]);
                if ((tid & 63) == 0) { red[(tt * 8 + wave) * 2 + 0] = pq; red[(tt * 8 + wave) * 2 + 1] = pk; }
            }
        }
        __syncthreads();
#pragma unroll
        for (int tt = 0; tt < TT; ++tt) {
            const int w0i = (wave >> 1) * 2;
            const float ssq = red[(tt * 8 + w0i) * 2 + 0] + red[(tt * 8 + w0i + 1) * 2 + 0], ssk = red[(tt * 8 + w0i) * 2 + 1] + red[(tt * 8 + w0i + 1) * 2 + 1];
            bf16_t* gp = GDNC + (size_t)(t0 + tt) * 1536 + c;
            gp[0] = f2bf(oq[tt] * rsqrtf(ssq + 1e-12f) * 0.08838834764831845f); gp[512] = f2bf(ok[tt] * rsqrtf(ssk + 1e-12f));
        }
        if (tid < TT * 16) { const int tt = tid >> 4, j = tid & 15, t = t0 + tt;
            float o;
            if (j < 8) { const float a = bf2f(PG[(size_t)t * PG_LD + GDN_A + j]); o = __expf(-__expf(alog[j]) * softplus_(a + dtb[j])); }
            else o = sigmoid_(bf2f(PG[(size_t)t * PG_LD + GDN_B + (j - 8)]));
            GDNGB[t * 16 + j] = o; }
        __syncthreads();
    }
}
__device__ __forceinline__ void build_wl(const P& p, int l, int wg, int nwg) {
    const float* w2 = p.in[I_RWW2] + (size_t)l * 2 * 64 * 512; const float* a2 = p.in[I_RWA2] + (size_t)l * 2 * 64 * 512; const float* g2 = p.in[I_RWG2] + (size_t)l * 128 * 512;
    bf16_t* WL = (bf16_t*)(p.ws + OFF_WL);
    const int tid = otid();
    for (int it = wg * 512 + tid; it < 2560 * 48; it += nwg * 512) {
        const int kc = it / 2560, n = it - kc * 2560, k0 = kc * 8, blk = n >> 9, cc = n & 511;
        const float* src = nullptr; int kb = 0, kn = 0;
        if (blk == 0) { src = w2; kb = 0; kn = 64; } else if (blk == 1) { src = w2 + 64 * 512; kb = 64; kn = 64; }
        else if (blk == 2) { src = a2; kb = 128; kn = 64; } else if (blk == 3) { src = a2 + 64 * 512; kb = 192; kn = 64; }
        else { src = g2; kb = 256; kn = 128; }
        float v[8];
#pragma unroll
        for (int j = 0; j < 8; ++j) { const int k = k0 + j - kb; v[j] = (k >= 0 && k < kn) ? src[(size_t)k * 512 + cc] : 0.f; }
        u32x4 o; o[0] = pk2(v[0], v[1]); o[1] = pk2(v[2], v[3]); o[2] = pk2(v[4], v[5]); o[3] = pk2(v[6], v[7]);
        *(u32x4*)(WL + (size_t)n * 384 + k0) = o;
    }
}

constexpr int TB = 32, NBLK = L / TB;
__device__ __forceinline__ int tok_seq(int z, int j) { return z == 0 ? j : (j < NCTX ? NCTX - 1 - j : L - 1 - (j - NCTX)); }
__device__ __forceinline__ int tok_gla(int z, int j) {
    if (j < NCTX) return z == 0 ? j : NCTX - 1 - j;
    const int jj = j - NCTX, pp = z == 0 ? jj : NLAT - 1 - jj;
    return NCTX + (pp & 255) * 64 + (pp >> 8);
}

template <int NCW> struct ScanRole {
    bool cons, prod; int ct;
    __device__ __forceinline__ ScanRole(int tid) {
        const int w = tid >> 6, lane = tid & 63;
        if (NCW == 4) { cons = w < 4; prod = !cons; ct = tid & 255; }
        else { cons = w < 2; prod = (w & 2) != 0; ct = cons ? tid : ((((w >> 2) << 1) | (w & 1)) * 64 + lane); }
    }
};
__device__ __forceinline__ float rowpair_sum(float x) {
    const unsigned u = __float_as_uint(x); auto r = __builtin_amdgcn_permlane16_swap(u, u, false, false);
    return __uint_as_float(r[0]) + __uint_as_float(r[1]);
}
#define SCAN_BARRIER() asm volatile("s_waitcnt lgkmcnt(0)\n\ts_barrier" ::: "memory")
__device__ __forceinline__ float bfraw2f(unsigned short b) { return __uint_as_float(((unsigned)b) << 16); }
__device__ __forceinline__ f32x4 bf4(u32x2 r) { return (f32x4){__uint_as_float(r[0] << 16), __uint_as_float(r[0] & 0xffff0000u), __uint_as_float(r[1] << 16), __uint_as_float(r[1] & 0xffff0000u)}; }

__device__ __forceinline__ void scan_rwkv(const P& p, int l, int unit, LAS unsigned char* lds) {
    const int z = unit >> 5, h = (unit >> 2) & 7, rq = unit & 3;
    const bf16_t* B = (const bf16_t*)(p.ws + OFF_B); bf16_t* Y = (bf16_t*)(p.ws + OFF_PG) + YRW_COL + z * 512 + h * 64 + rq * 16;
    const float* kaw = p.in[I_RWKA] + l * 512 + h * 64;
    LAS float* vec = (LAS float*)lds;
    LAS float* vv = vec + 2 * TB * 320;
    LAS float* yo = vv + 2 * TB * 16;
    const int tid = otid(); const ScanRole<4> role(tid); const int ct = role.ct; const bool prod = role.prod, cons = role.cons;
    u32x2 pr[2], pk[2], pkk[2], pa[2], pw[2]; unsigned short pv[2];
    const f32x4 kac4 = *(const f32x4*)(kaw + (ct & 15) * 4);
    auto p_load = [&](int blk) {
#pragma unroll
        for (int i = 0; i < 2; ++i) { const int idx = ct + i * 256, s = idx >> 4, n4 = idx & 15; const int t = tok_seq(z, blk * TB + s);
            const bf16_t* bp = B + (size_t)t * 4096 + h * 64 + n4 * 4;
            pr[i] = *(const u32x2*)(bp); pk[i] = *(const u32x2*)(bp + 512); pkk[i] = *(const u32x2*)(bp + 1536); pa[i] = *(const u32x2*)(bp + 2048 + z * 512); pw[i] = *(const u32x2*)(bp + 3072 + z * 512); }
#pragma unroll
        for (int i = 0; i < 2; ++i) { const int idx = ct + i * 256, s = idx >> 4, r = idx & 15; const int t = tok_seq(z, blk * TB + s); pv[i] = B[(size_t)t * 4096 + 1024 + h * 64 + rq * 16 + r]; }
    };
    auto p_write = [&](int buf) {
#pragma unroll
        for (int i = 0; i < 2; ++i) { const int idx = ct + i * 256, s = idx >> 4, n4 = idx & 15;
            LAS float* d = vec + ((buf * TB + s) * 16 + n4) * 20;
            const f32x4 kk = bf4(pkk[i]), a = bf4(pa[i]);
            *(LAS f32x4*)(d) = kk; *(LAS f32x4*)(d + 4) = 1.f - bf4(pw[i]); *(LAS f32x4*)(d + 8) = kk * a;
            *(LAS f32x4*)(d + 12) = bf4(pk[i]) * ((a - 1.f) * kac4 + 1.f); *(LAS f32x4*)(d + 16) = bf4(pr[i]); }
#pragma unroll
        for (int i = 0; i < 2; ++i) vv[buf * TB * 16 + ct + i * 256] = bfraw2f(pv[i]);
    };
    auto p_yout = [&](int blk) {
        const int buf = blk & 1;
#pragma unroll
        for (int i = 0; i < 2; ++i) { const int idx = ct + i * 256, s = idx >> 4, r = idx & 15; const int t = tok_seq(z, blk * TB + s);
            const f32x4 y0 = *(const LAS f32x4*)(yo + (buf * TB * 16 + idx) * 8), y1 = *(const LAS f32x4*)(yo + (buf * TB * 16 + idx) * 8 + 4);
            Y[(size_t)t * PG_LD + r] = f2bf(((y0[0] + y0[1]) + (y0[2] + y0[3])) + ((y1[0] + y1[1]) + (y1[2] + y1[3]))); }
    };
    const int irow = (ct >> 4) & 15, ks = ct & 15;
    const LAS float* vbase = vec; const LAS float* vvb = vv; LAS float* yob = yo;
    f32x2 S0 = (f32x2){0.f, 0.f}, S1 = S0;
    struct Vx { f32x4 kk, w, b, k, r; float v; };
    auto c_ld = [&](Vx& x, int buf, int s) {
        const LAS float* d = vbase + s * 320;
        x.kk = *(const LAS f32x4*)(d); x.w = *(const LAS f32x4*)(d + 4); x.b = *(const LAS f32x4*)(d + 8); x.k = *(const LAS f32x4*)(d + 12);
        x.r = *(const LAS f32x4*)(d + 16); x.v = vvb[s * 16];
    };
    float sa = 0.f;
    auto c_step = [&](const Vx& x, const f32x4& kkn, int buf, int s) {
        const f32x2 vv2 = (f32x2){x.v, x.v};
        const f32x2 pre0 = S0 * (f32x2){x.w[0], x.w[1]} + vv2 * (f32x2){x.k[0], x.k[1]}, pre1 = S1 * (f32x2){x.w[2], x.w[3]} + vv2 * (f32x2){x.k[2], x.k[3]};
        const f32x2 nsa = (f32x2){-sa, -sa};
        S0 = nsa * (f32x2){x.b[0], x.b[1]} + pre0;
        S1 = nsa * (f32x2){x.b[2], x.b[3]} + pre1;
        const f32x2 y2 = S0 * (f32x2){x.r[0], x.r[1]} + S1 * (f32x2){x.r[2], x.r[3]};
        const f32x2 s2 = S0 * (f32x2){kkn[0], kkn[1]} + S1 * (f32x2){kkn[2], kkn[3]};
        float yp = y2[0] + y2[1], sp = s2[0] + s2[1];
        yp += dpp_<0xB1>(yp); sp += dpp_<0xB1>(sp); sp += dpp_<0x4E>(sp);
        sp += dpp_<0x141>(sp); sp += dpp_<0x140>(sp);
        sa = sp;
        yob[s * 128] = yp;
    };
    if (cons) __builtin_amdgcn_s_setprio(3);
    if (prod) { p_load(0); p_write(0); p_load(1); }
    SCAN_BARRIER();
    for (int b = 0; b < NBLK; ++b) {
        if (prod) {
            if (b + 1 < NBLK) p_write((b + 1) & 1);
            if (b + 2 < NBLK) p_load(b + 2);
            if (b > 0) p_yout(b - 1);
        } else if (cons) {
            const int buf = b & 1;
            vbase = vec + (buf * TB * 16 + ks) * 20; vvb = vv + buf * TB * 16 + irow; yob = yo + (buf * TB * 16 + irow) * 8 + (ks >> 1);
            Vx xa, xb;
            c_ld(xa, buf, 0);
            { const f32x2 s2 = S0 * (f32x2){xa.kk[0], xa.kk[1]} + S1 * (f32x2){xa.kk[2], xa.kk[3]}; sa = reduce16(s2[0] + s2[1]); }
#pragma unroll
            for (int s = 0; s < TB; s += 2) {
                c_ld(xb, buf, s + 1); c_step(xa, xb.kk, buf, s);
                c_ld(xa, buf, s + 2);
                c_step(xb, xa.kk, buf, s + 1);
            }
        }
        SCAN_BARRIER();
    }
    __builtin_amdgcn_s_setprio(0);
    if (prod) p_yout(NBLK - 1);
    SCAN_BARRIER();
}

__device__ __forceinline__ void scan_gla(const P& p, int l, int unit, LAS unsigned char* lds) {
    const int z = unit >> 4, h = (unit >> 2) & 3, cb = unit & 3;
    const bf16_t* PG = (const bf16_t*)(p.ws + OFF_PG); const bf16_t* GLAD = (const bf16_t*)(p.ws + OFF_GLAD);
    bf16_t* O = (bf16_t*)(p.ws + OFF_R) + z * 512 + h * 128 + cb * 32;
    LAS float* vec = (LAS float*)lds;
    LAS float* vv = vec + 2 * TB * 192;
    LAS float* yo = vv + 2 * TB * 32;
    const int tid = otid(); const ScanRole<4> role(tid); const int ct = role.ct; const bool prod = role.prod, cons = role.cons;
    unsigned short pq[8], pk[8], pa[8], pv[4];
    auto p_load = [&](int blk) {
#pragma unroll
        for (int i = 0; i < 8; ++i) { const int idx = ct + i * 256, s = idx >> 6, n = idx & 63; const int t = tok_gla(z, blk * TB + s);
            const bf16_t* bp = PG + (size_t)t * PG_LD + h * 64 + n;
            pq[i] = bp[GLA_Q]; pk[i] = bp[GLA_K]; pa[i] = GLAD[(size_t)t * 512 + z * 256 + h * 64 + n]; }
#pragma unroll
        for (int i = 0; i < 4; ++i) { const int idx = ct + i * 256, s = idx >> 5, r = idx & 31; const int t = tok_gla(z, blk * TB + s);
            pv[i] = PG[(size_t)t * PG_LD + GLA_V + h * 128 + cb * 32 + r]; }
    };
    auto p_write = [&](int buf) {
#pragma unroll
        for (int i = 0; i < 8; ++i) { const int idx = ct + i * 256, s = idx >> 6, n = idx & 63;
            LAS float* d = vec + ((buf * TB + s) * 8 + (n >> 3)) * 24 + (n & 7);
            d[0] = bfraw2f(pq[i]) * 0.125f; d[8] = bfraw2f(pk[i]); d[16] = 1.f - bfraw2f(pa[i]); }
#pragma unroll
        for (int i = 0; i < 4; ++i) vv[buf * TB * 32 + ct + i * 256] = bfraw2f(pv[i]);
    };
    auto p_yout = [&](int blk) {
        const int buf = blk & 1;
#pragma unroll
        for (int i = 0; i < 4; ++i) { const int idx = ct + i * 256, s = idx >> 5, r = idx & 31; const int t = tok_gla(z, blk * TB + s);
            const f32x4 y0 = *(const LAS f32x4*)(yo + (buf * TB * 32 + idx) * 4);
            O[(size_t)t * R_LD + r] = f2bf((y0[0] + y0[1]) + (y0[2] + y0[3])); }
    };
    const int icol = (ct >> 3) & 31, ks = ct & 7;
    const LAS float* vbase = vec; const LAS float* vvb = vv; LAS float* yob = yo;
    f32x2 S[4];
#pragma unroll
    for (int j = 0; j < 4; ++j) S[j] = (f32x2){0.f, 0.f};
    struct Vx { f32x4 q0, q1, k0, k1, a0, a1; float v; };
    auto c_ld = [&](Vx& x, int buf, int s) {
        const LAS float* d = vbase + s * 192;
        x.q0 = *(const LAS f32x4*)(d); x.q1 = *(const LAS f32x4*)(d + 4); x.k0 = *(const LAS f32x4*)(d + 8); x.k1 = *(const LAS f32x4*)(d + 12);
        x.a0 = *(const LAS f32x4*)(d + 16); x.a1 = *(const LAS f32x4*)(d + 20); x.v = vvb[s * 32];
    };
    auto c_upd = [&](const Vx& x) -> float {
        const f32x2 vv2 = (f32x2){x.v, x.v};
        S[0] = S[0] * (f32x2){x.a0[0], x.a0[1]} + vv2 * (f32x2){x.k0[0], x.k0[1]};
        S[1] = S[1] * (f32x2){x.a0[2], x.a0[3]} + vv2 * (f32x2){x.k0[2], x.k0[3]};
        S[2] = S[2] * (f32x2){x.a1[0], x.a1[1]} + vv2 * (f32x2){x.k1[0], x.k1[1]};
        S[3] = S[3] * (f32x2){x.a1[2], x.a1[3]} + vv2 * (f32x2){x.k1[2], x.k1[3]};
        const f32x2 y2 = (S[0] * (f32x2){x.q0[0], x.q0[1]} + S[1] * (f32x2){x.q0[2], x.q0[3]}) + (S[2] * (f32x2){x.q1[0], x.q1[1]} + S[3] * (f32x2){x.q1[2], x.q1[3]});
        return y2[0] + y2[1];
    };
    if (cons) __builtin_amdgcn_s_setprio(3);
    if (prod) { p_load(0); p_write(0); p_load(1); }
    SCAN_BARRIER();
    for (int b = 0; b < NBLK; ++b) {
        if (prod) {
            if (b + 1 < NBLK) p_write((b + 1) & 1);
            if (b + 2 < NBLK) p_load(b + 2);
            if (b > 0) p_yout(b - 1);
        } else if (cons) {
            const int buf = b & 1;
            vbase = vec + (buf * TB * 8 + ks) * 24; vvb = vv + buf * TB * 32 + icol; yob = yo + (buf * TB * 32 + icol) * 4 + (ks >> 1);
            Vx xa, xb;
            c_ld(xa, buf, 0);
#pragma unroll
            for (int s = 0; s < TB; s += 2) {
                c_ld(xb, buf, s + 1);
                float ya = c_upd(xa);
                c_ld(xa, buf, s + 2);
                float yb = c_upd(xb);
                ya += dpp_<0xB1>(ya); yb += dpp_<0xB1>(yb);
                yob[s * 128] = ya; yob[(s + 1) * 128] = yb;
            }
        }
        SCAN_BARRIER();
    }
    __builtin_amdgcn_s_setprio(0);
    if (prod) p_yout(NBLK - 1);
    SCAN_BARRIER();
}

__device__ __forceinline__ void scan_gdn(const P& p, int l, int unit, LAS unsigned char* lds) {
    const int z = unit >> 6, h = (unit >> 4) & 3, cb = unit & 15;
    const bf16_t* GDNC = (const bf16_t*)(p.ws + OFF_GDNC); const float* GDNGB = (const float*)(p.ws + OFF_GDNGB);
    bf16_t* O = (bf16_t*)(p.ws + OFF_R) + 1024 + z * 512 + h * 128 + cb * 8;
    LAS float* vec = (LAS float*)lds;
    LAS float* vv = vec + 2 * TB * 384;
    LAS float* sc = vv + 2 * TB * 8;
    LAS float* yo = sc + 2 * TB * 2;
    const int tid = otid(); const ScanRole<4> role(tid); const int ct = role.ct; const bool prod = role.prod, cons = role.cons;
    u32x2 pq[4], pk[4]; unsigned short pv; float psc = 0.f;
    auto p_load = [&](int blk) {
#pragma unroll
        for (int i = 0; i < 4; ++i) { const int idx = ct + i * 256, s = idx >> 5, n4 = idx & 31; const int t = tok_seq(z, blk * TB + s);
            const bf16_t* bp = GDNC + (size_t)t * 1536 + h * 128 + n4 * 4;
            pq[i] = *(const u32x2*)(bp); pk[i] = *(const u32x2*)(bp + 512); }
        { const int s = ct >> 3, r = ct & 7; const int t = tok_seq(z, blk * TB + s); pv = GDNC[(size_t)t * 1536 + 1024 + h * 128 + cb * 8 + r]; }
        if (ct < 64) { const int s = ct >> 1, w = ct & 1; const int t = tok_seq(z, blk * TB + s); psc = GDNGB[t * 16 + w * 8 + z * 4 + h]; }
    };
    auto p_write = [&](int buf) {
#pragma unroll
        for (int i = 0; i < 4; ++i) { const int idx = ct + i * 256, s = idx >> 5, n4 = idx & 31;
            LAS float* d = vec + ((buf * TB + s) * 32 + n4) * 12;
            *(LAS f32x4*)(d) = bf4(pq[i]); *(LAS f32x4*)(d + 4) = bf4(pk[i]); }
        vv[buf * TB * 8 + ct] = bfraw2f(pv);
        if (ct < 64) sc[buf * TB * 2 + ct] = psc;
    };
    auto p_yout = [&](int blk) {
        const int buf = blk & 1; const int s = ct >> 3, r = ct & 7; const int t = tok_seq(z, blk * TB + s);
        const f32x4 y0 = *(const LAS f32x4*)(yo + (buf * TB * 8 + ct) * 8), y1 = *(const LAS f32x4*)(yo + (buf * TB * 8 + ct) * 8 + 4);
        O[(size_t)t * R_LD + r] = f2bf(((y0[0] + y0[1]) + (y0[2] + y0[3])) + ((y1[0] + y1[1]) + (y1[2] + y1[3])));
    };
    const int icol = (ct >> 5) & 7, ks = ct & 31;
    const LAS float* vbase = vec; const LAS float* vvb = vv; const LAS float* scb = sc; LAS float* yob = yo;
    f32x2 S0 = (f32x2){0.f, 0.f}, S1 = S0;
    struct Vx { f32x4 q, k; float v; f32x2 gb; };
    auto c_ld = [&](Vx& x, int buf, int s) {
        const LAS float* d = vbase + s * 384;
        x.q = *(const LAS f32x4*)(d); x.k = *(const LAS f32x4*)(d + 4);
        x.v = vvb[s * 8]; x.gb = *(const LAS f32x2*)(scb + s * 2);
    };
    float dd = 0.f;
    auto c_step = [&](const Vx& x, const f32x4& kn, int buf, int s) {
        const float eg = x.gb[0];
        const f32x2 eg2 = (f32x2){eg, eg};
        const f32x2 pre0 = S0 * eg2, pre1 = S1 * eg2;
        const float cc = x.gb[1] * (x.v - eg * dd);
        const f32x2 cc2 = (f32x2){cc, cc};
        S0 = cc2 * (f32x2){x.k[0], x.k[1]} + pre0;
        S1 = cc2 * (f32x2){x.k[2], x.k[3]} + pre1;
        const f32x2 y2 = S0 * (f32x2){x.q[0], x.q[1]} + S1 * (f32x2){x.q[2], x.q[3]};
        const f32x2 d2 = S0 * (f32x2){kn[0], kn[1]} + S1 * (f32x2){kn[2], kn[3]};
        float yp = y2[0] + y2[1], dp = d2[0] + d2[1];
        yp += dpp_<0xB1>(yp); dp += dpp_<0xB1>(dp); yp += dpp_<0x4E>(yp); dp += dpp_<0x4E>(dp);
        dp += dpp_<0x141>(dp); dp += dpp_<0x140>(dp);
        dp = rowpair_sum(dp);
        dd = dp;
        yob[s * 64] = yp;
    };
    if (cons) __builtin_amdgcn_s_setprio(3);
    if (prod) { p_load(0); p_write(0); p_load(1); }
    SCAN_BARRIER();
    for (int b = 0; b < NBLK; ++b) {
        if (prod) {
            if (b + 1 < NBLK) p_write((b + 1) & 1);
            if (b + 2 < NBLK) p_load(b + 2);
            if (b > 0) p_yout(b - 1);
        } else if (cons) {
            const int buf = b & 1;
            vbase = vec + (buf * TB * 32 + ks) * 12; vvb = vv + buf * TB * 8 + icol; scb = sc + buf * TB * 2; yob = yo + (buf * TB * 8 + icol) * 8 + (ks >> 2);
            Vx xa, xb;
            c_ld(xa, buf, 0);
            { const f32x2 d2 = S0 * (f32x2){xa.k[0], xa.k[1]} + S1 * (f32x2){xa.k[2], xa.k[3]}; dd = rowpair_sum(reduce16(d2[0] + d2[1])); }
#pragma unroll
            for (int s = 0; s < TB; s += 2) {
                c_ld(xb, buf, s + 1); c_step(xa, xb.k, buf, s);
                c_ld(xa, buf, s + 2);
                c_step(xb, xa.k, buf, s + 1);
            }
        }
        SCAN_BARRIER();
    }
    __builtin_amdgcn_s_setprio(0);
    if (prod) p_yout(NBLK - 1);
    SCAN_BARRIER();
}

__device__ __forceinline__ void unpack8(const u32x4 r, float (&f)[8]) {
#pragma unroll
    for (int j = 0; j < 4; ++j) { f[2 * j] = __uint_as_float(r[j] << 16); f[2 * j + 1] = __uint_as_float(r[j] & 0xffff0000u); }
}
__device__ __forceinline__ u32x4 pack8(const float (&f)[8]) { u32x4 o; o[0] = pk2(f[0], f[1]); o[1] = pk2(f[2], f[3]); o[2] = pk2(f[4], f[5]); o[3] = pk2(f[6], f[7]); return o; }
__device__ __forceinline__ void phase_post(const P& p, int l, LAS unsigned char* lds) {
    const bf16_t* PG = (const bf16_t*)(p.ws + OFF_PG); const bf16_t* Rb = (const bf16_t*)(p.ws + OFF_R); const bf16_t* B = (const bf16_t*)(p.ws + OFF_B);
    const bf16_t* RWG = (const bf16_t*)(p.ws + OFF_RWG);
    bf16_t* YC = (bf16_t*)(p.ws + OFF_GDNC);
    const int tid = otid(), wave = tid >> 6, lane = tid & 63, c0 = lane * 8;
    float lnw[8], lnb[8], kac[8], rkc[8], gng[8], dng[8];
#pragma unroll
    for (int j = 0; j < 8; ++j) { lnw[j] = p.in[I_RWLNW][l * 512 + c0 + j]; lnb[j] = p.in[I_RWLNB][l * 512 + c0 + j]; kac[j] = p.in[I_RWKA][l * 512 + c0 + j]; rkc[j] = p.in[I_RWRK][l * 512 + c0 + j];
        gng[j] = p.in[I_GLANG][l * 128 + ((c0 + j) & 127)]; dng[j] = p.in[I_GDNNG][l * 128 + ((c0 + j) & 127)]; }
#pragma unroll 1
    for (int t = blockIdx.x * 8 + wave; t < L; t += gridDim.x * 8) {
        const bf16_t* pgr = PG + (size_t)t * PG_LD; const bf16_t* br = B + (size_t)t * 4096 + c0; const bf16_t* rr = Rb + (size_t)t * R_LD + c0;
        const u32x4 qy0 = *(const u32x4*)(pgr + YRW_COL + c0), qy1 = *(const u32x4*)(pgr + YRW_COL + 512 + c0);
        const u32x4 qr = *(const u32x4*)(br), qk = *(const u32x4*)(br + 512), qv = *(const u32x4*)(br + 1024), qa0 = *(const u32x4*)(br + 2048), qa1 = *(const u32x4*)(br + 2560);
        const u32x4 qg = *(const u32x4*)(RWG + (size_t)t * 512 + c0);
        const u32x4 qo0 = *(const u32x4*)(rr), qo1 = *(const u32x4*)(rr + 512), qd0 = *(const u32x4*)(rr + 1024), qd1 = *(const u32x4*)(rr + 1536);
        const u32x4 qog = *(const u32x4*)(pgr + GLA_OG + c0), qzg = *(const u32x4*)(pgr + GDN_ZG + c0);
        float a[8], b[8], o[8];
        unpack8(qy0, a); unpack8(qy1, b);
        float s = 0.f;
#pragma unroll
        for (int j = 0; j < 8; ++j) { a[j] += b[j]; s += a[j]; }
        const float mean = reduce8(s) * (1.f / 64.f);
        float s2 = 0.f;
#pragma unroll
        for (int j = 0; j < 8; ++j) { a[j] -= mean; s2 += a[j] * a[j]; }
        const float rstd = rsqrtf(reduce8(s2) * (1.f / 64.f) + 64e-5f);
        {
            float r[8], k[8], z0[8], z1[8];
            unpack8(qr, r); unpack8(qk, k); unpack8(qa0, z0); unpack8(qa1, z1);
            float sb = 0.f;
#pragma unroll
            for (int j = 0; j < 8; ++j) sb += r[j] * rkc[j] * (k[j] * (1.f + (z0[j] - 1.f) * kac[j]) + k[j] * (1.f + (z1[j] - 1.f) * kac[j]));
            const float bon = reduce8(sb);
            unpack8(qv, r); unpack8(qg, k);
#pragma unroll
            for (int j = 0; j < 8; ++j) o[j] = (a[j] * rstd * lnw[j] + lnb[j] + bon * r[j]) * k[j];
            *(u32x4*)(YC + (size_t)t * 512 + c0) = pack8(o);
        }
        unpack8(qo0, a); unpack8(qo1, b);
        s = 0.f;
#pragma unroll
        for (int j = 0; j < 8; ++j) { a[j] += b[j]; s += a[j] * a[j]; }
        float rs = rsqrtf(reduce16(s) * (1.f / 128.f) + 1e-6f);
        unpack8(qog, b);
#pragma unroll
        for (int j = 0; j < 8; ++j) o[j] = a[j] * rs * gng[j] * silu_(b[j]);
        *(u32x4*)(YC + (size_t)L * 512 + (size_t)t * 512 + c0) = pack8(o);
        unpack8(qd0, a); unpack8(qd1, b);
        s = 0.f;
#pragma unroll
        for (int j = 0; j < 8; ++j) { a[j] += b[j]; s += a[j] * a[j]; }
        rs = rsqrtf(reduce16(s) * (1.f / 128.f) + 1e-6f);
        unpack8(qzg, b);
#pragma unroll
        for (int j = 0; j < 8; ++j) o[j] = a[j] * rs * dng[j] * silu_(b[j]);
        *(u32x4*)(YC + (size_t)2 * L * 512 + (size_t)t * 512 + c0) = pack8(o);
    }
}

__device__ __forceinline__ void phase_final(const P& p) {
    const float* H = (const float*)(p.ws + OFF_H); const float* gamma = p.in[I_FINALG];
    const int tid_ = otid(); const int wave = tid_ >> 6, lane = tid_ & 63;
    for (int row = blockIdx.x * 8 + wave; row < NLAT; row += gridDim.x * 8) {
        const float* src = H + (size_t)(row + NCTX) * 1024;
        f32x4 v[4]; float ss = 0.f;
#pragma unroll
        for (int j = 0; j < 4; ++j) { v[j] = *(const f32x4*)(src + j * 256 + lane * 4); ss += (v[j][0] * v[j][0] + v[j][1] * v[j][1]) + (v[j][2] * v[j][2] + v[j][3] * v[j][3]); }
        ss = wave_sum(ss);
        const float rstd = rsqrtf(ss * (1.f / 1024.f) + 1e-6f);
#pragma unroll
        for (int j = 0; j < 4; ++j) { const int col = j * 256 + lane * 4; const f32x4 g = *(const f32x4*)(gamma + col);
            *(f32x4*)(p.out + (size_t)row * 1024 + col) = v[j] * rstd * g; }
    }
}


#define XB_TMO      128
#define XB_XCNT(j)  (256  + 64 * (j))
#define XB_XSUB(j)  (1280 + 64 * (j))
#define XB_XGEN(j)  (2304 + 64 * (j))
#define XB_TOP      3328
#define XB_TOPGEN   3392
#define XCD_BAR_WORDS 3456
#define XB_SPIN_CAP (1u << 18)
__device__ __forceinline__ unsigned xb_ld(unsigned* p)              { return __hip_atomic_load(p, __ATOMIC_RELAXED, __HIP_MEMORY_SCOPE_AGENT); }
__device__ __forceinline__ unsigned xb_add(unsigned* p, unsigned v) { return __hip_atomic_fetch_add(p, v, __ATOMIC_RELAXED, __HIP_MEMORY_SCOPE_AGENT); }
__device__ __forceinline__ unsigned xb_xcc_id() { return (unsigned)__builtin_amdgcn_s_getreg((3 << 11) | 20) & 0xFu; }
#define XB_SPIN(cond, bar) do { unsigned _sp = 0; while (cond) { __builtin_amdgcn_s_sleep(1); \
    if ((++_sp & 255u) == 0u) { if (xb_ld(&(bar)[XB_TMO])) break; if (_sp > XB_SPIN_CAP) { atomicAdd(&(bar)[XB_TMO], 1u); break; } } } } while (0)
struct XcdBarrier { unsigned* bar; unsigned x; volatile LAS unsigned* st; };
__device__ __forceinline__ XcdBarrier xcd_barrier_post(unsigned* bar, volatile LAS unsigned* st) {
    XcdBarrier b; b.bar = bar; b.x = xb_xcc_id(); b.st = st;
    if (threadIdx.x == 0) (void)xb_add(&bar[XB_XCNT(b.x)], 1u);
    return b;
}
__device__ __forceinline__ void xcd_barrier_complete(unsigned* bar, unsigned x, unsigned& nloc, unsigned& nx) {
    const unsigned G = gridDim.x * gridDim.y * gridDim.z;
    unsigned sum, cnt, mine, sp = 0u;
    for (;;) {
        sum = 0u; cnt = 0u; mine = 0u;
#pragma unroll
        for (unsigned j = 0; j < 16; ++j) { const unsigned c = xb_ld(&bar[XB_XCNT(j)]); sum += c; cnt += (c > 0u) ? 1u : 0u; mine = (j == x) ? c : mine; }
        if (sum == G) break;
        __builtin_amdgcn_s_sleep(1);
        if ((++sp & 255u) == 0u) { if (xb_ld(&bar[XB_TMO])) break; if (sp > XB_SPIN_CAP) { atomicAdd(&bar[XB_TMO], 1u); break; } }
    }
    nloc = mine > 0u ? mine : 1u; nx = cnt > 0u ? cnt : 1u;
}
__device__ __forceinline__ void xcd_barrier(const XcdBarrier& b) {
    asm volatile("s_waitcnt vmcnt(0)" ::: "memory");
    __syncthreads();
    if (threadIdx.x == 0) {
        unsigned* bar = b.bar;
        __builtin_amdgcn_s_waitcnt(0);
        unsigned nloc = b.st[0], nx = b.st[1];
        if (nloc == 0u) { xcd_barrier_complete(bar, b.x, nloc, nx); b.st[0] = nloc; b.st[1] = nx; }
        const unsigned old = xb_add(&bar[XB_XSUB(b.x)], 1u);
        const unsigned gen = old / nloc;
        if (old + 1u == (gen + 1u) * nloc) {
            __builtin_amdgcn_fence(__ATOMIC_RELEASE, "agent");
            asm volatile("s_waitcnt vmcnt(0)" ::: "memory");
            const unsigned og = xb_add(&bar[XB_TOP], 1u);
            const unsigned tg = og / nx;
            if (og + 1u == (tg + 1u) * nx) xb_add(&bar[XB_TOPGEN], 1u);
            else XB_SPIN(xb_ld(&bar[XB_TOPGEN]) == tg, bar);
            __builtin_amdgcn_fence(__ATOMIC_ACQUIRE, "agent");
            xb_add(&bar[XB_XGEN(b.x)], 1u);
            asm volatile("s_waitcnt vmcnt(0)" ::: "memory");
        } else {
            XB_SPIN(xb_ld(&bar[XB_XGEN(b.x)]) == gen, bar);
            __builtin_amdgcn_fence(__ATOMIC_ACQUIRE, "agent");
            asm volatile("s_waitcnt vmcnt(0)" ::: "memory");
        }
    }
    __syncthreads();
}

__global__ void __launch_bounds__(512, 2) fwd_megakernel(P p) {
    extern __shared__ __attribute__((aligned(16))) unsigned char shm_raw[];
    LAS unsigned char* lds = (LAS unsigned char*)shm_raw;
    cg::grid_group grid = cg::this_grid();
    const int G = gridDim.x, wg = blockIdx.x;
    unsigned char* ws = p.ws;
    float* H = (float*)(ws + OFF_H); bf16_t* HN = (bf16_t*)(ws + OFF_HN); bf16_t* WIN = (bf16_t*)(ws + OFF_WIN);
    const float* MODall = (const float*)(ws + OFF_MOD);

    volatile LAS unsigned* xbst = (volatile LAS unsigned*)(lds + 131072);
    if (threadIdx.x == 0) { xbst[0] = 0u; xbst[1] = 0u; xbst[2] = 0u; xbst[3] = 0u; }
    __syncthreads();
    const XcdBarrier xb = xcd_barrier_post((unsigned*)(ws + OFF_BAR), xbst);
    phase_mod(p, lds);
    if (gridDim.x == 0x7fffffffu) grid.sync();
    xcd_barrier(xb);
    for (int l = 0; l < DEPTH; ++l) {
        const float* MOD = MODall + (size_t)l * 2 * 6144;
        const bool lastl = (l == DEPTH - 1);
        const int Mg = lastl ? NLAT : L, pm0 = lastl ? 1 : 0;
        if (l == 0) phase_norm<true>(p, l, p.in[I_N1G] + l * 1024, 0, 1); else phase_norm<false>(p, l, p.in[I_N1G] + l * 1024, 0, 1);
        {
            const float* win = p.in[I_WIN] + (size_t)l * 1024 * IN_COLS;
            convert_T(win, IN_COLS, 1024, 0, 1920, WIN, (LAS float*)lds, wg, G);
            convert_T(win, IN_COLS, 1024, 1920, 3632, WIN + (size_t)2048 * 1024, (LAS float*)lds, (wg + 64) % G, G);
            convert_T(win, IN_COLS, 1024, 5552, 3072, WIN + (size_t)NMAIN * 1024, (LAS float*)lds, (wg + 128) % G, G);
            build_wl(p, l, wg, G);
        }
        xcd_barrier(xb);
        {
            pg8::Gemm g{HN, WIN, L, NMAIN, 1024, 16}; pg8::StaticOrder S; S.init(L, NMAIN, G, wg);
            EpiInMain E{(bf16_t*)(ws + OFF_R), (bf16_t*)(ws + OFF_PG)};
            pg8::gemm_phase(lds, g, S, E);
        }
        xcd_barrier(xb);
#ifndef NO_PREP
        phase_prep(p, l, lds);
        xcd_barrier(xb);
        {
            pg8::Gemm g{(const bf16_t*)(ws + OFF_XL), (const bf16_t*)(ws + OFF_WL), L, 2560, 384, osgpr(6)}; pg8::StaticOrder S; S.init(L, 2560, G, wg);
            EpiLora E{(bf16_t*)(ws + OFF_B), (bf16_t*)(ws + OFF_RWG), p.in[I_RWW0] + (size_t)l * 1024, p.in[I_RWA0] + (size_t)l * 1024};
            pg8::gemm_phase(lds, g, S, E);
        }
#endif
        xcd_barrier(xb);
#ifndef NO_SCAN
        if (wg < 64) scan_rwkv(p, l, wg, lds);
        else if (wg < 96) scan_gla(p, l, wg - 64, lds);
        else if (wg < 224) scan_gdn(p, l, wg - 96, lds);
#endif
        xcd_barrier(xb);
#ifndef NO_POST
        phase_post(p, l, lds);
#endif
        xcd_barrier(xb);
        {
            convert_T(p.in[I_WBR] + (size_t)l * 3 * 512 * 1024, 1024, 512, 0, 1024, (bf16_t*)(ws + OFF_WBR), (LAS float*)lds, wg, G);
            convert_T(p.in[I_WBR] + (size_t)l * 3 * 512 * 1024 + (size_t)512 * 1024, 1024, 512, 0, 1024, (bf16_t*)(ws + OFF_WBR) + (size_t)1024 * 512, (LAS float*)lds, (wg + 128) % G, G);
            convert_T(p.in[I_WBR] + (size_t)l * 3 * 512 * 1024 + (size_t)2 * 512 * 1024, 1024, 512, 0, 1024, (bf16_t*)(ws + OFF_WBR) + (size_t)2 * 1024 * 512, (LAS float*)lds, wg, G);
            convert_T(p.in[I_WOUT] + (size_t)l * 1024 * 1024, 1024, 1024, 0, 1024, (bf16_t*)(ws + OFF_WOUT), (LAS float*)lds, wg, G);
            convert_T(p.in[I_W1] + (size_t)l * 1024 * 4096, 4096, 1024, 0, 4096, (bf16_t*)(ws + OFF_W1), (LAS float*)lds, wg, G);
            convert_T(p.in[I_W2] + (size_t)l * 4096 * 1024, 1024, 4096, 0, 1024, (bf16_t*)(ws + OFF_W2), (LAS float*)lds, wg, G);
            pg8::Gemm g{HN, WIN + (size_t)NMAIN * 1024, L, 3072, 1024, 16}; pg8::StaticOrder S; S.init(Mg, 3072, G, wg, pm0);
            EpiGates E{(bf16_t*)(ws + OFF_B)};
            pg8::gemm_phase(lds, g, S, E);
        }
        xcd_barrier(xb);
        {
            const bf16_t* YC = (const bf16_t*)(ws + OFF_GDNC); const bf16_t* WBR = (const bf16_t*)(ws + OFF_WBR);
            pg8::StaticOrder S; S.init(Mg, 1024, G, wg, pm0);
            { pg8::Gemm g{YC, WBR, L, 1024, 512, 8}; EpiBranch<0> E{(const bf16_t*)(ws + OFF_B), (float*)(ws + OFF_PG), HN}; pg8::gemm_phase(lds, g, S, E); }
            { pg8::Gemm g{YC + (size_t)L * 512, WBR + (size_t)1024 * 512, L, 1024, 512, 8}; EpiBranch<1> E{(const bf16_t*)(ws + OFF_B), (float*)(ws + OFF_PG), HN}; pg8::gemm_phase(lds, g, S, E); }
            { pg8::Gemm g{YC + (size_t)2 * L * 512, WBR + (size_t)2 * 1024 * 512, L, 1024, 512, 8}; EpiBranch<2> E{(const bf16_t*)(ws + OFF_B), (float*)(ws + OFF_PG), HN}; pg8::gemm_phase(lds, g, S, E); }
        }
        xcd_barrier(xb);
        {
            pg8::Gemm g{HN, (const bf16_t*)(ws + OFF_WOUT), L, 1024, 1024, 16}; pg8::StaticOrder S; S.init(Mg, 1024, G, wg, pm0);
            EpiResid E{H, MOD + 2 * 1024, MOD + 6144 + 2 * 1024};
            pg8::gemm_phase(lds, g, S, E);
        }
        xcd_barrier(xb);
        phase_norm<false>(p, l, p.in[I_N2G] + l * 1024, 3, 4);
        xcd_barrier(xb);
        {
            pg8::Gemm g{HN, (const bf16_t*)(ws + OFF_W1), L, 4096, 1024, 16}; pg8::StaticOrder S; S.init(Mg, 4096, G, wg, pm0);
            EpiMlp1 E{(bf16_t*)(ws + OFF_B)};
            pg8::gemm_phase(lds, g, S, E);
        }
        xcd_barrier(xb);
        {
            pg8::Gemm g{(const bf16_t*)(ws + OFF_B), (const bf16_t*)(ws + OFF_W2), L, 1024, 4096, 64}; pg8::StaticOrder S; S.init(Mg, 1024, G, wg, pm0);
            EpiResid E{H, MOD + 5 * 1024, MOD + 6144 + 5 * 1024};
            pg8::gemm_phase(lds, g, S, E);
        }
        xcd_barrier(xb);
    }
    phase_final(p);
}

extern "C" void kernel_launch(void* const* d_in, const int* in_sizes, int n_in, void* d_out, int out_size, void* d_ws, size_t ws_size, hipStream_t stream) {
    static int grid_blocks = 0;
    if (n_in != 32 || ws_size < WS_END || out_size != NLAT * DM) {
        fprintf(stderr, "kernel_launch: unexpected shapes / workspace (n_in %d, ws %zu need %zu, out %d)\n", n_in, ws_size, (size_t)WS_END, out_size);
        hipMemsetAsync(d_out, 0xFF, (size_t)out_size * 4, stream);
        return;
    }
    if (!grid_blocks) {
        int dev = 0, cus = 0, per_cu = 0;
        hipGetDevice(&dev);
        hipDeviceGetAttribute(&cus, hipDeviceAttributeMultiprocessorCount, dev);
        hipFuncSetAttribute((const void*)fwd_megakernel, hipFuncAttributeMaxDynamicSharedMemorySize, LDS_BYTES);
        hipOccupancyMaxActiveBlocksPerMultiprocessor(&per_cu, (const void*)fwd_megakernel, 512, LDS_BYTES);
        if (per_cu < 1) per_cu = 1;
        grid_blocks = cus * 1;
        (void)hipGetLastError();
    }
    P p{};
    for (int i = 0; i < 32; ++i) p.in[i] = (const float*)d_in[i];
    p.out = (float*)d_out; p.ws = (unsigned char*)d_ws;
    (void)hipMemsetAsync((unsigned char*)d_ws + OFF_BAR, 0, 16384, stream);
    void* args[] = {&p};
    hipError_t e = hipLaunchCooperativeKernel((const void*)fwd_megakernel, dim3(grid_blocks), dim3(512), args, LDS_BYTES, stream);
    if (e != hipSuccess) fprintf(stderr, "cooperative launch failed: %s (grid %d)\n", hipGetErrorString(e), grid_blocks);
}
```
